# Optimizing an MI355X kernel written in HIP

```python
import jax, jax.numpy as jnp
from jax import lax
import numpy as np

D_MODEL = 1024
BATCH = 2
SEQ = 8192
DEPTH = 2

GRID_W = 64
CTX_LEN = 256
HEAD_DIM = D_MODEL // 16
N_ATT_HEADS = 6
N_ATT_KV = 2
N_NA_HEADS = 4
N_RET_HEADS = 6
ATT_Q = N_ATT_HEADS * HEAD_DIM
ATT_KV = N_ATT_KV * HEAD_DIM
NA_W = N_NA_HEADS * HEAD_DIM
RET_W = N_RET_HEADS * HEAD_DIM
MIX_W = ATT_Q + NA_W + RET_W
IN_COLS = ATT_Q + 2 * ATT_KV + 3 * NA_W + 4 * RET_W
Q_BLOCK = 128
NA_WIN_ROWS = 8
NA_WIN_COLS = 16
RET_CHUNK = 128
ROPE_THETA = 10000.0
N_EXPERTS = 16
N_EXPERT_GROUPS = 4
TOP_GROUPS = 1
TOP_K = 2
D_EXPERT = 512
EPS = 1e-6
NEG_INF = -1e30

kernel_name = 'hybrid_diffusion_trunk'


def _rms(x, g):
    xf = x.astype(jnp.float32)
    y = xf * lax.rsqrt(jnp.mean(xf * xf, axis=-1, keepdims=True) + EPS)
    return (y * g.astype(jnp.float32)).astype(x.dtype)


def _heads(t, n_heads):
    b, n, _ = t.shape
    return t.reshape(b, n, n_heads, HEAD_DIM).transpose(0, 2, 1, 3)


def _flat(o):
    b, h, n, d = o.shape
    return o.transpose(0, 2, 1, 3).reshape(b, n, h * d)


def _head_norm(y, g):
    b, n, w = y.shape
    hh = w // HEAD_DIM
    return _rms(y.reshape(b, n, hh, HEAD_DIM), g.reshape(hh, HEAD_DIM)).reshape(b, n, w)


def _axial_angles(n):
    t = jnp.arange(n, dtype=jnp.int32)
    row = (t // GRID_W).astype(jnp.float32)
    col = (t % GRID_W).astype(jnp.float32)
    nf = HEAD_DIM // 4
    inv = ROPE_THETA ** (-jnp.arange(nf, dtype=jnp.float32) / nf)
    return row[:, None] * inv[None, :], col[:, None] * inv[None, :]


def _rope_1d(t, ang):
    nf = ang.shape[-1]
    cos = jnp.cos(ang).astype(t.dtype)
    sin = jnp.sin(ang).astype(t.dtype)
    t1, t2 = t[..., :nf], t[..., nf:]
    return jnp.concatenate([t1 * cos - t2 * sin, t2 * cos + t1 * sin], axis=-1)


def _rope_2d(t, ang_r, ang_c):
    half = HEAD_DIM // 2
    return jnp.concatenate([_rope_1d(t[..., :half], ang_r), _rope_1d(t[..., half:], ang_c)], axis=-1)


def _project(h, w_in):
    z = h @ w_in
    widths = (ATT_Q, ATT_KV, ATT_KV, NA_W, NA_W, NA_W, RET_W, RET_W, RET_W)
    counts = (N_ATT_HEADS, N_ATT_KV, N_ATT_KV, N_NA_HEADS, N_NA_HEADS, N_NA_HEADS,
              N_RET_HEADS, N_RET_HEADS, N_RET_HEADS)
    cuts = [int(v) for v in np.cumsum(widths)]
    parts = jnp.split(z, cuts, axis=-1)
    return tuple(_heads(p, hc) for p, hc in zip(parts[:-1], counts)) + (parts[-1],)


def _gqa(q, k, v, qc, kc, vc, q_g, k_g, ang_r, ang_c, with_ctx_out):
    b, hq, n, d = q.shape
    grp = hq // N_ATT_KV
    scale = d ** -0.5
    q = _rope_2d(_rms(q, q_g), ang_r, ang_c)
    k = _rope_2d(_rms(k, k_g), ang_r, ang_c)
    kc = _rms(kc, k_g)
    k_all = jnp.concatenate([k, kc], axis=2)
    v_all = jnp.concatenate([v, vc], axis=2)
    nblk = n // Q_BLOCK
    qb = q.reshape(b, N_ATT_KV, grp, nblk, Q_BLOCK, d).transpose(3, 0, 1, 2, 4, 5)

    def block(qi):
        s = jnp.einsum('bhgqd,bhkd->bhgqk', qi, k_all).astype(jnp.float32) * scale
        p = jax.nn.softmax(s, axis=-1).astype(v_all.dtype)
        return jnp.einsum('bhgqk,bhkd->bhgqd', p, v_all)

    o = lax.map(block, qb).transpose(1, 2, 3, 0, 4, 5).reshape(b, hq, n, d)
    if not with_ctx_out:
        return o, None
    cl = qc.shape[2]
    qcn = _rms(qc, q_g).reshape(b, N_ATT_KV, grp, cl, d)
    s = jnp.einsum('bhgqd,bhkd->bhgqk', qcn, kc).astype(jnp.float32) * scale
    p = jax.nn.softmax(s, axis=-1).astype(vc.dtype)
    oc = jnp.einsum('bhgqk,bhkd->bhgqd', p, vc).reshape(b, hq, cl, d)
    return o, oc


def _neigh_attn(q, k, v, qc, kc, vc, rpb, with_ctx_out):
    b, h, n, d = q.shape
    rows = n // GRID_W
    wr = min(NA_WIN_ROWS, rows)
    wc = NA_WIN_COLS
    nkeys = wr * GRID_W
    scale = d ** -0.5
    r = jnp.arange(rows)
    ridx = jnp.clip(r - wr // 2, 0, rows - wr)[:, None] + jnp.arange(wr)[None, :]
    col = jnp.arange(GRID_W)
    cstart = jnp.clip(col - wc // 2, 0, GRID_W - wc)
    col_ok = (col[None, :] >= cstart[:, None]) & (col[None, :] < cstart[:, None] + wc)
    mask = jnp.tile(col_ok, (1, wr))
    dr = ridx - r[:, None] + (NA_WIN_ROWS - 1)
    dc = jnp.clip(col[None, :] - col[:, None] + (wc - 1), 0, 2 * wc - 2)
    bias = rpb[:, dr][..., dc].transpose(0, 1, 3, 2, 4).reshape(h, rows, GRID_W, nkeys)

    def grid(t):
        return t.reshape(b, h, rows, GRID_W, d)

    kg = jnp.take(grid(k), ridx, axis=2).reshape(b, h, rows, nkeys, d)
    vg = jnp.take(grid(v), ridx, axis=2).reshape(b, h, rows, nkeys, d)
    qr = grid(q) * scale
    s_nb = jnp.einsum('bhrqd,bhrkd->bhrqk', qr, kg).astype(jnp.float32) + bias.astype(jnp.float32)[None]
    s_nb = jnp.where(mask[None, None, None], s_nb, NEG_INF)
    s_cx = jnp.einsum('bhrqd,bhkd->bhrqk', qr, kc).astype(jnp.float32)
    p = jax.nn.softmax(jnp.concatenate([s_nb, s_cx], axis=-1), axis=-1).astype(v.dtype)
    o = (jnp.einsum('bhrqk,bhrkd->bhrqd', p[..., :nkeys], vg)
         + jnp.einsum('bhrqk,bhkd->bhrqd', p[..., nkeys:], vc)).reshape(b, h, n, d)
    if not with_ctx_out:
        return o, None
    sc = jnp.einsum('bhqd,bhkd->bhqk', qc * scale, kc).astype(jnp.float32)
    pc = jax.nn.softmax(sc, axis=-1).astype(vc.dtype)
    return o, jnp.einsum('bhqk,bhkd->bhqd', pc, vc)


def _ret_chunk_states(k, v, log_g, s0):
    b, h, L, d = k.shape
    nc = L // RET_CHUNK
    kc = k.reshape(b, h, nc, RET_CHUNK, d)
    vc = v.reshape(b, h, nc, RET_CHUNK, d)
    pos = jnp.arange(RET_CHUNK, dtype=jnp.float32)
    zeta = jnp.exp(log_g[:, None] * (RET_CHUNK - 1.0 - pos)[None, :])
    u = jnp.einsum('bhnjd,bhnje->nbhde', kc * zeta[None, :, None, :, None], vc)
    decay = jnp.exp(log_g * RET_CHUNK)[None, :, None, None]

    def step(s, u_n):
        return decay * s + u_n, s

    s_fin, s_before = lax.scan(step, s0, u)
    return s_before, s_fin


def _ret_chunk_out(q, k, v, log_g, s_before):
    b, h, L, d = q.shape
    nc = L // RET_CHUNK
    qc = q.reshape(b, h, nc, RET_CHUNK, d)
    kc = k.reshape(b, h, nc, RET_CHUNK, d)
    vc = v.reshape(b, h, nc, RET_CHUNK, d)
    pos = jnp.arange(RET_CHUNK, dtype=jnp.float32)
    diff = pos[:, None] - pos[None, :]
    dmat = jnp.where(diff >= 0, jnp.exp(log_g[:, None, None] * jnp.maximum(diff, 0.0)[None]), 0.0)
    scores = jnp.einsum('bhnid,bhnjd->bhnij', qc, kc) * dmat[None, :, None]
    inner = jnp.einsum('bhnij,bhnjd->bhnid', scores, vc)
    xi = jnp.exp(log_g[:, None] * (pos + 1.0)[None, :])
    cross = jnp.einsum('bhnid,nbhde->bhnie', qc * xi[None, :, None, :, None], s_before)
    return (inner + cross).reshape(b, h, L, d)


def _retention(q, k, v, qc, kc, vc, log_g2, with_ctx_out):
    dt = q.dtype
    ks = HEAD_DIM ** -0.5
    f32 = lambda t: t.astype(jnp.float32)
    ql, kl, vl = f32(q), f32(k) * ks, f32(v)
    qx, kx, vx = f32(qc), f32(kc) * ks, f32(vc)
    b, h, _, d = ql.shape
    s0 = jnp.zeros((b, h, d, d), jnp.float32)

    def one_direction(ql, kl, vl, qx, kx, vx, lg):
        sb_c, sf_c = _ret_chunk_states(kx, vx, lg, s0)
        ol = _ret_chunk_out(ql, kl, vl, lg, _ret_chunk_states(kl, vl, lg, sf_c)[0])
        oc = _ret_chunk_out(qx, kx, vx, lg, sb_c) if with_ctx_out else None
        return ol, oc

    flip = lambda t: t[:, :, ::-1]
    ol_f, oc_f = one_direction(ql, kl, vl, qx, kx, vx, log_g2[0])
    ol_b, oc_b = one_direction(*map(flip, (ql, kl, vl, qx, kx, vx)), log_g2[1])
    out_lat = (ol_f + flip(ol_b)).astype(dt)
    out_ctx = (oc_f + flip(oc_b)).astype(dt) if with_ctx_out else None
    return out_lat, out_ctx


def _merge(o_a, o_n, o_r, g_r, mix_g, w_out):
    ga, gn, gr = jnp.split(mix_g, [ATT_Q, ATT_Q + NA_W])
    y = jnp.concatenate([_head_norm(_flat(o_a), ga),
                         _head_norm(_flat(o_n), gn),
                         _head_norm(_flat(o_r), gr) * jax.nn.silu(g_r)], axis=-1)
    return y @ w_out


def _moe(h, w_router, b_router, w1, w3, w2):
    per = N_EXPERTS // N_EXPERT_GROUPS
    logits = jnp.einsum('btd,de->bte', h, w_router).astype(jnp.float32) + b_router.astype(jnp.float32)
    probs = jax.nn.softmax(logits, axis=-1)
    pg = probs.reshape(probs.shape[:-1] + (N_EXPERT_GROUPS, per))
    gscore = lax.top_k(pg, TOP_K)[0].sum(-1)
    gsel = jax.nn.one_hot(lax.top_k(gscore, TOP_GROUPS)[1], N_EXPERT_GROUPS, dtype=jnp.float32).sum(-2)
    cand = (pg * gsel[..., None]).reshape(probs.shape)
    w, idx = lax.top_k(cand, TOP_K)
    w = w / w.sum(-1, keepdims=True)
    gates = (jax.nn.one_hot(idx, N_EXPERTS, dtype=jnp.float32) * w[..., None]).sum(-2).astype(h.dtype)
    out = jnp.zeros_like(h)
    for e in range(N_EXPERTS):
        act = jax.nn.silu(h @ w1[e]) * (h @ w3[e])
        out = out + gates[..., e:e + 1] * (act @ w2[e])
    return out


def _layer(x, xc, mod, mod_c, n1_g, n2_g, w_in, q_g, k_g, rpb, log_g2, mix_g, w_out,
           w_router, b_router, w1, w3, w2, ang_r, ang_c, last):
    sh1, sc1, gt1, sh2, sc2, gt2 = jnp.split(mod[:, None, :], 6, axis=-1)
    csh1, csc1, cgt1, csh2, csc2, cgt2 = jnp.split(mod_c, 6, axis=-1)
    want_ctx = not last
    h = _rms(x, n1_g) * (1 + sc1) + sh1
    hc = _rms(xc, n1_g) * (1 + csc1) + csh1
    aq, ak, av, nq, nk, nv, rq, rk, rv, rg = _project(h, w_in)
    caq, cak, cav, cnq, cnk, cnv, crq, crk, crv, crg = _project(hc, w_in)
    o_a, oc_a = _gqa(aq, ak, av, caq, cak, cav, q_g, k_g, ang_r, ang_c, want_ctx)
    o_n, oc_n = _neigh_attn(nq, nk, nv, cnq, cnk, cnv, rpb, want_ctx)
    o_r, oc_r = _retention(rq, rk, rv, crq, crk, crv, log_g2, want_ctx)
    x = x + gt1 * _merge(o_a, o_n, o_r, rg, mix_g, w_out)
    h2 = _rms(x, n2_g) * (1 + sc2) + sh2
    if last:
        return x + gt2 * _moe(h2, w_router, b_router, w1, w3, w2), None
    xc = xc + cgt1 * _merge(oc_a, oc_n, oc_r, crg, mix_g, w_out)
    h2c = _rms(xc, n2_g) * (1 + csc2) + csh2
    n = x.shape[1]
    m = _moe(jnp.concatenate([h2, h2c], axis=1), w_router, b_router, w1, w3, w2)
    return x + gt2 * m[:, :n], xc + cgt2 * m[:, n:]


def setup_inputs(seed: int = 0) -> dict:
    key = jax.random.key(seed)
    ks = jax.random.split(key, 21)
    nrm = jax.random.normal
    f = jnp.float32
    sd = D_MODEL ** -0.5
    decay_init = jnp.log(2.0 ** (5.0 + jnp.arange(N_RET_HEADS, dtype=f)) - 1.0)
    return {
        'x': nrm(ks[0], (BATCH, SEQ, D_MODEL), f),
        'c': nrm(ks[1], (BATCH, D_MODEL), f),
        'ctx': nrm(ks[2], (BATCH, CTX_LEN, D_MODEL), f),
        'c_ctx': nrm(ks[3], (D_MODEL,), f),
        'w_ada': nrm(ks[4], (DEPTH, D_MODEL, 6 * D_MODEL), f) * (0.5 * sd),
        'b_ada': 0.02 * nrm(ks[5], (DEPTH, 6 * D_MODEL), f),
        'norm1_g': 1.0 + 0.02 * nrm(ks[6], (DEPTH, D_MODEL), f),
        'norm2_g': 1.0 + 0.02 * nrm(ks[7], (DEPTH, D_MODEL), f),
        'w_in': nrm(ks[8], (DEPTH, D_MODEL, IN_COLS), f) * sd,
        'q_norm_g': 1.0 + 0.02 * nrm(ks[9], (DEPTH, HEAD_DIM), f),
        'k_norm_g': 1.0 + 0.02 * nrm(ks[10], (DEPTH, HEAD_DIM), f),
        'na_rpb': 0.1 * nrm(ks[11], (DEPTH, N_NA_HEADS, 2 * NA_WIN_ROWS - 1, 2 * NA_WIN_COLS - 1), f),
        'ret_decay': decay_init[None, None, :] + 0.05 * nrm(ks[12], (DEPTH, 2, N_RET_HEADS), f),
        'mix_g': 1.0 + 0.02 * nrm(ks[13], (DEPTH, MIX_W), f),
        'w_out': nrm(ks[14], (DEPTH, MIX_W, D_MODEL), f) * MIX_W ** -0.5,
        'w_router': nrm(ks[15], (D_MODEL, N_EXPERTS), f) * sd,
        'b_router': 0.01 * nrm(ks[16], (N_EXPERTS,), f),
        'w_exp1': nrm(ks[17], (DEPTH, N_EXPERTS, D_MODEL, D_EXPERT), f) * sd,
        'w_exp3': nrm(ks[18], (DEPTH, N_EXPERTS, D_MODEL, D_EXPERT), f) * sd,
        'w_exp2': nrm(ks[19], (DEPTH, N_EXPERTS, D_EXPERT, D_MODEL), f) * D_EXPERT ** -0.5,
        'final_g': 1.0 + 0.02 * nrm(ks[20], (D_MODEL,), f),
    }


def reference(x, c, ctx, c_ctx, w_ada, b_ada, norm1_g, norm2_g, w_in, q_norm_g, k_norm_g,
              na_rpb, ret_decay, mix_g, w_out, w_router, b_router, w_exp1, w_exp3, w_exp2, final_g):
    ang_r, ang_c = _axial_angles(x.shape[1])
    sc = jax.nn.silu(c)
    scc = jax.nn.silu(c_ctx)
    xc = ctx
    for l in range(DEPTH):
        mod = sc @ w_ada[l] + b_ada[l]
        mod_c = scc @ w_ada[l] + b_ada[l]
        log_g2 = jax.nn.log_sigmoid(ret_decay[l].astype(jnp.float32))
        x, xc = _layer(x, xc, mod, mod_c, norm1_g[l], norm2_g[l], w_in[l], q_norm_g[l], k_norm_g[l],
                       na_rpb[l], log_g2, mix_g[l], w_out[l], w_router, b_router,
                       w_exp1[l], w_exp3[l], w_exp2[l], ang_r, ang_c, l == DEPTH - 1)
    return _rms(x, final_g)
```

```cpp
#include <hip/hip_runtime.h>
#define PROBE 0
#define PROBE_NOS 0
#define PROBE_R 0
#include <hip/hip_cooperative_groups.h>
#include <cstdio>
#include <cstdint>
namespace cg = cooperative_groups;

typedef unsigned short bf16;
typedef short bf16x8 __attribute__((ext_vector_type(8)));
typedef short s16x4 __attribute__((ext_vector_type(4)));
typedef float f32x4 __attribute__((ext_vector_type(4)));
typedef float f32x2 __attribute__((ext_vector_type(2)));
typedef unsigned u32x4 __attribute__((ext_vector_type(4)));
typedef unsigned u32x2 __attribute__((ext_vector_type(2)));
typedef __bf16 bf2_t __attribute__((ext_vector_type(2)));
#define LAS __attribute__((address_space(3)))

constexpr int D = 1024, NSEQ = 8192, CL = 256, NT = NSEQ + CL, NLAT = 2 * NSEQ, NROWS = NLAT + 2 * CL;
constexpr int INC = 2944, NSLOT = 46;
constexpr float EPS = 1e-6f;
constexpr float LOG2E = 1.4426950408889634f;
constexpr float QSCALE = 0.125f * LOG2E;
constexpr int S_AQ = 0, S_AK = 6, S_AV = 8, S_NQ = 10, S_NK = 14, S_NV = 18, S_RQ = 22, S_RK = 28, S_RV = 34, S_RG = 40;

constexpr size_t WS_BAR = 0;
constexpr size_t WS_CNT = 16384;
constexpr size_t WS_ZERO_BYTES = 16384 + 4096;
constexpr size_t WS_MOD = WS_ZERO_BYTES;
constexpr size_t WS_BIAS = WS_MOD + 2 * 3 * 6144 * 4;
constexpr size_t WS_ROPE = WS_BIAS + 2 * 3 * 2944 * 4;
constexpr size_t WS_RSS = WS_ROPE + 128 * 16 * 2 * 4;
constexpr size_t WS_WR = WS_RSS + 16896 * 4;
constexpr size_t WS_CR = WS_WR + 2 * 3 * 1024 * 16 * 4;
constexpr size_t WS_GATEW = WS_CR + 4096;
constexpr size_t WS_LIST = WS_GATEW + 16896 * 2 * 4;
constexpr size_t WS_WIN = (WS_LIST + (size_t)2 * 16 * 16896 * 4 + 4095) / 4096 * 4096;
constexpr size_t WS_WO = WS_WIN + (size_t)2 * 2944 * 1024 * 2;
constexpr size_t WS_W13 = WS_WO + (size_t)2 * 1024 * 1024 * 2;
constexpr size_t WS_W2 = WS_W13 + (size_t)32 * 1024 * 1024 * 2;
constexpr size_t WS_XR = WS_W2 + (size_t)32 * 1024 * 512 * 2;
constexpr size_t WS_R1 = WS_XR + (size_t)NROWS * 1024 * 4;
constexpr size_t WS_Z = WS_R1 + (size_t)NROWS * 1024 * 2;
constexpr size_t WS_END = WS_Z + (size_t)2 * NSLOT * NT * 64 * 2;
constexpr size_t S_OFF = (size_t)34 << 20;
constexpr size_t Z_YM1 = 0, Z_ACT = (size_t)NROWS * 1024 * 2;
static_assert(Z_ACT + (size_t)(2 * NROWS + 128) * 512 * 2 <= (size_t)2 * NSLOT * NT * 64 * 2, "act overlay");
static_assert((size_t)2 * 6 * 2 * 66 * 4096 * 4 <= (size_t)NROWS * 1024 * 2, "U overlay");

struct Params {
  const float *x, *c, *ctx, *c_ctx, *w_ada, *b_ada, *n1g, *n2g, *w_in, *qg, *kg, *rpb, *ret_decay, *mix_g, *w_out, *w_router, *b_router, *w1, *w3, *w2, *final_g;
  float* out; unsigned char* ws;
};

__device__ __forceinline__ unsigned pk2(float lo, float hi) { f32x2 v = {lo, hi}; bf2_t b = __builtin_convertvector(v, bf2_t); return __builtin_bit_cast(unsigned, b); }
__device__ __forceinline__ float bflo(unsigned u) { return __builtin_bit_cast(float, u << 16); }
__device__ __forceinline__ float bfhi(unsigned u) { return __builtin_bit_cast(float, u & 0xffff0000u); }
__device__ __forceinline__ float wsum(float v) {
#pragma unroll
  for (int o = 1; o < 64; o <<= 1) v += __shfl_xor(v, o);
  return v;
}
__device__ __forceinline__ float silu_f(float v) { return v / (1.f + __expf(-v)); }
__device__ __forceinline__ int lds_swz(int row, int chunk) { return row * 128 + ((chunk ^ ((row >> 1) & 7)) << 4); }
#define VM_WAIT() asm volatile("s_waitcnt vmcnt(0)" ::: "memory")
__device__ __forceinline__ int get_tid() { int t = threadIdx.x; asm volatile("" : "+v"(t)); return t; }

template <int R>
__device__ __forceinline__ void stage_rows(unsigned char* lds, int dst, const bf16* src, int ld, int w, int lane) {
#pragma unroll
  for (int i = 0; i < R / 32; ++i) {
    const int q = w + 4 * i, row = q * 8 + (lane >> 3), ch = (lane & 7) ^ ((row >> 1) & 7);
    __builtin_amdgcn_global_load_lds((const void*)(src + (size_t)row * ld + ch * 8), (LAS void*)(lds + dst + q * 1024), 16, 0, 0);
  }
}
__device__ __forceinline__ bf16x8 lds_frag(const unsigned char* lds, int off) { return *(const bf16x8*)(lds + off); }
__device__ __forceinline__ bf16x8 lds_tr2(unsigned char* lds, int off0, int off1) {
  s16x4 a = __builtin_amdgcn_ds_read_tr16_b64_v4i16((LAS s16x4*)(lds + off0));
  s16x4 b = __builtin_amdgcn_ds_read_tr16_b64_v4i16((LAS s16x4*)(lds + off1));
  return __builtin_shufflevector(a, b, 0, 1, 2, 3, 4, 5, 6, 7);
}

template <class ARow, class Epi>
__device__ __forceinline__ void gemm_tile(unsigned char* lds, const ARow& arow, const bf16* __restrict__ Bt, int K, int m0, int n0, const Epi& epi) {
  const int tid = get_tid(), lane = tid & 63, w = __builtin_amdgcn_readfirstlane(tid >> 6);
  const int wr = w >> 1, wc = w & 1, g = lane >> 4, li = lane & 15;
  const bf16* ap[4]; const bf16* bp[4];
#pragma unroll
  for (int i = 0; i < 4; ++i) {
    const int q = w + 4 * i, row = q * 8 + (lane >> 3), ch = (lane & 7) ^ ((row >> 1) & 7);
    ap[i] = arow(row) + ch * 8; bp[i] = Bt + (size_t)(n0 + row) * K + ch * 8;
  }
  f32x4 acc[4][4];
#pragma unroll
  for (int a = 0; a < 4; ++a)
#pragma unroll
    for (int b = 0; b < 4; ++b) acc[a][b] = (f32x4){0.f, 0.f, 0.f, 0.f};
  const int f = (li >> 1) & 7;
  const int xoff = (wr * 64 + li) * 128 + ((g ^ f) << 4);
  const int woff = 16384 + (wc * 64 + li) * 128 + ((g ^ f) << 4);
  const int nk = K >> 6;
#define GT_STAGE(s, k0) do { _Pragma("unroll") for (int i = 0; i < 4; ++i) { const int q = w + 4 * i; \
    __builtin_amdgcn_global_load_lds((const void*)(ap[i] + (k0)), (LAS void*)(lds + (s) * 32768 + q * 1024), 16, 0, 0); \
    __builtin_amdgcn_global_load_lds((const void*)(bp[i] + (k0)), (LAS void*)(lds + (s) * 32768 + 16384 + q * 1024), 16, 0, 0); } } while (0)
  GT_STAGE(0, 0);
  VM_WAIT(); __syncthreads();
  for (int t = 0; t < nk; ++t) {
    const int s = t & 1;
    if (t + 1 < nk) GT_STAGE(s ^ 1, (t + 1) * 64);
    const unsigned char* base = lds + s * 32768;
#pragma unroll
    for (int kk = 0; kk < 2; ++kk) {
      bf16x8 wf[4], xf[4];
#pragma unroll
      for (int nt = 0; nt < 4; ++nt) wf[nt] = lds_frag(base, (woff + nt * 2048) ^ (kk << 6));
#pragma unroll
      for (int mt = 0; mt < 4; ++mt) xf[mt] = lds_frag(base, (xoff + mt * 2048) ^ (kk << 6));
#pragma unroll
      for (int mt = 0; mt < 4; ++mt)
#pragma unroll
        for (int nt = 0; nt < 4; ++nt) acc[mt][nt] = __builtin_amdgcn_mfma_f32_16x16x32_bf16(wf[nt], xf[mt], acc[mt][nt], 0, 0, 0);
    }
    VM_WAIT(); __syncthreads();
  }
#undef GT_STAGE
  epi(acc, m0, n0, wr, wc, g, li);
}

struct ARowLinear { const bf16* A; int K; int m0; __device__ __forceinline__ const bf16* operator()(int r) const { return A + (size_t)(m0 + r) * K; } };

struct EpiInProj {
  const float* rowss; const float* biasp; const float* qg; const float* kg; const float* rope; bf16* Z;
  __device__ __forceinline__ void operator()(f32x4 (&acc)[4][4], int m0, int n0, int wr, int wc, int g, int li) const {
    int b, seg, tokbase; bool latent;
    if (m0 < NLAT) { b = m0 >> 13; seg = b; tokbase = (m0 & 8191) + wr * 64; latent = true; }
    else { const int mc = m0 - NLAT; b = mc >> 8; seg = 2; tokbase = NSEQ + (mc & 255) + wr * 64; latent = false; }
    const int ncol0 = n0 + wc * 64, s = ncol0 >> 6;
    bf16* zb = Z + ((size_t)(b * NSLOT + s) * NT) * 64;
    f32x4 bv[4];
#pragma unroll
    for (int nt = 0; nt < 4; ++nt) bv[nt] = *(const f32x4*)(biasp + seg * INC + ncol0 + nt * 16 + 4 * g);
#pragma unroll
    for (int mt = 0; mt < 4; ++mt) {
      const int m = m0 + wr * 64 + mt * 16 + li, tok = tokbase + mt * 16 + li;
      const float irms = rsqrtf(rowss[m] * (1.f / 1024.f) + EPS);
      f32x4 v[4];
#pragma unroll
      for (int nt = 0; nt < 4; ++nt) v[nt] = acc[mt][nt] * irms + bv[nt];
      if (s < 8) {
        float ss = 0.f;
#pragma unroll
        for (int nt = 0; nt < 4; ++nt) ss += v[nt][0] * v[nt][0] + v[nt][1] * v[nt][1] + v[nt][2] * v[nt][2] + v[nt][3] * v[nt][3];
        ss += __shfl_xor(ss, 16); ss += __shfl_xor(ss, 32);
        const float r = rsqrtf(ss * (1.f / 64.f) + EPS);
        const float* gn = (s < 6) ? qg : kg;
#pragma unroll
        for (int nt = 0; nt < 4; ++nt) { const f32x4 gv = *(const f32x4*)(gn + nt * 16 + 4 * g); v[nt] = v[nt] * r * gv; }
        if (latent) {
          const int pr = tok >> 6, pc = tok & 63;
          const f32x4 r0 = *(const f32x4*)(rope + (pr * 16 + 4 * g) * 2), r1 = *(const f32x4*)(rope + (pr * 16 + 4 * g) * 2 + 4);
          const f32x4 c0 = *(const f32x4*)(rope + (pc * 16 + 4 * g) * 2), c1 = *(const f32x4*)(rope + (pc * 16 + 4 * g) * 2 + 4);
          const float cr_[4] = {r0[0], r0[2], r1[0], r1[2]}, sr_[4] = {r0[1], r0[3], r1[1], r1[3]};
          const float cc_[4] = {c0[0], c0[2], c1[0], c1[2]}, sc_[4] = {c0[1], c0[3], c1[1], c1[3]};
#pragma unroll
          for (int j = 0; j < 4; ++j) {
            const float t1 = v[0][j], t2 = v[1][j]; v[0][j] = t1 * cr_[j] - t2 * sr_[j]; v[1][j] = t2 * cr_[j] + t1 * sr_[j];
            const float u1 = v[2][j], u2 = v[3][j]; v[2][j] = u1 * cc_[j] - u2 * sc_[j]; v[3][j] = u2 * cc_[j] + u1 * sc_[j];
          }
        }
        if (s < 6) {
#pragma unroll
          for (int nt = 0; nt < 4; ++nt) v[nt] = v[nt] * QSCALE;
        }
      } else if (s >= S_NQ && s < S_NK) {
#pragma unroll
        for (int nt = 0; nt < 4; ++nt) v[nt] = v[nt] * QSCALE;
      } else if (s >= S_RK && s < S_RV) {
#pragma unroll
        for (int nt = 0; nt < 4; ++nt) v[nt] = v[nt] * 0.125f;
      } else if (s >= S_RG) {
#pragma unroll
        for (int nt = 0; nt < 4; ++nt)
#pragma unroll
          for (int j = 0; j < 4; ++j) v[nt][j] = silu_f(v[nt][j]);
      }
#pragma unroll
      for (int nt = 0; nt < 4; ++nt) { u32x2 o; o.x = pk2(v[nt][0], v[nt][1]); o.y = pk2(v[nt][2], v[nt][3]); *(u32x2*)(zb + (size_t)tok * 64 + nt * 16 + 4 * g) = o; }
    }
  }
};

struct EpiOutProj {
  const float* xlat; const float* xctx; const float* mod; float* XR;
  __device__ __forceinline__ void operator()(f32x4 (&acc)[4][4], int m0, int n0, int wr, int wc, int g, int li) const {
    const int seg = (m0 < NLAT) ? (m0 >> 13) : 2;
    const float* gt = mod + seg * 6144 + 2048;
#pragma unroll
    for (int mt = 0; mt < 4; ++mt) {
      const int m = m0 + wr * 64 + mt * 16 + li;
      const float* xr = (m < NLAT) ? (xlat + (size_t)m * D) : (xctx + (size_t)(m - NLAT) * D);
#pragma unroll
      for (int nt = 0; nt < 4; ++nt) {
        const int n = n0 + wc * 64 + nt * 16 + 4 * g;
        const f32x4 xv = *(const f32x4*)(xr + n), gv = *(const f32x4*)(gt + n);
        *(f32x4*)(XR + (size_t)m * D + n) = xv + gv * acc[mt][nt];
      }
    }
  }
};

struct EpiMoeUp {
  bf16* act; int slot0; int nvalid;
  __device__ __forceinline__ void operator()(f32x4 (&acc)[4][4], int m0, int n0, int wr, int wc, int g, int li) const {
#pragma unroll
    for (int mt = 0; mt < 4; ++mt) {
      const int r = wr * 64 + mt * 16 + li;
      if (r < nvalid) {
#pragma unroll
        for (int u = 0; u < 2; ++u) {
          const int hid = ((n0 + wc * 64) >> 1) + u * 16 + 4 * g;
          const f32x4 a1 = acc[mt][2 * u], a3 = acc[mt][2 * u + 1];
          u32x2 o; o.x = pk2(silu_f(a1[0]) * a3[0], silu_f(a1[1]) * a3[1]); o.y = pk2(silu_f(a1[2]) * a3[2], silu_f(a1[3]) * a3[3]);
          *(u32x2*)(act + (size_t)(slot0 + r) * 512 + hid) = o;
        }
      }
    }
  }
};

struct EpiMoeDown {
  const int* list; const float* gatew; bf16* ym0; bf16* ym1; int nvalid;
  __device__ __forceinline__ void operator()(f32x4 (&acc)[4][4], int m0, int n0, int wr, int wc, int g, int li) const {
#pragma unroll
    for (int mt = 0; mt < 4; ++mt) {
      const int r = wr * 64 + mt * 16 + li;
      if (r < nvalid) {
        const int ent = list[r]; const float gw = gatew[ent];
        bf16* y = ((ent & 1) ? ym1 : ym0) + (size_t)(ent >> 1) * D;
#pragma unroll
        for (int nt = 0; nt < 4; ++nt) {
          const int n = n0 + wc * 64 + nt * 16 + 4 * g;
          u32x2 o; o.x = pk2(acc[mt][nt][0] * gw, acc[mt][nt][1] * gw); o.y = pk2(acc[mt][nt][2] * gw, acc[mt][nt][3] * gw);
          *(u32x2*)(y + n) = o;
        }
      }
    }
  }
};

struct ARowGather { const bf16* H; const int* list; int nvalid; __device__ __forceinline__ const bf16* operator()(int r) const { const int rr = r < nvalid ? r : nvalid - 1; return H + (size_t)(list[rr] >> 1) * D; } };
struct ARowAct { const bf16* act; int slot0; __device__ __forceinline__ const bf16* operator()(int r) const { int s = slot0 + r; s = s < 2 * NROWS ? s : 2 * NROWS - 1; return act + (size_t)s * 512; } };

template <int NQB, bool NAM>
__device__ __forceinline__ void attn_item(unsigned char* lds, const bf16* zb, int sq0, int sk, int sv, int qtok0, int lat0, int nlat, int ntiles,
                                          int drbase, bf16* Y, size_t yrow0, int ycol0, const float* mixg) {
  const int tid = get_tid(), lane = tid & 63, w = __builtin_amdgcn_readfirstlane(tid >> 6), g = lane >> 4, li = lane & 15;
  const int qtok = qtok0 + 16 * w + li;
  bf16x8 qf[NQB][2];
#pragma unroll
  for (int qb = 0; qb < NQB; ++qb)
#pragma unroll
    for (int kk = 0; kk < 2; ++kk) qf[qb][kk] = *(const bf16x8*)(zb + ((size_t)(sq0 + qb) * NT + qtok) * 64 + kk * 32 + g * 8);
  const bf16* kbp = zb + (size_t)sk * NT * 64;
  const bf16* vbp = zb + (size_t)sv * NT * 64;
  f32x4 O[4][NQB]; float lsum[NQB];
#pragma unroll
  for (int qb = 0; qb < NQB; ++qb) { lsum[qb] = 0.f;
#pragma unroll
    for (int db = 0; db < 4; ++db) O[db][qb] = (f32x4){0.f, 0.f, 0.f, 0.f}; }
  const int f = (li >> 1) & 7;
  const int koff = li * 128 + ((g ^ f) << 4);
  const int q_ = li >> 2, p_ = li & 3, fv = (2 * g + (q_ >> 1)) & 7;
  const int voff = (4 * g + q_) * 128 + (p_ & 1) * 8;
  const float* rpbt = (const float*)(lds + 32768);
  const int qc = 16 * w + li;
  int cs = qc - 8; cs = cs < 0 ? 0 : (cs > 48 ? 48 : cs);
#define AT_TOK(t) ((t) < nlat ? lat0 + 64 * (t) : NSEQ + 64 * ((t) - nlat))
  { const int tk = AT_TOK(0); stage_rows<64>(lds, 0, kbp + (size_t)tk * 64, 64, w, lane); stage_rows<64>(lds, 8192, vbp + (size_t)tk * 64, 64, w, lane); }
  VM_WAIT(); __syncthreads();
  for (int t = 0; t < ntiles; ++t) {
    const int kb_off = (t & 1) * 16384, vb_off = kb_off + 8192;
    if (t + 1 < ntiles) { const int tk = AT_TOK(t + 1); stage_rows<64>(lds, kb_off ^ 16384, kbp + (size_t)tk * 64, 64, w, lane); stage_rows<64>(lds, (kb_off ^ 16384) + 8192, vbp + (size_t)tk * 64, 64, w, lane); }
#pragma unroll
    for (int ks = 0; ks < 2; ++ks) {
      f32x4 s[2][NQB];
#pragma unroll
      for (int h2 = 0; h2 < 2; ++h2) {
#pragma unroll
        for (int qb = 0; qb < NQB; ++qb) s[h2][qb] = (f32x4){0.f, 0.f, 0.f, 0.f};
#pragma unroll
        for (int kk = 0; kk < 2; ++kk) {
          const bf16x8 kf = lds_frag(lds, kb_off + (((2 * ks + h2) * 2048 + koff) ^ (kk << 6)));
#pragma unroll
          for (int qb = 0; qb < NQB; ++qb) s[h2][qb] = __builtin_amdgcn_mfma_f32_16x16x32_bf16(kf, qf[qb][kk], s[h2][qb], 0, 0, 0);
        }
      }
      bf16x8 pf[NQB];
#pragma unroll
      for (int qb = 0; qb < NQB; ++qb) {
        float p[8];
#pragma unroll
        for (int h2 = 0; h2 < 2; ++h2)
#pragma unroll
          for (int j = 0; j < 4; ++j) {
            float x = s[h2][qb][j];
            if (NAM) {
              if (t < nlat) {
                const int kc = (2 * ks + h2) * 16 + 4 * g + j;
                const bool valid = (kc >= cs) && (kc < cs + 16);
                int dc = kc - qc + 15; dc = dc < 0 ? 0 : (dc > 30 ? 30 : dc);
                x += rpbt[(drbase + t) * 31 + dc];
                x = valid ? x : -1e30f;
              }
            }
            const float e = __builtin_amdgcn_exp2f(x);
            p[h2 * 4 + j] = e; lsum[qb] += e;
          }
        u32x4 pw; pw.x = pk2(p[0], p[1]); pw.y = pk2(p[2], p[3]); pw.z = pk2(p[4], p[5]); pw.w = pk2(p[6], p[7]);
        pf[qb] = __builtin_bit_cast(bf16x8, pw);
      }
#pragma unroll
      for (int db = 0; db < 4; ++db) {
        const int a0 = vb_off + ks * 4096 + voff + (((db * 2 + (p_ >> 1)) ^ fv) << 4);
        const bf16x8 vf = lds_tr2(lds, a0, a0 + 2048);
#pragma unroll
        for (int qb = 0; qb < NQB; ++qb) O[db][qb] = __builtin_amdgcn_mfma_f32_16x16x32_bf16(vf, pf[qb], O[db][qb], 0, 0, 0);
      }
    }
    VM_WAIT(); __syncthreads();
  }
#undef AT_TOK
#pragma unroll
  for (int qb = 0; qb < NQB; ++qb) {
    float l = lsum[qb]; l += __shfl_xor(l, 16); l += __shfl_xor(l, 32);
    const float inv = 1.f / l;
    float ss = 0.f;
#pragma unroll
    for (int db = 0; db < 4; ++db) { O[db][qb] = O[db][qb] * inv; ss += O[db][qb][0] * O[db][qb][0] + O[db][qb][1] * O[db][qb][1] + O[db][qb][2] * O[db][qb][2] + O[db][qb][3] * O[db][qb][3]; }
    ss += __shfl_xor(ss, 16); ss += __shfl_xor(ss, 32);
    const float r = rsqrtf(ss * (1.f / 64.f) + EPS);
    bf16* yp = Y + (yrow0 + 16 * w + li) * D + ycol0 + qb * 64;
#pragma unroll
    for (int db = 0; db < 4; ++db) {
      const f32x4 gv = *(const f32x4*)(mixg + ycol0 + qb * 64 + db * 16 + 4 * g);
      const f32x4 y = O[db][qb] * r * gv;
      u32x2 o; o.x = pk2(y[0], y[1]); o.y = pk2(y[2], y[3]);
      *(u32x2*)(yp + db * 16 + 4 * g) = o;
    }
  }
}

__device__ __forceinline__ void ret_u_item(unsigned char* lds, const bf16* zb, int h, int c, float lgf2, float lgb2, float* Uf, float* Ub) {
  const int tid = get_tid(), lane = tid & 63, w = __builtin_amdgcn_readfirstlane(tid >> 6), g = lane >> 4, li = lane & 15;
  const int tok0 = c < 2 ? NSEQ + 128 * c : 128 * (c - 2);
  const bf16* kp = zb + ((size_t)(S_RK + h) * NT + tok0) * 64;
  const bf16* vp = zb + ((size_t)(S_RV + h) * NT + tok0) * 64;
  stage_rows<128>(lds, 0, kp, 64, w, lane);
  {
    const int row = tid >> 1, half = tid & 1;
    const float wf = __builtin_amdgcn_exp2f(lgf2 * (float)(127 - row)), wb = __builtin_amdgcn_exp2f(lgb2 * (float)row);
#pragma unroll
    for (int c4 = 0; c4 < 4; ++c4) {
      const int chunk = half * 4 + c4;
      const u32x4 v = *(const u32x4*)(vp + (size_t)row * 64 + chunk * 8);
      u32x4 of, ob;
#pragma unroll
      for (int i = 0; i < 4; ++i) { const float lo = bflo(v[i]), hi = bfhi(v[i]); of[i] = pk2(lo * wf, hi * wf); ob[i] = pk2(lo * wb, hi * wb); }
      *(u32x4*)(lds + 16384 + lds_swz(row, chunk)) = of;
      *(u32x4*)(lds + 32768 + lds_swz(row, chunk)) = ob;
    }
  }
  VM_WAIT(); __syncthreads();
  const int q_ = li >> 2, p_ = li & 3, fv = (2 * g + (q_ >> 1)) & 7;
  const int toff = (4 * g + q_) * 128 + (p_ & 1) * 8;
  f32x4 acc[2][4];
#pragma unroll
  for (int d_ = 0; d_ < 2; ++d_)
#pragma unroll
    for (int eb = 0; eb < 4; ++eb) acc[d_][eb] = (f32x4){0.f, 0.f, 0.f, 0.f};
#pragma unroll
  for (int ks = 0; ks < 4; ++ks) {
    const int a0 = ks * 4096 + toff + (((w * 2 + (p_ >> 1)) ^ fv) << 4);
    const bf16x8 kf = lds_tr2(lds, a0, a0 + 2048);
#pragma unroll
    for (int eb = 0; eb < 4; ++eb) {
      const int b0 = ks * 4096 + toff + (((eb * 2 + (p_ >> 1)) ^ fv) << 4);
      const bf16x8 vf = lds_tr2(lds, 16384 + b0, 16384 + b0 + 2048);
      const bf16x8 vb = lds_tr2(lds, 32768 + b0, 32768 + b0 + 2048);
      acc[0][eb] = __builtin_amdgcn_mfma_f32_16x16x32_bf16(kf, vf, acc[0][eb], 0, 0, 0);
      acc[1][eb] = __builtin_amdgcn_mfma_f32_16x16x32_bf16(kf, vb, acc[1][eb], 0, 0, 0);
    }
  }
#pragma unroll
  for (int eb = 0; eb < 4; ++eb) {
    *(f32x4*)(Uf + (eb * 16 + li) * 64 + w * 16 + 4 * g) = acc[0][eb];
    *(f32x4*)(Ub + (eb * 16 + li) * 64 + w * 16 + 4 * g) = acc[1][eb];
  }
  __syncthreads();
}

__device__ __forceinline__ void ret_out_item(unsigned char* lds, const bf16* zb, int h, int c, float lgf2, float lgb2, const float* Sf, const float* Sb,
                                             bf16* Y, size_t yrow0, const float* mixg) {
  const int tid = get_tid(), lane = tid & 63, w = __builtin_amdgcn_readfirstlane(tid >> 6), g = lane >> 4, li = lane & 15;
  const int tok0 = c < 2 ? NSEQ + 128 * c : 128 * (c - 2);
  const bf16* qp = zb + ((size_t)(S_RQ + h) * NT + tok0) * 64;
  const bf16* kp = zb + ((size_t)(S_RK + h) * NT + tok0) * 64;
  const bf16* vp = zb + ((size_t)(S_RV + h) * NT + tok0) * 64;
  const bf16* gp = zb + ((size_t)(S_RG + h) * NT + tok0) * 64;
  stage_rows<128>(lds, 0, kp, 64, w, lane);
  stage_rows<128>(lds, 16384, vp, 64, w, lane);
  {
    const int e = tid >> 2, dq = tid & 3;
#pragma unroll
    for (int hh = 0; hh < 2; ++hh) {
      const f32x4 a0 = *(const f32x4*)(Sf + e * 64 + dq * 16 + hh * 8), a1 = *(const f32x4*)(Sf + e * 64 + dq * 16 + hh * 8 + 4);
      const f32x4 b0 = *(const f32x4*)(Sb + e * 64 + dq * 16 + hh * 8), b1 = *(const f32x4*)(Sb + e * 64 + dq * 16 + hh * 8 + 4);
#if PROBE_NOS
      u32x4 oa = {0u,0u,0u,0u}, ob = oa; (void)a0; (void)a1; (void)b0; (void)b1;
#else
      u32x4 oa, ob; oa.x = pk2(a0[0], a0[1]); oa.y = pk2(a0[2], a0[3]); oa.z = pk2(a1[0], a1[1]); oa.w = pk2(a1[2], a1[3]);
      ob.x = pk2(b0[0], b0[1]); ob.y = pk2(b0[2], b0[3]); ob.z = pk2(b1[0], b1[1]); ob.w = pk2(b1[2], b1[3]);
#endif
      *(u32x4*)(lds + 32768 + lds_swz(e, dq * 2 + hh)) = oa;
      *(u32x4*)(lds + 40960 + lds_swz(e, dq * 2 + hh)) = ob;
    }
  }
  bf16x8 qf[2][2];
#pragma unroll
  for (int ib = 0; ib < 2; ++ib)
#pragma unroll
    for (int kk = 0; kk < 2; ++kk) qf[ib][kk] = *(const bf16x8*)(qp + (size_t)(32 * w + 16 * ib + li) * 64 + kk * 32 + g * 8);
  VM_WAIT(); __syncthreads();
  const int f = (li >> 1) & 7;
  const int koff = li * 128 + ((g ^ f) << 4);
  const int q_ = li >> 2, p_ = li & 3, fv = (2 * g + (q_ >> 1)) & 7;
  const int voff = 16384 + (4 * g + q_) * 128 + (p_ & 1) * 8;
  f32x4 O[4][2], CF[4][2], CB[4][2];
#pragma unroll
  for (int eb = 0; eb < 4; ++eb)
#pragma unroll
    for (int ib = 0; ib < 2; ++ib) { O[eb][ib] = (f32x4){0.f, 0.f, 0.f, 0.f}; CF[eb][ib] = O[eb][ib]; CB[eb][ib] = O[eb][ib]; }
#pragma unroll
  for (int ks = 0; ks < 4; ++ks) {
    f32x4 s[2][2];
#pragma unroll
    for (int h2 = 0; h2 < 2; ++h2) {
      s[h2][0] = (f32x4){0.f, 0.f, 0.f, 0.f}; s[h2][1] = s[h2][0];
#pragma unroll
      for (int kk = 0; kk < 2; ++kk) {
        const bf16x8 kf = lds_frag(lds, ((2 * ks + h2) * 2048 + koff) ^ (kk << 6));
        s[h2][0] = __builtin_amdgcn_mfma_f32_16x16x32_bf16(kf, qf[0][kk], s[h2][0], 0, 0, 0);
        s[h2][1] = __builtin_amdgcn_mfma_f32_16x16x32_bf16(kf, qf[1][kk], s[h2][1], 0, 0, 0);
      }
    }
    bf16x8 pf[2];
#pragma unroll
    for (int ib = 0; ib < 2; ++ib) {
      const int i = 32 * w + 16 * ib + li;
      float p[8];
#pragma unroll
      for (int h2 = 0; h2 < 2; ++h2)
#pragma unroll
        for (int j = 0; j < 4; ++j) { const int jj = (2 * ks + h2) * 16 + 4 * g + j; const int df = i - jj; const float dw = df > 0 ? __builtin_amdgcn_exp2f(lgf2 * (float)df) : (df < 0 ? __builtin_amdgcn_exp2f(lgb2 * (float)(-df)) : 2.f); p[h2 * 4 + j] = s[h2][ib][j] * dw; }
      u32x4 pw; pw.x = pk2(p[0], p[1]); pw.y = pk2(p[2], p[3]); pw.z = pk2(p[4], p[5]); pw.w = pk2(p[6], p[7]);
      pf[ib] = __builtin_bit_cast(bf16x8, pw);
    }
#pragma unroll
    for (int eb = 0; eb < 4; ++eb) {
      const int a0 = voff + ks * 4096 + (((eb * 2 + (p_ >> 1)) ^ fv) << 4);
      const bf16x8 vf = lds_tr2(lds, a0, a0 + 2048);
      O[eb][0] = __builtin_amdgcn_mfma_f32_16x16x32_bf16(vf, pf[0], O[eb][0], 0, 0, 0);
      O[eb][1] = __builtin_amdgcn_mfma_f32_16x16x32_bf16(vf, pf[1], O[eb][1], 0, 0, 0);
    }
  }
#pragma unroll
  for (int kk = 0; kk < 2; ++kk)
#pragma unroll
    for (int eb = 0; eb < 4; ++eb) {
      const bf16x8 sf = lds_frag(lds, 32768 + ((eb * 2048 + koff) ^ (kk << 6)));
      const bf16x8 sb = lds_frag(lds, 40960 + ((eb * 2048 + koff) ^ (kk << 6)));
#pragma unroll
      for (int ib = 0; ib < 2; ++ib) {
        CF[eb][ib] = __builtin_amdgcn_mfma_f32_16x16x32_bf16(sf, qf[ib][kk], CF[eb][ib], 0, 0, 0);
        CB[eb][ib] = __builtin_amdgcn_mfma_f32_16x16x32_bf16(sb, qf[ib][kk], CB[eb][ib], 0, 0, 0);
      }
    }
#pragma unroll
  for (int ib = 0; ib < 2; ++ib) {
    const int i = 32 * w + 16 * ib + li;
    const float xf = __builtin_amdgcn_exp2f(lgf2 * (float)(i + 1)), xb = __builtin_amdgcn_exp2f(lgb2 * (float)(128 - i));
    float ss = 0.f;
#pragma unroll
    for (int eb = 0; eb < 4; ++eb) { O[eb][ib] = O[eb][ib] + CF[eb][ib] * xf + CB[eb][ib] * xb; ss += O[eb][ib][0] * O[eb][ib][0] + O[eb][ib][1] * O[eb][ib][1] + O[eb][ib][2] * O[eb][ib][2] + O[eb][ib][3] * O[eb][ib][3]; }
    ss += __shfl_xor(ss, 16); ss += __shfl_xor(ss, 32);
    const float r = rsqrtf(ss * (1.f / 64.f) + EPS);
    bf16* yp = Y + (yrow0 + i) * D + 640 + h * 64;
#pragma unroll
    for (int eb = 0; eb < 4; ++eb) {
      const f32x4 gv = *(const f32x4*)(mixg + 640 + h * 64 + eb * 16 + 4 * g);
      const u32x2 gg = *(const u32x2*)(gp + (size_t)i * 64 + eb * 16 + 4 * g);
#if PROBE_R
      const f32x4 y = O[eb][ib]; (void)r; (void)gv; (void)gg;
      u32x2 o; o.x = pk2(y[0], y[1]); o.y = pk2(y[2], y[3]);
#else
      const f32x4 y = O[eb][ib] * r * gv;
      u32x2 o; o.x = pk2(y[0] * bflo(gg.x), y[1] * bfhi(gg.x)); o.y = pk2(y[2] * bflo(gg.y), y[3] * bfhi(gg.y));
#endif
      *(u32x2*)(yp + eb * 16 + 4 * g) = o;
    }
  }
  __syncthreads();
}

__device__ __forceinline__ float log_sigmoid_f(float x) { return x >= 0.f ? -log1pf(expf(-x)) : x - log1pf(expf(x)); }

__device__ __forceinline__ void p0_mod_item(unsigned char* lds, const Params& P, int item) {
  const int l = item / 96, chunk = item % 96, tid = get_tid(), ks = tid >> 4, cg4 = tid & 15;
  const float* wa = P.w_ada + (size_t)l * 1024 * 6144 + chunk * 64 + cg4 * 4;
  f32x4 a0 = {0.f, 0.f, 0.f, 0.f}, a1 = a0, a2 = a0;
#pragma unroll 8
  for (int i = 0; i < 64; ++i) {
    const int k = ks * 64 + i;
    const f32x4 wv = *(const f32x4*)(wa + (size_t)k * 6144);
    const float s0 = silu_f(P.c[k]), s1 = silu_f(P.c[1024 + k]), s2 = silu_f(P.c_ctx[k]);
    a0 += wv * s0; a1 += wv * s1; a2 += wv * s2;
  }
  float* red = (float*)lds;
  *(f32x4*)(red + (ks * 3 + 0) * 64 + cg4 * 4) = a0; *(f32x4*)(red + (ks * 3 + 1) * 64 + cg4 * 4) = a1; *(f32x4*)(red + (ks * 3 + 2) * 64 + cg4 * 4) = a2;
  __syncthreads();
  if (tid < 192) {
    const int seg = tid >> 6, col = tid & 63; float s = P.b_ada[l * 6144 + chunk * 64 + col];
#pragma unroll
    for (int k2 = 0; k2 < 16; ++k2) s += red[(k2 * 3 + seg) * 64 + col];
    ((float*)(P.ws + WS_MOD))[(l * 3 + seg) * 6144 + chunk * 64 + col] = s;
  }
  __syncthreads();
}

__device__ __forceinline__ void p0_tr_item(unsigned char* lds, const float* src, int srcN, int k0, int n0, bf16* dst, int dstK, int mode) {
  float* tile = (float*)lds;
  const int tid = get_tid();
#pragma unroll
  for (int ps = 0; ps < 4; ++ps) {
    const int kk = (tid >> 4) + 16 * ps, c4 = (tid & 15) * 4;
    const f32x4 v = *(const f32x4*)(src + (size_t)(k0 + kk) * srcN + n0 + c4);
    tile[kk * 65 + c4] = v[0]; tile[kk * 65 + c4 + 1] = v[1]; tile[kk * 65 + c4 + 2] = v[2]; tile[kk * 65 + c4 + 3] = v[3];
  }
  __syncthreads();
  const int n = tid >> 2, kc = tid & 3, ncol = n0 + n;
  int row = ncol;
  if (mode) row = (ncol >> 4) * 32 + (ncol & 15) + (mode == 2 ? 16 : 0);
  u32x4 o0, o1;
#pragma unroll
  for (int i = 0; i < 4; ++i) { o0[i] = pk2(tile[(kc * 16 + 2 * i) * 65 + n], tile[(kc * 16 + 2 * i + 1) * 65 + n]); o1[i] = pk2(tile[(kc * 16 + 8 + 2 * i) * 65 + n], tile[(kc * 16 + 8 + 2 * i + 1) * 65 + n]); }
  bf16* dp = dst + (size_t)row * dstK + k0 + kc * 16;
  *(u32x4*)dp = o0; *(u32x4*)(dp + 8) = o1;
  __syncthreads();
}

constexpr int P0_MOD = 192, P0_MISC = 1, P0_WIN = 2 * 16 * 46, P0_WO = 2 * 16 * 16, P0_W1 = 32 * 128, P0_W2 = 32 * 128;
constexpr int P0_ITEMS = P0_MOD + P0_MISC + P0_WIN + P0_WO + 2 * P0_W1 + P0_W2;

__device__ __forceinline__ void phase0(unsigned char* lds, const Params& P) {
  for (int it = blockIdx.x; it < P0_ITEMS; it += gridDim.x) {
    int r = it;
    if (r < P0_MOD) { p0_mod_item(lds, P, r); continue; } r -= P0_MOD;
    if (r < P0_MISC) {
      const int tid = get_tid();
      float* rope = (float*)(P.ws + WS_ROPE);
      for (int e = tid; e < 2048; e += 256) { const int pos = e >> 4, f = e & 15; const float inv = powf(10000.f, -(float)f / 16.f); const float ang = (float)pos * inv; rope[e * 2] = cosf(ang); rope[e * 2 + 1] = sinf(ang); }
      continue;
    } r -= P0_MISC;
    if (r < P0_WIN) { const int l = r / 736, q = r % 736, kt = q / 46, nt = q % 46;
      p0_tr_item(lds, P.w_in + (size_t)l * 1024 * INC, INC, kt * 64, nt * 64, (bf16*)(P.ws + WS_WIN) + (size_t)l * INC * 1024, 1024, 0); continue; } r -= P0_WIN;
    if (r < P0_WO) { const int l = r / 256, q = r % 256, kt = q / 16, nt = q % 16;
      p0_tr_item(lds, P.w_out + (size_t)l * 1024 * 1024, 1024, kt * 64, nt * 64, (bf16*)(P.ws + WS_WO) + (size_t)l * 1024 * 1024, 1024, 0); continue; } r -= P0_WO;
    if (r < 2 * P0_W1) { const int which = r / P0_W1, q2 = r % P0_W1, le = q2 / 128, q = q2 % 128, kt = q / 8, nt = q % 8;
      p0_tr_item(lds, (which ? P.w3 : P.w1) + (size_t)le * 1024 * 512, 512, kt * 64, nt * 64, (bf16*)(P.ws + WS_W13) + (size_t)le * 1024 * 1024, 1024, which ? 2 : 1); continue; } r -= 2 * P0_W1;
    { const int le = r / 128, q = r % 128, kt = q / 16, nt = q % 16;
      p0_tr_item(lds, P.w2 + (size_t)le * 512 * 1024, 1024, kt * 64, nt * 64, (bf16*)(P.ws + WS_W2) + (size_t)le * 1024 * 512, 512, 0); }
  }
}

constexpr int P1_XB = NROWS / 4, P1_BIAS = 2 * INC / 4, P1_WR = 6, P1_ITEMS = P1_XB + P1_BIAS + P1_WR;
__device__ __forceinline__ void phase1(unsigned char* lds, const Params& P) {
  const int tid = get_tid(), lane = tid & 63, w = tid >> 6;
  const float* mod = (const float*)(P.ws + WS_MOD);
  for (int it = blockIdx.x; it < P1_ITEMS; it += gridDim.x) {
    int r = it;
    if (r < P1_XB) {
      const int row = r * 4 + w, seg = row < NSEQ ? 0 : (row < NLAT ? 1 : 2);
      const float* xr = row < NLAT ? P.x + (size_t)row * D : P.ctx + (size_t)(row - NLAT) * D;
      const float* sc1 = mod + (0 * 3 + seg) * 6144 + 1024;
      bf16* xb = (bf16*)(P.ws + WS_R1) + (size_t)row * D;
      float ss = 0.f;
#pragma unroll
      for (int j = 0; j < 4; ++j) {
        const int k = 4 * lane + 256 * j;
        const f32x4 v = *(const f32x4*)(xr + k), gg = *(const f32x4*)(P.n1g + k), sc = *(const f32x4*)(sc1 + k);
        ss += v[0] * v[0] + v[1] * v[1] + v[2] * v[2] + v[3] * v[3];
        const f32x4 o = v * gg * (sc + 1.f);
        u32x2 ov; ov.x = pk2(o[0], o[1]); ov.y = pk2(o[2], o[3]); *(u32x2*)(xb + k) = ov;
      }
      ss = wsum(ss);
      if (lane == 0) ((float*)(P.ws + WS_RSS))[row] = ss;
      continue;
    } r -= P1_XB;
    if (r < P1_BIAS) {
      const int idx = r * 4 + w, l = idx / INC, n = idx % INC;
      const bf16* wrow = (const bf16*)(P.ws + WS_WIN) + ((size_t)l * INC + n) * 1024 + lane * 16;
      const u32x4 w0 = *(const u32x4*)wrow, w1 = *(const u32x4*)(wrow + 8);
      float wv[16];
#pragma unroll
      for (int i = 0; i < 4; ++i) { wv[2 * i] = bflo(w0[i]); wv[2 * i + 1] = bfhi(w0[i]); wv[8 + 2 * i] = bflo(w1[i]); wv[8 + 2 * i + 1] = bfhi(w1[i]); }
#pragma unroll
      for (int seg = 0; seg < 3; ++seg) {
        const float* sh = mod + (l * 3 + seg) * 6144 + lane * 16; float a = 0.f;
#pragma unroll
        for (int i = 0; i < 16; ++i) a += wv[i] * sh[i];
        a = wsum(a);
        if (lane == 0) ((float*)(P.ws + WS_BIAS))[(l * 3 + seg) * INC + n] = a;
      }
      continue;
    } r -= P1_BIAS;
    { const int l = r / 3, seg = r % 3;
      const float* m = mod + (l * 3 + seg) * 6144;
      float* wr = (float*)(P.ws + WS_WR) + (size_t)(l * 3 + seg) * 16384;
      for (int e = tid; e < 16384; e += 256) { const int k = e >> 4; wr[e] = P.n2g[l * 1024 + k] * (1.f + m[4096 + k]) * P.w_router[e]; }
      const int ex = tid & 15, ks = tid >> 4; float a = 0.f;
      for (int i = 0; i < 64; ++i) { const int k = ks * 64 + i; a += m[3072 + k] * P.w_router[k * 16 + ex]; }
      float* red = (float*)lds; red[ks * 16 + ex] = a; __syncthreads();
      if (tid < 16) { float s = P.b_router[tid]; for (int k2 = 0; k2 < 16; ++k2) s += red[k2 * 16 + tid]; ((float*)(P.ws + WS_CR))[(l * 3 + seg) * 16 + tid] = s; }
      __syncthreads();
    }
  }
}

__device__ __forceinline__ void phaseA(unsigned char* lds, const Params& P, int l) {
  const bf16* XB = (const bf16*)(P.ws + WS_R1);
  const bf16* Wt = (const bf16*)(P.ws + WS_WIN) + (size_t)l * INC * 1024;
  EpiInProj E{(const float*)(P.ws + WS_RSS), (const float*)(P.ws + WS_BIAS) + l * 3 * INC, P.qg + l * 64, P.kg + l * 64, (const float*)(P.ws + WS_ROPE), (bf16*)(P.ws + WS_Z)};
  constexpr int NMT = NROWS / 128, NNT = INC / 128;
  for (int it = blockIdx.x; it < NMT * NNT; it += gridDim.x) {
    const int mt = it / NNT, nt = it % NNT;
    ARowLinear ar{XB, 1024, mt * 128};
    gemm_tile(lds, ar, Wt, 1024, mt * 128, nt * 128, E);
  }
}

__device__ __forceinline__ void phaseB(unsigned char* lds, const Params& P, int l) {
  const bool ctxout = (l == 0);
  const bf16* Z = (const bf16*)(P.ws + WS_Z);
  bf16* Y = (bf16*)P.out;
  const float* mixg = P.mix_g + l * 1024;
  const int tid = get_tid(), G = gridDim.x;
  { const int n = 512 + (ctxout ? 16 : 0);
#pragma unroll 1
    for (int r = blockIdx.x; r < n; r += G) {
      int b, kvh, qtok0, nlat, ntiles; size_t yrow0;
      if (r < 512) { b = r >> 8; kvh = (r >> 7) & 1; const int qt = r & 127; qtok0 = qt * 64; nlat = 128; ntiles = 132; yrow0 = (size_t)b * NSEQ + qt * 64; }
      else { const int q = r - 512; b = q >> 3; kvh = (q >> 2) & 1; const int qt = q & 3; qtok0 = NSEQ + qt * 64; nlat = 0; ntiles = 4; yrow0 = (size_t)NLAT + b * CL + qt * 64; }
      attn_item<3, false>(lds, Z + (size_t)b * NSLOT * NT * 64, S_AQ + kvh * 3, S_AK + kvh, S_AV + kvh, qtok0, 0, nlat, ntiles, 0, Y, yrow0, kvh * 192, mixg);
    }
  }
  { const int n = 1024 + (ctxout ? 32 : 0);
    int start = (int)blockIdx.x - 16; if (start < 0) start += G;
#pragma unroll 1
    for (int r = start; r < n; r += G) {
      int b, h, qtok0, lat0, nlat, ntiles, drbase; size_t yrow0;
      if (r < 1024) { b = r >> 9; h = (r >> 7) & 3; const int row = r & 127; int rs = row - 4; rs = rs < 0 ? 0 : (rs > 120 ? 120 : rs);
        qtok0 = row * 64; lat0 = rs * 64; nlat = 8; ntiles = 12; drbase = rs - row + 7; yrow0 = (size_t)b * NSEQ + row * 64; }
      else { const int q = r - 1024; b = q >> 4; h = (q >> 2) & 3; const int qt = q & 3; qtok0 = NSEQ + qt * 64; lat0 = 0; nlat = 0; ntiles = 4; drbase = 0; yrow0 = (size_t)NLAT + b * CL + qt * 64; }
      float* rp = (float*)(lds + 32768);
      const float* src = P.rpb + ((size_t)l * 4 + h) * 465;
      for (int e = tid; e < 465; e += 256) rp[e] = src[e] * LOG2E;
      __syncthreads();
      attn_item<1, true>(lds, Z + (size_t)b * NSLOT * NT * 64, S_NQ + h, S_NK + h, S_NV + h, qtok0, lat0, nlat, ntiles, drbase, Y, yrow0, 384 + h * 64, mixg);
    }
  }
  { int start = (int)blockIdx.x - 80; if (start < 0) start += G;
#pragma unroll 1
    for (int r = start; r < 2 * 6 * 66; r += G) {
      const int b = r / 396, q = r % 396, h = q / 66, c = q % 66;
      const float lgf2 = log_sigmoid_f(P.ret_decay[(l * 2 + 0) * 6 + h]) * LOG2E, lgb2 = log_sigmoid_f(P.ret_decay[(l * 2 + 1) * 6 + h]) * LOG2E;
      float* U = (float*)(P.ws + WS_R1);
      ret_u_item(lds, Z + (size_t)b * NSLOT * NT * 64, h, c, lgf2, lgb2, U + ((size_t)((b * 6 + h) * 2 + 0) * 66 + c) * 4096, U + ((size_t)((b * 6 + h) * 2 + 1) * 66 + c) * 4096);
    }
  }
}

__device__ __forceinline__ void phaseB2(const Params& P, int l) {
  float* U = (float*)(P.ws + WS_R1);
  for (int it = blockIdx.x; it < 96; it += gridDim.x) {
    const int seq = it >> 2, off = ((it & 3) * 256 + get_tid()) * 4;
    const int dir = seq & 1, h = (seq >> 1) % 6;
    const float lg = log_sigmoid_f(P.ret_decay[(l * 2 + dir) * 6 + h]);
    const float decay = expf(128.f * lg);
    const float* base = U + (size_t)seq * 66 * 4096 + off;
    float* sbase = (float*)((unsigned char*)P.out + S_OFF) + (size_t)seq * 66 * 4096 + off;
    f32x4 s = {0.f, 0.f, 0.f, 0.f};
    for (int st = 0; st < 66; ++st) {
      const int c = dir == 0 ? st : (st < 2 ? 1 - st : 67 - st);
      const f32x4 u = *(const f32x4*)(base + (size_t)c * 4096);
      *(f32x4*)(sbase + (size_t)c * 4096) = s;
      s = s * decay + u;
    }
  }
}

__device__ __forceinline__ void phaseB3(unsigned char* lds, const Params& P, int l) {
  const bf16* Z = (const bf16*)(P.ws + WS_Z);
  bf16* Y = (bf16*)P.out;
  const float* mixg = P.mix_g + l * 1024;
  const float* U = (const float*)((const unsigned char*)P.out + S_OFF);
  const int cpb = (l == 0) ? 66 : 64, total = 2 * 6 * cpb;
  for (int it = blockIdx.x; it < total; it += gridDim.x) {
    const int b = it / (6 * cpb), q = it % (6 * cpb), h = q / cpb, c = (q % cpb) + (66 - cpb);
    const float lgf2 = log_sigmoid_f(P.ret_decay[(l * 2 + 0) * 6 + h]) * LOG2E, lgb2 = log_sigmoid_f(P.ret_decay[(l * 2 + 1) * 6 + h]) * LOG2E;
    const size_t yrow0 = c < 2 ? (size_t)NLAT + b * CL + 128 * c : (size_t)b * NSEQ + 128 * (c - 2);
    ret_out_item(lds, Z + (size_t)b * NSLOT * NT * 64, h, c, lgf2, lgb2, U + ((size_t)((b * 6 + h) * 2 + 0) * 66 + c) * 4096, U + ((size_t)((b * 6 + h) * 2 + 1) * 66 + c) * 4096, Y, yrow0, mixg);
  }
}

__device__ __forceinline__ void phaseC(unsigned char* lds, const Params& P, int l) {
  const bf16* Y = (const bf16*)P.out;
  const bf16* Wt = (const bf16*)(P.ws + WS_WO) + (size_t)l * 1024 * 1024;
  float* XR = (float*)(P.ws + WS_XR);
  EpiOutProj E{l == 0 ? P.x : XR, l == 0 ? P.ctx : XR + (size_t)NLAT * D, (const float*)(P.ws + WS_MOD) + l * 3 * 6144, XR};
  const int nmt = (l == 0 ? NROWS : NLAT) / 128;
  for (int it = blockIdx.x; it < nmt * 8; it += gridDim.x) {
    const int mt = it >> 3, nt = it & 7;
    ARowLinear ar{Y, 1024, mt * 128};
    gemm_tile(lds, ar, Wt, 1024, mt * 128, nt * 128, E);
  }
}

__device__ __forceinline__ void phaseD(unsigned char* lds, const Params& P, int l) {
  const int tid = get_tid(), lane = tid & 63, w = tid >> 6, g = lane >> 4, li = lane & 15;
  const float* XR = (const float*)(P.ws + WS_XR);
  bf16* H2 = (bf16*)(P.ws + WS_R1);
  int* cnt = (int*)(P.ws + WS_CNT) + l * 16;
  int* list = (int*)(P.ws + WS_LIST) + (size_t)l * 16 * NROWS;
  float* gatew = (float*)(P.ws + WS_GATEW);
  float* part = (float*)lds;
  float* ssqp = part + 1024;
  float* rsl = ssqp + 64;
  const int nitems = (l == 0 ? NROWS : NLAT) / 16;
  for (int it = blockIdx.x; it < nitems; it += gridDim.x) {
    const int r0 = it * 16, seg = r0 < NSEQ ? 0 : (r0 < NLAT ? 1 : 2);
    const float* wr = (const float*)(P.ws + WS_WR) + (size_t)(l * 3 + seg) * 16384;
    const float* xrow = XR + (size_t)(r0 + li) * D + 256 * w + 4 * g;
    f32x4 acc = {0.f, 0.f, 0.f, 0.f}; float ssq = 0.f;
#pragma unroll 4
    for (int c = 0; c < 16; ++c) {
      const f32x4 xv = *(const f32x4*)(xrow + 16 * c);
      ssq += xv[0] * xv[0] + xv[1] * xv[1] + xv[2] * xv[2] + xv[3] * xv[3];
      const float* wp = wr + (size_t)(256 * w + 16 * c + 4 * g) * 16 + li;
      acc = __builtin_amdgcn_mfma_f32_16x16x4f32(xv[0], wp[0], acc, 0, 0, 0);
      acc = __builtin_amdgcn_mfma_f32_16x16x4f32(xv[1], wp[16], acc, 0, 0, 0);
      acc = __builtin_amdgcn_mfma_f32_16x16x4f32(xv[2], wp[32], acc, 0, 0, 0);
      acc = __builtin_amdgcn_mfma_f32_16x16x4f32(xv[3], wp[48], acc, 0, 0, 0);
    }
    ssq += __shfl_xor(ssq, 16); ssq += __shfl_xor(ssq, 32);
#pragma unroll
    for (int j = 0; j < 4; ++j) part[(w * 16 + 4 * g + j) * 16 + li] = acc[j];
    if (g == 0) ssqp[w * 16 + li] = ssq;
    __syncthreads();
    if (tid < 16) {
      const int row = r0 + tid;
      const float ss = ssqp[tid] + ssqp[16 + tid] + ssqp[32 + tid] + ssqp[48 + tid];
      const float rs = rsqrtf(ss * (1.f / 1024.f) + EPS);
      rsl[tid] = rs;
      const float* cr = (const float*)(P.ws + WS_CR) + (l * 3 + seg) * 16;
      float lg[16]; float mx = -1e30f;
#pragma unroll
      for (int e = 0; e < 16; ++e) { lg[e] = rs * (part[(0 * 16 + tid) * 16 + e] + part[(1 * 16 + tid) * 16 + e] + part[(2 * 16 + tid) * 16 + e] + part[(3 * 16 + tid) * 16 + e]) + cr[e]; mx = fmaxf(mx, lg[e]); }
#pragma unroll
      for (int e = 0; e < 16; ++e) lg[e] = expf(lg[e] - mx);
      float best = -1.f; int bg = 0; float b0 = 0.f, b1 = 0.f, b2 = 0.f, b3 = 0.f;
#pragma unroll
      for (int gi = 0; gi < 4; ++gi) {
        const float a0 = lg[4 * gi], a1 = lg[4 * gi + 1], a2 = lg[4 * gi + 2], a3 = lg[4 * gi + 3];
        const float sc = fmaxf(fmaxf(fmaxf(a0 + a1, a0 + a2), fmaxf(a0 + a3, a1 + a2)), fmaxf(a1 + a3, a2 + a3));
        if (sc > best) { best = sc; bg = gi; b0 = a0; b1 = a1; b2 = a2; b3 = a3; }
      }
      int i1 = 0; float v1 = b0;
      if (b1 > v1) { v1 = b1; i1 = 1; } if (b2 > v1) { v1 = b2; i1 = 2; } if (b3 > v1) { v1 = b3; i1 = 3; }
      int i2 = -1; float v2 = -1.f;
      if (i1 != 0 && b0 > v2) { v2 = b0; i2 = 0; } if (i1 != 1 && b1 > v2) { v2 = b1; i2 = 1; } if (i1 != 2 && b2 > v2) { v2 = b2; i2 = 2; } if (i1 != 3 && b3 > v2) { v2 = b3; i2 = 3; }
      const float inv = 1.f / (v1 + v2);
      const int e1 = bg * 4 + i1, e2 = bg * 4 + i2;
      const int p1 = atomicAdd(&cnt[e1], 1); list[(size_t)e1 * NROWS + p1] = row * 2; gatew[row * 2] = v1 * inv;
      const int p2 = atomicAdd(&cnt[e2], 1); list[(size_t)e2 * NROWS + p2] = row * 2 + 1; gatew[row * 2 + 1] = v2 * inv;
    }
    __syncthreads();
    { const int rr = tid >> 4, cc = tid & 15; const float rs = rsl[rr];
      const float* xr = XR + (size_t)(r0 + rr) * D + cc * 64;
      const float* m = (const float*)(P.ws + WS_MOD) + (l * 3 + seg) * 6144;
      bf16* hp = H2 + (size_t)(r0 + rr) * D + cc * 64;
#pragma unroll
      for (int i = 0; i < 8; ++i) {
        const int k = cc * 64 + i * 8;
        const f32x4 x0 = *(const f32x4*)(xr + i * 8), x1 = *(const f32x4*)(xr + i * 8 + 4);
        const f32x4 g0 = *(const f32x4*)(P.n2g + l * 1024 + k), g1 = *(const f32x4*)(P.n2g + l * 1024 + k + 4);
        const f32x4 s0 = *(const f32x4*)(m + 4096 + k), s1 = *(const f32x4*)(m + 4096 + k + 4);
        const f32x4 h0 = *(const f32x4*)(m + 3072 + k), h1 = *(const f32x4*)(m + 3072 + k + 4);
        const f32x4 o0 = x0 * rs * g0 * (s0 + 1.f) + h0, o1 = x1 * rs * g1 * (s1 + 1.f) + h1;
        u32x4 o; o.x = pk2(o0[0], o0[1]); o.y = pk2(o0[2], o0[3]); o.z = pk2(o1[0], o1[1]); o.w = pk2(o1[2], o1[3]);
        *(u32x4*)(hp + i * 8) = o;
      }
    }
    __syncthreads();
  }
}

__device__ __forceinline__ void phaseEF(unsigned char* lds, const Params& P, int l, bool down) {
  const int* cnt = (const int*)(P.ws + WS_CNT) + l * 16;
  const int* list = (const int*)(P.ws + WS_LIST) + (size_t)l * 16 * NROWS;
  int total = 0;
#pragma unroll 1
  for (int e = 0; e < 16; ++e) total += (cnt[e] + 127) >> 7;
  total *= 8;
  bf16* act = (bf16*)(P.ws + WS_Z + Z_ACT);
#pragma unroll 1
  for (int it = blockIdx.x; it < total; it += gridDim.x) {
    const int ti = it >> 3, nt = it & 7;
    int e = 0, tb = 0, sb = 0, ce = cnt[0];
#pragma unroll 1
    for (int q = 0; q < 15; ++q) { const int ntq = (ce + 127) >> 7; if (ti >= tb + ntq) { tb += ntq; sb += ce; e = q + 1; ce = cnt[q + 1]; } else break; }
    const int mt = ti - tb;
    const int nvalid = (ce - mt * 128) < 128 ? (ce - mt * 128) : 128;
    const int slot0 = sb + mt * 128;
    const int* lst = list + (size_t)e * NROWS + mt * 128;
    if (!down) {
      ARowGather ar{(const bf16*)(P.ws + WS_R1), lst, nvalid};
      EpiMoeUp E{act, slot0, nvalid};
      gemm_tile(lds, ar, (const bf16*)(P.ws + WS_W13) + (size_t)(l * 16 + e) * 1024 * 1024, 1024, 0, nt * 128, E);
    } else {
      ARowAct ar{act, slot0};
      EpiMoeDown E{lst, (const float*)(P.ws + WS_GATEW), (bf16*)(P.ws + WS_R1), (bf16*)(P.ws + WS_Z + Z_YM1), nvalid};
      gemm_tile(lds, ar, (const bf16*)(P.ws + WS_W2) + (size_t)(l * 16 + e) * 1024 * 512, 512, 0, nt * 128, E);
    }
  }
}

__device__ __forceinline__ void phaseG(const Params& P, int l) {
  const int tid = get_tid(), lane = tid & 63, w = tid >> 6;
  float* XR = (float*)(P.ws + WS_XR);
  const bf16* Y0 = (const bf16*)(P.ws + WS_R1); const bf16* Y1 = (const bf16*)(P.ws + WS_Z + Z_YM1);
  const float* mod = (const float*)(P.ws + WS_MOD);
  const int nrows = l == 0 ? NROWS : NLAT;
  for (int it = blockIdx.x; it < nrows / 4; it += gridDim.x) {
    const int row = it * 4 + w, seg = row < NSEQ ? 0 : (row < NLAT ? 1 : 2);
    const float* gt2 = mod + (l * 3 + seg) * 6144 + 5120;
    f32x4 xv[4]; float ss = 0.f;
#pragma unroll
    for (int j = 0; j < 4; ++j) {
      const int k = 4 * lane + 256 * j;
      const f32x4 x1 = *(const f32x4*)(XR + (size_t)row * D + k), gv = *(const f32x4*)(gt2 + k);
      const u32x2 a = *(const u32x2*)(Y0 + (size_t)row * D + k), b = *(const u32x2*)(Y1 + (size_t)row * D + k);
      f32x4 m; m[0] = bflo(a.x) + bflo(b.x); m[1] = bfhi(a.x) + bfhi(b.x); m[2] = bflo(a.y) + bflo(b.y); m[3] = bfhi(a.y) + bfhi(b.y);
      xv[j] = x1 + gv * m;
      ss += xv[j][0] * xv[j][0] + xv[j][1] * xv[j][1] + xv[j][2] * xv[j][2] + xv[j][3] * xv[j][3];
    }
    ss = wsum(ss);
    if (l == 0) {
      const float* sc1 = mod + (1 * 3 + seg) * 6144 + 1024;
      bf16* xb = (bf16*)(P.ws + WS_R1) + (size_t)row * D;
      if (lane == 0) ((float*)(P.ws + WS_RSS))[row] = ss;
#pragma unroll
      for (int j = 0; j < 4; ++j) {
        const int k = 4 * lane + 256 * j;
        *(f32x4*)(XR + (size_t)row * D + k) = xv[j];
        const f32x4 gg = *(const f32x4*)(P.n1g + 1024 + k), sc = *(const f32x4*)(sc1 + k);
        const f32x4 o = xv[j] * gg * (sc + 1.f);
        u32x2 ov; ov.x = pk2(o[0], o[1]); ov.y = pk2(o[2], o[3]); *(u32x2*)(xb + k) = ov;
      }
    } else {
      const float rs = rsqrtf(ss * (1.f / 1024.f) + EPS);
#pragma unroll
      for (int j = 0; j < 4; ++j) {
        const int k = 4 * lane + 256 * j;
        const f32x4 gg = *(const f32x4*)(P.final_g + k);
        *(f32x4*)(P.out + (size_t)row * D + k) = xv[j] * rs * gg;
      }
    }
  }
}

#define XB_TMO      128
#define XB_XCNT(j)  (256  + 64 * (j))
#define XB_XSUB(j)  (1280 + 64 * (j))
#define XB_XGEN(j)  (2304 + 64 * (j))
#define XB_TOP      3328
#define XB_TOPGEN   3392
#define XB_SPIN_CAP (1u << 20)
__device__ __forceinline__ unsigned xb_ld(unsigned* p)              { return __hip_atomic_load(p, __ATOMIC_RELAXED, __HIP_MEMORY_SCOPE_AGENT); }
__device__ __forceinline__ unsigned xb_add(unsigned* p, unsigned v) { return __hip_atomic_fetch_add(p, v, __ATOMIC_RELAXED, __HIP_MEMORY_SCOPE_AGENT); }
__device__ __forceinline__ unsigned xb_xcc_id() { return (unsigned)__builtin_amdgcn_s_getreg((3 << 11) | 20) & 0xFu; }
#define XB_SPIN(cond, bar) do { unsigned _sp = 0; while (cond) { __builtin_amdgcn_s_sleep(1); \
    if ((++_sp & 255u) == 0u) { if (xb_ld(&(bar)[XB_TMO])) break; if (_sp > XB_SPIN_CAP) { atomicAdd(&(bar)[XB_TMO], 1u); break; } } } } while (0)
struct XBar { unsigned* bar; unsigned x, nloc, nx; };
__device__ __forceinline__ void xbar_init(XBar& b, unsigned* bar) {
  b.bar = bar; b.x = xb_xcc_id(); b.nloc = 0u; b.nx = 0u;
  if (threadIdx.x == 0) (void)xb_add(&bar[XB_XCNT(b.x)], 1u);
}
__device__ __forceinline__ void xbar_sync(XBar& b) {
  asm volatile("s_waitcnt vmcnt(0)" ::: "memory");
  __syncthreads();
  if (threadIdx.x == 0) {
    unsigned* bar = b.bar;
    __builtin_amdgcn_s_waitcnt(0);
    if (b.nloc == 0u) {
      const unsigned G = gridDim.x; unsigned sum, cnt, mine, sp = 0u;
      for (;;) {
        sum = 0u; cnt = 0u; mine = 0u;
#pragma unroll
        for (unsigned j = 0; j < 16; ++j) { const unsigned c = xb_ld(&bar[XB_XCNT(j)]); sum += c; cnt += (c > 0u) ? 1u : 0u; mine = (j == b.x) ? c : mine; }
        if (sum == G) break;
        __builtin_amdgcn_s_sleep(1);
        if ((++sp & 255u) == 0u) { if (xb_ld(&bar[XB_TMO])) break; if (sp > XB_SPIN_CAP) { atomicAdd(&bar[XB_TMO], 1u); break; } }
      }
      b.nloc = mine > 0u ? mine : 1u; b.nx = cnt > 0u ? cnt : 1u;
    }
    const unsigned nloc = b.nloc, nx = b.nx;
    const unsigned old = xb_add(&bar[XB_XSUB(b.x)], 1u);
    const unsigned gen = old / nloc;
    if (old + 1u == (gen + 1u) * nloc) {
      __builtin_amdgcn_fence(__ATOMIC_RELEASE, "agent");
      asm volatile("s_waitcnt vmcnt(0)" ::: "memory");
      const unsigned og = xb_add(&bar[XB_TOP], 1u);
      const unsigned tg = og / nx;
      if (og + 1u == (tg + 1u) * nx) xb_add(&bar[XB_TOPGEN], 1u);
      else XB_SPIN(xb_ld(&bar[XB_TOPGEN]) == tg, bar);
      __builtin_amdgcn_fence(__ATOMIC_ACQUIRE, "agent");
      xb_add(&bar[XB_XGEN(b.x)], 1u);
      asm volatile("s_waitcnt vmcnt(0)" ::: "memory");
    } else {
      XB_SPIN(xb_ld(&bar[XB_XGEN(b.x)]) == gen, bar);
      __builtin_amdgcn_fence(__ATOMIC_ACQUIRE, "agent");
      asm volatile("s_waitcnt vmcnt(0)" ::: "memory");
    }
  }
  __syncthreads();
}

__global__ void __launch_bounds__(256, 2) fwd_mega(Params P) {
  __shared__ __attribute__((aligned(16))) unsigned char lds[65536];
  cg::grid_group grid = cg::this_grid();
  XBar xb; xbar_init(xb, (unsigned*)(P.ws + WS_BAR));
#define GSYNC() xbar_sync(xb)
  phase0(lds, P);
  VM_WAIT(); __syncthreads(); grid.sync();
  phase1(lds, P); GSYNC();
#pragma unroll 1
  for (int l = 0; l < 2; ++l) {
    phaseA(lds, P, l); GSYNC();
#if PROBE == 2
    { const bf16* s = (const bf16*)(P.ws + WS_Z); for (size_t i = (size_t)blockIdx.x * 256 + threadIdx.x; i < (size_t)NLAT * 1024; i += (size_t)gridDim.x * 256) { const size_t NZ = (size_t)2 * NSLOT * NT * 64, C = (size_t)NLAT * 1024; float a = bflo(s[i]) + bflo(s[i + C]); if (i + 2 * C < NZ) a += bflo(s[i + 2 * C]); P.out[i] = a; } return; }
#endif
    phaseB(lds, P, l); GSYNC();
#if PROBE == 3
    { const u32x4* s = (const u32x4*)P.out; u32x4* d = (u32x4*)(P.ws + WS_XR);
      for (size_t i = (size_t)blockIdx.x * 256 + threadIdx.x; i < (size_t)NLAT * 128; i += (size_t)gridDim.x * 256) d[i] = s[i];
      GSYNC();
      const bf16* s2 = (const bf16*)(P.ws + WS_XR);
      for (size_t i = (size_t)blockIdx.x * 256 + threadIdx.x; i < (size_t)NLAT * 1024; i += (size_t)gridDim.x * 256) P.out[i] = ((i & 1023) < 640) ? bflo(s2[i]) : 0.f;
      return; }
#endif
    phaseB2(P, l); GSYNC();
#if PROBE == 4
    { const float* s = (const float*)(P.ws + WS_R1);
      for (size_t i = (size_t)blockIdx.x * 256 + threadIdx.x; i < (size_t)NLAT * 1024; i += (size_t)gridDim.x * 256) P.out[i] = (i < (size_t)24 * 66 * 4096) ? s[i] : 0.f;
      return; }
#endif
    phaseB3(lds, P, l); GSYNC();
#if PROBE == 5
    { const u32x4* s = (const u32x4*)P.out; u32x4* d = (u32x4*)(P.ws + WS_XR);
      for (size_t i = (size_t)blockIdx.x * 256 + threadIdx.x; i < (size_t)NLAT * 128; i += (size_t)gridDim.x * 256) d[i] = s[i];
      GSYNC();
      const bf16* s2 = (const bf16*)(P.ws + WS_XR);
      for (size_t i = (size_t)blockIdx.x * 256 + threadIdx.x; i < (size_t)NLAT * 1024; i += (size_t)gridDim.x * 256) P.out[i] = ((i & 1023) >= 640) ? bflo(s2[i]) : 0.f;
      return; }
#endif
    phaseC(lds, P, l); GSYNC();
#if PROBE == 1
    { const f32x4* s4 = (const f32x4*)(P.ws + WS_XR); f32x4* d4 = (f32x4*)P.out; for (size_t i = (size_t)blockIdx.x * 256 + threadIdx.x; i < (size_t)NLAT * 256; i += (size_t)gridDim.x * 256) d4[i] = s4[i]; return; }
#endif
    phaseD(lds, P, l); GSYNC();
    phaseEF(lds, P, l, false); GSYNC();
    phaseEF(lds, P, l, true); GSYNC();
    phaseG(P, l);
    if (l == 0) GSYNC();
  }
#undef GSYNC
}

extern "C" void kernel_launch(void* const* d_in, const int* in_sizes, int n_in, void* d_out, int out_size, void* d_ws, size_t ws_size, hipStream_t stream) {
  static int grid_blocks = 0;
  if (!grid_blocks) {
    int dev = 0, cus = 0, per_cu = 0;
    (void)hipGetDevice(&dev);
    (void)hipDeviceGetAttribute(&cus, hipDeviceAttributeMultiprocessorCount, dev);
    (void)hipOccupancyMaxActiveBlocksPerMultiprocessor(&per_cu, fwd_mega, 256, 0);
    if (per_cu > 2) per_cu = 2;
    if (per_cu < 1) per_cu = 1;
    grid_blocks = cus * per_cu;
    if (ws_size < WS_END) fprintf(stderr, "kernel_launch: workspace too small: %zu < %zu\n", ws_size, (size_t)WS_END);
  }
  (void)hipMemsetAsync(d_ws, 0, WS_ZERO_BYTES, stream);
  Params p{};
  const float** pp = (const float**)&p;
  for (int i = 0; i < 21; ++i) pp[i] = (const float*)d_in[i];
  p.out = (float*)d_out; p.ws = (unsigned char*)d_ws;
  void* args[] = {&p};
  hipError_t e = hipLaunchCooperativeKernel((void*)fwd_mega, dim3(grid_blocks), dim3(256), args, 0, stream);
  if (e != hipSuccess) fprintf(stderr, "cooperative launch failed: %s (grid %d)\n", hipGetErrorString(e), grid_blocks);
}
```

```cpp
#include <hip/hip_runtime.h>
#include <hip/hip_cooperative_groups.h>
#include <cstdio>
#include <cstdint>
namespace cg = cooperative_groups;

typedef unsigned short bf16;
typedef short bf16x8 __attribute__((ext_vector_type(8)));
typedef short s16x4 __attribute__((ext_vector_type(4)));
typedef float f32x4 __attribute__((ext_vector_type(4)));
typedef float f32x2 __attribute__((ext_vector_type(2)));
typedef unsigned u32x4 __attribute__((ext_vector_type(4)));
typedef unsigned u32x2 __attribute__((ext_vector_type(2)));
typedef __bf16 bf2_t __attribute__((ext_vector_type(2)));
#define LAS __attribute__((address_space(3)))
constexpr int NTHR = 512;
constexpr int LDS_BYTES = 147456;
constexpr int LDS_MISC = 131072;

constexpr int D = 1024, NSEQ = 8192, CL = 256, NT_TOK = NSEQ + CL, NLAT = 2 * NSEQ, NROWS = NLAT + 2 * CL;
constexpr int INC = 2944, NSLOT = 46;
constexpr float EPS = 1e-6f;
constexpr float LOG2E = 1.4426950408889634f;
constexpr float QSCALE = 0.125f * LOG2E;
constexpr int S_AQ = 0, S_AK = 6, S_AV = 8, S_NQ = 10, S_NK = 14, S_NV = 18, S_RQ = 22, S_RK = 28, S_RV = 34, S_RG = 40;

constexpr size_t WS_BAR = 0;
constexpr size_t WS_CNT = 16384;
constexpr size_t WS_ZERO_BYTES = 16384 + 4096;
constexpr size_t WS_MOD = WS_ZERO_BYTES;
constexpr size_t WS_BIAS = WS_MOD + 2 * 3 * 6144 * 4;
constexpr size_t WS_ROPE = WS_BIAS + 2 * 3 * 2944 * 4;
constexpr size_t WS_RSS = WS_ROPE + 128 * 16 * 2 * 4;
constexpr size_t WS_WR = WS_RSS + 16896 * 4;
constexpr size_t WS_CR = WS_WR + 2 * 3 * 1024 * 16 * 4;
constexpr size_t WS_GATEW = WS_CR + 4096;
constexpr size_t WS_LIST = WS_GATEW + 16896 * 2 * 4;
constexpr size_t WS_WIN = (WS_LIST + (size_t)2 * 16 * 16896 * 4 + 4095) / 4096 * 4096;
constexpr size_t WS_WO = WS_WIN + (size_t)2 * 2944 * 1024 * 2;
constexpr size_t WS_W13 = WS_WO + (size_t)2 * 1024 * 1024 * 2;
constexpr size_t WS_W2 = WS_W13 + (size_t)32 * 1024 * 1024 * 2;
constexpr size_t WS_XR = WS_W2 + (size_t)32 * 1024 * 512 * 2;
constexpr size_t WS_R1 = WS_XR + (size_t)NROWS * 1024 * 4;
constexpr size_t WS_Z = WS_R1 + (size_t)NROWS * 1024 * 2;
constexpr size_t WS_END = WS_Z + (size_t)2 * NSLOT * NT_TOK * 64 * 2;
constexpr size_t S_OFF = (size_t)34 << 20;
constexpr size_t Z_YM1 = 0, Z_ACT = (size_t)NROWS * 1024 * 2;
static_assert(Z_ACT + (size_t)(2 * NROWS + 128) * 512 * 2 <= (size_t)2 * NSLOT * NT_TOK * 64 * 2, "act overlay");
static_assert((size_t)2 * 6 * 2 * 66 * 4096 * 4 <= (size_t)NROWS * 1024 * 2, "U overlay");

struct Params {
  const float *x, *c, *ctx, *c_ctx, *w_ada, *b_ada, *n1g, *n2g, *w_in, *qg, *kg, *rpb, *ret_decay, *mix_g, *w_out, *w_router, *b_router, *w1, *w3, *w2, *final_g;
  float* out; unsigned char* ws;
};

__device__ __forceinline__ unsigned pk2(float lo, float hi) { f32x2 v = {lo, hi}; bf2_t b = __builtin_convertvector(v, bf2_t); return __builtin_bit_cast(unsigned, b); }
__device__ __forceinline__ float bflo(unsigned u) { return __builtin_bit_cast(float, u << 16); }
__device__ __forceinline__ float bfhi(unsigned u) { return __builtin_bit_cast(float, u & 0xffff0000u); }
__device__ __forceinline__ float wsum(float v) {
#pragma unroll
  for (int o = 1; o < 64; o <<= 1) v += __shfl_xor(v, o);
  return v;
}
__device__ __forceinline__ float silu_f(float v) { return v / (1.f + __expf(-v)); }
__device__ __forceinline__ int lds_swz(int row, int chunk) { return row * 128 + ((chunk ^ ((row >> 1) & 7)) << 4); }
#define VM_WAIT() asm volatile("s_waitcnt vmcnt(0)" ::: "memory")
__device__ __forceinline__ int get_tid() { int t = threadIdx.x; asm volatile("" : "+v"(t)); return t; }

template <int R, int NW>
__device__ __forceinline__ void stage_rows(unsigned char* lds, int dst, const bf16* src, int ld, int wl, int lane) {
#pragma unroll
  for (int i = 0; i < R / (8 * NW); ++i) {
    const int q = wl + NW * i, row = q * 8 + (lane >> 3), ch = (lane & 7) ^ ((row >> 1) & 7);
    __builtin_amdgcn_global_load_lds((const void*)(src + (size_t)row * ld + ch * 8), (LAS void*)(lds + dst + q * 1024), 16, 0, 0);
  }
}
#define VMCNT(n) asm volatile("s_waitcnt vmcnt(" #n ")" ::: "memory")
#define LGKM0() asm volatile("s_waitcnt lgkmcnt(0)" ::: "memory")
#define RAW_BAR() __builtin_amdgcn_s_barrier()
__device__ __forceinline__ bf16x8 lds_frag(const unsigned char* lds, int off) { return *(const bf16x8*)(lds + off); }
__device__ __forceinline__ bf16x8 lds_tr2(unsigned char* lds, int off0, int off1) {
  s16x4 a = __builtin_amdgcn_ds_read_tr16_b64_v4i16((LAS s16x4*)(lds + off0));
  s16x4 b = __builtin_amdgcn_ds_read_tr16_b64_v4i16((LAS s16x4*)(lds + off1));
  return __builtin_shufflevector(a, b, 0, 1, 2, 3, 4, 5, 6, 7);
}

template <int MT, int NT, class ARow, class Epi>
__device__ __forceinline__ void gemm_tile(unsigned char* lds, const ARow& arow, const bf16* __restrict__ Bt, int K, int m0, int n0, const Epi& epi) {
  const int tid = get_tid(), lane = tid & 63, w = __builtin_amdgcn_readfirstlane(tid >> 6);
  const int wr = w >> 2, wc = w & 3, g = lane >> 4, li = lane & 15;
  constexpr int NA = MT / 2, NB = NT;
  const bf16* ap[NA]; const bf16* bp[NB];
#pragma unroll
  for (int i = 0; i < NA; ++i) { const int q = w + 8 * i, row = q * 8 + (lane >> 3), ch = (lane & 7) ^ ((row >> 1) & 7); ap[i] = arow(row) + ch * 8; }
#pragma unroll
  for (int i = 0; i < NB; ++i) { const int q = w + 8 * i, row = q * 8 + (lane >> 3), ch = (lane & 7) ^ ((row >> 1) & 7); bp[i] = Bt + (size_t)(n0 + row) * K + ch * 8; }
  f32x4 acc[MT][NT];
#pragma unroll
  for (int a = 0; a < MT; ++a)
#pragma unroll
    for (int b = 0; b < NT; ++b) acc[a][b] = (f32x4){0.f, 0.f, 0.f, 0.f};
  const int f = (li >> 1) & 7;
  const int xoff = (wr * (MT * 16) + li) * 128 + ((g ^ f) << 4);
  const int woff = 32768 + (wc * (NT * 16) + li) * 128 + ((g ^ f) << 4);
  const int nk = K >> 6;
#define GT_STAGE(s, k0) do { _Pragma("unroll") for (int i = 0; i < NA; ++i) \
    __builtin_amdgcn_global_load_lds((const void*)(ap[i] + (k0)), (LAS void*)(lds + (s) * 65536 + (w + 8 * i) * 1024), 16, 0, 0); \
    _Pragma("unroll") for (int i = 0; i < NB; ++i) \
    __builtin_amdgcn_global_load_lds((const void*)(bp[i] + (k0)), (LAS void*)(lds + (s) * 65536 + 32768 + (w + 8 * i) * 1024), 16, 0, 0); } while (0)
  GT_STAGE(0, 0);
  VM_WAIT(); __syncthreads();
  for (int t = 0; t < nk; ++t) {
    const int s = t & 1;
    if (t + 1 < nk) GT_STAGE(s ^ 1, (t + 1) * 64);
    const unsigned char* base = lds + s * 65536;
#pragma unroll
    for (int kk = 0; kk < 2; ++kk) {
      bf16x8 wf[NT], xf[MT];
#pragma unroll
      for (int nt = 0; nt < NT; ++nt) wf[nt] = lds_frag(base, (woff + nt * 2048) ^ (kk << 6));
#pragma unroll
      for (int mt = 0; mt < MT; ++mt) xf[mt] = lds_frag(base, (xoff + mt * 2048) ^ (kk << 6));
#pragma unroll
      for (int mt = 0; mt < MT; ++mt)
#pragma unroll
        for (int nt = 0; nt < NT; ++nt) acc[mt][nt] = __builtin_amdgcn_mfma_f32_16x16x32_bf16(wf[nt], xf[mt], acc[mt][nt], 0, 0, 0);
    }
    VM_WAIT(); __syncthreads();
  }
#undef GT_STAGE
  epi(acc, m0 + wr * (MT * 16), n0 + wc * (NT * 16), g, li);
}

struct ARowLinear { const bf16* A; int K; int m0; __device__ __forceinline__ const bf16* operator()(int r) const { return A + (size_t)(m0 + r) * K; } };

template <int MT, int NT>
struct EpiInProj {
  const float* rowss; const float* biasp; const float* qg; const float* kg; const float* rope  ; bf16* Z;
  __device__ __forceinline__ void operator()(f32x4 (&acc)[MT][NT], int mw, int nw, int g, int li) const {
    int b, seg, tokbase; bool latent;
    if (mw < NLAT) { b = mw >> 13; seg = b; tokbase = (mw & 8191); latent = true; }
    else { const int mc = mw - NLAT; b = mc >> 8; seg = 2; tokbase = NSEQ + (mc & 255); latent = false; }
    const int s = nw >> 6, coff = nw & 63;
    bf16* zb = Z + ((size_t)(b * NSLOT + s) * NT_TOK) * 64 + coff;
    float rss[MT];
#pragma unroll
    for (int mt = 0; mt < MT; ++mt) rss[mt] = rowss[mw + mt * 16 + li];
    f32x4 bv[NT], gvv[NT];
#pragma unroll
    for (int nt = 0; nt < NT; ++nt) bv[nt] = *(const f32x4*)(biasp + seg * INC + nw + nt * 16 + 4 * g);
    if (NT == 4 && s < 8) {
      const float* gn = (s < 6) ? qg : kg;
#pragma unroll
      for (int nt = 0; nt < NT; ++nt) gvv[nt] = *(const f32x4*)(gn + nt * 16 + 4 * g);
    } else {
#pragma unroll
      for (int nt = 0; nt < NT; ++nt) gvv[nt] = (f32x4){1.f, 1.f, 1.f, 1.f};
    }
#pragma unroll
    for (int mt = 0; mt < MT; ++mt) {
      const int tok = tokbase + mt * 16 + li;
      const float irms = rsqrtf(rss[mt] * (1.f / 1024.f) + EPS);
      f32x4 v[NT];
#pragma unroll
      for (int nt = 0; nt < NT; ++nt) v[nt] = acc[mt][nt] * irms + bv[nt];
      if constexpr (NT == 4) {
        if (s < 8) {
          float ss = 0.f;
#pragma unroll
          for (int nt = 0; nt < 4; ++nt) ss += v[nt][0] * v[nt][0] + v[nt][1] * v[nt][1] + v[nt][2] * v[nt][2] + v[nt][3] * v[nt][3];
          ss += __shfl_xor(ss, 16); ss += __shfl_xor(ss, 32);
          const float r = rsqrtf(ss * (1.f / 64.f) + EPS) * (s < 6 ? QSCALE : 1.f);
#pragma unroll
          for (int nt = 0; nt < 4; ++nt) v[nt] = v[nt] * r * gvv[nt];
          if (latent) {
            const int pr = tok >> 6, pc = tok & 63;
            const f32x4 r0 = *(const f32x4*)(rope + (pr * 16 + 4 * g) * 2), r1 = *(const f32x4*)(rope + (pr * 16 + 4 * g) * 2 + 4);
            const f32x4 c0 = *(const f32x4*)(rope + (pc * 16 + 4 * g) * 2), c1 = *(const f32x4*)(rope + (pc * 16 + 4 * g) * 2 + 4);
            const float cr_[4] = {r0[0], r0[2], r1[0], r1[2]}, sr_[4] = {r0[1], r0[3], r1[1], r1[3]};
            const float cc_[4] = {c0[0], c0[2], c1[0], c1[2]}, sc_[4] = {c0[1], c0[3], c1[1], c1[3]};
#pragma unroll
            for (int j = 0; j < 4; ++j) {
              const float t1 = v[0][j], t2 = v[1][j]; v[0][j] = t1 * cr_[j] - t2 * sr_[j]; v[1][j] = t2 * cr_[j] + t1 * sr_[j];
              const float u1 = v[2][j], u2 = v[3][j]; v[2][j] = u1 * cc_[j] - u2 * sc_[j]; v[3][j] = u2 * cc_[j] + u1 * sc_[j];
            }
          }
        }
      }
      if (s >= S_NQ && s < S_NK) {
#pragma unroll
        for (int nt = 0; nt < NT; ++nt) v[nt] = v[nt] * QSCALE;
      } else if (s >= S_RK && s < S_RV) {
#pragma unroll
        for (int nt = 0; nt < NT; ++nt) v[nt] = v[nt] * 0.125f;
      } else if (s >= S_RG) {
#pragma unroll
        for (int nt = 0; nt < NT; ++nt)
#pragma unroll
          for (int j = 0; j < 4; ++j) v[nt][j] = silu_f(v[nt][j]);
      }
#pragma unroll
      for (int nt = 0; nt < NT; ++nt) { u32x2 o; o.x = pk2(v[nt][0], v[nt][1]); o.y = pk2(v[nt][2], v[nt][3]); *(u32x2*)(zb + (size_t)tok * 64 + nt * 16 + 4 * g) = o; }
    }
  }
};

struct EpiOutProj {
  const float* xlat; const float* xctx; const float* mod; float* XR;
  __device__ __forceinline__ void operator()(f32x4 (&acc)[8][4], int mw, int nw, int g, int li) const {
    const int seg = (mw < NLAT) ? (mw >> 13) : 2;
    const float* gt = mod + seg * 6144 + 2048;
    f32x4 gv[4];
#pragma unroll
    for (int nt = 0; nt < 4; ++nt) gv[nt] = *(const f32x4*)(gt + nw + nt * 16 + 4 * g);
    const float* xbase = (mw < NLAT) ? (xlat + (size_t)mw * D) : (xctx + (size_t)(mw - NLAT) * D);
#pragma unroll
    for (int mb = 0; mb < 8; mb += 2) {
      f32x4 xv[2][4];
#pragma unroll
      for (int u = 0; u < 2; ++u)
#pragma unroll
        for (int nt = 0; nt < 4; ++nt) xv[u][nt] = *(const f32x4*)(xbase + (size_t)((mb + u) * 16 + li) * D + nw + nt * 16 + 4 * g);
#pragma unroll
      for (int u = 0; u < 2; ++u)
#pragma unroll
        for (int nt = 0; nt < 4; ++nt) *(f32x4*)(XR + (size_t)(mw + (mb + u) * 16 + li) * D + nw + nt * 16 + 4 * g) = xv[u][nt] + gv[nt] * acc[mb + u][nt];
    }
  }
};

struct EpiMoeUp {
  bf16* act; int slot0; int nvalid;
  __device__ __forceinline__ void operator()(f32x4 (&acc)[4][4], int mw, int nw, int g, int li) const {
#pragma unroll
    for (int mt = 0; mt < 4; ++mt) {
      const int r = mw + mt * 16 + li;
      if (r < nvalid) {
#pragma unroll
        for (int u = 0; u < 2; ++u) {
          const int hid = (nw >> 1) + u * 16 + 4 * g;
          const f32x4 a1 = acc[mt][2 * u], a3 = acc[mt][2 * u + 1];
          u32x2 o; o.x = pk2(silu_f(a1[0]) * a3[0], silu_f(a1[1]) * a3[1]); o.y = pk2(silu_f(a1[2]) * a3[2], silu_f(a1[3]) * a3[3]);
          *(u32x2*)(act + (size_t)(slot0 + r) * 512 + hid) = o;
        }
      }
    }
  }
};

struct EpiMoeDown {
  const int* list; const float* gatew; bf16* ym0; bf16* ym1; int nvalid;
  __device__ __forceinline__ void operator()(f32x4 (&acc)[4][4], int mw, int nw, int g, int li) const {
    int ent[4]; float gw[4];
#pragma unroll
    for (int mt = 0; mt < 4; ++mt) { const int r = mw + mt * 16 + li; ent[mt] = list[r < nvalid ? r : nvalid - 1]; }
#pragma unroll
    for (int mt = 0; mt < 4; ++mt) gw[mt] = gatew[ent[mt]];
#pragma unroll
    for (int mt = 0; mt < 4; ++mt) {
      const int r = mw + mt * 16 + li;
      if (r < nvalid) {
        bf16* y = ((ent[mt] & 1) ? ym1 : ym0) + (size_t)(ent[mt] >> 1) * D;
#pragma unroll
        for (int nt = 0; nt < 4; ++nt) {
          const int n = nw + nt * 16 + 4 * g;
          u32x2 o; o.x = pk2(acc[mt][nt][0] * gw[mt], acc[mt][nt][1] * gw[mt]); o.y = pk2(acc[mt][nt][2] * gw[mt], acc[mt][nt][3] * gw[mt]);
          *(u32x2*)(y + n) = o;
        }
      }
    }
  }
};

struct ARowGather { const bf16* H; const int* list; int nvalid; __device__ __forceinline__ const bf16* operator()(int r) const { const int rr = r < nvalid ? r : nvalid - 1; return H + (size_t)(list[rr] >> 1) * D; } };
struct ARowAct { const bf16* act; int slot0; __device__ __forceinline__ const bf16* operator()(int r) const { int s = slot0 + r; s = s < 2 * NROWS ? s : 2 * NROWS - 1; return act + (size_t)s * 512; } };

template <int NQB, bool NAM, int NW>
__device__ __forceinline__ void attn_item(unsigned char* lds, int gb, int wl, int lane, const bf16* zb, int sq0, int sk, int sv, int qtok0, int lat0, int nlat, int ntiles,
                                          int drbase, bf16* Y, size_t yrow0, int ycol0, const float* mixg) {
  const int g = lane >> 4, li = lane & 15;
  const int qtok = qtok0 + 16 * wl + li;
  bf16x8 qf[NQB][2];
#pragma unroll
  for (int qb = 0; qb < NQB; ++qb)
#pragma unroll
    for (int kk = 0; kk < 2; ++kk) qf[qb][kk] = *(const bf16x8*)(zb + ((size_t)(sq0 + qb) * NT_TOK + qtok) * 64 + kk * 32 + g * 8);
  const bf16* kbp = zb + (size_t)sk * NT_TOK * 64;
  const bf16* vbp = zb + (size_t)sv * NT_TOK * 64;
  f32x4 O[4][NQB]; float lsum[NQB];
#pragma unroll
  for (int qb = 0; qb < NQB; ++qb) { lsum[qb] = 0.f;
#pragma unroll
    for (int db = 0; db < 4; ++db) O[db][qb] = (f32x4){0.f, 0.f, 0.f, 0.f}; }
  const int f = (li >> 1) & 7;
  const int koff = li * 128 + ((g ^ f) << 4);
  const int q_ = li >> 2, p_ = li & 3, fv = (2 * g + (q_ >> 1)) & 7;
  const int voff = (4 * g + q_) * 128 + (p_ & 1) * 8;
  const float* rpbt = (const float*)(lds + gb + 49152);
  const int qc = 16 * wl + li;
  int cs = qc - 8; cs = cs < 0 ? 0 : (cs > 48 ? 48 : cs);
#define AT_TOK(t) ((t) < nlat ? lat0 + 64 * (t) : NSEQ + 64 * ((t) - nlat))
#define AT_STAGE(t, bi) do { const int tk_ = AT_TOK(t); stage_rows<64, NW>(lds, gb + (bi) * 16384, kbp + (size_t)tk_ * 64, 64, wl, lane); \
                             stage_rows<64, NW>(lds, gb + (bi) * 16384 + 8192, vbp + (size_t)tk_ * 64, 64, wl, lane); } while (0)
#define AT_WAIT1() do { if (NW == 8) VMCNT(2); else VMCNT(4); } while (0)
  AT_STAGE(0, 0);
  if (ntiles > 1) { AT_STAGE(1, 1); AT_WAIT1(); } else { VMCNT(0); }
  RAW_BAR();
  int cur = 0;
  for (int t = 0; t < ntiles; ++t) {
    const int kb_off = gb + cur * 16384, vb_off = kb_off + 8192;
    const int pfb = cur == 0 ? 2 : cur - 1;
    if (t + 2 < ntiles) AT_STAGE(t + 2, pfb);
#pragma unroll
    for (int ks = 0; ks < 2; ++ks) {
      f32x4 s[2][NQB];
#pragma unroll
      for (int h2 = 0; h2 < 2; ++h2) {
#pragma unroll
        for (int qb = 0; qb < NQB; ++qb) s[h2][qb] = (f32x4){0.f, 0.f, 0.f, 0.f};
#pragma unroll
        for (int kk = 0; kk < 2; ++kk) {
          const bf16x8 kf = lds_frag(lds, kb_off + (((2 * ks + h2) * 2048 + koff) ^ (kk << 6)));
#pragma unroll
          for (int qb = 0; qb < NQB; ++qb) s[h2][qb] = __builtin_amdgcn_mfma_f32_16x16x32_bf16(kf, qf[qb][kk], s[h2][qb], 0, 0, 0);
        }
      }
      bf16x8 pf[NQB];
#pragma unroll
      for (int qb = 0; qb < NQB; ++qb) {
        float p[8];
#pragma unroll
        for (int h2 = 0; h2 < 2; ++h2)
#pragma unroll
          for (int j = 0; j < 4; ++j) {
            float x = s[h2][qb][j];
            if (NAM) {
              if (t < nlat) {
                const int kc = (2 * ks + h2) * 16 + 4 * g + j;
                const bool valid = (kc >= cs) && (kc < cs + 16);
                int dc = kc - qc + 15; dc = dc < 0 ? 0 : (dc > 30 ? 30 : dc);
                x += rpbt[(drbase + t) * 31 + dc];
                x = valid ? x : -1e30f;
              }
            }
            const float e = __builtin_amdgcn_exp2f(x);
            p[h2 * 4 + j] = e; lsum[qb] += e;
          }
        u32x4 pw; pw.x = pk2(p[0], p[1]); pw.y = pk2(p[2], p[3]); pw.z = pk2(p[4], p[5]); pw.w = pk2(p[6], p[7]);
        pf[qb] = __builtin_bit_cast(bf16x8, pw);
      }
#pragma unroll
      for (int db = 0; db < 4; ++db) {
        const int a0 = vb_off + ks * 4096 + voff + (((db * 2 + (p_ >> 1)) ^ fv) << 4);
        const bf16x8 vf = lds_tr2(lds, a0, a0 + 2048);
#pragma unroll
        for (int qb = 0; qb < NQB; ++qb) O[db][qb] = __builtin_amdgcn_mfma_f32_16x16x32_bf16(vf, pf[qb], O[db][qb], 0, 0, 0);
      }
    }
    if (t + 2 < ntiles) { AT_WAIT1(); } else { VMCNT(0); }
    LGKM0(); RAW_BAR();
    cur = cur == 2 ? 0 : cur + 1;
  }
#undef AT_TOK
#undef AT_STAGE
#undef AT_WAIT1
#pragma unroll
  for (int qb = 0; qb < NQB; ++qb) {
    float l = lsum[qb]; l += __shfl_xor(l, 16); l += __shfl_xor(l, 32);
    const float inv = 1.f / l;
    float ss = 0.f;
#pragma unroll
    for (int db = 0; db < 4; ++db) { O[db][qb] = O[db][qb] * inv; ss += O[db][qb][0] * O[db][qb][0] + O[db][qb][1] * O[db][qb][1] + O[db][qb][2] * O[db][qb][2] + O[db][qb][3] * O[db][qb][3]; }
    ss += __shfl_xor(ss, 16); ss += __shfl_xor(ss, 32);
    const float r = rsqrtf(ss * (1.f / 64.f) + EPS);
    bf16* yp = Y + (yrow0 + 16 * wl + li) * D + ycol0 + qb * 64;
#pragma unroll
    for (int db = 0; db < 4; ++db) {
      const f32x4 gv = *(const f32x4*)(mixg + ycol0 + qb * 64 + db * 16 + 4 * g);
      const f32x4 y = O[db][qb] * r * gv;
      u32x2 o; o.x = pk2(y[0], y[1]); o.y = pk2(y[2], y[3]);
      *(u32x2*)(yp + db * 16 + 4 * g) = o;
    }
  }
}

__device__ __forceinline__ void ret_u_item(unsigned char* lds, int gb, int tg, const bf16* zb, int h, int c, float lgf2, float lgb2, float* Uf, float* Ub) {
  const int lane = tg & 63, w = __builtin_amdgcn_readfirstlane(tg >> 6), g = lane >> 4, li = lane & 15;
  const int tok0 = c < 2 ? NSEQ + 128 * c : 128 * (c - 2);
  const bf16* kp = zb + ((size_t)(S_RK + h) * NT_TOK + tok0) * 64;
  const bf16* vp = zb + ((size_t)(S_RV + h) * NT_TOK + tok0) * 64;
  stage_rows<128, 4>(lds, gb, kp, 64, w, lane);
  {
    const int row = tg >> 1, half = tg & 1;
    const float wf = __builtin_amdgcn_exp2f(lgf2 * (float)(127 - row)), wb = __builtin_amdgcn_exp2f(lgb2 * (float)row);
#pragma unroll
    for (int c4 = 0; c4 < 4; ++c4) {
      const int chunk = half * 4 + c4;
      const u32x4 v = *(const u32x4*)(vp + (size_t)row * 64 + chunk * 8);
      u32x4 of, ob;
#pragma unroll
      for (int i = 0; i < 4; ++i) { const float lo = bflo(v[i]), hi = bfhi(v[i]); of[i] = pk2(lo * wf, hi * wf); ob[i] = pk2(lo * wb, hi * wb); }
      *(u32x4*)(lds + gb + 16384 + lds_swz(row, chunk)) = of;
      *(u32x4*)(lds + gb + 32768 + lds_swz(row, chunk)) = ob;
    }
  }
  VM_WAIT(); __syncthreads();
  const int q_ = li >> 2, p_ = li & 3, fv = (2 * g + (q_ >> 1)) & 7;
  const int toff = gb + (4 * g + q_) * 128 + (p_ & 1) * 8;
  f32x4 acc[2][4];
#pragma unroll
  for (int d_ = 0; d_ < 2; ++d_)
#pragma unroll
    for (int eb = 0; eb < 4; ++eb) acc[d_][eb] = (f32x4){0.f, 0.f, 0.f, 0.f};
#pragma unroll
  for (int ks = 0; ks < 4; ++ks) {
    const int a0 = ks * 4096 + toff + (((w * 2 + (p_ >> 1)) ^ fv) << 4);
    const bf16x8 kf = lds_tr2(lds, a0, a0 + 2048);
#pragma unroll
    for (int eb = 0; eb < 4; ++eb) {
      const int b0 = ks * 4096 + toff + (((eb * 2 + (p_ >> 1)) ^ fv) << 4);
      const bf16x8 vf = lds_tr2(lds, 16384 + b0, 16384 + b0 + 2048);
      const bf16x8 vb = lds_tr2(lds, 32768 + b0, 32768 + b0 + 2048);
      acc[0][eb] = __builtin_amdgcn_mfma_f32_16x16x32_bf16(kf, vf, acc[0][eb], 0, 0, 0);
      acc[1][eb] = __builtin_amdgcn_mfma_f32_16x16x32_bf16(kf, vb, acc[1][eb], 0, 0, 0);
    }
  }
#pragma unroll
  for (int eb = 0; eb < 4; ++eb) {
    *(f32x4*)(Uf + (eb * 16 + li) * 64 + w * 16 + 4 * g) = acc[0][eb];
    *(f32x4*)(Ub + (eb * 16 + li) * 64 + w * 16 + 4 * g) = acc[1][eb];
  }
  __syncthreads();
}

__device__ __forceinline__ void ret_out_item(unsigned char* lds, int gb, int tg, const bf16* zb, int h, int c, float lgf2, float lgb2, const float* Sf, const float* Sb,
                                             bf16* Y, size_t yrow0, const float* mixg) {
  const int lane = tg & 63, w = __builtin_amdgcn_readfirstlane(tg >> 6), g = lane >> 4, li = lane & 15;
  const int tok0 = c < 2 ? NSEQ + 128 * c : 128 * (c - 2);
  const bf16* qp = zb + ((size_t)(S_RQ + h) * NT_TOK + tok0) * 64;
  const bf16* kp = zb + ((size_t)(S_RK + h) * NT_TOK + tok0) * 64;
  const bf16* vp = zb + ((size_t)(S_RV + h) * NT_TOK + tok0) * 64;
  const bf16* gp = zb + ((size_t)(S_RG + h) * NT_TOK + tok0) * 64;
  stage_rows<128, 4>(lds, gb, kp, 64, w, lane);
  stage_rows<128, 4>(lds, gb + 16384, vp, 64, w, lane);
  {
    const int e = tg >> 2, dq = tg & 3;
#pragma unroll
    for (int hh = 0; hh < 2; ++hh) {
      const f32x4 a0 = *(const f32x4*)(Sf + e * 64 + dq * 16 + hh * 8), a1 = *(const f32x4*)(Sf + e * 64 + dq * 16 + hh * 8 + 4);
      const f32x4 b0 = *(const f32x4*)(Sb + e * 64 + dq * 16 + hh * 8), b1 = *(const f32x4*)(Sb + e * 64 + dq * 16 + hh * 8 + 4);
      u32x4 oa, ob; oa.x = pk2(a0[0], a0[1]); oa.y = pk2(a0[2], a0[3]); oa.z = pk2(a1[0], a1[1]); oa.w = pk2(a1[2], a1[3]);
      ob.x = pk2(b0[0], b0[1]); ob.y = pk2(b0[2], b0[3]); ob.z = pk2(b1[0], b1[1]); ob.w = pk2(b1[2], b1[3]);
      *(u32x4*)(lds + gb + 32768 + lds_swz(e, dq * 2 + hh)) = oa;
      *(u32x4*)(lds + gb + 40960 + lds_swz(e, dq * 2 + hh)) = ob;
    }
  }
  bf16x8 qf[2][2];
#pragma unroll
  for (int ib = 0; ib < 2; ++ib)
#pragma unroll
    for (int kk = 0; kk < 2; ++kk) qf[ib][kk] = *(const bf16x8*)(qp + (size_t)(32 * w + 16 * ib + li) * 64 + kk * 32 + g * 8);
  VM_WAIT(); __syncthreads();
  const int f = (li >> 1) & 7;
  const int koff = gb + li * 128 + ((g ^ f) << 4);
  const int q_ = li >> 2, p_ = li & 3, fv = (2 * g + (q_ >> 1)) & 7;
  const int voff = gb + 16384 + (4 * g + q_) * 128 + (p_ & 1) * 8;
  f32x4 O[4][2], CF[4][2], CB[4][2];
#pragma unroll
  for (int eb = 0; eb < 4; ++eb)
#pragma unroll
    for (int ib = 0; ib < 2; ++ib) { O[eb][ib] = (f32x4){0.f, 0.f, 0.f, 0.f}; CF[eb][ib] = O[eb][ib]; CB[eb][ib] = O[eb][ib]; }
#pragma unroll
  for (int ks = 0; ks < 4; ++ks) {
    f32x4 s[2][2];
#pragma unroll
    for (int h2 = 0; h2 < 2; ++h2) {
      s[h2][0] = (f32x4){0.f, 0.f, 0.f, 0.f}; s[h2][1] = s[h2][0];
#pragma unroll
      for (int kk = 0; kk < 2; ++kk) {
        const bf16x8 kf = lds_frag(lds, ((2 * ks + h2) * 2048 + koff) ^ (kk << 6));
        s[h2][0] = __builtin_amdgcn_mfma_f32_16x16x32_bf16(kf, qf[0][kk], s[h2][0], 0, 0, 0);
        s[h2][1] = __builtin_amdgcn_mfma_f32_16x16x32_bf16(kf, qf[1][kk], s[h2][1], 0, 0, 0);
      }
    }
    bf16x8 pf[2];
#pragma unroll
    for (int ib = 0; ib < 2; ++ib) {
      const int i = 32 * w + 16 * ib + li;
      float p[8];
#pragma unroll
      for (int h2 = 0; h2 < 2; ++h2)
#pragma unroll
        for (int j = 0; j < 4; ++j) {
          const int jj = (2 * ks + h2) * 16 + 4 * g + j, df = i - jj;
          const float dw = df > 0 ? __builtin_amdgcn_exp2f(lgf2 * (float)df) : (df < 0 ? __builtin_amdgcn_exp2f(lgb2 * (float)(-df)) : 2.f);
          p[h2 * 4 + j] = s[h2][ib][j] * dw;
        }
      u32x4 pw; pw.x = pk2(p[0], p[1]); pw.y = pk2(p[2], p[3]); pw.z = pk2(p[4], p[5]); pw.w = pk2(p[6], p[7]);
      pf[ib] = __builtin_bit_cast(bf16x8, pw);
    }
#pragma unroll
    for (int eb = 0; eb < 4; ++eb) {
      const int a0 = voff + ks * 4096 + (((eb * 2 + (p_ >> 1)) ^ fv) << 4);
      const bf16x8 vf = lds_tr2(lds, a0, a0 + 2048);
      O[eb][0] = __builtin_amdgcn_mfma_f32_16x16x32_bf16(vf, pf[0], O[eb][0], 0, 0, 0);
      O[eb][1] = __builtin_amdgcn_mfma_f32_16x16x32_bf16(vf, pf[1], O[eb][1], 0, 0, 0);
    }
  }
#pragma unroll
  for (int kk = 0; kk < 2; ++kk)
#pragma unroll
    for (int eb = 0; eb < 4; ++eb) {
      const bf16x8 sf = lds_frag(lds, 32768 + ((eb * 2048 + koff) ^ (kk << 6)));
      const bf16x8 sb = lds_frag(lds, 40960 + ((eb * 2048 + koff) ^ (kk << 6)));
#pragma unroll
      for (int ib = 0; ib < 2; ++ib) {
        CF[eb][ib] = __builtin_amdgcn_mfma_f32_16x16x32_bf16(sf, qf[ib][kk], CF[eb][ib], 0, 0, 0);
        CB[eb][ib] = __builtin_amdgcn_mfma_f32_16x16x32_bf16(sb, qf[ib][kk], CB[eb][ib], 0, 0, 0);
      }
    }
#pragma unroll
  for (int ib = 0; ib < 2; ++ib) {
    const int i = 32 * w + 16 * ib + li;
    const float xf = __builtin_amdgcn_exp2f(lgf2 * (float)(i + 1)), xb = __builtin_amdgcn_exp2f(lgb2 * (float)(128 - i));
    float ss = 0.f;
#pragma unroll
    for (int eb = 0; eb < 4; ++eb) { O[eb][ib] = O[eb][ib] + CF[eb][ib] * xf + CB[eb][ib] * xb; ss += O[eb][ib][0] * O[eb][ib][0] + O[eb][ib][1] * O[eb][ib][1] + O[eb][ib][2] * O[eb][ib][2] + O[eb][ib][3] * O[eb][ib][3]; }
    ss += __shfl_xor(ss, 16); ss += __shfl_xor(ss, 32);
    const float r = rsqrtf(ss * (1.f / 64.f) + EPS);
    bf16* yp = Y + (yrow0 + i) * D + 640 + h * 64;
#pragma unroll
    for (int eb = 0; eb < 4; ++eb) {
      const f32x4 gv = *(const f32x4*)(mixg + 640 + h * 64 + eb * 16 + 4 * g);
      const u32x2 gg = *(const u32x2*)(gp + (size_t)i * 64 + eb * 16 + 4 * g);
      const f32x4 y = O[eb][ib] * r * gv;
      u32x2 o; o.x = pk2(y[0] * bflo(gg.x), y[1] * bfhi(gg.x)); o.y = pk2(y[2] * bflo(gg.y), y[3] * bfhi(gg.y));
      *(u32x2*)(yp + eb * 16 + 4 * g) = o;
    }
  }
  __syncthreads();
}

__device__ __forceinline__ float log_sigmoid_f(float x) { return x >= 0.f ? -log1pf(expf(-x)) : x - log1pf(expf(x)); }

__device__ __forceinline__ void p0_mod_item(unsigned char* lds, const Params& P, int item) {
  const int l = item / 96, chunk = item % 96, tid = get_tid(), ks = tid >> 4, cg4 = tid & 15;
  float* red = (float*)lds;
  float* sil = (float*)(lds + 32768);
#pragma unroll
  for (int i = 0; i < 2; ++i) { const int k = tid + 512 * i; sil[k] = silu_f(P.c[k]); sil[1024 + k] = silu_f(P.c[1024 + k]); sil[2048 + k] = silu_f(P.c_ctx[k]); }
  __syncthreads();
  const float* wa = P.w_ada + (size_t)l * 1024 * 6144 + chunk * 64 + cg4 * 4;
  f32x4 a0 = {0.f, 0.f, 0.f, 0.f}, a1 = a0, a2 = a0;
#pragma unroll 16
  for (int i = 0; i < 32; ++i) {
    const int k = ks * 32 + i;
    const f32x4 wv = __builtin_nontemporal_load((const f32x4*)(wa + (size_t)k * 6144));
    a0 += wv * sil[k]; a1 += wv * sil[1024 + k]; a2 += wv * sil[2048 + k];
  }
  *(f32x4*)(red + (ks * 3 + 0) * 64 + cg4 * 4) = a0; *(f32x4*)(red + (ks * 3 + 1) * 64 + cg4 * 4) = a1; *(f32x4*)(red + (ks * 3 + 2) * 64 + cg4 * 4) = a2;
  __syncthreads();
  if (tid < 192) {
    const int seg = tid >> 6, col = tid & 63; float s = P.b_ada[l * 6144 + chunk * 64 + col];
#pragma unroll
    for (int k2 = 0; k2 < 32; ++k2) s += red[(k2 * 3 + seg) * 64 + col];
    ((float*)(P.ws + WS_MOD))[(l * 3 + seg) * 6144 + chunk * 64 + col] = s;
  }
  __syncthreads();
}

__device__ __forceinline__ void p0_tr_item(unsigned char* lds, const float* src, int srcN, int k0, int n0, bf16* dst, int dstK, int mode) {
  float* tile = (float*)lds;
  const int tid = get_tid();
  f32x4 v[8];
#pragma unroll
  for (int ps = 0; ps < 8; ++ps) v[ps] = __builtin_nontemporal_load((const f32x4*)(src + (size_t)(k0 + (tid >> 5) + 16 * ps) * srcN + n0 + (tid & 31) * 4));
#pragma unroll
  for (int ps = 0; ps < 8; ++ps) { float* tp = tile + ((tid >> 5) + 16 * ps) * 129 + (tid & 31) * 4; tp[0] = v[ps][0]; tp[1] = v[ps][1]; tp[2] = v[ps][2]; tp[3] = v[ps][3]; }
  __syncthreads();
  const int n = tid >> 2, kc = tid & 3, ncol = n0 + n;
  int row = ncol;
  if (mode) row = (ncol >> 4) * 32 + (ncol & 15) + (mode == 2 ? 16 : 0);
  bf16* dp = dst + (size_t)row * dstK + k0 + kc * 32;
  const float* tp = tile + (kc * 32) * 129 + n;
#pragma unroll
  for (int q = 0; q < 4; ++q) {
    u32x4 o;
#pragma unroll
    for (int i = 0; i < 4; ++i) o[i] = pk2(tp[(q * 8 + 2 * i) * 129], tp[(q * 8 + 2 * i + 1) * 129]);
    *(u32x4*)(dp + q * 8) = o;
  }
  __syncthreads();
}

constexpr int P0_MOD = 192, P0_MISC = 1, P0_WIN = 2 * 8 * 23, P0_WO = 2 * 8 * 8, P0_W1 = 32 * 32, P0_W2 = 32 * 32;
constexpr int P0_ITEMS = P0_MOD + P0_MISC + P0_WIN + P0_WO + 2 * P0_W1 + P0_W2;

__device__ __forceinline__ void phase0(unsigned char* lds, const Params& P) {
#pragma unroll 1
  for (int it = blockIdx.x; it < P0_ITEMS; it += gridDim.x) {
    int r = it;
    if (r < P0_MOD) { p0_mod_item(lds, P, r); continue; } r -= P0_MOD;
    if (r < P0_MISC) {
      const int tid = get_tid();
      float* rope = (float*)(P.ws + WS_ROPE);
      for (int e = tid; e < 2048; e += NTHR) { const int pos = e >> 4, f = e & 15; const float inv = powf(10000.f, -(float)f / 16.f); const float ang = (float)pos * inv; rope[e * 2] = cosf(ang); rope[e * 2 + 1] = sinf(ang); }
      continue;
    } r -= P0_MISC;
    const float* src; int srcN, k0, n0, dstK, mode; bf16* dst;
    if (r < P0_WIN) { const int l = r / 184, q = r % 184, kt = q / 23, nt = q % 23;
      src = P.w_in + (size_t)l * 1024 * INC; srcN = INC; k0 = kt * 128; n0 = nt * 128; dst = (bf16*)(P.ws + WS_WIN) + (size_t)l * INC * 1024; dstK = 1024; mode = 0; }
    else if (r < P0_WIN + P0_WO) { const int r2 = r - P0_WIN, l = r2 / 64, q = r2 % 64, kt = q / 8, nt = q % 8;
      src = P.w_out + (size_t)l * 1024 * 1024; srcN = 1024; k0 = kt * 128; n0 = nt * 128; dst = (bf16*)(P.ws + WS_WO) + (size_t)l * 1024 * 1024; dstK = 1024; mode = 0; }
    else if (r < P0_WIN + P0_WO + 2 * P0_W1) { const int r2 = r - P0_WIN - P0_WO, which = r2 / P0_W1, q2 = r2 % P0_W1, le = q2 / 32, q = q2 % 32, kt = q / 4, nt = q % 4;
      src = (which ? P.w3 : P.w1) + (size_t)le * 1024 * 512; srcN = 512; k0 = kt * 128; n0 = nt * 128; dst = (bf16*)(P.ws + WS_W13) + (size_t)le * 1024 * 1024; dstK = 1024; mode = which ? 2 : 1; }
    else { const int r2 = r - P0_WIN - P0_WO - 2 * P0_W1, le = r2 / 32, q = r2 % 32, kt = q / 8, nt = q % 8;
      src = P.w2 + (size_t)le * 512 * 1024; srcN = 1024; k0 = kt * 128; n0 = nt * 128; dst = (bf16*)(P.ws + WS_W2) + (size_t)le * 1024 * 512; dstK = 512; mode = 0; }
    p0_tr_item(lds, src, srcN, k0, n0, dst, dstK, mode);
  }
}

constexpr int P1_XB = NROWS / 8, P1_BIAS = 2 * INC / 8, P1_WR = 6, P1_ITEMS = P1_XB + P1_BIAS + P1_WR;
__device__ __forceinline__ void phase1(unsigned char* lds, const Params& P) {
  const int tid = get_tid(), lane = tid & 63, w = tid >> 6;
  const float* mod = (const float*)(P.ws + WS_MOD);
#pragma unroll 1
  for (int it = blockIdx.x; it < P1_ITEMS; it += gridDim.x) {
    int r = it;
    if (r < P1_XB) {
      const int row = r * 8 + w, seg = row < NSEQ ? 0 : (row < NLAT ? 1 : 2);
      const float* xr = row < NLAT ? P.x + (size_t)row * D : P.ctx + (size_t)(row - NLAT) * D;
      const float* sc1 = mod + (0 * 3 + seg) * 6144 + 1024;
      bf16* xb = (bf16*)(P.ws + WS_R1) + (size_t)row * D;
      float ss = 0.f;
#pragma unroll
      for (int j = 0; j < 4; ++j) {
        const int k = 4 * lane + 256 * j;
        const f32x4 v = *(const f32x4*)(xr + k), gg = *(const f32x4*)(P.n1g + k), sc = *(const f32x4*)(sc1 + k);
        ss += v[0] * v[0] + v[1] * v[1] + v[2] * v[2] + v[3] * v[3];
        const f32x4 o = v * gg * (sc + 1.f);
        u32x2 ov; ov.x = pk2(o[0], o[1]); ov.y = pk2(o[2], o[3]); *(u32x2*)(xb + k) = ov;
      }
      ss = wsum(ss);
      if (lane == 0) ((float*)(P.ws + WS_RSS))[row] = ss;
      continue;
    } r -= P1_XB;
    if (r < P1_BIAS) {
      const int idx = r * 8 + w, l = idx / INC, n = idx % INC;
      const bf16* wrow = (const bf16*)(P.ws + WS_WIN) + ((size_t)l * INC + n) * 1024 + lane * 16;
      const u32x4 w0 = *(const u32x4*)wrow, w1 = *(const u32x4*)(wrow + 8);
      float wv[16];
#pragma unroll
      for (int i = 0; i < 4; ++i) { wv[2 * i] = bflo(w0[i]); wv[2 * i + 1] = bfhi(w0[i]); wv[8 + 2 * i] = bflo(w1[i]); wv[8 + 2 * i + 1] = bfhi(w1[i]); }
#pragma unroll
      for (int seg = 0; seg < 3; ++seg) {
        const float* sh = mod + (l * 3 + seg) * 6144 + lane * 16; float a = 0.f;
#pragma unroll
        for (int i = 0; i < 16; ++i) a += wv[i] * sh[i];
        a = wsum(a);
        if (lane == 0) ((float*)(P.ws + WS_BIAS))[(l * 3 + seg) * INC + n] = a;
      }
      continue;
    } r -= P1_BIAS;
    { const int l = r / 3, seg = r % 3;
      const float* m = mod + (l * 3 + seg) * 6144;
      float* wr = (float*)(P.ws + WS_WR) + (size_t)(l * 3 + seg) * 16384;
      for (int e = tid; e < 16384; e += NTHR) { const int k = e >> 4; wr[e] = P.n2g[l * 1024 + k] * (1.f + m[4096 + k]) * P.w_router[e]; }
      const int ex = tid & 15, ks = tid >> 4; float a = 0.f;
      for (int i = 0; i < 32; ++i) { const int k = ks * 32 + i; a += m[3072 + k] * P.w_router[k * 16 + ex]; }
      float* red = (float*)lds; red[ks * 16 + ex] = a; __syncthreads();
      if (tid < 16) { float s = P.b_router[tid]; for (int k2 = 0; k2 < 32; ++k2) s += red[k2 * 16 + tid]; ((float*)(P.ws + WS_CR))[(l * 3 + seg) * 16 + tid] = s; }
      __syncthreads();
    }
  }
}

__device__ __forceinline__ int xcd_vidx(int round) {
  const int G = gridDim.x, b = blockIdx.x;
  return (G & 7) == 0 ? round * G + (b & 7) * (G >> 3) + (b >> 3) : round * G + b;
}

__device__ __forceinline__ void phaseA(unsigned char* lds, const Params& P, int l) {
  const bf16* XB = (const bf16*)(P.ws + WS_R1);
  const bf16* Wt = (const bf16*)(P.ws + WS_WIN) + (size_t)l * INC * 1024;
  { const int tid = get_tid(); const f32x4* s4 = (const f32x4*)(P.ws + WS_ROPE); f32x4* d4 = (f32x4*)(lds + LDS_MISC);
    for (int e = tid; e < 1024; e += NTHR) d4[e] = s4[e];
    __syncthreads(); }
  const float* ropel = (const float*)(lds + LDS_MISC);
  EpiInProj<8, 4> E4{(const float*)(P.ws + WS_RSS), (const float*)(P.ws + WS_BIAS) + l * 3 * INC, P.qg + l * 64, P.kg + l * 64, ropel, (bf16*)(P.ws + WS_Z)};
  EpiInProj<8, 2> E2{(const float*)(P.ws + WS_RSS), (const float*)(P.ws + WS_BIAS) + l * 3 * INC, P.qg + l * 64, P.kg + l * 64, ropel, (bf16*)(P.ws + WS_Z)};
  constexpr int NFULL = 66 * 11, NITEM = NFULL + 33;
#pragma unroll 1
  for (int round = 0; ; ++round) {
    const int v = xcd_vidx(round);
    if (round * (int)gridDim.x >= NITEM) break;
    if (v >= NITEM) continue;
    if (v < NFULL) {
      const int m = v / 11, n = v % 11;
      ARowLinear ar{XB, 1024, m * 256};
      gemm_tile<8, 4>(lds, ar, Wt, 1024, m * 256, n * 256, E4);
    } else {
      const int m2 = (v - NFULL) * 2;
#pragma unroll 1
      for (int h = 0; h < 2; ++h) { ARowLinear ar{XB, 1024, (m2 + h) * 256}; gemm_tile<8, 2>(lds, ar, Wt, 1024, (m2 + h) * 256, 2816, E2); }
    }
  }
}

__device__ __forceinline__ void phaseB(unsigned char* lds, const Params& P, int l) {
  const bool ctxout = (l == 0);
  const bf16* Z = (const bf16*)(P.ws + WS_Z);
  bf16* Y = (bf16*)P.out;
  const float* mixg = P.mix_g + l * 1024;
  const int tid = get_tid(), lane = tid & 63, w = __builtin_amdgcn_readfirstlane(tid >> 6), grp = w >> 2, wl4 = w & 3, tg = tid & 255, G = gridDim.x;
  { const int n = 256 + (ctxout ? 8 : 0);
#pragma unroll 1
    for (int r = blockIdx.x; r < n; r += G) {
      int b, kvh, qtok0, nlat, ntiles; size_t yrow0;
      if (r < 256) { b = r >> 7; kvh = (r >> 6) & 1; const int qt = r & 63; qtok0 = qt * 128; nlat = 128; ntiles = 132; yrow0 = (size_t)b * NSEQ + qt * 128; }
      else { const int q = r - 256; b = q >> 2; kvh = (q >> 1) & 1; const int qt = q & 1; qtok0 = NSEQ + qt * 128; nlat = 0; ntiles = 4; yrow0 = (size_t)NLAT + b * CL + qt * 128; }
      attn_item<3, false, 8>(lds, 0, w, lane, Z + (size_t)b * NSLOT * NT_TOK * 64, S_AQ + kvh * 3, S_AK + kvh, S_AV + kvh, qtok0, 0, nlat, ntiles, 0, Y, yrow0, kvh * 192, mixg);
    }
  }
  { const int n = 1024 + (ctxout ? 32 : 0);
    int start = (int)blockIdx.x - 8; if (start < 0) start += G;
#pragma unroll 1
    for (int pr = start; pr * 2 < n; pr += G) {
      const int r = pr * 2 + grp;
      int b, h, qtok0, lat0, nlat, ntiles, drbase; size_t yrow0;
      if (r < 1024) { b = r >> 9; h = (r >> 7) & 3; const int row = r & 127; int rs = row - 4; rs = rs < 0 ? 0 : (rs > 120 ? 120 : rs);
        qtok0 = row * 64; lat0 = rs * 64; nlat = 8; ntiles = 12; drbase = rs - row + 7; yrow0 = (size_t)b * NSEQ + row * 64; }
      else { const int q = r - 1024; b = q >> 4; h = (q >> 2) & 3; const int qt = q & 3; qtok0 = NSEQ + qt * 64; lat0 = 0; nlat = 0; ntiles = 4; drbase = 0; yrow0 = (size_t)NLAT + b * CL + qt * 64; }
      float* rp = (float*)(lds + grp * 65536 + 49152);
      const float* src = P.rpb + ((size_t)l * 4 + h) * 465;
      for (int e = tg; e < 465; e += 256) rp[e] = src[e] * LOG2E;
      __syncthreads();
      attn_item<1, true, 4>(lds, grp * 65536, wl4, lane, Z + (size_t)b * NSLOT * NT_TOK * 64, S_NQ + h, S_NK + h, S_NV + h, qtok0, lat0, nlat, ntiles, drbase, Y, yrow0, 384 + h * 64, mixg);
    }
  }
  { int start = (int)blockIdx.x - 40; if (start < 0) start += G;
#pragma unroll 1
    for (int pr = start; pr * 2 < 2 * 6 * 66; pr += G) {
      const int r = pr * 2 + grp;
      const int b = r / 396, q = r % 396, h = q / 66, c = q % 66;
      const float lgf2 = log_sigmoid_f(P.ret_decay[(l * 2 + 0) * 6 + h]) * LOG2E, lgb2 = log_sigmoid_f(P.ret_decay[(l * 2 + 1) * 6 + h]) * LOG2E;
      float* U = (float*)(P.ws + WS_R1);
      ret_u_item(lds, grp * 65536, tg, Z + (size_t)b * NSLOT * NT_TOK * 64, h, c, lgf2, lgb2, U + ((size_t)((b * 6 + h) * 2 + 0) * 66 + c) * 4096, U + ((size_t)((b * 6 + h) * 2 + 1) * 66 + c) * 4096);
    }
  }
}

__device__ __forceinline__ void phaseB2(const Params& P, int l) {
  const float* U = (const float*)(P.ws + WS_R1);
#pragma unroll 1
  for (int it = blockIdx.x; it < 48; it += gridDim.x) {
    const int seq = it >> 1, off = ((it & 1) * 512 + get_tid()) * 4;
    const int dir = seq & 1, h = (seq >> 1) % 6;
    const float lg = log_sigmoid_f(P.ret_decay[(l * 2 + dir) * 6 + h]);
    const float decay = expf(128.f * lg);
    const float* base = U + (size_t)seq * 66 * 4096 + off;
    float* sbase = (float*)((unsigned char*)P.out + S_OFF) + (size_t)seq * 66 * 4096 + off;
    f32x4 s = {0.f, 0.f, 0.f, 0.f};
#pragma unroll 1
    for (int s0 = 0; s0 < 66; s0 += 11) {
      f32x4 u[11];
#pragma unroll
      for (int k = 0; k < 11; ++k) { const int st = s0 + k; const int c = dir == 0 ? st : (st < 2 ? 1 - st : 67 - st); u[k] = __builtin_nontemporal_load((const f32x4*)(base + (size_t)c * 4096)); }
#pragma unroll
      for (int k = 0; k < 11; ++k) { const int st = s0 + k; const int c = dir == 0 ? st : (st < 2 ? 1 - st : 67 - st); *(f32x4*)(sbase + (size_t)c * 4096) = s; s = s * decay + u[k]; }
    }
  }
}

__device__ __forceinline__ void phaseB3(unsigned char* lds, const Params& P, int l) {
  const bf16* Z = (const bf16*)(P.ws + WS_Z);
  bf16* Y = (bf16*)P.out;
  const float* mixg = P.mix_g + l * 1024;
  const float* U = (const float*)((const unsigned char*)P.out + S_OFF);
  const int tid = get_tid(), grp = __builtin_amdgcn_readfirstlane(tid >> 8), tg = tid & 255;
  const int cpb = (l == 0) ? 66 : 64, total = 2 * 6 * cpb;
#pragma unroll 1
  for (int pr = blockIdx.x; pr * 2 < total; pr += gridDim.x) {
    const int it = pr * 2 + grp;
    const int b = it / (6 * cpb), q = it % (6 * cpb), h = q / cpb, c = (q % cpb) + (66 - cpb);
    const float lgf2 = log_sigmoid_f(P.ret_decay[(l * 2 + 0) * 6 + h]) * LOG2E, lgb2 = log_sigmoid_f(P.ret_decay[(l * 2 + 1) * 6 + h]) * LOG2E;
    const size_t yrow0 = c < 2 ? (size_t)NLAT + b * CL + 128 * c : (size_t)b * NSEQ + 128 * (c - 2);
    ret_out_item(lds, grp * 65536, tg, Z + (size_t)b * NSLOT * NT_TOK * 64, h, c, lgf2, lgb2, U + ((size_t)((b * 6 + h) * 2 + 0) * 66 + c) * 4096, U + ((size_t)((b * 6 + h) * 2 + 1) * 66 + c) * 4096, Y, yrow0, mixg);
  }
}

__device__ __forceinline__ void phaseC(unsigned char* lds, const Params& P, int l) {
  const bf16* Y = (const bf16*)P.out;
  const bf16* Wt = (const bf16*)(P.ws + WS_WO) + (size_t)l * 1024 * 1024;
  float* XR = (float*)(P.ws + WS_XR);
  EpiOutProj E{l == 0 ? P.x : XR, l == 0 ? P.ctx : XR + (size_t)NLAT * D, (const float*)(P.ws + WS_MOD) + l * 3 * 6144, XR};
  const int nitem = (l == 0 ? NROWS : NLAT) / 256 * 4;
#pragma unroll 1
  for (int round = 0; round * (int)gridDim.x < nitem; ++round) {
    const int v = xcd_vidx(round);
    if (v >= nitem) continue;
    const int mt = v >> 2, nt = v & 3;
    ARowLinear ar{Y, 1024, mt * 256};
    gemm_tile<8, 4>(lds, ar, Wt, 1024, mt * 256, nt * 256, E);
  }
}

__device__ __forceinline__ void phaseD(unsigned char* lds, const Params& P, int l) {
  const int tid = get_tid(), lane = tid & 63, w = tid >> 6, g = lane >> 4, li = lane & 15;
  const float* XR = (const float*)(P.ws + WS_XR);
  bf16* H2 = (bf16*)(P.ws + WS_R1);
  int* cnt = (int*)(P.ws + WS_CNT) + l * 16;
  int* list = (int*)(P.ws + WS_LIST) + (size_t)l * 16 * NROWS;
  float* gatew = (float*)(P.ws + WS_GATEW);
  float* part = (float*)lds;
  float* ssqp = part + 2048;
  float* rsl = ssqp + 128;
  int* hist = (int*)(rsl + 64);
  const int nitems = (l == 0 ? NROWS : NLAT) / 64;
  const int rgp = w >> 1, kh = w & 1;
#pragma unroll 1
  for (int it = blockIdx.x; it < nitems; it += gridDim.x) {
    const int r0 = it * 64, seg = r0 < NSEQ ? 0 : (r0 < NLAT ? 1 : 2);
    const float* wr = (const float*)(P.ws + WS_WR) + (size_t)(l * 3 + seg) * 16384;
    const float* xrow = XR + (size_t)(r0 + rgp * 16 + li) * D + 512 * kh + 4 * g;
    const float* wp0 = wr + (size_t)(512 * kh + 4 * g) * 16 + li;
    if (tid < 32) hist[tid] = 0;
    f32x4 acc = {0.f, 0.f, 0.f, 0.f}; float ssq = 0.f;
#pragma unroll 1
    for (int cb = 0; cb < 32; cb += 8) {
      f32x4 xv[8]; float bw[8][4];
#pragma unroll
      for (int c = 0; c < 8; ++c) {
        xv[c] = *(const f32x4*)(xrow + 16 * (cb + c));
        const float* wp = wp0 + (cb + c) * 256;
        bw[c][0] = wp[0]; bw[c][1] = wp[16]; bw[c][2] = wp[32]; bw[c][3] = wp[48];
      }
#pragma unroll
      for (int c = 0; c < 8; ++c) {
        ssq += xv[c][0] * xv[c][0] + xv[c][1] * xv[c][1] + xv[c][2] * xv[c][2] + xv[c][3] * xv[c][3];
        acc = __builtin_amdgcn_mfma_f32_16x16x4f32(xv[c][0], bw[c][0], acc, 0, 0, 0);
        acc = __builtin_amdgcn_mfma_f32_16x16x4f32(xv[c][1], bw[c][1], acc, 0, 0, 0);
        acc = __builtin_amdgcn_mfma_f32_16x16x4f32(xv[c][2], bw[c][2], acc, 0, 0, 0);
        acc = __builtin_amdgcn_mfma_f32_16x16x4f32(xv[c][3], bw[c][3], acc, 0, 0, 0);
      }
    }
    ssq += __shfl_xor(ssq, 16); ssq += __shfl_xor(ssq, 32);
#pragma unroll
    for (int j = 0; j < 4; ++j) part[(w * 16 + 4 * g + j) * 16 + li] = acc[j];
    if (g == 0) ssqp[w * 16 + li] = ssq;
    __syncthreads();
    int e1 = 0, e2 = 0, q1 = 0, q2 = 0; float g1 = 0.f, g2 = 0.f;
    if (tid < 64) {
      const int rg2 = tid >> 4, rr = tid & 15;
      const float ss = ssqp[(2 * rg2) * 16 + rr] + ssqp[(2 * rg2 + 1) * 16 + rr];
      const float rs = rsqrtf(ss * (1.f / 1024.f) + EPS);
      rsl[tid] = rs;
      const float* cr = (const float*)(P.ws + WS_CR) + (l * 3 + seg) * 16;
      float lg[16]; float mx = -1e30f;
#pragma unroll
      for (int e = 0; e < 16; ++e) { lg[e] = rs * (part[((2 * rg2) * 16 + rr) * 16 + e] + part[((2 * rg2 + 1) * 16 + rr) * 16 + e]) + cr[e]; mx = fmaxf(mx, lg[e]); }
#pragma unroll
      for (int e = 0; e < 16; ++e) lg[e] = expf(lg[e] - mx);
      float best = -1.f; int bg = 0; float b0 = 0.f, b1 = 0.f, b2 = 0.f, b3 = 0.f;
#pragma unroll
      for (int gi = 0; gi < 4; ++gi) {
        const float a0 = lg[4 * gi], a1 = lg[4 * gi + 1], a2 = lg[4 * gi + 2], a3 = lg[4 * gi + 3];
        const float sc = fmaxf(fmaxf(fmaxf(a0 + a1, a0 + a2), fmaxf(a0 + a3, a1 + a2)), fmaxf(a1 + a3, a2 + a3));
        if (sc > best) { best = sc; bg = gi; b0 = a0; b1 = a1; b2 = a2; b3 = a3; }
      }
      int i1 = 0; float v1 = b0;
      if (b1 > v1) { v1 = b1; i1 = 1; } if (b2 > v1) { v1 = b2; i1 = 2; } if (b3 > v1) { v1 = b3; i1 = 3; }
      int i2 = -1; float v2 = -1.f;
      if (i1 != 0 && b0 > v2) { v2 = b0; i2 = 0; } if (i1 != 1 && b1 > v2) { v2 = b1; i2 = 1; } if (i1 != 2 && b2 > v2) { v2 = b2; i2 = 2; } if (i1 != 3 && b3 > v2) { v2 = b3; i2 = 3; }
      const float inv = 1.f / (v1 + v2);
      e1 = bg * 4 + i1; e2 = bg * 4 + i2; g1 = v1 * inv; g2 = v2 * inv;
      q1 = atomicAdd(&hist[e1], 1); q2 = atomicAdd(&hist[e2], 1);
    }
    __syncthreads();
    if (tid < 16) hist[16 + tid] = atomicAdd(&cnt[tid], hist[tid]);
    __syncthreads();
    if (tid < 64) {
      const int row = r0 + tid;
      list[(size_t)e1 * NROWS + hist[16 + e1] + q1] = row * 2; gatew[row * 2] = g1;
      list[(size_t)e2 * NROWS + hist[16 + e2] + q2] = row * 2 + 1; gatew[row * 2 + 1] = g2;
    }
    {
      const float* m = (const float*)(P.ws + WS_MOD) + (l * 3 + seg) * 6144;
      f32x4 gs[4], sh[4];
#pragma unroll
      for (int j = 0; j < 4; ++j) { const int k = 4 * lane + 256 * j; gs[j] = *(const f32x4*)(P.n2g + l * 1024 + k) * (*(const f32x4*)(m + 4096 + k) + 1.f); sh[j] = *(const f32x4*)(m + 3072 + k); }
#pragma unroll 1
      for (int q = 0; q < 8; q += 4) {
        f32x4 xx[4][4];
#pragma unroll
        for (int u = 0; u < 4; ++u)
#pragma unroll
          for (int j = 0; j < 4; ++j) xx[u][j] = *(const f32x4*)(XR + (size_t)(r0 + 8 * w + q + u) * D + 4 * lane + 256 * j);
#pragma unroll
        for (int u = 0; u < 4; ++u) {
          const int rr = 8 * w + q + u; const float rs = rsl[rr]; bf16* hp = H2 + (size_t)(r0 + rr) * D;
#pragma unroll
          for (int j = 0; j < 4; ++j) { const f32x4 o = xx[u][j] * rs * gs[j] + sh[j]; u32x2 ov; ov.x = pk2(o[0], o[1]); ov.y = pk2(o[2], o[3]); *(u32x2*)(hp + 4 * lane + 256 * j) = ov; }
        }
      }
    }
    __syncthreads();
  }
}

__device__ __forceinline__ void phaseEF(unsigned char* lds, const Params& P, int l, bool down) {
  const int* cnt = (const int*)(P.ws + WS_CNT) + l * 16;
  const int* list = (const int*)(P.ws + WS_LIST) + (size_t)l * 16 * NROWS;
  int total = 0;
#pragma unroll 1
  for (int e = 0; e < 16; ++e) total += (cnt[e] + 127) >> 7;
  total *= 4;
  bf16* act = (bf16*)(P.ws + WS_Z + Z_ACT);
#pragma unroll 1
  for (int round = 0; round * (int)gridDim.x < total; ++round) {
    const int it = xcd_vidx(round);
    if (it >= total) continue;
    const int ti = it >> 2, nt = it & 3;
    int e = 0, tb = 0, sb = 0, ce = cnt[0];
#pragma unroll 1
    for (int q = 0; q < 15; ++q) { const int ntq = (ce + 127) >> 7; if (ti >= tb + ntq) { tb += ntq; sb += ce; e = q + 1; ce = cnt[q + 1]; } else break; }
    const int mt = ti - tb;
    const int nvalid = (ce - mt * 128) < 128 ? (ce - mt * 128) : 128;
    const int slot0 = sb + mt * 128;
    const int* lst = list + (size_t)e * NROWS + mt * 128;
    if (!down) {
      ARowGather ar{(const bf16*)(P.ws + WS_R1), lst, nvalid};
      EpiMoeUp E{act, slot0, nvalid};
      gemm_tile<4, 4>(lds, ar, (const bf16*)(P.ws + WS_W13) + (size_t)(l * 16 + e) * 1024 * 1024, 1024, 0, nt * 256, E);
    } else {
      ARowAct ar{act, slot0};
      EpiMoeDown E{lst, (const float*)(P.ws + WS_GATEW), (bf16*)(P.ws + WS_R1), (bf16*)(P.ws + WS_Z + Z_YM1), nvalid};
      gemm_tile<4, 4>(lds, ar, (const bf16*)(P.ws + WS_W2) + (size_t)(l * 16 + e) * 1024 * 512, 512, 0, nt * 256, E);
    }
  }
}

__device__ __forceinline__ void phaseG(const Params& P, int l) {
  const int tid = get_tid(), lane = tid & 63, w = tid >> 6;
  float* XR = (float*)(P.ws + WS_XR);
  const bf16* Y0 = (const bf16*)(P.ws + WS_R1); const bf16* Y1 = (const bf16*)(P.ws + WS_Z + Z_YM1);
  const float* mod = (const float*)(P.ws + WS_MOD);
  const int nrows = l == 0 ? NROWS : NLAT;
#pragma unroll 1
  for (int it = blockIdx.x; it < nrows / 8; it += gridDim.x) {
    const int row = it * 8 + w, seg = row < NSEQ ? 0 : (row < NLAT ? 1 : 2);
    const float* gt2 = mod + (l * 3 + seg) * 6144 + 5120;
    f32x4 xv[4]; float ss = 0.f;
#pragma unroll
    for (int j = 0; j < 4; ++j) {
      const int k = 4 * lane + 256 * j;
      const f32x4 x1 = *(const f32x4*)(XR + (size_t)row * D + k), gv = *(const f32x4*)(gt2 + k);
      const u32x2 a = *(const u32x2*)(Y0 + (size_t)row * D + k), b = *(const u32x2*)(Y1 + (size_t)row * D + k);
      f32x4 m; m[0] = bflo(a.x) + bflo(b.x); m[1] = bfhi(a.x) + bfhi(b.x); m[2] = bflo(a.y) + bflo(b.y); m[3] = bfhi(a.y) + bfhi(b.y);
      xv[j] = x1 + gv * m;
      ss += xv[j][0] * xv[j][0] + xv[j][1] * xv[j][1] + xv[j][2] * xv[j][2] + xv[j][3] * xv[j][3];
    }
    ss = wsum(ss);
    if (l == 0) {
      const float* sc1 = mod + (1 * 3 + seg) * 6144 + 1024;
      bf16* xb = (bf16*)(P.ws + WS_R1) + (size_t)row * D;
      if (lane == 0) ((float*)(P.ws + WS_RSS))[row] = ss;
#pragma unroll
      for (int j = 0; j < 4; ++j) {
        const int k = 4 * lane + 256 * j;
        *(f32x4*)(XR + (size_t)row * D + k) = xv[j];
        const f32x4 gg = *(const f32x4*)(P.n1g + 1024 + k), sc = *(const f32x4*)(sc1 + k);
        const f32x4 o = xv[j] * gg * (sc + 1.f);
        u32x2 ov; ov.x = pk2(o[0], o[1]); ov.y = pk2(o[2], o[3]); *(u32x2*)(xb + k) = ov;
      }
    } else {
      const float rs = rsqrtf(ss * (1.f / 1024.f) + EPS);
#pragma unroll
      for (int j = 0; j < 4; ++j) {
        const int k = 4 * lane + 256 * j;
        const f32x4 gg = *(const f32x4*)(P.final_g + k);
        *(f32x4*)(P.out + (size_t)row * D + k) = xv[j] * rs * gg;
      }
    }
  }
}

#define XB_TMO      128
#define XB_XCNT(j)  (256  + 64 * (j))
#define XB_XSUB(j)  (1280 + 64 * (j))
#define XB_XGEN(j)  (2304 + 64 * (j))
#define XB_TOP      3328
#define XB_TOPGEN   3392
#define XB_SPIN_CAP (1u << 20)
__device__ __forceinline__ unsigned xb_ld(unsigned* p)              { return __hip_atomic_load(p, __ATOMIC_RELAXED, __HIP_MEMORY_SCOPE_AGENT); }
__device__ __forceinline__ unsigned xb_add(unsigned* p, unsigned v) { return __hip_atomic_fetch_add(p, v, __ATOMIC_RELAXED, __HIP_MEMORY_SCOPE_AGENT); }
__device__ __forceinline__ unsigned xb_xcc_id() { return (unsigned)__builtin_amdgcn_s_getreg((3 << 11) | 20) & 0xFu; }
#define XB_SPIN(cond, bar) do { unsigned _sp = 0; while (cond) { __builtin_amdgcn_s_sleep(1); \
    if ((++_sp & 255u) == 0u) { if (xb_ld(&(bar)[XB_TMO])) break; if (_sp > XB_SPIN_CAP) { atomicAdd(&(bar)[XB_TMO], 1u); break; } } } } while (0)
struct XBar { unsigned* bar; unsigned x, nloc, nx; };
__device__ __forceinline__ void xbar_init(XBar& b, unsigned* bar) {
  b.bar = bar; b.x = xb_xcc_id(); b.nloc = 0u; b.nx = 0u;
  if (threadIdx.x == 0) (void)xb_add(&bar[XB_XCNT(b.x)], 1u);
}
__device__ __forceinline__ void xbar_sync(XBar& b) {
  asm volatile("s_waitcnt vmcnt(0)" ::: "memory");
  __syncthreads();
  if (threadIdx.x == 0) {
    unsigned* bar = b.bar;
    __builtin_amdgcn_s_waitcnt(0);
    if (b.nloc == 0u) {
      const unsigned G = gridDim.x; unsigned sum, cnt, mine, sp = 0u;
      for (;;) {
        sum = 0u; cnt = 0u; mine = 0u;
#pragma unroll
        for (unsigned j = 0; j < 16; ++j) { const unsigned c = xb_ld(&bar[XB_XCNT(j)]); sum += c; cnt += (c > 0u) ? 1u : 0u; mine = (j == b.x) ? c : mine; }
        if (sum == G) break;
        __builtin_amdgcn_s_sleep(1);
        if ((++sp & 255u) == 0u) { if (xb_ld(&bar[XB_TMO])) break; if (sp > XB_SPIN_CAP) { atomicAdd(&bar[XB_TMO], 1u); break; } }
      }
      b.nloc = mine > 0u ? mine : 1u; b.nx = cnt > 0u ? cnt : 1u;
    }
    const unsigned nloc = b.nloc, nx = b.nx;
    const unsigned old = xb_add(&bar[XB_XSUB(b.x)], 1u);
    const unsigned gen = old / nloc;
    if (old + 1u == (gen + 1u) * nloc) {
      __builtin_amdgcn_fence(__ATOMIC_RELEASE, "agent");
      asm volatile("s_waitcnt vmcnt(0)" ::: "memory");
      const unsigned og = xb_add(&bar[XB_TOP], 1u);
      const unsigned tg = og / nx;
      if (og + 1u == (tg + 1u) * nx) xb_add(&bar[XB_TOPGEN], 1u);
      else XB_SPIN(xb_ld(&bar[XB_TOPGEN]) == tg, bar);
      __builtin_amdgcn_fence(__ATOMIC_ACQUIRE, "agent");
      xb_add(&bar[XB_XGEN(b.x)], 1u);
      asm volatile("s_waitcnt vmcnt(0)" ::: "memory");
    } else {
      XB_SPIN(xb_ld(&bar[XB_XGEN(b.x)]) == gen, bar);
      __builtin_amdgcn_fence(__ATOMIC_ACQUIRE, "agent");
      asm volatile("s_waitcnt vmcnt(0)" ::: "memory");
    }
  }
  __syncthreads();
}

__global__ void __launch_bounds__(NTHR, 2) fwd_mega(Params P) {
  extern __shared__ __attribute__((aligned(16))) unsigned char lds[];
  cg::grid_group grid = cg::this_grid();
  XBar xb; xbar_init(xb, (unsigned*)(P.ws + WS_BAR));
#define GSYNC() xbar_sync(xb)
  phase0(lds, P);
  VM_WAIT(); __syncthreads(); grid.sync();
  phase1(lds, P); GSYNC();
#pragma unroll 1
  for (int l = 0; l < 2; ++l) {
    phaseA(lds, P, l); GSYNC();
    phaseB(lds, P, l); GSYNC();
    phaseB2(P, l); GSYNC();
    phaseB3(lds, P, l); GSYNC();
    phaseC(lds, P, l); GSYNC();
    phaseD(lds, P, l); GSYNC();
    phaseEF(lds, P, l, false); GSYNC();
    phaseEF(lds, P, l, true); GSYNC();
    phaseG(P, l);
    if (l == 0) GSYNC();
  }
#undef GSYNC
}

extern "C" void kernel_launch(void* const* d_in, const int* in_sizes, int n_in, void* d_out, int out_size, void* d_ws, size_t ws_size, hipStream_t stream) {
  static int grid_blocks = 0;
  if (!grid_blocks) {
    int dev = 0, cus = 0, per_cu = 0;
    (void)hipGetDevice(&dev);
    (void)hipDeviceGetAttribute(&cus, hipDeviceAttributeMultiprocessorCount, dev);
    (void)hipFuncSetAttribute((const void*)fwd_mega, hipFuncAttributeMaxDynamicSharedMemorySize, LDS_BYTES);
    (void)hipOccupancyMaxActiveBlocksPerMultiprocessor(&per_cu, fwd_mega, NTHR, LDS_BYTES);
    if (per_cu > 1) per_cu = 1;
    if (per_cu < 1) per_cu = 1;
    grid_blocks = cus * per_cu;
    if (ws_size < WS_END) fprintf(stderr, "kernel_launch: workspace too small: %zu < %zu\n", ws_size, (size_t)WS_END);
  }
  (void)hipMemsetAsync(d_ws, 0, WS_ZERO_BYTES, stream);
  Params p{};
  const float** pp = (const float**)&p;
  for (int i = 0; i < 21; ++i) pp[i] = (const float*)d_in[i];
  p.out = (float*)d_out; p.ws = (unsigned char*)d_ws;
  void* args[] = {&p};
  hipError_t e = hipLaunchCooperativeKernel((void*)fwd_mega, dim3(grid_blocks), dim3(NTHR), args, LDS_BYTES, stream);
  if (e != hipSuccess) fprintf(stderr, "cooperative launch failed: %s (grid %d)\n", hipGetErrorString(e), grid_blocks);
}
```

```cpp
#include <hip/hip_runtime.h>
#include <hip/hip_cooperative_groups.h>
#include <cstdio>
#include <cstdint>
namespace cg = cooperative_groups;

typedef unsigned short bf16;
typedef short bf16x8 __attribute__((ext_vector_type(8)));
typedef short s16x4 __attribute__((ext_vector_type(4)));
typedef float f32x4 __attribute__((ext_vector_type(4)));
typedef float f32x2 __attribute__((ext_vector_type(2)));
typedef unsigned u32x4 __attribute__((ext_vector_type(4)));
typedef unsigned u32x2 __attribute__((ext_vector_type(2)));
typedef __bf16 bf2_t __attribute__((ext_vector_type(2)));
#define LAS __attribute__((address_space(3)))
constexpr int NTHR = 512;
constexpr int LDS_BYTES = 147456;
constexpr int LDS_MISC = 131072;

constexpr int D = 1024, NSEQ = 8192, CL = 256, NT_TOK = NSEQ + CL, NLAT = 2 * NSEQ, NROWS = NLAT + 2 * CL;
constexpr int INC = 2944, NSLOT = 46;
constexpr float EPS = 1e-6f;
constexpr float LOG2E = 1.4426950408889634f;
constexpr float QSCALE = 0.125f * LOG2E;
constexpr int S_AQ = 0, S_AK = 6, S_AV = 8, S_NQ = 10, S_NK = 14, S_NV = 18, S_RQ = 22, S_RK = 28, S_RV = 34, S_RG = 40;

constexpr size_t WS_BAR = 0;
constexpr size_t WS_CNT = 16384;
constexpr size_t WS_ZERO_BYTES = 16384 + 4096;
constexpr size_t WS_MOD = WS_ZERO_BYTES;
constexpr size_t WS_BIAS = WS_MOD + 2 * 3 * 6144 * 4;
constexpr size_t WS_ROPE = WS_BIAS + 2 * 3 * 2944 * 4;
constexpr size_t WS_RSS = WS_ROPE + 128 * 16 * 2 * 4;
constexpr size_t WS_WR = WS_RSS + 16896 * 4;
constexpr size_t WS_CR = WS_WR + 2 * 3 * 1024 * 16 * 4;
constexpr size_t WS_GATEW = WS_CR + 4096;
constexpr size_t WS_LIST = WS_GATEW + 16896 * 2 * 4;
constexpr size_t WS_WIN = (WS_LIST + (size_t)2 * 16 * 16896 * 4 + 4095) / 4096 * 4096;
constexpr size_t WS_WO = WS_WIN + (size_t)2 * 2944 * 1024 * 2;
constexpr size_t WS_W13 = WS_WO + (size_t)2 * 1024 * 1024 * 2;
constexpr size_t WS_W2 = WS_W13 + (size_t)32 * 1024 * 1024 * 2;
constexpr size_t WS_XR = WS_W2 + (size_t)32 * 1024 * 512 * 2;
constexpr size_t WS_R1 = WS_XR + (size_t)NROWS * 1024 * 4;
constexpr size_t WS_Z = WS_R1 + (size_t)NROWS * 1024 * 2;
constexpr size_t WS_END = WS_Z + (size_t)2 * NSLOT * NT_TOK * 64 * 2;
constexpr size_t S_OFF = (size_t)34 << 20;
constexpr size_t Z_YM1 = 0, Z_ACT = (size_t)NROWS * 1024 * 2;
static_assert(Z_ACT + (size_t)(2 * NROWS + 128) * 512 * 2 <= (size_t)2 * NSLOT * NT_TOK * 64 * 2, "act overlay");
static_assert((size_t)2 * 6 * 2 * 66 * 4096 * 4 <= (size_t)NROWS * 1024 * 2, "U overlay");

struct Params {
  const float *x, *c, *ctx, *c_ctx, *w_ada, *b_ada, *n1g, *n2g, *w_in, *qg, *kg, *rpb, *ret_decay, *mix_g, *w_out, *w_router, *b_router, *w1, *w3, *w2, *final_g;
  float* out; unsigned char* ws;
};

__device__ __forceinline__ unsigned pk2(float lo, float hi) { f32x2 v = {lo, hi}; bf2_t b = __builtin_convertvector(v, bf2_t); return __builtin_bit_cast(unsigned, b); }
__device__ __forceinline__ float bflo(unsigned u) { return __builtin_bit_cast(float, u << 16); }
__device__ __forceinline__ float bfhi(unsigned u) { return __builtin_bit_cast(float, u & 0xffff0000u); }
__device__ __forceinline__ float wsum(float v) {
#pragma unroll
  for (int o = 1; o < 64; o <<= 1) v += __shfl_xor(v, o);
  return v;
}
__device__ __forceinline__ float silu_f(float v) { return v / (1.f + __expf(-v)); }
__device__ __forceinline__ int lds_swz(int row, int chunk) { return row * 128 + ((chunk ^ ((row >> 1) & 7)) << 4); }
#define VM_WAIT() asm volatile("s_waitcnt vmcnt(0)" ::: "memory")
__device__ __forceinline__ int get_tid() { int t = threadIdx.x; asm volatile("" : "+v"(t)); return t; }

template <int R, int NW>
__device__ __forceinline__ void stage_rows(unsigned char* lds, int dst, const bf16* src, int ld, int wl, int lane) {
#pragma unroll
  for (int i = 0; i < R / (8 * NW); ++i) {
    const int q = wl + NW * i, row = q * 8 + (lane >> 3), ch = (lane & 7) ^ ((row >> 1) & 7);
    __builtin_amdgcn_global_load_lds((const void*)(src + (size_t)row * ld + ch * 8), (LAS void*)(lds + dst + q * 1024), 16, 0, 0);
  }
}
#define VMCNT(n) asm volatile("s_waitcnt vmcnt(" #n ")" ::: "memory")
#define LGKM0() asm volatile("s_waitcnt lgkmcnt(0)" ::: "memory")
#define RAW_BAR() __builtin_amdgcn_s_barrier()
__device__ __forceinline__ bf16x8 lds_frag(const unsigned char* lds, int off) { return *(const bf16x8*)(lds + off); }
__device__ __forceinline__ bf16x8 lds_tr2(unsigned char* lds, int off0, int off1) {
  s16x4 a = __builtin_amdgcn_ds_read_tr16_b64_v4i16((LAS s16x4*)(lds + off0));
  s16x4 b = __builtin_amdgcn_ds_read_tr16_b64_v4i16((LAS s16x4*)(lds + off1));
  return __builtin_shufflevector(a, b, 0, 1, 2, 3, 4, 5, 6, 7);
}

template <int MT, int NT, int ST> struct GStep {
  static __device__ __forceinline__ void run(f32x4 (&acc)[MT][NT], bf16x8 (&W0)[NT], bf16x8 (&W1)[NT], bf16x8 (&X)[2 * MT], const unsigned char* base, int xoff, int woff) {
    constexpr int S = 2 * MT, kk = ST / MT, mt = ST % MT;
#pragma unroll
    for (int nt = 0; nt < NT; ++nt) acc[mt][nt] = __builtin_amdgcn_mfma_f32_16x16x32_bf16(kk ? W1[nt] : W0[nt], X[ST], acc[mt][nt], 0, 0, 0);
    __builtin_amdgcn_sched_group_barrier(0x008, NT, 0);
    if constexpr (ST + 2 < S) { constexpr int k2 = (ST + 2) / MT, m2 = (ST + 2) % MT; X[ST + 2] = lds_frag(base, (xoff + m2 * 2048) ^ (k2 << 6)); }
    if constexpr (ST < NT) W1[ST] = lds_frag(base, (woff + ST * 2048) ^ 64);
    constexpr int nds = (ST + 2 < S ? 1 : 0) + (ST < NT ? 1 : 0);
    if constexpr (nds > 0) __builtin_amdgcn_sched_group_barrier(0x100, nds, 0);
    if constexpr (ST + 1 < S) GStep<MT, NT, ST + 1>::run(acc, W0, W1, X, base, xoff, woff);
  }
};

template <int MT, int NT, class ARow, class Epi>
__device__ __forceinline__ void gemm_tile(unsigned char* lds, const ARow& arow, const bf16* __restrict__ Bt, int K, int m0, int n0, const Epi& epi,
                                          bool staged0 = false, bool hasnext = false, const ARow* narow = nullptr, const bf16* nBt = nullptr, int nn0 = 0) {
  const int tid = get_tid(), lane = tid & 63, w = __builtin_amdgcn_readfirstlane(tid >> 6);
  const int wr = w >> 2, wc = w & 3, g = lane >> 4, li = lane & 15;
  constexpr int NA = MT / 2, NB = NT;
  const bf16* ap[NA]; const bf16* bp[NB];
#pragma unroll
  for (int i = 0; i < NA; ++i) { const int q = w + 8 * i, row = q * 8 + (lane >> 3), ch = (lane & 7) ^ ((row >> 1) & 7); ap[i] = arow(row) + ch * 8; }
#pragma unroll
  for (int i = 0; i < NB; ++i) { const int q = w + 8 * i, row = q * 8 + (lane >> 3), ch = (lane & 7) ^ ((row >> 1) & 7); bp[i] = Bt + (size_t)(n0 + row) * K + ch * 8; }
  f32x4 acc[MT][NT];
#pragma unroll
  for (int a = 0; a < MT; ++a)
#pragma unroll
    for (int b = 0; b < NT; ++b) acc[a][b] = (f32x4){0.f, 0.f, 0.f, 0.f};
  const int f = (li >> 1) & 7;
  const int xoff = (wr * (MT * 16) + li) * 128 + ((g ^ f) << 4);
  const int woff = 32768 + (wc * (NT * 16) + li) * 128 + ((g ^ f) << 4);
  const int nk = K >> 6;
#define GT_STAGE(s, k0) do { _Pragma("unroll") for (int i = 0; i < NA; ++i) \
    __builtin_amdgcn_global_load_lds((const void*)(ap[i] + (k0)), (LAS void*)(lds + (s) * 65536 + (w + 8 * i) * 1024), 16, 0, 0); \
    _Pragma("unroll") for (int i = 0; i < NB; ++i) \
    __builtin_amdgcn_global_load_lds((const void*)(bp[i] + (k0)), (LAS void*)(lds + (s) * 65536 + 32768 + (w + 8 * i) * 1024), 16, 0, 0); } while (0)
  if (!staged0) GT_STAGE(0, 0);
  VM_WAIT(); __syncthreads();
  for (int t = 0; t < nk; ++t) {
    const int s = t & 1;
    if (t + 1 < nk) GT_STAGE(s ^ 1, (t + 1) * 64);
    const unsigned char* base = lds + s * 65536;
    {
      bf16x8 W0[NT], W1[NT], X[2 * MT];
#pragma unroll
      for (int nt = 0; nt < NT; ++nt) W0[nt] = lds_frag(base, woff + nt * 2048);
      X[0] = lds_frag(base, xoff); X[1] = lds_frag(base, xoff + 2048);
      __builtin_amdgcn_sched_group_barrier(0x100, NT + 2, 0);
      GStep<MT, NT, 0>::run(acc, W0, W1, X, base, xoff, woff);
    }
    VM_WAIT(); __syncthreads();
  }
  if (hasnext) {
#pragma unroll
    for (int i = 0; i < NA; ++i) { const int q = w + 8 * i, row = q * 8 + (lane >> 3), ch = (lane & 7) ^ ((row >> 1) & 7); ap[i] = (*narow)(row) + ch * 8; }
#pragma unroll
    for (int i = 0; i < NB; ++i) { const int q = w + 8 * i, row = q * 8 + (lane >> 3), ch = (lane & 7) ^ ((row >> 1) & 7); bp[i] = nBt + (size_t)(nn0 + row) * K + ch * 8; }
    GT_STAGE(0, 0);
  }
#undef GT_STAGE
  epi(acc, m0 + wr * (MT * 16), n0 + wc * (NT * 16), g, li);
}

struct ARowLinear { const bf16* A; int K; int m0; __device__ __forceinline__ const bf16* operator()(int r) const { return A + (size_t)(m0 + r) * K; } };

template <int MT, int NT>
struct EpiInProj {
  const float* rowss; const float* biasp; const float* qg; const float* kg; const float* rope  ; bf16* Z;
  __device__ __forceinline__ void operator()(f32x4 (&acc)[MT][NT], int mw, int nw, int g, int li) const {
    int b, seg, tokbase; bool latent;
    if (mw < NLAT) { b = mw >> 13; seg = b; tokbase = (mw & 8191); latent = true; }
    else { const int mc = mw - NLAT; b = mc >> 8; seg = 2; tokbase = NSEQ + (mc & 255); latent = false; }
    const int s = nw >> 6, coff = nw & 63;
    bf16* zb = Z + ((size_t)(b * NSLOT + s) * NT_TOK) * 64 + coff;
    float rss[MT];
#pragma unroll
    for (int mt = 0; mt < MT; ++mt) rss[mt] = rowss[mw + mt * 16 + li];
    f32x4 bv[NT], gvv[NT];
#pragma unroll
    for (int nt = 0; nt < NT; ++nt) bv[nt] = *(const f32x4*)(biasp + seg * INC + nw + nt * 16 + 4 * g);
    if (NT == 4 && s < 8) {
      const float* gn = (s < 6) ? qg : kg;
#pragma unroll
      for (int nt = 0; nt < NT; ++nt) gvv[nt] = *(const f32x4*)(gn + nt * 16 + 4 * g);
    } else {
#pragma unroll
      for (int nt = 0; nt < NT; ++nt) gvv[nt] = (f32x4){1.f, 1.f, 1.f, 1.f};
    }
#pragma unroll
    for (int mt = 0; mt < MT; ++mt) {
      const int tok = tokbase + mt * 16 + li;
      const float irms = rsqrtf(rss[mt] * (1.f / 1024.f) + EPS);
      f32x4 v[NT];
#pragma unroll
      for (int nt = 0; nt < NT; ++nt) v[nt] = acc[mt][nt] * irms + bv[nt];
      if constexpr (NT == 4) {
        if (s < 8) {
          float ss = 0.f;
#pragma unroll
          for (int nt = 0; nt < 4; ++nt) ss += v[nt][0] * v[nt][0] + v[nt][1] * v[nt][1] + v[nt][2] * v[nt][2] + v[nt][3] * v[nt][3];
          ss += __shfl_xor(ss, 16); ss += __shfl_xor(ss, 32);
          const float r = rsqrtf(ss * (1.f / 64.f) + EPS) * (s < 6 ? QSCALE : 1.f);
#pragma unroll
          for (int nt = 0; nt < 4; ++nt) v[nt] = v[nt] * r * gvv[nt];
          if (latent) {
            const int pr = tok >> 6, pc = tok & 63;
            const f32x4 r0 = *(const f32x4*)(rope + (pr * 16 + 4 * g) * 2), r1 = *(const f32x4*)(rope + (pr * 16 + 4 * g) * 2 + 4);
            const f32x4 c0 = *(const f32x4*)(rope + (pc * 16 + 4 * g) * 2), c1 = *(const f32x4*)(rope + (pc * 16 + 4 * g) * 2 + 4);
            const float cr_[4] = {r0[0], r0[2], r1[0], r1[2]}, sr_[4] = {r0[1], r0[3], r1[1], r1[3]};
            const float cc_[4] = {c0[0], c0[2], c1[0], c1[2]}, sc_[4] = {c0[1], c0[3], c1[1], c1[3]};
#pragma unroll
            for (int j = 0; j < 4; ++j) {
              const float t1 = v[0][j], t2 = v[1][j]; v[0][j] = t1 * cr_[j] - t2 * sr_[j]; v[1][j] = t2 * cr_[j] + t1 * sr_[j];
              const float u1 = v[2][j], u2 = v[3][j]; v[2][j] = u1 * cc_[j] - u2 * sc_[j]; v[3][j] = u2 * cc_[j] + u1 * sc_[j];
            }
          }
        }
      }
      if (s >= S_NQ && s < S_NK) {
#pragma unroll
        for (int nt = 0; nt < NT; ++nt) v[nt] = v[nt] * QSCALE;
      } else if (s >= S_RK && s < S_RV) {
#pragma unroll
        for (int nt = 0; nt < NT; ++nt) v[nt] = v[nt] * 0.125f;
      } else if (s >= S_RG) {
#pragma unroll
        for (int nt = 0; nt < NT; ++nt)
#pragma unroll
          for (int j = 0; j < 4; ++j) v[nt][j] = silu_f(v[nt][j]);
      }
#pragma unroll
      for (int nt = 0; nt < NT; ++nt) { u32x2 o; o.x = pk2(v[nt][0], v[nt][1]); o.y = pk2(v[nt][2], v[nt][3]); *(u32x2*)(zb + (size_t)tok * 64 + nt * 16 + 4 * g) = o; }
    }
  }
};

struct EpiOutProj {
  const float* xlat; const float* xctx; const float* mod; float* XR;
  __device__ __forceinline__ void operator()(f32x4 (&acc)[8][4], int mw, int nw, int g, int li) const {
    const int seg = (mw < NLAT) ? (mw >> 13) : 2;
    const float* gt = mod + seg * 6144 + 2048;
    f32x4 gv[4];
#pragma unroll
    for (int nt = 0; nt < 4; ++nt) gv[nt] = *(const f32x4*)(gt + nw + nt * 16 + 4 * g);
    const float* xbase = (mw < NLAT) ? (xlat + (size_t)mw * D) : (xctx + (size_t)(mw - NLAT) * D);
#pragma unroll
    for (int mb = 0; mb < 8; mb += 2) {
      f32x4 xv[2][4];
#pragma unroll
      for (int u = 0; u < 2; ++u)
#pragma unroll
        for (int nt = 0; nt < 4; ++nt) xv[u][nt] = *(const f32x4*)(xbase + (size_t)((mb + u) * 16 + li) * D + nw + nt * 16 + 4 * g);
#pragma unroll
      for (int u = 0; u < 2; ++u)
#pragma unroll
        for (int nt = 0; nt < 4; ++nt) *(f32x4*)(XR + (size_t)(mw + (mb + u) * 16 + li) * D + nw + nt * 16 + 4 * g) = xv[u][nt] + gv[nt] * acc[mb + u][nt];
    }
  }
};

struct EpiMoeUp {
  bf16* act; int slot0; int nvalid;
  __device__ __forceinline__ void operator()(f32x4 (&acc)[4][4], int mw, int nw, int g, int li) const {
#pragma unroll
    for (int mt = 0; mt < 4; ++mt) {
      const int r = mw + mt * 16 + li;
      if (r < nvalid) {
#pragma unroll
        for (int u = 0; u < 2; ++u) {
          const int hid = (nw >> 1) + u * 16 + 4 * g;
          const f32x4 a1 = acc[mt][2 * u], a3 = acc[mt][2 * u + 1];
          u32x2 o; o.x = pk2(silu_f(a1[0]) * a3[0], silu_f(a1[1]) * a3[1]); o.y = pk2(silu_f(a1[2]) * a3[2], silu_f(a1[3]) * a3[3]);
          *(u32x2*)(act + (size_t)(slot0 + r) * 512 + hid) = o;
        }
      }
    }
  }
};

struct EpiMoeDown {
  const int* list; const float* gatew; bf16* ym0; bf16* ym1; int nvalid;
  __device__ __forceinline__ void operator()(f32x4 (&acc)[4][4], int mw, int nw, int g, int li) const {
    int ent[4]; float gw[4];
#pragma unroll
    for (int mt = 0; mt < 4; ++mt) { const int r = mw + mt * 16 + li; ent[mt] = list[r < nvalid ? r : nvalid - 1]; }
#pragma unroll
    for (int mt = 0; mt < 4; ++mt) gw[mt] = gatew[ent[mt]];
#pragma unroll
    for (int mt = 0; mt < 4; ++mt) {
      const int r = mw + mt * 16 + li;
      if (r < nvalid) {
        bf16* y = ((ent[mt] & 1) ? ym1 : ym0) + (size_t)(ent[mt] >> 1) * D;
#pragma unroll
        for (int nt = 0; nt < 4; ++nt) {
          const int n = nw + nt * 16 + 4 * g;
          u32x2 o; o.x = pk2(acc[mt][nt][0] * gw[mt], acc[mt][nt][1] * gw[mt]); o.y = pk2(acc[mt][nt][2] * gw[mt], acc[mt][nt][3] * gw[mt]);
          *(u32x2*)(y + n) = o;
        }
      }
    }
  }
};

struct ARowGather { const bf16* H; const int* list; int nvalid; __device__ __forceinline__ const bf16* operator()(int r) const { const int rr = r < nvalid ? r : nvalid - 1; return H + (size_t)(list[rr] >> 1) * D; } };
struct ARowAct { const bf16* act; int slot0; __device__ __forceinline__ const bf16* operator()(int r) const { int s = slot0 + r; s = s < 2 * NROWS ? s : 2 * NROWS - 1; return act + (size_t)s * 512; } };

template <int NQB, bool NAM, int NW>
__device__ __forceinline__ void attn_item(unsigned char* lds, int gb, int wl, int lane, const bf16* zb, int sq0, int sk, int sv, int qtok0, int lat0, int nlat, int ntiles,
                                          int drbase, bf16* Y, size_t yrow0, int ycol0, const float* mixg) {
  const int g = lane >> 4, li = lane & 15;
  const int qtok = qtok0 + 16 * wl + li;
  bf16x8 qf[NQB][2];
#pragma unroll
  for (int qb = 0; qb < NQB; ++qb)
#pragma unroll
    for (int kk = 0; kk < 2; ++kk) qf[qb][kk] = *(const bf16x8*)(zb + ((size_t)(sq0 + qb) * NT_TOK + qtok) * 64 + kk * 32 + g * 8);
  const bf16* kbp = zb + (size_t)sk * NT_TOK * 64;
  const bf16* vbp = zb + (size_t)sv * NT_TOK * 64;
  f32x4 O[4][NQB], L[NQB];
  const bf16x8 ones = {0x3f80, 0x3f80, 0x3f80, 0x3f80, 0x3f80, 0x3f80, 0x3f80, 0x3f80};
#pragma unroll
  for (int qb = 0; qb < NQB; ++qb) { L[qb] = (f32x4){0.f, 0.f, 0.f, 0.f};
#pragma unroll
    for (int db = 0; db < 4; ++db) O[db][qb] = (f32x4){0.f, 0.f, 0.f, 0.f}; }
  const int f = (li >> 1) & 7;
  const int koff = li * 128 + ((g ^ f) << 4);
  const int q_ = li >> 2, p_ = li & 3, fv = (2 * g + (q_ >> 1)) & 7;
  const int voff = (4 * g + q_) * 128 + (p_ & 1) * 8;
  const float* rpbt = (const float*)(lds + gb + 49152);
  const int qc = 16 * wl + li;
  int cs = qc - 8; cs = cs < 0 ? 0 : (cs > 48 ? 48 : cs);
#define AT_TOK(t) ((t) < nlat ? lat0 + 64 * (t) : NSEQ + 64 * ((t) - nlat))
#define AT_STAGE(t, bi) do { const int tk_ = AT_TOK(t); stage_rows<64, NW>(lds, gb + (bi) * 16384, kbp + (size_t)tk_ * 64, 64, wl, lane); \
                             stage_rows<64, NW>(lds, gb + (bi) * 16384 + 8192, vbp + (size_t)tk_ * 64, 64, wl, lane); } while (0)
#define AT_WAIT1() do { if (NW == 8) VMCNT(2); else VMCNT(4); } while (0)
  AT_STAGE(0, 0);
  if (ntiles > 1) { AT_STAGE(1, 1); AT_WAIT1(); } else { VMCNT(0); }
  RAW_BAR();
  int cur = 0;
  for (int t = 0; t < ntiles; ++t) {
    const int kb_off = gb + cur * 16384, vb_off = kb_off + 8192;
    const int pfb = cur == 0 ? 2 : cur - 1;
    if (t + 2 < ntiles) AT_STAGE(t + 2, pfb);
#pragma unroll
    for (int ks = 0; ks < 2; ++ks) {
      f32x4 s[2][NQB];
#pragma unroll
      for (int h2 = 0; h2 < 2; ++h2) {
#pragma unroll
        for (int qb = 0; qb < NQB; ++qb) s[h2][qb] = (f32x4){0.f, 0.f, 0.f, 0.f};
#pragma unroll
        for (int kk = 0; kk < 2; ++kk) {
          const bf16x8 kf = lds_frag(lds, kb_off + (((2 * ks + h2) * 2048 + koff) ^ (kk << 6)));
#pragma unroll
          for (int qb = 0; qb < NQB; ++qb) s[h2][qb] = __builtin_amdgcn_mfma_f32_16x16x32_bf16(kf, qf[qb][kk], s[h2][qb], 0, 0, 0);
        }
      }
      bf16x8 pf[NQB];
#pragma unroll
      for (int qb = 0; qb < NQB; ++qb) {
        float p[8];
#pragma unroll
        for (int h2 = 0; h2 < 2; ++h2)
#pragma unroll
          for (int j = 0; j < 4; ++j) {
            float x = s[h2][qb][j];
            if (NAM) {
              if (t < nlat) {
                const int kc = (2 * ks + h2) * 16 + 4 * g + j;
                const bool valid = (kc >= cs) && (kc < cs + 16);
                int dc = kc - qc + 15; dc = dc < 0 ? 0 : (dc > 30 ? 30 : dc);
                x += rpbt[(drbase + t) * 31 + dc];
                x = valid ? x : -1e30f;
              }
            }
            const float e = __builtin_amdgcn_exp2f(x);
            p[h2 * 4 + j] = e;
          }
        u32x4 pw; pw.x = pk2(p[0], p[1]); pw.y = pk2(p[2], p[3]); pw.z = pk2(p[4], p[5]); pw.w = pk2(p[6], p[7]);
        pf[qb] = __builtin_bit_cast(bf16x8, pw);
        L[qb] = __builtin_amdgcn_mfma_f32_16x16x32_bf16(ones, pf[qb], L[qb], 0, 0, 0);
      }
#pragma unroll
      for (int db = 0; db < 4; ++db) {
        const int a0 = vb_off + ks * 4096 + voff + (((db * 2 + (p_ >> 1)) ^ fv) << 4);
        const bf16x8 vf = lds_tr2(lds, a0, a0 + 2048);
#pragma unroll
        for (int qb = 0; qb < NQB; ++qb) O[db][qb] = __builtin_amdgcn_mfma_f32_16x16x32_bf16(vf, pf[qb], O[db][qb], 0, 0, 0);
      }
    }
    if (t + 2 < ntiles) { AT_WAIT1(); } else { VMCNT(0); }
    LGKM0(); RAW_BAR();
    cur = cur == 2 ? 0 : cur + 1;
  }
#undef AT_TOK
#undef AT_STAGE
#undef AT_WAIT1
#pragma unroll
  for (int qb = 0; qb < NQB; ++qb) {
    const float inv = 1.f / L[qb][0];
    float ss = 0.f;
#pragma unroll
    for (int db = 0; db < 4; ++db) { O[db][qb] = O[db][qb] * inv; ss += O[db][qb][0] * O[db][qb][0] + O[db][qb][1] * O[db][qb][1] + O[db][qb][2] * O[db][qb][2] + O[db][qb][3] * O[db][qb][3]; }
    ss += __shfl_xor(ss, 16); ss += __shfl_xor(ss, 32);
    const float r = rsqrtf(ss * (1.f / 64.f) + EPS);
    bf16* yp = Y + (yrow0 + 16 * wl + li) * D + ycol0 + qb * 64;
#pragma unroll
    for (int db = 0; db < 4; ++db) {
      const f32x4 gv = *(const f32x4*)(mixg + ycol0 + qb * 64 + db * 16 + 4 * g);
      const f32x4 y = O[db][qb] * r * gv;
      u32x2 o; o.x = pk2(y[0], y[1]); o.y = pk2(y[2], y[3]);
      *(u32x2*)(yp + db * 16 + 4 * g) = o;
    }
  }
}

__device__ __forceinline__ void ret_u_item(unsigned char* lds, int gb, int tg, const bf16* zb, int h, int c, float lgf2, float lgb2, float* Uf, float* Ub) {
  const int lane = tg & 63, w = __builtin_amdgcn_readfirstlane(tg >> 6), g = lane >> 4, li = lane & 15;
  const int tok0 = c < 2 ? NSEQ + 128 * c : 128 * (c - 2);
  const bf16* kp = zb + ((size_t)(S_RK + h) * NT_TOK + tok0) * 64;
  const bf16* vp = zb + ((size_t)(S_RV + h) * NT_TOK + tok0) * 64;
  stage_rows<128, 4>(lds, gb, kp, 64, w, lane);
  {
    const int row = tg >> 1, half = tg & 1;
    const float wf = __builtin_amdgcn_exp2f(lgf2 * (float)(127 - row)), wb = __builtin_amdgcn_exp2f(lgb2 * (float)row);
#pragma unroll
    for (int c4 = 0; c4 < 4; ++c4) {
      const int chunk = half * 4 + c4;
      const u32x4 v = *(const u32x4*)(vp + (size_t)row * 64 + chunk * 8);
      u32x4 of, ob;
#pragma unroll
      for (int i = 0; i < 4; ++i) { const float lo = bflo(v[i]), hi = bfhi(v[i]); of[i] = pk2(lo * wf, hi * wf); ob[i] = pk2(lo * wb, hi * wb); }
      *(u32x4*)(lds + gb + 16384 + lds_swz(row, chunk)) = of;
      *(u32x4*)(lds + gb + 32768 + lds_swz(row, chunk)) = ob;
    }
  }
  VM_WAIT(); __syncthreads();
  const int q_ = li >> 2, p_ = li & 3, fv = (2 * g + (q_ >> 1)) & 7;
  const int toff = gb + (4 * g + q_) * 128 + (p_ & 1) * 8;
  f32x4 acc[2][4];
#pragma unroll
  for (int d_ = 0; d_ < 2; ++d_)
#pragma unroll
    for (int eb = 0; eb < 4; ++eb) acc[d_][eb] = (f32x4){0.f, 0.f, 0.f, 0.f};
#pragma unroll
  for (int ks = 0; ks < 4; ++ks) {
    const int a0 = ks * 4096 + toff + (((w * 2 + (p_ >> 1)) ^ fv) << 4);
    const bf16x8 kf = lds_tr2(lds, a0, a0 + 2048);
#pragma unroll
    for (int eb = 0; eb < 4; ++eb) {
      const int b0 = ks * 4096 + toff + (((eb * 2 + (p_ >> 1)) ^ fv) << 4);
      const bf16x8 vf = lds_tr2(lds, 16384 + b0, 16384 + b0 + 2048);
      const bf16x8 vb = lds_tr2(lds, 32768 + b0, 32768 + b0 + 2048);
      acc[0][eb] = __builtin_amdgcn_mfma_f32_16x16x32_bf16(kf, vf, acc[0][eb], 0, 0, 0);
      acc[1][eb] = __builtin_amdgcn_mfma_f32_16x16x32_bf16(kf, vb, acc[1][eb], 0, 0, 0);
    }
  }
#pragma unroll
  for (int eb = 0; eb < 4; ++eb) {
    *(f32x4*)(Uf + (eb * 16 + li) * 64 + w * 16 + 4 * g) = acc[0][eb];
    *(f32x4*)(Ub + (eb * 16 + li) * 64 + w * 16 + 4 * g) = acc[1][eb];
  }
  __syncthreads();
}

__device__ __forceinline__ void ret_out_item(unsigned char* lds, int gb, int tg, const bf16* zb, int h, int c, float lgf2, float lgb2, const float* Sf, const float* Sb,
                                             bf16* Y, size_t yrow0, const float* mixg) {
  const int lane = tg & 63, w = __builtin_amdgcn_readfirstlane(tg >> 6), g = lane >> 4, li = lane & 15;
  const int tok0 = c < 2 ? NSEQ + 128 * c : 128 * (c - 2);
  const bf16* qp = zb + ((size_t)(S_RQ + h) * NT_TOK + tok0) * 64;
  const bf16* kp = zb + ((size_t)(S_RK + h) * NT_TOK + tok0) * 64;
  const bf16* vp = zb + ((size_t)(S_RV + h) * NT_TOK + tok0) * 64;
  const bf16* gp = zb + ((size_t)(S_RG + h) * NT_TOK + tok0) * 64;
  stage_rows<128, 4>(lds, gb, kp, 64, w, lane);
  stage_rows<128, 4>(lds, gb + 16384, vp, 64, w, lane);
  {
    const int e = tg >> 2, dq = tg & 3;
#pragma unroll
    for (int hh = 0; hh < 2; ++hh) {
      const f32x4 a0 = *(const f32x4*)(Sf + e * 64 + dq * 16 + hh * 8), a1 = *(const f32x4*)(Sf + e * 64 + dq * 16 + hh * 8 + 4);
      const f32x4 b0 = *(const f32x4*)(Sb + e * 64 + dq * 16 + hh * 8), b1 = *(const f32x4*)(Sb + e * 64 + dq * 16 + hh * 8 + 4);
      u32x4 oa, ob; oa.x = pk2(a0[0], a0[1]); oa.y = pk2(a0[2], a0[3]); oa.z = pk2(a1[0], a1[1]); oa.w = pk2(a1[2], a1[3]);
      ob.x = pk2(b0[0], b0[1]); ob.y = pk2(b0[2], b0[3]); ob.z = pk2(b1[0], b1[1]); ob.w = pk2(b1[2], b1[3]);
      *(u32x4*)(lds + gb + 32768 + lds_swz(e, dq * 2 + hh)) = oa;
      *(u32x4*)(lds + gb + 40960 + lds_swz(e, dq * 2 + hh)) = ob;
    }
  }
  bf16x8 qf[2][2];
#pragma unroll
  for (int ib = 0; ib < 2; ++ib)
#pragma unroll
    for (int kk = 0; kk < 2; ++kk) qf[ib][kk] = *(const bf16x8*)(qp + (size_t)(32 * w + 16 * ib + li) * 64 + kk * 32 + g * 8);
  VM_WAIT(); __syncthreads();
  const int f = (li >> 1) & 7;
  const int koff = gb + li * 128 + ((g ^ f) << 4);
  const int q_ = li >> 2, p_ = li & 3, fv = (2 * g + (q_ >> 1)) & 7;
  const int voff = gb + 16384 + (4 * g + q_) * 128 + (p_ & 1) * 8;
  f32x4 O[4][2], CF[4][2], CB[4][2];
#pragma unroll
  for (int eb = 0; eb < 4; ++eb)
#pragma unroll
    for (int ib = 0; ib < 2; ++ib) { O[eb][ib] = (f32x4){0.f, 0.f, 0.f, 0.f}; CF[eb][ib] = O[eb][ib]; CB[eb][ib] = O[eb][ib]; }
#pragma unroll
  for (int ks = 0; ks < 4; ++ks) {
    f32x4 s[2][2];
#pragma unroll
    for (int h2 = 0; h2 < 2; ++h2) {
      s[h2][0] = (f32x4){0.f, 0.f, 0.f, 0.f}; s[h2][1] = s[h2][0];
#pragma unroll
      for (int kk = 0; kk < 2; ++kk) {
        const bf16x8 kf = lds_frag(lds, ((2 * ks + h2) * 2048 + koff) ^ (kk << 6));
        s[h2][0] = __builtin_amdgcn_mfma_f32_16x16x32_bf16(kf, qf[0][kk], s[h2][0], 0, 0, 0);
        s[h2][1] = __builtin_amdgcn_mfma_f32_16x16x32_bf16(kf, qf[1][kk], s[h2][1], 0, 0, 0);
      }
    }
    bf16x8 pf[2];
#pragma unroll
    for (int ib = 0; ib < 2; ++ib) {
      const int i = 32 * w + 16 * ib + li;
      float p[8];
#pragma unroll
      for (int h2 = 0; h2 < 2; ++h2)
#pragma unroll
        for (int j = 0; j < 4; ++j) {
          const int jj = (2 * ks + h2) * 16 + 4 * g + j, df = i - jj;
          const float dw = df > 0 ? __builtin_amdgcn_exp2f(lgf2 * (float)df) : (df < 0 ? __builtin_amdgcn_exp2f(lgb2 * (float)(-df)) : 2.f);
          p[h2 * 4 + j] = s[h2][ib][j] * dw;
        }
      u32x4 pw; pw.x = pk2(p[0], p[1]); pw.y = pk2(p[2], p[3]); pw.z = pk2(p[4], p[5]); pw.w = pk2(p[6], p[7]);
      pf[ib] = __builtin_bit_cast(bf16x8, pw);
    }
#pragma unroll
    for (int eb = 0; eb < 4; ++eb) {
      const int a0 = voff + ks * 4096 + (((eb * 2 + (p_ >> 1)) ^ fv) << 4);
      const bf16x8 vf = lds_tr2(lds, a0, a0 + 2048);
      O[eb][0] = __builtin_amdgcn_mfma_f32_16x16x32_bf16(vf, pf[0], O[eb][0], 0, 0, 0);
      O[eb][1] = __builtin_amdgcn_mfma_f32_16x16x32_bf16(vf, pf[1], O[eb][1], 0, 0, 0);
    }
  }
#pragma unroll
  for (int kk = 0; kk < 2; ++kk)
#pragma unroll
    for (int eb = 0; eb < 4; ++eb) {
      const bf16x8 sf = lds_frag(lds, 32768 + ((eb * 2048 + koff) ^ (kk << 6)));
      const bf16x8 sb = lds_frag(lds, 40960 + ((eb * 2048 + koff) ^ (kk << 6)));
#pragma unroll
      for (int ib = 0; ib < 2; ++ib) {
        CF[eb][ib] = __builtin_amdgcn_mfma_f32_16x16x32_bf16(sf, qf[ib][kk], CF[eb][ib], 0, 0, 0);
        CB[eb][ib] = __builtin_amdgcn_mfma_f32_16x16x32_bf16(sb, qf[ib][kk], CB[eb][ib], 0, 0, 0);
      }
    }
#pragma unroll
  for (int ib = 0; ib < 2; ++ib) {
    const int i = 32 * w + 16 * ib + li;
    const float xf = __builtin_amdgcn_exp2f(lgf2 * (float)(i + 1)), xb = __builtin_amdgcn_exp2f(lgb2 * (float)(128 - i));
    float ss = 0.f;
#pragma unroll
    for (int eb = 0; eb < 4; ++eb) { O[eb][ib] = O[eb][ib] + CF[eb][ib] * xf + CB[eb][ib] * xb; ss += O[eb][ib][0] * O[eb][ib][0] + O[eb][ib][1] * O[eb][ib][1] + O[eb][ib][2] * O[eb][ib][2] + O[eb][ib][3] * O[eb][ib][3]; }
    ss += __shfl_xor(ss, 16); ss += __shfl_xor(ss, 32);
    const float r = rsqrtf(ss * (1.f / 64.f) + EPS);
    bf16* yp = Y + (yrow0 + i) * D + 640 + h * 64;
#pragma unroll
    for (int eb = 0; eb < 4; ++eb) {
      const f32x4 gv = *(const f32x4*)(mixg + 640 + h * 64 + eb * 16 + 4 * g);
      const u32x2 gg = *(const u32x2*)(gp + (size_t)i * 64 + eb * 16 + 4 * g);
      const f32x4 y = O[eb][ib] * r * gv;
      u32x2 o; o.x = pk2(y[0] * bflo(gg.x), y[1] * bfhi(gg.x)); o.y = pk2(y[2] * bflo(gg.y), y[3] * bfhi(gg.y));
      *(u32x2*)(yp + eb * 16 + 4 * g) = o;
    }
  }
  __syncthreads();
}

__device__ __forceinline__ float log_sigmoid_f(float x) { return x >= 0.f ? -log1pf(expf(-x)) : x - log1pf(expf(x)); }

__device__ __forceinline__ void p0_mod_item(unsigned char* lds, const Params& P, int item) {
  const int l = item / 96, chunk = item % 96, tid = get_tid(), ks = tid >> 4, cg4 = tid & 15;
  float* red = (float*)lds;
  float* sil = (float*)(lds + 32768);
#pragma unroll
  for (int i = 0; i < 2; ++i) { const int k = tid + 512 * i; sil[k] = silu_f(P.c[k]); sil[1024 + k] = silu_f(P.c[1024 + k]); sil[2048 + k] = silu_f(P.c_ctx[k]); }
  __syncthreads();
  const float* wa = P.w_ada + (size_t)l * 1024 * 6144 + chunk * 64 + cg4 * 4;
  f32x4 a0 = {0.f, 0.f, 0.f, 0.f}, a1 = a0, a2 = a0;
#pragma unroll 16
  for (int i = 0; i < 32; ++i) {
    const int k = ks * 32 + i;
    const f32x4 wv = __builtin_nontemporal_load((const f32x4*)(wa + (size_t)k * 6144));
    a0 += wv * sil[k]; a1 += wv * sil[1024 + k]; a2 += wv * sil[2048 + k];
  }
  *(f32x4*)(red + (ks * 3 + 0) * 64 + cg4 * 4) = a0; *(f32x4*)(red + (ks * 3 + 1) * 64 + cg4 * 4) = a1; *(f32x4*)(red + (ks * 3 + 2) * 64 + cg4 * 4) = a2;
  __syncthreads();
  if (tid < 192) {
    const int seg = tid >> 6, col = tid & 63; float s = P.b_ada[l * 6144 + chunk * 64 + col];
#pragma unroll
    for (int k2 = 0; k2 < 32; ++k2) s += red[(k2 * 3 + seg) * 64 + col];
    ((float*)(P.ws + WS_MOD))[(l * 3 + seg) * 6144 + chunk * 64 + col] = s;
  }
  __syncthreads();
}

__device__ __forceinline__ void p0_tr_item(unsigned char* lds, const float* src, int srcN, int k0, int n0, bf16* dst, int dstK, int mode) {
  float* tile = (float*)lds;
  const int tid = get_tid();
  f32x4 v[8];
#pragma unroll
  for (int ps = 0; ps < 8; ++ps) v[ps] = __builtin_nontemporal_load((const f32x4*)(src + (size_t)(k0 + (tid >> 5) + 16 * ps) * srcN + n0 + (tid & 31) * 4));
#pragma unroll
  for (int ps = 0; ps < 8; ++ps) { float* tp = tile + ((tid >> 5) + 16 * ps) * 129 + (tid & 31) * 4; tp[0] = v[ps][0]; tp[1] = v[ps][1]; tp[2] = v[ps][2]; tp[3] = v[ps][3]; }
  __syncthreads();
  const int n = tid >> 2, kc = tid & 3, ncol = n0 + n;
  int row = ncol;
  if (mode) row = (ncol >> 4) * 32 + (ncol & 15) + (mode == 2 ? 16 : 0);
  bf16* dp = dst + (size_t)row * dstK + k0 + kc * 32;
  const float* tp = tile + (kc * 32) * 129 + n;
#pragma unroll
  for (int q = 0; q < 4; ++q) {
    u32x4 o;
#pragma unroll
    for (int i = 0; i < 4; ++i) o[i] = pk2(tp[(q * 8 + 2 * i) * 129], tp[(q * 8 + 2 * i + 1) * 129]);
    *(u32x4*)(dp + q * 8) = o;
  }
  __syncthreads();
}

constexpr int P0_MOD = 192, P0_MISC = 1, P0_WIN = 2 * 8 * 23, P0_WO = 2 * 8 * 8, P0_W1 = 32 * 32, P0_W2 = 32 * 32;
constexpr int P0_ITEMS = P0_MOD + P0_MISC + P0_WIN + P0_WO + 2 * P0_W1 + P0_W2;

__device__ __forceinline__ void phase0(unsigned char* lds, const Params& P) {
#pragma unroll 1
  for (int it = blockIdx.x; it < P0_ITEMS; it += gridDim.x) {
    int r = it;
    if (r < P0_MOD) { p0_mod_item(lds, P, r); continue; } r -= P0_MOD;
    if (r < P0_MISC) {
      const int tid = get_tid();
      float* rope = (float*)(P.ws + WS_ROPE);
      for (int e = tid; e < 2048; e += NTHR) { const int pos = e >> 4, f = e & 15; const float inv = powf(10000.f, -(float)f / 16.f); const float ang = (float)pos * inv; rope[e * 2] = cosf(ang); rope[e * 2 + 1] = sinf(ang); }
      continue;
    } r -= P0_MISC;
    const float* src; int srcN, k0, n0, dstK, mode; bf16* dst;
    if (r < P0_WIN) { const int l = r / 184, q = r % 184, kt = q / 23, nt = q % 23;
      src = P.w_in + (size_t)l * 1024 * INC; srcN = INC; k0 = kt * 128; n0 = nt * 128; dst = (bf16*)(P.ws + WS_WIN) + (size_t)l * INC * 1024; dstK = 1024; mode = 0; }
    else if (r < P0_WIN + P0_WO) { const int r2 = r - P0_WIN, l = r2 / 64, q = r2 % 64, kt = q / 8, nt = q % 8;
      src = P.w_out + (size_t)l * 1024 * 1024; srcN = 1024; k0 = kt * 128; n0 = nt * 128; dst = (bf16*)(P.ws + WS_WO) + (size_t)l * 1024 * 1024; dstK = 1024; mode = 0; }
    else if (r < P0_WIN + P0_WO + 2 * P0_W1) { const int r2 = r - P0_WIN - P0_WO, which = r2 / P0_W1, q2 = r2 % P0_W1, le = q2 / 32, q = q2 % 32, kt = q / 4, nt = q % 4;
      src = (which ? P.w3 : P.w1) + (size_t)le * 1024 * 512; srcN = 512; k0 = kt * 128; n0 = nt * 128; dst = (bf16*)(P.ws + WS_W13) + (size_t)le * 1024 * 1024; dstK = 1024; mode = which ? 2 : 1; }
    else { const int r2 = r - P0_WIN - P0_WO - 2 * P0_W1, le = r2 / 32, q = r2 % 32, kt = q / 8, nt = q % 8;
      src = P.w2 + (size_t)le * 512 * 1024; srcN = 1024; k0 = kt * 128; n0 = nt * 128; dst = (bf16*)(P.ws + WS_W2) + (size_t)le * 1024 * 512; dstK = 512; mode = 0; }
    p0_tr_item(lds, src, srcN, k0, n0, dst, dstK, mode);
  }
}

constexpr int P1_XB = NROWS / 16, P1_BIAS = 2 * INC / 8, P1_WR = 6, P1_ITEMS = P1_XB + P1_BIAS + P1_WR;
__device__ __forceinline__ void phase1(unsigned char* lds, const Params& P) {
  const int tid = get_tid(), lane = tid & 63, w = tid >> 6;
  const float* mod = (const float*)(P.ws + WS_MOD);
#pragma unroll 1
  for (int it = blockIdx.x; it < P1_ITEMS; it += gridDim.x) {
    int r = it;
    if (r < P1_XB) {
      f32x4 v[2][4];
#pragma unroll
      for (int u = 0; u < 2; ++u) { const int row = r * 16 + 2 * w + u; const float* xr = row < NLAT ? P.x + (size_t)row * D : P.ctx + (size_t)(row - NLAT) * D;
#pragma unroll
        for (int j = 0; j < 4; ++j) v[u][j] = *(const f32x4*)(xr + 4 * lane + 256 * j); }
      const int row0 = r * 16 + 2 * w, seg = row0 < NSEQ ? 0 : (row0 < NLAT ? 1 : 2);
      const float* sc1 = mod + (0 * 3 + seg) * 6144 + 1024;
      f32x4 gs[4];
#pragma unroll
      for (int j = 0; j < 4; ++j) { const int k = 4 * lane + 256 * j; gs[j] = *(const f32x4*)(P.n1g + k) * (*(const f32x4*)(sc1 + k) + 1.f); }
#pragma unroll
      for (int u = 0; u < 2; ++u) {
        const int row = row0 + u; bf16* xb = (bf16*)(P.ws + WS_R1) + (size_t)row * D; float ss = 0.f;
#pragma unroll
        for (int j = 0; j < 4; ++j) { const f32x4 x = v[u][j]; ss += x[0] * x[0] + x[1] * x[1] + x[2] * x[2] + x[3] * x[3]; const f32x4 o = x * gs[j]; u32x2 ov; ov.x = pk2(o[0], o[1]); ov.y = pk2(o[2], o[3]); *(u32x2*)(xb + 4 * lane + 256 * j) = ov; }
        ss = wsum(ss);
        if (lane == 0) ((float*)(P.ws + WS_RSS))[row] = ss;
      }
      continue;
    } r -= P1_XB;
    if (r < P1_BIAS) {
      const int idx = r * 8 + w, l = idx / INC, n = idx % INC;
      const bf16* wrow = (const bf16*)(P.ws + WS_WIN) + ((size_t)l * INC + n) * 1024 + lane * 16;
      const u32x4 w0 = *(const u32x4*)wrow, w1 = *(const u32x4*)(wrow + 8);
      float wv[16];
#pragma unroll
      for (int i = 0; i < 4; ++i) { wv[2 * i] = bflo(w0[i]); wv[2 * i + 1] = bfhi(w0[i]); wv[8 + 2 * i] = bflo(w1[i]); wv[8 + 2 * i + 1] = bfhi(w1[i]); }
#pragma unroll
      for (int seg = 0; seg < 3; ++seg) {
        const float* sh = mod + (l * 3 + seg) * 6144 + lane * 16; float a = 0.f;
#pragma unroll
        for (int i = 0; i < 16; ++i) a += wv[i] * sh[i];
        a = wsum(a);
        if (lane == 0) ((float*)(P.ws + WS_BIAS))[(l * 3 + seg) * INC + n] = a;
      }
      continue;
    } r -= P1_BIAS;
    { const int l = r / 3, seg = r % 3;
      const float* m = mod + (l * 3 + seg) * 6144;
      float* wr = (float*)(P.ws + WS_WR) + (size_t)(l * 3 + seg) * 16384;
      for (int e = tid; e < 16384; e += NTHR) { const int k = e >> 4; wr[e] = P.n2g[l * 1024 + k] * (1.f + m[4096 + k]) * P.w_router[e]; }
      const int ex = tid & 15, ks = tid >> 4; float a = 0.f;
      for (int i = 0; i < 32; ++i) { const int k = ks * 32 + i; a += m[3072 + k] * P.w_router[k * 16 + ex]; }
      float* red = (float*)lds; red[ks * 16 + ex] = a; __syncthreads();
      if (tid < 16) { float s = P.b_router[tid]; for (int k2 = 0; k2 < 32; ++k2) s += red[k2 * 16 + tid]; ((float*)(P.ws + WS_CR))[(l * 3 + seg) * 16 + tid] = s; }
      __syncthreads();
    }
  }
}

__device__ __forceinline__ int xcd_vidx(int round) {
  const int G = gridDim.x, b = blockIdx.x;
  return (G & 7) == 0 ? round * G + (b & 7) * (G >> 3) + (b >> 3) : round * G + b;
}

__device__ __forceinline__ void phaseA(unsigned char* lds, const Params& P, int l) {
  const bf16* XB = (const bf16*)(P.ws + WS_R1);
  const bf16* Wt = (const bf16*)(P.ws + WS_WIN) + (size_t)l * INC * 1024;
  { const int tid = get_tid(); const f32x4* s4 = (const f32x4*)(P.ws + WS_ROPE); f32x4* d4 = (f32x4*)(lds + LDS_MISC);
    for (int e = tid; e < 1024; e += NTHR) d4[e] = s4[e];
    __syncthreads(); }
  const float* ropel = (const float*)(lds + LDS_MISC);
  EpiInProj<8, 4> E4{(const float*)(P.ws + WS_RSS), (const float*)(P.ws + WS_BIAS) + l * 3 * INC, P.qg + l * 64, P.kg + l * 64, ropel, (bf16*)(P.ws + WS_Z)};
  EpiInProj<8, 2> E2{(const float*)(P.ws + WS_RSS), (const float*)(P.ws + WS_BIAS) + l * 3 * INC, P.qg + l * 64, P.kg + l * 64, ropel, (bf16*)(P.ws + WS_Z)};
  constexpr int NFULL = 66 * 11, NITEM = NFULL + 33;
  bool staged = false;
#pragma unroll 1
  for (int round = 0; round * (int)gridDim.x < NITEM; ++round) {
    const int v = xcd_vidx(round);
    if (v >= NITEM) continue;
    if (v < NFULL) {
      const int m = v / 11, n = v % 11;
      const int vn = xcd_vidx(round + 1);
      const bool hn = vn < NFULL;
      ARowLinear ar{XB, 1024, m * 256}, arn{XB, 1024, (hn ? vn / 11 : 0) * 256};
      gemm_tile<8, 4>(lds, ar, Wt, 1024, m * 256, n * 256, E4, staged, hn, &arn, Wt, (hn ? vn % 11 : 0) * 256);
      staged = hn;
    } else {
      const int m2 = (v - NFULL) * 2;
#pragma unroll 1
      for (int h = 0; h < 2; ++h) { ARowLinear ar{XB, 1024, (m2 + h) * 256}; gemm_tile<8, 2>(lds, ar, Wt, 1024, (m2 + h) * 256, 2816, E2); }
      staged = false;
    }
  }
}

__device__ __forceinline__ void phaseB(unsigned char* lds, const Params& P, int l) {
  const bool ctxout = (l == 0);
  const bf16* Z = (const bf16*)(P.ws + WS_Z);
  bf16* Y = (bf16*)P.out;
  const float* mixg = P.mix_g + l * 1024;
  const int tid = get_tid(), lane = tid & 63, w = __builtin_amdgcn_readfirstlane(tid >> 6), grp = w >> 2, wl4 = w & 3, tg = tid & 255, G = gridDim.x;
  { const int n = 256 + (ctxout ? 8 : 0);
#pragma unroll 1
    for (int r = blockIdx.x; r < n; r += G) {
      int b, kvh, qtok0, nlat, ntiles; size_t yrow0;
      if (r < 256) { b = r >> 7; kvh = (r >> 6) & 1; const int qt = r & 63; qtok0 = qt * 128; nlat = 128; ntiles = 132; yrow0 = (size_t)b * NSEQ + qt * 128; }
      else { const int q = r - 256; b = q >> 2; kvh = (q >> 1) & 1; const int qt = q & 1; qtok0 = NSEQ + qt * 128; nlat = 0; ntiles = 4; yrow0 = (size_t)NLAT + b * CL + qt * 128; }
      attn_item<3, false, 8>(lds, 0, w, lane, Z + (size_t)b * NSLOT * NT_TOK * 64, S_AQ + kvh * 3, S_AK + kvh, S_AV + kvh, qtok0, 0, nlat, ntiles, 0, Y, yrow0, kvh * 192, mixg);
    }
  }
  { const int n = 1024 + (ctxout ? 32 : 0);
    int start = (int)blockIdx.x - 8; if (start < 0) start += G;
#pragma unroll 1
    for (int pr = start; pr * 2 < n; pr += G) {
      const int r = pr * 2 + grp;
      int b, h, qtok0, lat0, nlat, ntiles, drbase; size_t yrow0;
      if (r < 1024) { b = r >> 9; h = (r >> 7) & 3; const int row = r & 127; int rs = row - 4; rs = rs < 0 ? 0 : (rs > 120 ? 120 : rs);
        qtok0 = row * 64; lat0 = rs * 64; nlat = 8; ntiles = 12; drbase = rs - row + 7; yrow0 = (size_t)b * NSEQ + row * 64; }
      else { const int q = r - 1024; b = q >> 4; h = (q >> 2) & 3; const int qt = q & 3; qtok0 = NSEQ + qt * 64; lat0 = 0; nlat = 0; ntiles = 4; drbase = 0; yrow0 = (size_t)NLAT + b * CL + qt * 64; }
      float* rp = (float*)(lds + grp * 65536 + 49152);
      const float* src = P.rpb + ((size_t)l * 4 + h) * 465;
      for (int e = tg; e < 465; e += 256) rp[e] = src[e] * LOG2E;
      __syncthreads();
      attn_item<1, true, 4>(lds, grp * 65536, wl4, lane, Z + (size_t)b * NSLOT * NT_TOK * 64, S_NQ + h, S_NK + h, S_NV + h, qtok0, lat0, nlat, ntiles, drbase, Y, yrow0, 384 + h * 64, mixg);
    }
  }
  { int start = (int)blockIdx.x - 40; if (start < 0) start += G;
#pragma unroll 1
    for (int pr = start; pr * 2 < 2 * 6 * 66; pr += G) {
      const int r = pr * 2 + grp;
      const int b = r / 396, q = r % 396, h = q / 66, c = q % 66;
      const float lgf2 = log_sigmoid_f(P.ret_decay[(l * 2 + 0) * 6 + h]) * LOG2E, lgb2 = log_sigmoid_f(P.ret_decay[(l * 2 + 1) * 6 + h]) * LOG2E;
      float* U = (float*)(P.ws + WS_R1);
      ret_u_item(lds, grp * 65536, tg, Z + (size_t)b * NSLOT * NT_TOK * 64, h, c, lgf2, lgb2, U + ((size_t)((b * 6 + h) * 2 + 0) * 66 + c) * 4096, U + ((size_t)((b * 6 + h) * 2 + 1) * 66 + c) * 4096);
    }
  }
}

__device__ __forceinline__ void phaseB2(const Params& P, int l) {
  const float* U = (const float*)(P.ws + WS_R1);
#pragma unroll 1
  for (int it = blockIdx.x; it < 48; it += gridDim.x) {
    const int seq = it >> 1, off = ((it & 1) * 512 + get_tid()) * 4;
    const int dir = seq & 1, h = (seq >> 1) % 6;
    const float lg = log_sigmoid_f(P.ret_decay[(l * 2 + dir) * 6 + h]);
    const float decay = expf(128.f * lg);
    const float* base = U + (size_t)seq * 66 * 4096 + off;
    float* sbase = (float*)((unsigned char*)P.out + S_OFF) + (size_t)seq * 66 * 4096 + off;
    f32x4 s = {0.f, 0.f, 0.f, 0.f};
#pragma unroll 1
    for (int s0 = 0; s0 < 66; s0 += 11) {
      f32x4 u[11];
#pragma unroll
      for (int k = 0; k < 11; ++k) { const int st = s0 + k; const int c = dir == 0 ? st : (st < 2 ? 1 - st : 67 - st); u[k] = __builtin_nontemporal_load((const f32x4*)(base + (size_t)c * 4096)); }
#pragma unroll
      for (int k = 0; k < 11; ++k) { const int st = s0 + k; const int c = dir == 0 ? st : (st < 2 ? 1 - st : 67 - st); *(f32x4*)(sbase + (size_t)c * 4096) = s; s = s * decay + u[k]; }
    }
  }
}

__device__ __forceinline__ void phaseB3(unsigned char* lds, const Params& P, int l) {
  const bf16* Z = (const bf16*)(P.ws + WS_Z);
  bf16* Y = (bf16*)P.out;
  const float* mixg = P.mix_g + l * 1024;
  const float* U = (const float*)((const unsigned char*)P.out + S_OFF);
  const int tid = get_tid(), grp = __builtin_amdgcn_readfirstlane(tid >> 8), tg = tid & 255;
  const int cpb = (l == 0) ? 66 : 64, total = 2 * 6 * cpb;
#pragma unroll 1
  for (int pr = blockIdx.x; pr * 2 < total; pr += gridDim.x) {
    const int it = pr * 2 + grp;
    const int b = it / (6 * cpb), q = it % (6 * cpb), h = q / cpb, c = (q % cpb) + (66 - cpb);
    const float lgf2 = log_sigmoid_f(P.ret_decay[(l * 2 + 0) * 6 + h]) * LOG2E, lgb2 = log_sigmoid_f(P.ret_decay[(l * 2 + 1) * 6 + h]) * LOG2E;
    const size_t yrow0 = c < 2 ? (size_t)NLAT + b * CL + 128 * c : (size_t)b * NSEQ + 128 * (c - 2);
    ret_out_item(lds, grp * 65536, tg, Z + (size_t)b * NSLOT * NT_TOK * 64, h, c, lgf2, lgb2, U + ((size_t)((b * 6 + h) * 2 + 0) * 66 + c) * 4096, U + ((size_t)((b * 6 + h) * 2 + 1) * 66 + c) * 4096, Y, yrow0, mixg);
  }
}

__device__ __forceinline__ void pc_small_item(const Params& P, int l, int item) {
  const int tid = get_tid(), lane = tid & 63, w = tid >> 6, g = lane >> 4, li = lane & 15;
  const bf16* Y = (const bf16*)P.out;
  const bf16* Wt = (const bf16*)(P.ws + WS_WO) + (size_t)l * 1024 * 1024;
  float* XR = (float*)(P.ws + WS_XR);
  const int mb = item >> 5, nb = item & 31;
  const int m0 = NLAT + mb * 64 + (w >> 1) * 16, n0 = nb * 32 + (w & 1) * 16;
  const bf16* ar = Y + (size_t)(m0 + li) * D + g * 8;
  const bf16* br = Wt + (size_t)(n0 + li) * D + g * 8;
  f32x4 acc = {0.f, 0.f, 0.f, 0.f};
#pragma unroll 1
  for (int kb = 0; kb < 32; kb += 8) {
    bf16x8 af[8], bf[8];
#pragma unroll
    for (int c = 0; c < 8; ++c) { af[c] = *(const bf16x8*)(ar + (kb + c) * 32); bf[c] = *(const bf16x8*)(br + (kb + c) * 32); }
#pragma unroll
    for (int c = 0; c < 8; ++c) acc = __builtin_amdgcn_mfma_f32_16x16x32_bf16(bf[c], af[c], acc, 0, 0, 0);
  }
  const int m = m0 + li, n = n0 + 4 * g;
  const float* gt = (const float*)(P.ws + WS_MOD) + (l * 3 + 2) * 6144 + 2048;
  const f32x4 xv = *(const f32x4*)(P.ctx + (size_t)(m - NLAT) * D + n), gv = *(const f32x4*)(gt + n);
  *(f32x4*)(XR + (size_t)m * D + n) = xv + gv * acc;
}
__device__ __forceinline__ void phaseC(unsigned char* lds, const Params& P, int l) {
  const bf16* Y = (const bf16*)P.out;
  const bf16* Wt = (const bf16*)(P.ws + WS_WO) + (size_t)l * 1024 * 1024;
  float* XR = (float*)(P.ws + WS_XR);
  EpiOutProj E{l == 0 ? P.x : XR, l == 0 ? P.ctx : XR + (size_t)NLAT * D, (const float*)(P.ws + WS_MOD) + l * 3 * 6144, XR};
  const int nitem = NLAT / 256 * 4;
  bool staged = false;
#pragma unroll 1
  for (int round = 0; round * (int)gridDim.x < nitem; ++round) {
    const int v = xcd_vidx(round);
    if (v >= nitem) continue;
    const int vn = xcd_vidx(round + 1);
    const bool hn = vn < nitem;
    ARowLinear ar{Y, 1024, (v >> 2) * 256}, arn{Y, 1024, (hn ? vn >> 2 : 0) * 256};
    gemm_tile<8, 4>(lds, ar, Wt, 1024, (v >> 2) * 256, (v & 3) * 256, E, staged, hn, &arn, Wt, (hn ? vn & 3 : 0) * 256);
    staged = hn;
  }
  if (l == 0) {
#pragma unroll 1
    for (int it = blockIdx.x; it < 256; it += gridDim.x) pc_small_item(P, l, it);
  }
}

__device__ __forceinline__ void phaseD(unsigned char* lds, const Params& P, int l) {
  const int tid = get_tid(), lane = tid & 63, w = tid >> 6, g = lane >> 4, li = lane & 15;
  const float* XR = (const float*)(P.ws + WS_XR);
  bf16* H2 = (bf16*)(P.ws + WS_R1);
  int* cnt = (int*)(P.ws + WS_CNT) + l * 16;
  int* list = (int*)(P.ws + WS_LIST) + (size_t)l * 16 * NROWS;
  float* gatew = (float*)(P.ws + WS_GATEW);
  float* part = (float*)lds;
  float* ssqp = part + 2048;
  float* rsl = ssqp + 128;
  int* hist = (int*)(rsl + 64);
  const int nitems = (l == 0 ? NROWS : NLAT) / 64;
  const int rgp = w >> 1, kh = w & 1;
#pragma unroll 1
  for (int it = blockIdx.x; it < nitems; it += gridDim.x) {
    const int r0 = it * 64, seg = r0 < NSEQ ? 0 : (r0 < NLAT ? 1 : 2);
    const float* wr = (const float*)(P.ws + WS_WR) + (size_t)(l * 3 + seg) * 16384;
    const float* xrow = XR + (size_t)(r0 + rgp * 16 + li) * D + 512 * kh + 4 * g;
    const float* wp0 = wr + (size_t)(512 * kh + 4 * g) * 16 + li;
    if (tid < 32) hist[tid] = 0;
    f32x4 acc = {0.f, 0.f, 0.f, 0.f}; float ssq = 0.f;
#pragma unroll 1
    for (int cb = 0; cb < 32; cb += 8) {
      f32x4 xv[8]; float bw[8][4];
#pragma unroll
      for (int c = 0; c < 8; ++c) {
        xv[c] = *(const f32x4*)(xrow + 16 * (cb + c));
        const float* wp = wp0 + (cb + c) * 256;
        bw[c][0] = wp[0]; bw[c][1] = wp[16]; bw[c][2] = wp[32]; bw[c][3] = wp[48];
      }
#pragma unroll
      for (int c = 0; c < 8; ++c) {
        ssq += xv[c][0] * xv[c][0] + xv[c][1] * xv[c][1] + xv[c][2] * xv[c][2] + xv[c][3] * xv[c][3];
        acc = __builtin_amdgcn_mfma_f32_16x16x4f32(xv[c][0], bw[c][0], acc, 0, 0, 0);
        acc = __builtin_amdgcn_mfma_f32_16x16x4f32(xv[c][1], bw[c][1], acc, 0, 0, 0);
        acc = __builtin_amdgcn_mfma_f32_16x16x4f32(xv[c][2], bw[c][2], acc, 0, 0, 0);
        acc = __builtin_amdgcn_mfma_f32_16x16x4f32(xv[c][3], bw[c][3], acc, 0, 0, 0);
      }
    }
    ssq += __shfl_xor(ssq, 16); ssq += __shfl_xor(ssq, 32);
#pragma unroll
    for (int j = 0; j < 4; ++j) part[(w * 16 + 4 * g + j) * 16 + li] = acc[j];
    if (g == 0) ssqp[w * 16 + li] = ssq;
    __syncthreads();
    int e1 = 0, e2 = 0, q1 = 0, q2 = 0; float g1 = 0.f, g2 = 0.f;
    if (tid < 64) {
      const int rg2 = tid >> 4, rr = tid & 15;
      const float ss = ssqp[(2 * rg2) * 16 + rr] + ssqp[(2 * rg2 + 1) * 16 + rr];
      const float rs = rsqrtf(ss * (1.f / 1024.f) + EPS);
      rsl[tid] = rs;
      const float* cr = (const float*)(P.ws + WS_CR) + (l * 3 + seg) * 16;
      float lg[16]; float mx = -1e30f;
#pragma unroll
      for (int e = 0; e < 16; ++e) { lg[e] = rs * (part[((2 * rg2) * 16 + rr) * 16 + e] + part[((2 * rg2 + 1) * 16 + rr) * 16 + e]) + cr[e]; mx = fmaxf(mx, lg[e]); }
#pragma unroll
      for (int e = 0; e < 16; ++e) lg[e] = expf(lg[e] - mx);
      float best = -1.f; int bg = 0; float b0 = 0.f, b1 = 0.f, b2 = 0.f, b3 = 0.f;
#pragma unroll
      for (int gi = 0; gi < 4; ++gi) {
        const float a0 = lg[4 * gi], a1 = lg[4 * gi + 1], a2 = lg[4 * gi + 2], a3 = lg[4 * gi + 3];
        const float sc = fmaxf(fmaxf(fmaxf(a0 + a1, a0 + a2), fmaxf(a0 + a3, a1 + a2)), fmaxf(a1 + a3, a2 + a3));
        if (sc > best) { best = sc; bg = gi; b0 = a0; b1 = a1; b2 = a2; b3 = a3; }
      }
      int i1 = 0; float v1 = b0;
      if (b1 > v1) { v1 = b1; i1 = 1; } if (b2 > v1) { v1 = b2; i1 = 2; } if (b3 > v1) { v1 = b3; i1 = 3; }
      int i2 = -1; float v2 = -1.f;
      if (i1 != 0 && b0 > v2) { v2 = b0; i2 = 0; } if (i1 != 1 && b1 > v2) { v2 = b1; i2 = 1; } if (i1 != 2 && b2 > v2) { v2 = b2; i2 = 2; } if (i1 != 3 && b3 > v2) { v2 = b3; i2 = 3; }
      const float inv = 1.f / (v1 + v2);
      e1 = bg * 4 + i1; e2 = bg * 4 + i2; g1 = v1 * inv; g2 = v2 * inv;
      q1 = atomicAdd(&hist[e1], 1); q2 = atomicAdd(&hist[e2], 1);
    }
    __syncthreads();
    if (tid < 16) hist[16 + tid] = atomicAdd(&cnt[tid], hist[tid]);
    __syncthreads();
    if (tid < 64) {
      const int row = r0 + tid;
      list[(size_t)e1 * NROWS + hist[16 + e1] + q1] = row * 2; gatew[row * 2] = g1;
      list[(size_t)e2 * NROWS + hist[16 + e2] + q2] = row * 2 + 1; gatew[row * 2 + 1] = g2;
    }
    {
      const float* m = (const float*)(P.ws + WS_MOD) + (l * 3 + seg) * 6144;
      f32x4 gs[4], sh[4];
#pragma unroll
      for (int j = 0; j < 4; ++j) { const int k = 4 * lane + 256 * j; gs[j] = *(const f32x4*)(P.n2g + l * 1024 + k) * (*(const f32x4*)(m + 4096 + k) + 1.f); sh[j] = *(const f32x4*)(m + 3072 + k); }
#pragma unroll 1
      for (int q = 0; q < 8; q += 4) {
        f32x4 xx[4][4];
#pragma unroll
        for (int u = 0; u < 4; ++u)
#pragma unroll
          for (int j = 0; j < 4; ++j) xx[u][j] = *(const f32x4*)(XR + (size_t)(r0 + 8 * w + q + u) * D + 4 * lane + 256 * j);
#pragma unroll
        for (int u = 0; u < 4; ++u) {
          const int rr = 8 * w + q + u; const float rs = rsl[rr]; bf16* hp = H2 + (size_t)(r0 + rr) * D;
#pragma unroll
          for (int j = 0; j < 4; ++j) { const f32x4 o = xx[u][j] * rs * gs[j] + sh[j]; u32x2 ov; ov.x = pk2(o[0], o[1]); ov.y = pk2(o[2], o[3]); *(u32x2*)(hp + 4 * lane + 256 * j) = ov; }
        }
      }
    }
    __syncthreads();
  }
}

__device__ __forceinline__ void phaseEF(unsigned char* lds, const Params& P, int l, bool down) {
  const int* cnt = (const int*)(P.ws + WS_CNT) + l * 16;
  const int* list = (const int*)(P.ws + WS_LIST) + (size_t)l * 16 * NROWS;
  int total = 0;
#pragma unroll 1
  for (int e = 0; e < 16; ++e) total += (cnt[e] + 127) >> 7;
  total *= 4;
  bf16* act = (bf16*)(P.ws + WS_Z + Z_ACT);
  bool staged = false;
  int it = xcd_vidx(0);
#define MOE_LOOKUP(IT, E_, MT_, NT_, CE_, SB_) do { const int ti_ = (IT) >> 2; NT_ = (IT) & 3; int tb_ = 0; E_ = 0; SB_ = 0; CE_ = cnt[0]; \
    _Pragma("unroll 1") for (int q_ = 0; q_ < 15; ++q_) { const int ntq_ = (CE_ + 127) >> 7; if (ti_ >= tb_ + ntq_) { tb_ += ntq_; SB_ += CE_; E_ = q_ + 1; CE_ = cnt[q_ + 1]; } else break; } MT_ = ti_ - tb_; } while (0)
#pragma unroll 1
  for (int round = 0; round * (int)gridDim.x < total; ++round) {
    if (it >= total) { it = xcd_vidx(round + 1); continue; }
    int e, mt, nt, ce, sb; MOE_LOOKUP(it, e, mt, nt, ce, sb);
    const int itn = xcd_vidx(round + 1);
    const bool hn = itn < total;
    int en = 0, mtn = 0, ntn = 0, cen = 1, sbn = 0;
    if (hn) MOE_LOOKUP(itn, en, mtn, ntn, cen, sbn);
    const int nvalid = (ce - mt * 128) < 128 ? (ce - mt * 128) : 128, nvalidn = (cen - mtn * 128) < 128 ? (cen - mtn * 128) : 128;
    const int slot0 = sb + mt * 128, slot0n = sbn + mtn * 128;
    const int* lst = list + (size_t)e * NROWS + mt * 128; const int* lstn = list + (size_t)en * NROWS + mtn * 128;
    if (!down) {
      ARowGather ar{(const bf16*)(P.ws + WS_R1), lst, nvalid}, arn{(const bf16*)(P.ws + WS_R1), lstn, nvalidn};
      EpiMoeUp E{act, slot0, nvalid};
      const bf16* W = (const bf16*)(P.ws + WS_W13) + (size_t)(l * 16) * 1024 * 1024;
      gemm_tile<4, 4>(lds, ar, W + (size_t)e * 1024 * 1024, 1024, 0, nt * 256, E, staged, hn, &arn, W + (size_t)en * 1024 * 1024, ntn * 256);
    } else {
      ARowAct ar{act, slot0}, arn{act, slot0n};
      EpiMoeDown E{lst, (const float*)(P.ws + WS_GATEW), (bf16*)(P.ws + WS_R1), (bf16*)(P.ws + WS_Z + Z_YM1), nvalid};
      const bf16* W = (const bf16*)(P.ws + WS_W2) + (size_t)(l * 16) * 1024 * 512;
      gemm_tile<4, 4>(lds, ar, W + (size_t)e * 1024 * 512, 512, 0, nt * 256, E, staged, hn, &arn, W + (size_t)en * 1024 * 512, ntn * 256);
    }
    staged = hn; it = itn;
  }
#undef MOE_LOOKUP
}

__device__ __forceinline__ void phaseG(const Params& P, int l) {
  const int tid = get_tid(), lane = tid & 63, w = tid >> 6;
  float* XR = (float*)(P.ws + WS_XR);
  const bf16* Y0 = (const bf16*)(P.ws + WS_R1); const bf16* Y1 = (const bf16*)(P.ws + WS_Z + Z_YM1);
  const float* mod = (const float*)(P.ws + WS_MOD);
  const int nrows = l == 0 ? NROWS : NLAT;
#pragma unroll 1
  for (int it = blockIdx.x; it < nrows / 16; it += gridDim.x) {
    const int row0 = it * 16 + 2 * w, seg = row0 < NSEQ ? 0 : (row0 < NLAT ? 1 : 2);
    const float* gt2 = mod + (l * 3 + seg) * 6144 + 5120;
    f32x4 x1[2][4]; u32x2 ya[2][4], yb[2][4];
#pragma unroll
    for (int u = 0; u < 2; ++u)
#pragma unroll
      for (int j = 0; j < 4; ++j) { const size_t o = (size_t)(row0 + u) * D + 4 * lane + 256 * j; x1[u][j] = *(const f32x4*)(XR + o); ya[u][j] = *(const u32x2*)(Y0 + o); yb[u][j] = *(const u32x2*)(Y1 + o); }
    f32x4 gv[4];
#pragma unroll
    for (int j = 0; j < 4; ++j) gv[j] = *(const f32x4*)(gt2 + 4 * lane + 256 * j);
#pragma unroll
    for (int u = 0; u < 2; ++u) {
      const int row = row0 + u;
      f32x4 xv[4]; float ss = 0.f;
#pragma unroll
      for (int j = 0; j < 4; ++j) {
        const u32x2 a = ya[u][j], b = yb[u][j];
        f32x4 m; m[0] = bflo(a.x) + bflo(b.x); m[1] = bfhi(a.x) + bfhi(b.x); m[2] = bflo(a.y) + bflo(b.y); m[3] = bfhi(a.y) + bfhi(b.y);
        xv[j] = x1[u][j] + gv[j] * m;
        ss += xv[j][0] * xv[j][0] + xv[j][1] * xv[j][1] + xv[j][2] * xv[j][2] + xv[j][3] * xv[j][3];
      }
      ss = wsum(ss);
      if (l == 0) {
        const float* sc1 = mod + (1 * 3 + seg) * 6144 + 1024;
        bf16* xb = (bf16*)(P.ws + WS_R1) + (size_t)row * D;
        if (lane == 0) ((float*)(P.ws + WS_RSS))[row] = ss;
#pragma unroll
        for (int j = 0; j < 4; ++j) {
          const int k = 4 * lane + 256 * j;
          *(f32x4*)(XR + (size_t)row * D + k) = xv[j];
          const f32x4 gg = *(const f32x4*)(P.n1g + 1024 + k), sc = *(const f32x4*)(sc1 + k);
          const f32x4 o = xv[j] * gg * (sc + 1.f);
          u32x2 ov; ov.x = pk2(o[0], o[1]); ov.y = pk2(o[2], o[3]); *(u32x2*)(xb + k) = ov;
        }
      } else {
        const float rs = rsqrtf(ss * (1.f / 1024.f) + EPS);
#pragma unroll
        for (int j = 0; j < 4; ++j) {
          const int k = 4 * lane + 256 * j;
          const f32x4 gg = *(const f32x4*)(P.final_g + k);
          *(f32x4*)(P.out + (size_t)row * D + k) = xv[j] * rs * gg;
        }
      }
    }
  }
}

#define XB_TMO      128
#define XB_XCNT(j)  (256  + 64 * (j))
#define XB_XSUB(j)  (1280 + 64 * (j))
#define XB_XGEN(j)  (2304 + 64 * (j))
#define XB_TOP      3328
#define XB_TOPGEN   3392
#define XB_SPIN_CAP (1u << 20)
__device__ __forceinline__ unsigned xb_ld(unsigned* p)              { return __hip_atomic_load(p, __ATOMIC_RELAXED, __HIP_MEMORY_SCOPE_AGENT); }
__device__ __forceinline__ unsigned xb_add(unsigned* p, unsigned v) { return __hip_atomic_fetch_add(p, v, __ATOMIC_RELAXED, __HIP_MEMORY_SCOPE_AGENT); }
__device__ __forceinline__ unsigned xb_xcc_id() { return (unsigned)__builtin_amdgcn_s_getreg((3 << 11) | 20) & 0xFu; }
#define XB_SPIN(cond, bar) do { unsigned _sp = 0; while (cond) { __builtin_amdgcn_s_sleep(1); \
    if ((++_sp & 255u) == 0u) { if (xb_ld(&(bar)[XB_TMO])) break; if (_sp > XB_SPIN_CAP) { atomicAdd(&(bar)[XB_TMO], 1u); break; } } } } while (0)
struct XBar { unsigned* bar; unsigned x, nloc, nx; };
__device__ __forceinline__ void xbar_init(XBar& b, unsigned* bar) {
  b.bar = bar; b.x = xb_xcc_id(); b.nloc = 0u; b.nx = 0u;
  if (threadIdx.x == 0) (void)xb_add(&bar[XB_XCNT(b.x)], 1u);
}
__device__ __forceinline__ void xbar_sync(XBar& b) {
  asm volatile("s_waitcnt vmcnt(0)" ::: "memory");
  __syncthreads();
  if (threadIdx.x == 0) {
    unsigned* bar = b.bar;
    __builtin_amdgcn_s_waitcnt(0);
    if (b.nloc == 0u) {
      const unsigned G = gridDim.x; unsigned sum, cnt, mine, sp = 0u;
      for (;;) {
        sum = 0u; cnt = 0u; mine = 0u;
#pragma unroll
        for (unsigned j = 0; j < 16; ++j) { const unsigned c = xb_ld(&bar[XB_XCNT(j)]); sum += c; cnt += (c > 0u) ? 1u : 0u; mine = (j == b.x) ? c : mine; }
        if (sum == G) break;
        __builtin_amdgcn_s_sleep(1);
        if ((++sp & 255u) == 0u) { if (xb_ld(&bar[XB_TMO])) break; if (sp > XB_SPIN_CAP) { atomicAdd(&bar[XB_TMO], 1u); break; } }
      }
      b.nloc = mine > 0u ? mine : 1u; b.nx = cnt > 0u ? cnt : 1u;
    }
    const unsigned nloc = b.nloc, nx = b.nx;
    const unsigned old = xb_add(&bar[XB_XSUB(b.x)], 1u);
    const unsigned gen = old / nloc;
    if (old + 1u == (gen + 1u) * nloc) {
      __builtin_amdgcn_fence(__ATOMIC_RELEASE, "agent");
      asm volatile("s_waitcnt vmcnt(0)" ::: "memory");
      const unsigned og = xb_add(&bar[XB_TOP], 1u);
      const unsigned tg = og / nx;
      if (og + 1u == (tg + 1u) * nx) xb_add(&bar[XB_TOPGEN], 1u);
      else XB_SPIN(xb_ld(&bar[XB_TOPGEN]) == tg, bar);
      __builtin_amdgcn_fence(__ATOMIC_ACQUIRE, "agent");
      xb_add(&bar[XB_XGEN(b.x)], 1u);
      asm volatile("s_waitcnt vmcnt(0)" ::: "memory");
    } else {
      XB_SPIN(xb_ld(&bar[XB_XGEN(b.x)]) == gen, bar);
      __builtin_amdgcn_fence(__ATOMIC_ACQUIRE, "agent");
      asm volatile("s_waitcnt vmcnt(0)" ::: "memory");
    }
  }
  __syncthreads();
}

__global__ void __launch_bounds__(NTHR, 2) fwd_mega(Params P) {
  extern __shared__ __attribute__((aligned(16))) unsigned char lds[];
  cg::grid_group grid = cg::this_grid();
  XBar xb; xbar_init(xb, (unsigned*)(P.ws + WS_BAR));
#define GSYNC() xbar_sync(xb)
  phase0(lds, P);
  VM_WAIT(); __syncthreads(); grid.sync();
  phase1(lds, P); GSYNC();
#pragma unroll 1
  for (int l = 0; l < 2; ++l) {
    phaseA(lds, P, l); GSYNC();
    phaseB(lds, P, l); GSYNC();
    phaseB2(P, l); GSYNC();
    phaseB3(lds, P, l); GSYNC();
    phaseC(lds, P, l); GSYNC();
    phaseD(lds, P, l); GSYNC();
    phaseEF(lds, P, l, false); GSYNC();
    phaseEF(lds, P, l, true); GSYNC();
    phaseG(P, l);
    if (l == 0) GSYNC();
  }
#undef GSYNC
}

extern "C" void kernel_launch(void* const* d_in, const int* in_sizes, int n_in, void* d_out, int out_size, void* d_ws, size_t ws_size, hipStream_t stream) {
  static int grid_blocks = 0;
  if (!grid_blocks) {
    int dev = 0, cus = 0, per_cu = 0;
    (void)hipGetDevice(&dev);
    (void)hipDeviceGetAttribute(&cus, hipDeviceAttributeMultiprocessorCount, dev);
    (void)hipFuncSetAttribute((const void*)fwd_mega, hipFuncAttributeMaxDynamicSharedMemorySize, LDS_BYTES);
    (void)hipOccupancyMaxActiveBlocksPerMultiprocessor(&per_cu, fwd_mega, NTHR, LDS_BYTES);
    if (per_cu > 1) per_cu = 1;
    if (per_cu < 1) per_cu = 1;
    grid_blocks = cus * per_cu;
    if (ws_size < WS_END) fprintf(stderr, "kernel_launch: workspace too small: %zu < %zu\n", ws_size, (size_t)WS_END);
  }
  (void)hipMemsetAsync(d_ws, 0, WS_ZERO_BYTES, stream);
  Params p{};
  const float** pp = (const float**)&p;
  for (int i = 0; i < 21; ++i) pp[i] = (const float*)d_in[i];
  p.out = (float*)d_out; p.ws = (unsigned char*)d_ws;
  void* args[] = {&p};
  hipError_t e = hipLaunchCooperativeKernel((void*)fwd_mega, dim3(grid_blocks), dim3(NTHR), args, LDS_BYTES, stream);
  if (e != hipSuccess) fprintf(stderr, "cooperative launch failed: %s (grid %d)\n", hipGetErrorString(e), grid_blocks);
}
```

```cpp
#include <hip/hip_runtime.h>
#include <hip/hip_cooperative_groups.h>
#include <cstdio>
#include <cstdint>
namespace cg = cooperative_groups;

typedef unsigned short bf16;
typedef short bf16x8 __attribute__((ext_vector_type(8)));
typedef short s16x4 __attribute__((ext_vector_type(4)));
typedef float f32x4 __attribute__((ext_vector_type(4)));
typedef float f32x2 __attribute__((ext_vector_type(2)));
typedef unsigned u32x4 __attribute__((ext_vector_type(4)));
typedef unsigned u32x2 __attribute__((ext_vector_type(2)));
typedef __bf16 bf2_t __attribute__((ext_vector_type(2)));
#define LAS __attribute__((address_space(3)))
constexpr int NTHR = 512;
constexpr int LDS_BYTES = 147456 + 64;
constexpr int LDS_BARW = 147456;
constexpr int LDS_MISC = 131072;

constexpr int D = 1024, NSEQ = 8192, CL = 256, NT_TOK = NSEQ + CL, NLAT = 2 * NSEQ, NROWS = NLAT + 2 * CL;
constexpr int INC = 2944, NSLOT = 46;
constexpr float EPS = 1e-6f;
constexpr float LOG2E = 1.4426950408889634f;
constexpr float QSCALE = 0.125f * LOG2E;
constexpr int S_AQ = 0, S_AK = 6, S_AV = 8, S_NQ = 10, S_NK = 14, S_NV = 18, S_RQ = 22, S_RK = 28, S_RV = 34, S_RG = 40;

constexpr size_t WS_BAR = 0;
constexpr size_t WS_CNT = 16384;
constexpr size_t WS_ZERO_BYTES = 16384 + 4096;
constexpr size_t WS_MOD = WS_ZERO_BYTES;
constexpr size_t WS_BIAS = WS_MOD + 2 * 3 * 6144 * 4;
constexpr size_t WS_ROPE = WS_BIAS + 2 * 3 * 2944 * 4;
constexpr size_t WS_RSS = WS_ROPE + 128 * 16 * 2 * 4;
constexpr size_t WS_WR = WS_RSS + 16896 * 4;
constexpr size_t WS_CR = WS_WR + 2 * 3 * 1024 * 16 * 4;
constexpr size_t WS_GATEW = WS_CR + 4096;
constexpr size_t WS_LIST = WS_GATEW + 16896 * 2 * 4;
constexpr size_t WS_WIN = (WS_LIST + (size_t)2 * 16 * 16896 * 4 + 4095) / 4096 * 4096;
constexpr size_t WS_WO = WS_WIN + (size_t)2 * 2944 * 1024 * 2;
constexpr size_t WS_W13 = WS_WO + (size_t)2 * 1024 * 1024 * 2;
constexpr size_t WS_W2 = WS_W13 + (size_t)32 * 1024 * 1024 * 2;
constexpr size_t WS_XR = WS_W2 + (size_t)32 * 1024 * 512 * 2;
constexpr size_t WS_R1 = WS_XR + (size_t)NROWS * 1024 * 4;
constexpr size_t WS_Z = WS_R1 + (size_t)NROWS * 1024 * 2;
constexpr size_t WS_END = WS_Z + (size_t)2 * NSLOT * NT_TOK * 64 * 2;
constexpr size_t S_OFF = (size_t)34 << 20;
constexpr size_t Z_YM1 = 0, Z_ACT = (size_t)NROWS * 1024 * 2;
static_assert(Z_ACT + (size_t)(2 * NROWS + 128) * 512 * 2 <= (size_t)2 * NSLOT * NT_TOK * 64 * 2, "act overlay");
static_assert((size_t)2 * 6 * 2 * 66 * 4096 * 4 <= (size_t)NROWS * 1024 * 2, "U overlay");

struct Params {
  const float *x, *c, *ctx, *c_ctx, *w_ada, *b_ada, *n1g, *n2g, *w_in, *qg, *kg, *rpb, *ret_decay, *mix_g, *w_out, *w_router, *b_router, *w1, *w3, *w2, *final_g;
  float* out; unsigned char* ws;
};

__device__ __forceinline__ unsigned pk2(float lo, float hi) { f32x2 v = {lo, hi}; bf2_t b = __builtin_convertvector(v, bf2_t); return __builtin_bit_cast(unsigned, b); }
__device__ __forceinline__ float bflo(unsigned u) { return __builtin_bit_cast(float, u << 16); }
__device__ __forceinline__ float bfhi(unsigned u) { return __builtin_bit_cast(float, u & 0xffff0000u); }
__device__ __forceinline__ float wsum(float v) {
#pragma unroll
  for (int o = 1; o < 64; o <<= 1) v += __shfl_xor(v, o);
  return v;
}
__device__ __forceinline__ float silu_f(float v) { return v / (1.f + __expf(-v)); }
__device__ __forceinline__ int lds_swz(int row, int chunk) { return row * 128 + ((chunk ^ ((row >> 1) & 7)) << 4); }
#define VM_WAIT() asm volatile("s_waitcnt vmcnt(0)" ::: "memory")
__device__ __forceinline__ int get_tid() { int t = threadIdx.x; asm volatile("" : "+v"(t)); return t; }

template <int R, int NW>
__device__ __forceinline__ void stage_rows(unsigned char* lds, int dst, const bf16* src, int ld, int wl, int lane) {
#pragma unroll
  for (int i = 0; i < R / (8 * NW); ++i) {
    const int q = wl + NW * i, row = q * 8 + (lane >> 3), ch = (lane & 7) ^ ((row >> 1) & 7);
    __builtin_amdgcn_global_load_lds((const void*)(src + (size_t)row * ld + ch * 8), (LAS void*)(lds + dst + q * 1024), 16, 0, 0);
  }
}
#define VMCNT(n) asm volatile("s_waitcnt vmcnt(" #n ")" ::: "memory")
#define LGKM0() asm volatile("s_waitcnt lgkmcnt(0)" ::: "memory")
#define RAW_BAR() __builtin_amdgcn_s_barrier()
__device__ __forceinline__ bf16x8 lds_frag(const unsigned char* lds, int off) { return *(const bf16x8*)(lds + off); }
__device__ __forceinline__ bf16x8 lds_tr2(unsigned char* lds, int off0, int off1) {
  s16x4 a = __builtin_amdgcn_ds_read_tr16_b64_v4i16((LAS s16x4*)(lds + off0));
  s16x4 b = __builtin_amdgcn_ds_read_tr16_b64_v4i16((LAS s16x4*)(lds + off1));
  return __builtin_shufflevector(a, b, 0, 1, 2, 3, 4, 5, 6, 7);
}

template <int MT, int NT, int ST> struct GStep {
  static __device__ __forceinline__ void run(f32x4 (&acc)[MT][NT], bf16x8 (&W0)[NT], bf16x8 (&W1)[NT], bf16x8 (&X)[2 * MT], const unsigned char* base, int xoff, int woff) {
    constexpr int S = 2 * MT, kk = ST / MT, mt = ST % MT;
#pragma unroll
    for (int nt = 0; nt < NT; ++nt) acc[mt][nt] = __builtin_amdgcn_mfma_f32_16x16x32_bf16(kk ? W1[nt] : W0[nt], X[ST], acc[mt][nt], 0, 0, 0);
    __builtin_amdgcn_sched_group_barrier(0x008, NT, 0);
    if constexpr (ST + 2 < S) { constexpr int k2 = (ST + 2) / MT, m2 = (ST + 2) % MT; X[ST + 2] = lds_frag(base, (xoff + m2 * 2048) ^ (k2 << 6)); }
    if constexpr (ST < NT) W1[ST] = lds_frag(base, (woff + ST * 2048) ^ 64);
    constexpr int nds = (ST + 2 < S ? 1 : 0) + (ST < NT ? 1 : 0);
    if constexpr (nds > 0) __builtin_amdgcn_sched_group_barrier(0x100, nds, 0);
    if constexpr (ST + 1 < S) GStep<MT, NT, ST + 1>::run(acc, W0, W1, X, base, xoff, woff);
  }
};

template <int MT, int NT, class ARow, class Epi>
__device__ __forceinline__ void gemm_tile(unsigned char* lds, const ARow& arow, const bf16* __restrict__ Bt, int K, int m0, int n0, const Epi& epi,
                                          bool staged0 = false, bool hasnext = false, const ARow* narow = nullptr, const bf16* nBt = nullptr, int nn0 = 0) {
  const int tid = get_tid(), lane = tid & 63, w = __builtin_amdgcn_readfirstlane(tid >> 6);
  const int wr = w >> 2, wc = w & 3, g = lane >> 4, li = lane & 15;
  constexpr int NA = MT / 2, NB = NT;
  const bf16* ap[NA]; const bf16* bp[NB];
#pragma unroll
  for (int i = 0; i < NA; ++i) { const int q = w + 8 * i, row = q * 8 + (lane >> 3), ch = (lane & 7) ^ ((row >> 1) & 7); ap[i] = arow(row) + ch * 8; }
#pragma unroll
  for (int i = 0; i < NB; ++i) { const int q = w + 8 * i, row = q * 8 + (lane >> 3), ch = (lane & 7) ^ ((row >> 1) & 7); bp[i] = Bt + (size_t)(n0 + row) * K + ch * 8; }
  f32x4 acc[MT][NT];
#pragma unroll
  for (int a = 0; a < MT; ++a)
#pragma unroll
    for (int b = 0; b < NT; ++b) acc[a][b] = (f32x4){0.f, 0.f, 0.f, 0.f};
  const int f = (li >> 1) & 7;
  const int xoff = (wr * (MT * 16) + li) * 128 + ((g ^ f) << 4);
  const int woff = 32768 + (wc * (NT * 16) + li) * 128 + ((g ^ f) << 4);
  const int nk = K >> 6;
#define GT_STAGE(s, k0) do { _Pragma("unroll") for (int i = 0; i < NA; ++i) \
    __builtin_amdgcn_global_load_lds((const void*)(ap[i] + (k0)), (LAS void*)(lds + (s) * 65536 + (w + 8 * i) * 1024), 16, 0, 0); \
    _Pragma("unroll") for (int i = 0; i < NB; ++i) \
    __builtin_amdgcn_global_load_lds((const void*)(bp[i] + (k0)), (LAS void*)(lds + (s) * 65536 + 32768 + (w + 8 * i) * 1024), 16, 0, 0); } while (0)
  if (!staged0) GT_STAGE(0, 0);
  VM_WAIT(); __syncthreads();
  for (int t = 0; t < nk; ++t) {
    const int s = t & 1;
    if (t + 1 < nk) GT_STAGE(s ^ 1, (t + 1) * 64);
    const unsigned char* base = lds + s * 65536;
    {
      bf16x8 W0[NT], W1[NT], X[2 * MT];
#pragma unroll
      for (int nt = 0; nt < NT; ++nt) W0[nt] = lds_frag(base, woff + nt * 2048);
      X[0] = lds_frag(base, xoff); X[1] = lds_frag(base, xoff + 2048);
      __builtin_amdgcn_sched_group_barrier(0x100, NT + 2, 0);
      GStep<MT, NT, 0>::run(acc, W0, W1, X, base, xoff, woff);
    }
    VM_WAIT(); __syncthreads();
  }
  if (hasnext) {
#pragma unroll
    for (int i = 0; i < NA; ++i) { const int q = w + 8 * i, row = q * 8 + (lane >> 3), ch = (lane & 7) ^ ((row >> 1) & 7); ap[i] = (*narow)(row) + ch * 8; }
#pragma unroll
    for (int i = 0; i < NB; ++i) { const int q = w + 8 * i, row = q * 8 + (lane >> 3), ch = (lane & 7) ^ ((row >> 1) & 7); bp[i] = nBt + (size_t)(nn0 + row) * K + ch * 8; }
    GT_STAGE(0, 0);
  }
#undef GT_STAGE
  epi(acc, m0 + wr * (MT * 16), n0 + wc * (NT * 16), g, li);
}


namespace g8 {
constexpr int HT_B = 128 * 64 * 2;
__device__ __forceinline__ int lds_byte(int r, int c) { const int st = (r >> 4) * 2 + (c >> 5), rr = r & 15, cc = c & 31, ob = rr * 64 + cc * 2; return st * 1024 + (ob ^ (((ob >> 9) & 1) << 5)); }
__device__ __forceinline__ void stage_rc(int b, int& R, int& C) { const int st = b / 1024, sb = b % 1024, swz = sb ^ (((sb >> 9) & 1) << 5); R = (st >> 1) * 16 + swz / 64; C = (st & 1) * 32 + (swz % 64) / 2; }
}
template <class ARow, class Epi>
__device__ __forceinline__ void gemm8_tile(unsigned char* lds, const ARow& arow, const bf16* __restrict__ Bt, int K, int m0, int n0, const Epi& epi) {
  using namespace g8;
  const int tid = get_tid(), lane = tid & 63, wid = __builtin_amdgcn_readfirstlane(tid >> 6), wr = wid >> 2, wc = wid & 3, fr = lane & 15, fq = lane >> 4;
  const char* abase = (const char*)arow(0);
  const char* bbase = (const char*)(Bt + (size_t)n0 * K);
  unsigned oa[2][2], ob[2][2];
#pragma unroll
  for (int i = 0; i < 2; ++i) {
    int R, C; stage_rc(tid * 16 + i * 8192, R, C);
    const int ra = (R >> 6) * 128 + ((R >> 4) & 3) * 16 + (R & 15);
    const int rb = (R >> 5) * 64 + ((R >> 4) & 1) * 16 + (R & 15);
#pragma unroll
    for (int hh = 0; hh < 2; ++hh) { oa[hh][i] = (unsigned)((ra + hh * 64) * K + C) * 2u; ob[hh][i] = (unsigned)((rb + hh * 32) * K + C) * 2u; }
  }
#define G8_SA(b, h) (((b) * 2 + (h)) * HT_B)
#define G8_SB(b, h) ((4 + (b) * 2 + (h)) * HT_B)
#define G8_STAGE(bufoff, BASE, O2, kt) do { _Pragma("unroll") for (int _i = 0; _i < 2; ++_i) \
    __builtin_amdgcn_global_load_lds((const void*)((BASE) + (O2)[_i] + (unsigned)(kt) * 128u), (LAS void*)(lds + (bufoff) + wid * 1024 + _i * 8192), 16, 0, 0); } while (0)
  const int aoff = lds_byte(wr * 64 + fr, fq * 8), boff = lds_byte(wc * 32 + fr, fq * 8);
#define G8_LDA(dst, b, h) do { _Pragma("unroll") for (int m = 0; m < 4; ++m) _Pragma("unroll") for (int k = 0; k < 2; ++k) dst[m][k] = *(const bf16x8*)(lds + G8_SA(b, h) + aoff + m * 2048 + k * 1024); } while (0)
#define G8_LDB(dst, b, h) do { _Pragma("unroll") for (int n = 0; n < 2; ++n) _Pragma("unroll") for (int k = 0; k < 2; ++k) dst[n][k] = *(const bf16x8*)(lds + G8_SB(b, h) + boff + n * 2048 + k * 1024); } while (0)
#define G8_MMA(ai, bj, At_, Bt_) do { __builtin_amdgcn_s_setprio(1); _Pragma("unroll") for (int m = 0; m < 4; ++m) _Pragma("unroll") for (int n = 0; n < 2; ++n) _Pragma("unroll") for (int k = 0; k < 2; ++k) \
    acc[(ai) * 4 + m][(bj) * 2 + n] = __builtin_amdgcn_mfma_f32_16x16x32_bf16(Bt_[n][k], At_[m][k], acc[(ai) * 4 + m][(bj) * 2 + n], 0, 0, 0); __builtin_amdgcn_s_setprio(0); } while (0)
#define G8_WV(n) asm volatile("s_waitcnt vmcnt(" #n ")" ::: "memory")
#define G8_WL(n) asm volatile("s_waitcnt lgkmcnt(" #n ")" ::: "memory")
#define G8_BAR __builtin_amdgcn_s_barrier()
#define G8_SCHED __builtin_amdgcn_sched_barrier(0)
  f32x4 acc[8][4];
#pragma unroll
  for (int a = 0; a < 8; ++a)
#pragma unroll
    for (int b = 0; b < 4; ++b) acc[a][b] = (f32x4){0.f, 0.f, 0.f, 0.f};
  bf16x8 At[4][2], B0[2][2], B1[2][2];
  const int nt = K >> 6;
  G8_STAGE(G8_SB(0, 0), bbase, ob[0], 0); G8_STAGE(G8_SA(0, 0), abase, oa[0], 0);
  G8_STAGE(G8_SB(0, 1), bbase, ob[1], 0); G8_STAGE(G8_SA(0, 1), abase, oa[1], 0);
  if (wr == 1) G8_BAR;
  G8_WV(4); G8_BAR;
  G8_STAGE(G8_SB(1, 0), bbase, ob[0], 1); G8_STAGE(G8_SA(1, 0), abase, oa[0], 1); G8_STAGE(G8_SB(1, 1), bbase, ob[1], 1);
  G8_WV(6); G8_BAR;
#pragma unroll 1
  for (int t = 0; t < nt - 2; t += 2) {
    G8_LDB(B0, 0, 0); G8_SCHED; G8_LDA(At, 0, 0); G8_STAGE(G8_SA(1, 1), abase, oa[1], t + 1);
    G8_WL(8); G8_BAR; G8_WL(0); G8_MMA(0, 0, At, B0); G8_BAR; G8_SCHED;
    G8_LDB(B1, 0, 1); G8_STAGE(G8_SB(0, 0), bbase, ob[0], t + 2);
    G8_BAR; G8_WL(0); G8_MMA(0, 1, At, B1); G8_BAR;
    G8_LDA(At, 0, 1); G8_STAGE(G8_SA(0, 0), abase, oa[0], t + 2);
    G8_BAR; G8_WL(0); G8_MMA(1, 0, At, B0); G8_BAR; G8_SCHED;
    G8_STAGE(G8_SB(0, 1), bbase, ob[1], t + 2);
    G8_WV(6); G8_BAR; G8_MMA(1, 1, At, B1); G8_BAR;
    G8_LDB(B0, 1, 0); G8_SCHED; G8_LDA(At, 1, 0); G8_STAGE(G8_SA(0, 1), abase, oa[1], t + 2);
    G8_WL(8); G8_BAR; G8_WL(0); G8_MMA(0, 0, At, B0); G8_BAR; G8_SCHED;
    G8_LDB(B1, 1, 1); G8_STAGE(G8_SB(1, 0), bbase, ob[0], t + 3);
    G8_BAR; G8_WL(0); G8_MMA(0, 1, At, B1); G8_BAR;
    G8_LDA(At, 1, 1); G8_STAGE(G8_SA(1, 0), abase, oa[0], t + 3);
    G8_BAR; G8_WL(0); G8_MMA(1, 0, At, B0); G8_BAR; G8_SCHED;
    G8_STAGE(G8_SB(1, 1), bbase, ob[1], t + 3);
    G8_WV(6); G8_BAR; G8_MMA(1, 1, At, B1); G8_BAR;
  }
  { G8_LDB(B0, 0, 0); G8_LDA(At, 0, 0); G8_STAGE(G8_SA(1, 1), abase, oa[1], nt - 1);
    G8_BAR; G8_WL(0); G8_MMA(0, 0, At, B0); G8_BAR;
    G8_LDB(B1, 0, 1); G8_BAR; G8_WL(0); G8_MMA(0, 1, At, B1); G8_BAR;
    G8_LDA(At, 0, 1); G8_WV(4); G8_BAR; G8_WL(0); G8_MMA(1, 0, At, B0); G8_MMA(1, 1, At, B1); G8_BAR; }
  { G8_LDB(B0, 1, 0); G8_LDA(At, 1, 0); G8_WV(2); G8_BAR; G8_WL(0); G8_MMA(0, 0, At, B0); G8_BAR;
    G8_LDB(B1, 1, 1); G8_WV(0); G8_BAR; G8_WL(0); G8_MMA(0, 1, At, B1); G8_BAR;
    G8_LDA(At, 1, 1); G8_BAR; G8_WL(0); G8_MMA(1, 0, At, B0); G8_MMA(1, 1, At, B1); G8_BAR; }
  if (wr == 0) G8_BAR;
#undef G8_SA
#undef G8_SB
#undef G8_STAGE
#undef G8_LDA
#undef G8_LDB
#undef G8_MMA
#undef G8_WV
#undef G8_WL
#undef G8_BAR
#undef G8_SCHED
  epi(acc, m0 + wr * 128, n0 + wc * 64, fq, fr);
  __syncthreads();
}

struct ARowLinear { const bf16* A; int K; int m0; __device__ __forceinline__ const bf16* operator()(int r) const { return A + (size_t)(m0 + r) * K; } };

template <int MT, int NT>
struct EpiInProj {
  const float* rowss; const float* biasp; const float* qg; const float* kg; const float* rope  ; bf16* Z;
  __device__ __forceinline__ void operator()(f32x4 (&acc)[MT][NT], int mw, int nw, int g, int li) const {
    int b, seg, tokbase; bool latent;
    if (mw < NLAT) { b = mw >> 13; seg = b; tokbase = (mw & 8191); latent = true; }
    else { const int mc = mw - NLAT; b = mc >> 8; seg = 2; tokbase = NSEQ + (mc & 255); latent = false; }
    const int s = nw >> 6, coff = nw & 63;
    bf16* zb = Z + ((size_t)(b * NSLOT + s) * NT_TOK) * 64 + coff;
    float rss[MT];
#pragma unroll
    for (int mt = 0; mt < MT; ++mt) rss[mt] = rowss[mw + mt * 16 + li];
    f32x4 bv[NT], gvv[NT];
#pragma unroll
    for (int nt = 0; nt < NT; ++nt) bv[nt] = *(const f32x4*)(biasp + seg * INC + nw + nt * 16 + 4 * g);
    if (NT == 4 && s < 8) {
      const float* gn = (s < 6) ? qg : kg;
#pragma unroll
      for (int nt = 0; nt < NT; ++nt) gvv[nt] = *(const f32x4*)(gn + nt * 16 + 4 * g);
    } else {
#pragma unroll
      for (int nt = 0; nt < NT; ++nt) gvv[nt] = (f32x4){1.f, 1.f, 1.f, 1.f};
    }
#pragma unroll
    for (int mt = 0; mt < MT; ++mt) {
      const int tok = tokbase + mt * 16 + li;
      const float irms = rsqrtf(rss[mt] * (1.f / 1024.f) + EPS);
      f32x4 v[NT];
#pragma unroll
      for (int nt = 0; nt < NT; ++nt) v[nt] = acc[mt][nt] * irms + bv[nt];
      if constexpr (NT == 4) {
        if (s < 8) {
          float ss = 0.f;
#pragma unroll
          for (int nt = 0; nt < 4; ++nt) ss += v[nt][0] * v[nt][0] + v[nt][1] * v[nt][1] + v[nt][2] * v[nt][2] + v[nt][3] * v[nt][3];
          ss += __shfl_xor(ss, 16); ss += __shfl_xor(ss, 32);
          const float r = rsqrtf(ss * (1.f / 64.f) + EPS) * (s < 6 ? QSCALE : 1.f);
#pragma unroll
          for (int nt = 0; nt < 4; ++nt) v[nt] = v[nt] * r * gvv[nt];
          if (latent) {
            const int pr = tok >> 6, pc = tok & 63;
            const f32x4 r0 = *(const f32x4*)(rope + (pr * 16 + 4 * g) * 2), r1 = *(const f32x4*)(rope + (pr * 16 + 4 * g) * 2 + 4);
            const f32x4 c0 = *(const f32x4*)(rope + (pc * 16 + 4 * g) * 2), c1 = *(const f32x4*)(rope + (pc * 16 + 4 * g) * 2 + 4);
            const float cr_[4] = {r0[0], r0[2], r1[0], r1[2]}, sr_[4] = {r0[1], r0[3], r1[1], r1[3]};
            const float cc_[4] = {c0[0], c0[2], c1[0], c1[2]}, sc_[4] = {c0[1], c0[3], c1[1], c1[3]};
#pragma unroll
            for (int j = 0; j < 4; ++j) {
              const float t1 = v[0][j], t2 = v[1][j]; v[0][j] = t1 * cr_[j] - t2 * sr_[j]; v[1][j] = t2 * cr_[j] + t1 * sr_[j];
              const float u1 = v[2][j], u2 = v[3][j]; v[2][j] = u1 * cc_[j] - u2 * sc_[j]; v[3][j] = u2 * cc_[j] + u1 * sc_[j];
            }
          }
        }
      }
      if (s >= S_NQ && s < S_NK) {
#pragma unroll
        for (int nt = 0; nt < NT; ++nt) v[nt] = v[nt] * QSCALE;
      } else if (s >= S_RK && s < S_RV) {
#pragma unroll
        for (int nt = 0; nt < NT; ++nt) v[nt] = v[nt] * 0.125f;
      } else if (s >= S_RG) {
#pragma unroll
        for (int nt = 0; nt < NT; ++nt)
#pragma unroll
          for (int j = 0; j < 4; ++j) v[nt][j] = silu_f(v[nt][j]);
      }
#pragma unroll
      for (int nt = 0; nt < NT; ++nt) { u32x2 o; o.x = pk2(v[nt][0], v[nt][1]); o.y = pk2(v[nt][2], v[nt][3]); *(u32x2*)(zb + (size_t)tok * 64 + nt * 16 + 4 * g) = o; }
    }
  }
};

struct EpiOutProj {
  const float* xlat; const float* xctx; const float* mod; float* XR;
  __device__ __forceinline__ void operator()(f32x4 (&acc)[8][4], int mw, int nw, int g, int li) const {
    const int seg = (mw < NLAT) ? (mw >> 13) : 2;
    const float* gt = mod + seg * 6144 + 2048;
    f32x4 gv[4];
#pragma unroll
    for (int nt = 0; nt < 4; ++nt) gv[nt] = *(const f32x4*)(gt + nw + nt * 16 + 4 * g);
    const float* xbase = (mw < NLAT) ? (xlat + (size_t)mw * D) : (xctx + (size_t)(mw - NLAT) * D);
#pragma unroll
    for (int mb = 0; mb < 8; mb += 2) {
      f32x4 xv[2][4];
#pragma unroll
      for (int u = 0; u < 2; ++u)
#pragma unroll
        for (int nt = 0; nt < 4; ++nt) xv[u][nt] = *(const f32x4*)(xbase + (size_t)((mb + u) * 16 + li) * D + nw + nt * 16 + 4 * g);
#pragma unroll
      for (int u = 0; u < 2; ++u)
#pragma unroll
        for (int nt = 0; nt < 4; ++nt) *(f32x4*)(XR + (size_t)(mw + (mb + u) * 16 + li) * D + nw + nt * 16 + 4 * g) = xv[u][nt] + gv[nt] * acc[mb + u][nt];
    }
  }
};

struct EpiMoeUp {
  bf16* act; int slot0; int nvalid;
  __device__ __forceinline__ void operator()(f32x4 (&acc)[4][4], int mw, int nw, int g, int li) const {
#pragma unroll
    for (int mt = 0; mt < 4; ++mt) {
      const int r = mw + mt * 16 + li;
      if (r < nvalid) {
#pragma unroll
        for (int u = 0; u < 2; ++u) {
          const int hid = (nw >> 1) + u * 16 + 4 * g;
          const f32x4 a1 = acc[mt][2 * u], a3 = acc[mt][2 * u + 1];
          u32x2 o; o.x = pk2(silu_f(a1[0]) * a3[0], silu_f(a1[1]) * a3[1]); o.y = pk2(silu_f(a1[2]) * a3[2], silu_f(a1[3]) * a3[3]);
          *(u32x2*)(act + (size_t)(slot0 + r) * 512 + hid) = o;
        }
      }
    }
  }
};

struct EpiMoeDown {
  const int* list; const float* gatew; bf16* ym0; bf16* ym1; int nvalid;
  __device__ __forceinline__ void operator()(f32x4 (&acc)[4][4], int mw, int nw, int g, int li) const {
    int ent[4]; float gw[4];
#pragma unroll
    for (int mt = 0; mt < 4; ++mt) { const int r = mw + mt * 16 + li; ent[mt] = list[r < nvalid ? r : nvalid - 1]; }
#pragma unroll
    for (int mt = 0; mt < 4; ++mt) gw[mt] = gatew[ent[mt]];
#pragma unroll
    for (int mt = 0; mt < 4; ++mt) {
      const int r = mw + mt * 16 + li;
      if (r < nvalid) {
        bf16* y = ((ent[mt] & 1) ? ym1 : ym0) + (size_t)(ent[mt] >> 1) * D;
#pragma unroll
        for (int nt = 0; nt < 4; ++nt) {
          const int n = nw + nt * 16 + 4 * g;
          u32x2 o; o.x = pk2(acc[mt][nt][0] * gw[mt], acc[mt][nt][1] * gw[mt]); o.y = pk2(acc[mt][nt][2] * gw[mt], acc[mt][nt][3] * gw[mt]);
          *(u32x2*)(y + n) = o;
        }
      }
    }
  }
};

struct ARowGather { const bf16* H; const int* list; int nvalid; __device__ __forceinline__ const bf16* operator()(int r) const { const int rr = r < nvalid ? r : nvalid - 1; return H + (size_t)(list[rr] >> 1) * D; } };
struct ARowAct { const bf16* act; int slot0; __device__ __forceinline__ const bf16* operator()(int r) const { int s = slot0 + r; s = s < 2 * NROWS ? s : 2 * NROWS - 1; return act + (size_t)s * 512; } };

template <int NQB, bool NAM, int NW>
__device__ __forceinline__ void attn_item(unsigned char* lds, int gb, int wl, int lane, const bf16* zb, int sq0, int sk, int sv, int qtok0, int lat0, int nlat, int ntiles,
                                          int drbase, bf16* Y, size_t yrow0, int ycol0, const float* mixg) {
  const int g = lane >> 4, li = lane & 15;
  const int qtok = qtok0 + 16 * wl + li;
  bf16x8 qf[NQB][2];
#pragma unroll
  for (int qb = 0; qb < NQB; ++qb)
#pragma unroll
    for (int kk = 0; kk < 2; ++kk) qf[qb][kk] = *(const bf16x8*)(zb + ((size_t)(sq0 + qb) * NT_TOK + qtok) * 64 + kk * 32 + g * 8);
  const bf16* kbp = zb + (size_t)sk * NT_TOK * 64;
  const bf16* vbp = zb + (size_t)sv * NT_TOK * 64;
  f32x4 O[4][NQB], L[NQB];
  const bf16x8 ones = {0x3f80, 0x3f80, 0x3f80, 0x3f80, 0x3f80, 0x3f80, 0x3f80, 0x3f80};
#pragma unroll
  for (int qb = 0; qb < NQB; ++qb) { L[qb] = (f32x4){0.f, 0.f, 0.f, 0.f};
#pragma unroll
    for (int db = 0; db < 4; ++db) O[db][qb] = (f32x4){0.f, 0.f, 0.f, 0.f}; }
  const int f = (li >> 1) & 7;
  const int koff = li * 128 + ((g ^ f) << 4);
  const int q_ = li >> 2, p_ = li & 3, fv = (2 * g + (q_ >> 1)) & 7;
  const int voff = (4 * g + q_) * 128 + (p_ & 1) * 8;
  const float* rpbt = (const float*)(lds + gb + 49152);
  const int qc = 16 * wl + li;
  int cs = qc - 8; cs = cs < 0 ? 0 : (cs > 48 ? 48 : cs);
#define AT_TOK(t) ((t) < nlat ? lat0 + 64 * (t) : NSEQ + 64 * ((t) - nlat))
#define AT_STAGE(t, bi) do { const int tk_ = AT_TOK(t); stage_rows<64, NW>(lds, gb + (bi) * 16384, kbp + (size_t)tk_ * 64, 64, wl, lane); \
                             stage_rows<64, NW>(lds, gb + (bi) * 16384 + 8192, vbp + (size_t)tk_ * 64, 64, wl, lane); } while (0)
#define AT_WAIT1() do { if (NW == 8) VMCNT(2); else VMCNT(4); } while (0)
  AT_STAGE(0, 0);
  if (ntiles > 1) { AT_STAGE(1, 1); AT_WAIT1(); } else { VMCNT(0); }
  RAW_BAR();
  int cur = 0;
  for (int t = 0; t < ntiles; ++t) {
    const int kb_off = gb + cur * 16384, vb_off = kb_off + 8192;
    const int pfb = cur == 0 ? 2 : cur - 1;
    if (t + 2 < ntiles) AT_STAGE(t + 2, pfb);
#pragma unroll
    for (int ks = 0; ks < 2; ++ks) {
      f32x4 s[2][NQB];
#pragma unroll
      for (int h2 = 0; h2 < 2; ++h2) {
#pragma unroll
        for (int qb = 0; qb < NQB; ++qb) s[h2][qb] = (f32x4){0.f, 0.f, 0.f, 0.f};
#pragma unroll
        for (int kk = 0; kk < 2; ++kk) {
          const bf16x8 kf = lds_frag(lds, kb_off + (((2 * ks + h2) * 2048 + koff) ^ (kk << 6)));
#pragma unroll
          for (int qb = 0; qb < NQB; ++qb) s[h2][qb] = __builtin_amdgcn_mfma_f32_16x16x32_bf16(kf, qf[qb][kk], s[h2][qb], 0, 0, 0);
        }
      }
      bf16x8 pf[NQB];
#pragma unroll
      for (int qb = 0; qb < NQB; ++qb) {
        float p[8];
#pragma unroll
        for (int h2 = 0; h2 < 2; ++h2)
#pragma unroll
          for (int j = 0; j < 4; ++j) {
            float x = s[h2][qb][j];
            if (NAM) {
              if (t < nlat) {
                const int kc = (2 * ks + h2) * 16 + 4 * g + j;
                const bool valid = (kc >= cs) && (kc < cs + 16);
                int dc = kc - qc + 15; dc = dc < 0 ? 0 : (dc > 30 ? 30 : dc);
                x += rpbt[(drbase + t) * 31 + dc];
                x = valid ? x : -1e30f;
              }
            }
            const float e = __builtin_amdgcn_exp2f(x);
            p[h2 * 4 + j] = e;
          }
        u32x4 pw; pw.x = pk2(p[0], p[1]); pw.y = pk2(p[2], p[3]); pw.z = pk2(p[4], p[5]); pw.w = pk2(p[6], p[7]);
        pf[qb] = __builtin_bit_cast(bf16x8, pw);
        L[qb] = __builtin_amdgcn_mfma_f32_16x16x32_bf16(ones, pf[qb], L[qb], 0, 0, 0);
      }
#pragma unroll
      for (int db = 0; db < 4; ++db) {
        const int a0 = vb_off + ks * 4096 + voff + (((db * 2 + (p_ >> 1)) ^ fv) << 4);
        const bf16x8 vf = lds_tr2(lds, a0, a0 + 2048);
#pragma unroll
        for (int qb = 0; qb < NQB; ++qb) O[db][qb] = __builtin_amdgcn_mfma_f32_16x16x32_bf16(vf, pf[qb], O[db][qb], 0, 0, 0);
      }
    }
    if (t + 2 < ntiles) { AT_WAIT1(); } else { VMCNT(0); }
    LGKM0(); RAW_BAR();
    cur = cur == 2 ? 0 : cur + 1;
  }
#undef AT_TOK
#undef AT_STAGE
#undef AT_WAIT1
#pragma unroll
  for (int qb = 0; qb < NQB; ++qb) {
    const float inv = 1.f / L[qb][0];
    float ss = 0.f;
#pragma unroll
    for (int db = 0; db < 4; ++db) { O[db][qb] = O[db][qb] * inv; ss += O[db][qb][0] * O[db][qb][0] + O[db][qb][1] * O[db][qb][1] + O[db][qb][2] * O[db][qb][2] + O[db][qb][3] * O[db][qb][3]; }
    ss += __shfl_xor(ss, 16); ss += __shfl_xor(ss, 32);
    const float r = rsqrtf(ss * (1.f / 64.f) + EPS);
    bf16* yp = Y + (yrow0 + 16 * wl + li) * D + ycol0 + qb * 64;
#pragma unroll
    for (int db = 0; db < 4; ++db) {
      const f32x4 gv = *(const f32x4*)(mixg + ycol0 + qb * 64 + db * 16 + 4 * g);
      const f32x4 y = O[db][qb] * r * gv;
      u32x2 o; o.x = pk2(y[0], y[1]); o.y = pk2(y[2], y[3]);
      *(u32x2*)(yp + db * 16 + 4 * g) = o;
    }
  }
}

__device__ __forceinline__ void ret_u_item(unsigned char* lds, int gb, int tg, const bf16* zb, int h, int c, float lgf2, float lgb2, float* Uf, float* Ub) {
  const int lane = tg & 63, w = __builtin_amdgcn_readfirstlane(tg >> 6), g = lane >> 4, li = lane & 15;
  const int tok0 = c < 2 ? NSEQ + 128 * c : 128 * (c - 2);
  const bf16* kp = zb + ((size_t)(S_RK + h) * NT_TOK + tok0) * 64;
  const bf16* vp = zb + ((size_t)(S_RV + h) * NT_TOK + tok0) * 64;
  stage_rows<128, 4>(lds, gb, kp, 64, w, lane);
  {
    const int row = tg >> 1, half = tg & 1;
    const float wf = __builtin_amdgcn_exp2f(lgf2 * (float)(127 - row)), wb = __builtin_amdgcn_exp2f(lgb2 * (float)row);
#pragma unroll
    for (int c4 = 0; c4 < 4; ++c4) {
      const int chunk = half * 4 + c4;
      const u32x4 v = *(const u32x4*)(vp + (size_t)row * 64 + chunk * 8);
      u32x4 of, ob;
#pragma unroll
      for (int i = 0; i < 4; ++i) { const float lo = bflo(v[i]), hi = bfhi(v[i]); of[i] = pk2(lo * wf, hi * wf); ob[i] = pk2(lo * wb, hi * wb); }
      *(u32x4*)(lds + gb + 16384 + lds_swz(row, chunk)) = of;
      *(u32x4*)(lds + gb + 32768 + lds_swz(row, chunk)) = ob;
    }
  }
  VM_WAIT(); __syncthreads();
  const int q_ = li >> 2, p_ = li & 3, fv = (2 * g + (q_ >> 1)) & 7;
  const int toff = gb + (4 * g + q_) * 128 + (p_ & 1) * 8;
  f32x4 acc[2][4];
#pragma unroll
  for (int d_ = 0; d_ < 2; ++d_)
#pragma unroll
    for (int eb = 0; eb < 4; ++eb) acc[d_][eb] = (f32x4){0.f, 0.f, 0.f, 0.f};
#pragma unroll
  for (int ks = 0; ks < 4; ++ks) {
    const int a0 = ks * 4096 + toff + (((w * 2 + (p_ >> 1)) ^ fv) << 4);
    const bf16x8 kf = lds_tr2(lds, a0, a0 + 2048);
#pragma unroll
    for (int eb = 0; eb < 4; ++eb) {
      const int b0 = ks * 4096 + toff + (((eb * 2 + (p_ >> 1)) ^ fv) << 4);
      const bf16x8 vf = lds_tr2(lds, 16384 + b0, 16384 + b0 + 2048);
      const bf16x8 vb = lds_tr2(lds, 32768 + b0, 32768 + b0 + 2048);
      acc[0][eb] = __builtin_amdgcn_mfma_f32_16x16x32_bf16(kf, vf, acc[0][eb], 0, 0, 0);
      acc[1][eb] = __builtin_amdgcn_mfma_f32_16x16x32_bf16(kf, vb, acc[1][eb], 0, 0, 0);
    }
  }
#pragma unroll
  for (int eb = 0; eb < 4; ++eb) {
    *(f32x4*)(Uf + (eb * 16 + li) * 64 + w * 16 + 4 * g) = acc[0][eb];
    *(f32x4*)(Ub + (eb * 16 + li) * 64 + w * 16 + 4 * g) = acc[1][eb];
  }
  __syncthreads();
}

__device__ __forceinline__ void ret_out_item(unsigned char* lds, int gb, int tg, const bf16* zb, int h, int c, float lgf2, float lgb2, const float* Sf, const float* Sb,
                                             bf16* Y, size_t yrow0, const float* mixg) {
  const int lane = tg & 63, w = __builtin_amdgcn_readfirstlane(tg >> 6), g = lane >> 4, li = lane & 15;
  const int tok0 = c < 2 ? NSEQ + 128 * c : 128 * (c - 2);
  const bf16* qp = zb + ((size_t)(S_RQ + h) * NT_TOK + tok0) * 64;
  const bf16* kp = zb + ((size_t)(S_RK + h) * NT_TOK + tok0) * 64;
  const bf16* vp = zb + ((size_t)(S_RV + h) * NT_TOK + tok0) * 64;
  const bf16* gp = zb + ((size_t)(S_RG + h) * NT_TOK + tok0) * 64;
  stage_rows<128, 4>(lds, gb, kp, 64, w, lane);
  stage_rows<128, 4>(lds, gb + 16384, vp, 64, w, lane);
  {
    const int e = tg >> 2, dq = tg & 3;
#pragma unroll
    for (int hh = 0; hh < 2; ++hh) {
      const f32x4 a0 = *(const f32x4*)(Sf + e * 64 + dq * 16 + hh * 8), a1 = *(const f32x4*)(Sf + e * 64 + dq * 16 + hh * 8 + 4);
      const f32x4 b0 = *(const f32x4*)(Sb + e * 64 + dq * 16 + hh * 8), b1 = *(const f32x4*)(Sb + e * 64 + dq * 16 + hh * 8 + 4);
      u32x4 oa, ob; oa.x = pk2(a0[0], a0[1]); oa.y = pk2(a0[2], a0[3]); oa.z = pk2(a1[0], a1[1]); oa.w = pk2(a1[2], a1[3]);
      ob.x = pk2(b0[0], b0[1]); ob.y = pk2(b0[2], b0[3]); ob.z = pk2(b1[0], b1[1]); ob.w = pk2(b1[2], b1[3]);
      *(u32x4*)(lds + gb + 32768 + lds_swz(e, dq * 2 + hh)) = oa;
      *(u32x4*)(lds + gb + 40960 + lds_swz(e, dq * 2 + hh)) = ob;
    }
  }
  bf16x8 qf[2][2];
#pragma unroll
  for (int ib = 0; ib < 2; ++ib)
#pragma unroll
    for (int kk = 0; kk < 2; ++kk) qf[ib][kk] = *(const bf16x8*)(qp + (size_t)(32 * w + 16 * ib + li) * 64 + kk * 32 + g * 8);
  VM_WAIT(); __syncthreads();
  const int f = (li >> 1) & 7;
  const int koff = gb + li * 128 + ((g ^ f) << 4);
  const int q_ = li >> 2, p_ = li & 3, fv = (2 * g + (q_ >> 1)) & 7;
  const int voff = gb + 16384 + (4 * g + q_) * 128 + (p_ & 1) * 8;
  f32x4 O[4][2], CF[4][2], CB[4][2];
#pragma unroll
  for (int eb = 0; eb < 4; ++eb)
#pragma unroll
    for (int ib = 0; ib < 2; ++ib) { O[eb][ib] = (f32x4){0.f, 0.f, 0.f, 0.f}; CF[eb][ib] = O[eb][ib]; CB[eb][ib] = O[eb][ib]; }
#pragma unroll
  for (int ks = 0; ks < 4; ++ks) {
    f32x4 s[2][2];
#pragma unroll
    for (int h2 = 0; h2 < 2; ++h2) {
      s[h2][0] = (f32x4){0.f, 0.f, 0.f, 0.f}; s[h2][1] = s[h2][0];
#pragma unroll
      for (int kk = 0; kk < 2; ++kk) {
        const bf16x8 kf = lds_frag(lds, ((2 * ks + h2) * 2048 + koff) ^ (kk << 6));
        s[h2][0] = __builtin_amdgcn_mfma_f32_16x16x32_bf16(kf, qf[0][kk], s[h2][0], 0, 0, 0);
        s[h2][1] = __builtin_amdgcn_mfma_f32_16x16x32_bf16(kf, qf[1][kk], s[h2][1], 0, 0, 0);
      }
    }
    bf16x8 pf[2];
#pragma unroll
    for (int ib = 0; ib < 2; ++ib) {
      const int i = 32 * w + 16 * ib + li;
      float p[8];
#pragma unroll
      for (int h2 = 0; h2 < 2; ++h2)
#pragma unroll
        for (int j = 0; j < 4; ++j) {
          const int jj = (2 * ks + h2) * 16 + 4 * g + j, df = i - jj;
          const float dw = df > 0 ? __builtin_amdgcn_exp2f(lgf2 * (float)df) : (df < 0 ? __builtin_amdgcn_exp2f(lgb2 * (float)(-df)) : 2.f);
          p[h2 * 4 + j] = s[h2][ib][j] * dw;
        }
      u32x4 pw; pw.x = pk2(p[0], p[1]); pw.y = pk2(p[2], p[3]); pw.z = pk2(p[4], p[5]); pw.w = pk2(p[6], p[7]);
      pf[ib] = __builtin_bit_cast(bf16x8, pw);
    }
#pragma unroll
    for (int eb = 0; eb < 4; ++eb) {
      const int a0 = voff + ks * 4096 + (((eb * 2 + (p_ >> 1)) ^ fv) << 4);
      const bf16x8 vf = lds_tr2(lds, a0, a0 + 2048);
      O[eb][0] = __builtin_amdgcn_mfma_f32_16x16x32_bf16(vf, pf[0], O[eb][0], 0, 0, 0);
      O[eb][1] = __builtin_amdgcn_mfma_f32_16x16x32_bf16(vf, pf[1], O[eb][1], 0, 0, 0);
    }
  }
#pragma unroll
  for (int kk = 0; kk < 2; ++kk)
#pragma unroll
    for (int eb = 0; eb < 4; ++eb) {
      const bf16x8 sf = lds_frag(lds, 32768 + ((eb * 2048 + koff) ^ (kk << 6)));
      const bf16x8 sb = lds_frag(lds, 40960 + ((eb * 2048 + koff) ^ (kk << 6)));
#pragma unroll
      for (int ib = 0; ib < 2; ++ib) {
        CF[eb][ib] = __builtin_amdgcn_mfma_f32_16x16x32_bf16(sf, qf[ib][kk], CF[eb][ib], 0, 0, 0);
        CB[eb][ib] = __builtin_amdgcn_mfma_f32_16x16x32_bf16(sb, qf[ib][kk], CB[eb][ib], 0, 0, 0);
      }
    }
#pragma unroll
  for (int ib = 0; ib < 2; ++ib) {
    const int i = 32 * w + 16 * ib + li;
    const float xf = __builtin_amdgcn_exp2f(lgf2 * (float)(i + 1)), xb = __builtin_amdgcn_exp2f(lgb2 * (float)(128 - i));
    float ss = 0.f;
#pragma unroll
    for (int eb = 0; eb < 4; ++eb) { O[eb][ib] = O[eb][ib] + CF[eb][ib] * xf + CB[eb][ib] * xb; ss += O[eb][ib][0] * O[eb][ib][0] + O[eb][ib][1] * O[eb][ib][1] + O[eb][ib][2] * O[eb][ib][2] + O[eb][ib][3] * O[eb][ib][3]; }
    ss += __shfl_xor(ss, 16); ss += __shfl_xor(ss, 32);
    const float r = rsqrtf(ss * (1.f / 64.f) + EPS);
    bf16* yp = Y + (yrow0 + i) * D + 640 + h * 64;
#pragma unroll
    for (int eb = 0; eb < 4; ++eb) {
      const f32x4 gv = *(const f32x4*)(mixg + 640 + h * 64 + eb * 16 + 4 * g);
      const u32x2 gg = *(const u32x2*)(gp + (size_t)i * 64 + eb * 16 + 4 * g);
      const f32x4 y = O[eb][ib] * r * gv;
      u32x2 o; o.x = pk2(y[0] * bflo(gg.x), y[1] * bfhi(gg.x)); o.y = pk2(y[2] * bflo(gg.y), y[3] * bfhi(gg.y));
      *(u32x2*)(yp + eb * 16 + 4 * g) = o;
    }
  }
  __syncthreads();
}

__device__ __forceinline__ float log_sigmoid_f(float x) { return x >= 0.f ? -log1pf(expf(-x)) : x - log1pf(expf(x)); }

__device__ __forceinline__ void p0_mod_item(unsigned char* lds, const Params& P, int item) {
  const int l = item / 96, chunk = item % 96, tid = get_tid(), ks = tid >> 4, cg4 = tid & 15;
  float* red = (float*)lds;
  float* sil = (float*)(lds + 32768);
#pragma unroll
  for (int i = 0; i < 2; ++i) { const int k = tid + 512 * i; sil[k] = silu_f(P.c[k]); sil[1024 + k] = silu_f(P.c[1024 + k]); sil[2048 + k] = silu_f(P.c_ctx[k]); }
  __syncthreads();
  const float* wa = P.w_ada + (size_t)l * 1024 * 6144 + chunk * 64 + cg4 * 4;
  f32x4 a0 = {0.f, 0.f, 0.f, 0.f}, a1 = a0, a2 = a0;
#pragma unroll 16
  for (int i = 0; i < 32; ++i) {
    const int k = ks * 32 + i;
    const f32x4 wv = __builtin_nontemporal_load((const f32x4*)(wa + (size_t)k * 6144));
    a0 += wv * sil[k]; a1 += wv * sil[1024 + k]; a2 += wv * sil[2048 + k];
  }
  *(f32x4*)(red + (ks * 3 + 0) * 64 + cg4 * 4) = a0; *(f32x4*)(red + (ks * 3 + 1) * 64 + cg4 * 4) = a1; *(f32x4*)(red + (ks * 3 + 2) * 64 + cg4 * 4) = a2;
  __syncthreads();
  if (tid < 192) {
    const int seg = tid >> 6, col = tid & 63; float s = P.b_ada[l * 6144 + chunk * 64 + col];
#pragma unroll
    for (int k2 = 0; k2 < 32; ++k2) s += red[(k2 * 3 + seg) * 64 + col];
    ((float*)(P.ws + WS_MOD))[(l * 3 + seg) * 6144 + chunk * 64 + col] = s;
  }
  __syncthreads();
}

__device__ __forceinline__ void p0_tr_item(unsigned char* lds, const float* src, int srcN, int k0, int n0, bf16* dst, int dstK, int mode) {
  float* tile = (float*)lds;
  const int tid = get_tid();
  f32x4 v[8];
#pragma unroll
  for (int ps = 0; ps < 8; ++ps) v[ps] = __builtin_nontemporal_load((const f32x4*)(src + (size_t)(k0 + (tid >> 5) + 16 * ps) * srcN + n0 + (tid & 31) * 4));
#pragma unroll
  for (int ps = 0; ps < 8; ++ps) { float* tp = tile + ((tid >> 5) + 16 * ps) * 129 + (tid & 31) * 4; tp[0] = v[ps][0]; tp[1] = v[ps][1]; tp[2] = v[ps][2]; tp[3] = v[ps][3]; }
  __syncthreads();
  const int n = tid >> 2, kc = tid & 3, ncol = n0 + n;
  int row = ncol;
  if (mode) row = (ncol >> 4) * 32 + (ncol & 15) + (mode == 2 ? 16 : 0);
  bf16* dp = dst + (size_t)row * dstK + k0 + kc * 32;
  const float* tp = tile + (kc * 32) * 129 + n;
#pragma unroll
  for (int q = 0; q < 4; ++q) {
    u32x4 o;
#pragma unroll
    for (int i = 0; i < 4; ++i) o[i] = pk2(tp[(q * 8 + 2 * i) * 129], tp[(q * 8 + 2 * i + 1) * 129]);
    *(u32x4*)(dp + q * 8) = o;
  }
  __syncthreads();
}

constexpr int P0_MOD = 192, P0_MISC = 1, P0_WIN = 2 * 8 * 23, P0_WO = 2 * 8 * 8, P0_W1 = 32 * 32, P0_W2 = 32 * 32;
constexpr int P0_ITEMS = P0_MOD + P0_MISC + P0_WIN + P0_WO + 2 * P0_W1 + P0_W2;

__device__ __forceinline__ void phase0(unsigned char* lds, const Params& P) {
#pragma unroll 1
  for (int it = blockIdx.x; it < P0_ITEMS; it += gridDim.x) {
    int r = it;
    if (r < P0_MOD) { p0_mod_item(lds, P, r); continue; } r -= P0_MOD;
    if (r < P0_MISC) {
      const int tid = get_tid();
      float* rope = (float*)(P.ws + WS_ROPE);
      for (int e = tid; e < 2048; e += NTHR) { const int pos = e >> 4, f = e & 15; const float inv = powf(10000.f, -(float)f / 16.f); const float ang = (float)pos * inv; rope[e * 2] = cosf(ang); rope[e * 2 + 1] = sinf(ang); }
      continue;
    } r -= P0_MISC;
    const float* src; int srcN, k0, n0, dstK, mode; bf16* dst;
    if (r < P0_WIN) { const int l = r / 184, q = r % 184, kt = q / 23, nt = q % 23;
      src = P.w_in + (size_t)l * 1024 * INC; srcN = INC; k0 = kt * 128; n0 = nt * 128; dst = (bf16*)(P.ws + WS_WIN) + (size_t)l * INC * 1024; dstK = 1024; mode = 0; }
    else if (r < P0_WIN + P0_WO) { const int r2 = r - P0_WIN, l = r2 / 64, q = r2 % 64, kt = q / 8, nt = q % 8;
      src = P.w_out + (size_t)l * 1024 * 1024; srcN = 1024; k0 = kt * 128; n0 = nt * 128; dst = (bf16*)(P.ws + WS_WO) + (size_t)l * 1024 * 1024; dstK = 1024; mode = 0; }
    else if (r < P0_WIN + P0_WO + 2 * P0_W1) { const int r2 = r - P0_WIN - P0_WO, which = r2 / P0_W1, q2 = r2 % P0_W1, le = q2 / 32, q = q2 % 32, kt = q / 4, nt = q % 4;
      src = (which ? P.w3 : P.w1) + (size_t)le * 1024 * 512; srcN = 512; k0 = kt * 128; n0 = nt * 128; dst = (bf16*)(P.ws + WS_W13) + (size_t)le * 1024 * 1024; dstK = 1024; mode = which ? 2 : 1; }
    else { const int r2 = r - P0_WIN - P0_WO - 2 * P0_W1, le = r2 / 32, q = r2 % 32, kt = q / 8, nt = q % 8;
      src = P.w2 + (size_t)le * 512 * 1024; srcN = 1024; k0 = kt * 128; n0 = nt * 128; dst = (bf16*)(P.ws + WS_W2) + (size_t)le * 1024 * 512; dstK = 512; mode = 0; }
    p0_tr_item(lds, src, srcN, k0, n0, dst, dstK, mode);
  }
}

constexpr int P1_XB = NROWS / 16, P1_BIAS = 2 * INC / 8, P1_WR = 6, P1_ITEMS = P1_XB + P1_BIAS + P1_WR;
__device__ __forceinline__ void phase1(unsigned char* lds, const Params& P) {
  const int tid = get_tid(), lane = tid & 63, w = tid >> 6;
  const float* mod = (const float*)(P.ws + WS_MOD);
#pragma unroll 1
  for (int it = blockIdx.x; it < P1_ITEMS; it += gridDim.x) {
    int r = it;
    if (r < P1_XB) {
      f32x4 v[2][4];
#pragma unroll
      for (int u = 0; u < 2; ++u) { const int row = r * 16 + 2 * w + u; const float* xr = row < NLAT ? P.x + (size_t)row * D : P.ctx + (size_t)(row - NLAT) * D;
#pragma unroll
        for (int j = 0; j < 4; ++j) v[u][j] = *(const f32x4*)(xr + 4 * lane + 256 * j); }
      const int row0 = r * 16 + 2 * w, seg = row0 < NSEQ ? 0 : (row0 < NLAT ? 1 : 2);
      const float* sc1 = mod + (0 * 3 + seg) * 6144 + 1024;
      f32x4 gs[4];
#pragma unroll
      for (int j = 0; j < 4; ++j) { const int k = 4 * lane + 256 * j; gs[j] = *(const f32x4*)(P.n1g + k) * (*(const f32x4*)(sc1 + k) + 1.f); }
#pragma unroll
      for (int u = 0; u < 2; ++u) {
        const int row = row0 + u; bf16* xb = (bf16*)(P.ws + WS_R1) + (size_t)row * D; float ss = 0.f;
#pragma unroll
        for (int j = 0; j < 4; ++j) { const f32x4 x = v[u][j]; ss += x[0] * x[0] + x[1] * x[1] + x[2] * x[2] + x[3] * x[3]; const f32x4 o = x * gs[j]; u32x2 ov; ov.x = pk2(o[0], o[1]); ov.y = pk2(o[2], o[3]); *(u32x2*)(xb + 4 * lane + 256 * j) = ov; }
        ss = wsum(ss);
        if (lane == 0) ((float*)(P.ws + WS_RSS))[row] = ss;
      }
      continue;
    } r -= P1_XB;
    if (r < P1_BIAS) {
      const int idx = r * 8 + w, l = idx / INC, n = idx % INC;
      const bf16* wrow = (const bf16*)(P.ws + WS_WIN) + ((size_t)l * INC + n) * 1024 + lane * 16;
      const u32x4 w0 = *(const u32x4*)wrow, w1 = *(const u32x4*)(wrow + 8);
      float wv[16];
#pragma unroll
      for (int i = 0; i < 4; ++i) { wv[2 * i] = bflo(w0[i]); wv[2 * i + 1] = bfhi(w0[i]); wv[8 + 2 * i] = bflo(w1[i]); wv[8 + 2 * i + 1] = bfhi(w1[i]); }
#pragma unroll
      for (int seg = 0; seg < 3; ++seg) {
        const float* sh = mod + (l * 3 + seg) * 6144 + lane * 16; float a = 0.f;
#pragma unroll
        for (int i = 0; i < 16; ++i) a += wv[i] * sh[i];
        a = wsum(a);
        if (lane == 0) ((float*)(P.ws + WS_BIAS))[(l * 3 + seg) * INC + n] = a;
      }
      continue;
    } r -= P1_BIAS;
    { const int l = r / 3, seg = r % 3;
      const float* m = mod + (l * 3 + seg) * 6144;
      float* wr = (float*)(P.ws + WS_WR) + (size_t)(l * 3 + seg) * 16384;
      for (int e = tid; e < 16384; e += NTHR) { const int k = e >> 4; wr[e] = P.n2g[l * 1024 + k] * (1.f + m[4096 + k]) * P.w_router[e]; }
      const int ex = tid & 15, ks = tid >> 4; float a = 0.f;
      for (int i = 0; i < 32; ++i) { const int k = ks * 32 + i; a += m[3072 + k] * P.w_router[k * 16 + ex]; }
      float* red = (float*)lds; red[ks * 16 + ex] = a; __syncthreads();
      if (tid < 16) { float s = P.b_router[tid]; for (int k2 = 0; k2 < 32; ++k2) s += red[k2 * 16 + tid]; ((float*)(P.ws + WS_CR))[(l * 3 + seg) * 16 + tid] = s; }
      __syncthreads();
    }
  }
}

__device__ __forceinline__ int xcd_vidx(int round) {
  const int G = gridDim.x, b = blockIdx.x;
  return (G & 7) == 0 ? round * G + (b & 7) * (G >> 3) + (b >> 3) : round * G + b;
}

__device__ __forceinline__ void phaseA(unsigned char* lds, const Params& P, int l) {
  const bf16* XB = (const bf16*)(P.ws + WS_R1);
  const bf16* Wt = (const bf16*)(P.ws + WS_WIN) + (size_t)l * INC * 1024;
  { const int tid = get_tid(); const f32x4* s4 = (const f32x4*)(P.ws + WS_ROPE); f32x4* d4 = (f32x4*)(lds + LDS_MISC);
    for (int e = tid; e < 1024; e += NTHR) d4[e] = s4[e];
    __syncthreads(); }
  const float* ropel = (const float*)(lds + LDS_MISC);
  EpiInProj<8, 4> E4{(const float*)(P.ws + WS_RSS), (const float*)(P.ws + WS_BIAS) + l * 3 * INC, P.qg + l * 64, P.kg + l * 64, ropel, (bf16*)(P.ws + WS_Z)};
  EpiInProj<8, 2> E2{(const float*)(P.ws + WS_RSS), (const float*)(P.ws + WS_BIAS) + l * 3 * INC, P.qg + l * 64, P.kg + l * 64, ropel, (bf16*)(P.ws + WS_Z)};
  constexpr int NFULL = 66 * 11, NITEM = NFULL + 33;
  bool staged = false;
#pragma unroll 1
  for (int round = 0; round * (int)gridDim.x < NITEM; ++round) {
    const int v = xcd_vidx(round);
    if (v >= NITEM) continue;
    if (v < NFULL) {
      const int m = v / 11, n = v % 11;
      const int vn = xcd_vidx(round + 1);
      const bool hn = vn < NFULL;
      ARowLinear ar{XB, 1024, m * 256}, arn{XB, 1024, (hn ? vn / 11 : 0) * 256};
      gemm8_tile(lds, ar, Wt, 1024, m * 256, n * 256, E4); (void)arn; (void)hn;
      staged = false;
    } else {
      const int m2 = (v - NFULL) * 2;
#pragma unroll 1
      for (int h = 0; h < 2; ++h) { ARowLinear ar{XB, 1024, (m2 + h) * 256}; gemm_tile<8, 2>(lds, ar, Wt, 1024, (m2 + h) * 256, 2816, E2); }
      staged = false;
    }
  }
}

__device__ __forceinline__ void phaseB(unsigned char* lds, const Params& P, int l) {
  const bool ctxout = (l == 0);
  const bf16* Z = (const bf16*)(P.ws + WS_Z);
  bf16* Y = (bf16*)P.out;
  const float* mixg = P.mix_g + l * 1024;
  const int tid = get_tid(), lane = tid & 63, w = __builtin_amdgcn_readfirstlane(tid >> 6), grp = w >> 2, wl4 = w & 3, tg = tid & 255, G = gridDim.x;
  { const int n = 256 + (ctxout ? 8 : 0);
#pragma unroll 1
    for (int r = blockIdx.x; r < n; r += G) {
      int b, kvh, qtok0, nlat, ntiles; size_t yrow0;
      if (r < 256) { b = r >> 7; kvh = (r >> 6) & 1; const int qt = r & 63; qtok0 = qt * 128; nlat = 128; ntiles = 132; yrow0 = (size_t)b * NSEQ + qt * 128; }
      else { const int q = r - 256; b = q >> 2; kvh = (q >> 1) & 1; const int qt = q & 1; qtok0 = NSEQ + qt * 128; nlat = 0; ntiles = 4; yrow0 = (size_t)NLAT + b * CL + qt * 128; }
      attn_item<3, false, 8>(lds, 0, w, lane, Z + (size_t)b * NSLOT * NT_TOK * 64, S_AQ + kvh * 3, S_AK + kvh, S_AV + kvh, qtok0, 0, nlat, ntiles, 0, Y, yrow0, kvh * 192, mixg);
    }
  }
  { const int n = 1024 + (ctxout ? 32 : 0);
    int start = (int)blockIdx.x - 8; if (start < 0) start += G;
#pragma unroll 1
    for (int pr = start; pr * 2 < n; pr += G) {
      const int r = pr * 2 + grp;
      int b, h, qtok0, lat0, nlat, ntiles, drbase; size_t yrow0;
      if (r < 1024) { b = r >> 9; h = (r >> 7) & 3; const int row = r & 127; int rs = row - 4; rs = rs < 0 ? 0 : (rs > 120 ? 120 : rs);
        qtok0 = row * 64; lat0 = rs * 64; nlat = 8; ntiles = 12; drbase = rs - row + 7; yrow0 = (size_t)b * NSEQ + row * 64; }
      else { const int q = r - 1024; b = q >> 4; h = (q >> 2) & 3; const int qt = q & 3; qtok0 = NSEQ + qt * 64; lat0 = 0; nlat = 0; ntiles = 4; drbase = 0; yrow0 = (size_t)NLAT + b * CL + qt * 64; }
      float* rp = (float*)(lds + grp * 65536 + 49152);
      const float* src = P.rpb + ((size_t)l * 4 + h) * 465;
      for (int e = tg; e < 465; e += 256) rp[e] = src[e] * LOG2E;
      __syncthreads();
      attn_item<1, true, 4>(lds, grp * 65536, wl4, lane, Z + (size_t)b * NSLOT * NT_TOK * 64, S_NQ + h, S_NK + h, S_NV + h, qtok0, lat0, nlat, ntiles, drbase, Y, yrow0, 384 + h * 64, mixg);
    }
  }
  { int start = (int)blockIdx.x - 40; if (start < 0) start += G;
#pragma unroll 1
    for (int pr = start; pr * 2 < 2 * 6 * 66; pr += G) {
      const int r = pr * 2 + grp;
      const int b = r / 396, q = r % 396, h = q / 66, c = q % 66;
      const float lgf2 = log_sigmoid_f(P.ret_decay[(l * 2 + 0) * 6 + h]) * LOG2E, lgb2 = log_sigmoid_f(P.ret_decay[(l * 2 + 1) * 6 + h]) * LOG2E;
      float* U = (float*)(P.ws + WS_R1);
      ret_u_item(lds, grp * 65536, tg, Z + (size_t)b * NSLOT * NT_TOK * 64, h, c, lgf2, lgb2, U + ((size_t)((b * 6 + h) * 2 + 0) * 66 + c) * 4096, U + ((size_t)((b * 6 + h) * 2 + 1) * 66 + c) * 4096);
    }
  }
}

__device__ __forceinline__ void phaseB2(const Params& P, int l) {
  const float* U = (const float*)(P.ws + WS_R1);
#pragma unroll 1
  for (int it = blockIdx.x; it < 192; it += gridDim.x) {
    const int seq = it >> 3, off = (it & 7) * 512 + get_tid();
    const int dir = seq & 1, h = (seq >> 1) % 6;
    const float lg = log_sigmoid_f(P.ret_decay[(l * 2 + dir) * 6 + h]);
    const float decay = expf(128.f * lg);
    const float* base = U + (size_t)seq * 66 * 4096 + off;
    float* sbase = (float*)((unsigned char*)P.out + S_OFF) + (size_t)seq * 66 * 4096 + off;
    float u[66];
    if (dir == 0) {
#pragma unroll
      for (int st = 0; st < 66; ++st) u[st] = __builtin_nontemporal_load(base + (size_t)st * 4096);
      float s = 0.f;
#pragma unroll
      for (int st = 0; st < 66; ++st) { sbase[(size_t)st * 4096] = s; s = s * decay + u[st]; }
    } else {
#pragma unroll
      for (int st = 0; st < 66; ++st) { const int c = st < 2 ? 1 - st : 67 - st; u[st] = __builtin_nontemporal_load(base + (size_t)c * 4096); }
      float s = 0.f;
#pragma unroll
      for (int st = 0; st < 66; ++st) { const int c = st < 2 ? 1 - st : 67 - st; sbase[(size_t)c * 4096] = s; s = s * decay + u[st]; }
    }
  }
}

__device__ __forceinline__ void phaseB3(unsigned char* lds, const Params& P, int l) {
  const bf16* Z = (const bf16*)(P.ws + WS_Z);
  bf16* Y = (bf16*)P.out;
  const float* mixg = P.mix_g + l * 1024;
  const float* U = (const float*)((const unsigned char*)P.out + S_OFF);
  const int tid = get_tid(), grp = __builtin_amdgcn_readfirstlane(tid >> 8), tg = tid & 255;
  const int cpb = (l == 0) ? 66 : 64, total = 2 * 6 * cpb;
#pragma unroll 1
  for (int pr = blockIdx.x; pr * 2 < total; pr += gridDim.x) {
    const int it = pr * 2 + grp;
    const int b = it / (6 * cpb), q = it % (6 * cpb), h = q / cpb, c = (q % cpb) + (66 - cpb);
    const float lgf2 = log_sigmoid_f(P.ret_decay[(l * 2 + 0) * 6 + h]) * LOG2E, lgb2 = log_sigmoid_f(P.ret_decay[(l * 2 + 1) * 6 + h]) * LOG2E;
    const size_t yrow0 = c < 2 ? (size_t)NLAT + b * CL + 128 * c : (size_t)b * NSEQ + 128 * (c - 2);
    ret_out_item(lds, grp * 65536, tg, Z + (size_t)b * NSLOT * NT_TOK * 64, h, c, lgf2, lgb2, U + ((size_t)((b * 6 + h) * 2 + 0) * 66 + c) * 4096, U + ((size_t)((b * 6 + h) * 2 + 1) * 66 + c) * 4096, Y, yrow0, mixg);
  }
}

__device__ __forceinline__ void pc_small_item(const Params& P, int l, int item) {
  const int tid = get_tid(), lane = tid & 63, w = tid >> 6, g = lane >> 4, li = lane & 15;
  const bf16* Y = (const bf16*)P.out;
  const bf16* Wt = (const bf16*)(P.ws + WS_WO) + (size_t)l * 1024 * 1024;
  float* XR = (float*)(P.ws + WS_XR);
  const int mb = item >> 5, nb = item & 31;
  const int m0 = NLAT + mb * 64 + (w >> 1) * 16, n0 = nb * 32 + (w & 1) * 16;
  const bf16* ar = Y + (size_t)(m0 + li) * D + g * 8;
  const bf16* br = Wt + (size_t)(n0 + li) * D + g * 8;
  f32x4 acc = {0.f, 0.f, 0.f, 0.f};
#pragma unroll 1
  for (int kb = 0; kb < 32; kb += 8) {
    bf16x8 af[8], bf[8];
#pragma unroll
    for (int c = 0; c < 8; ++c) { af[c] = *(const bf16x8*)(ar + (kb + c) * 32); bf[c] = *(const bf16x8*)(br + (kb + c) * 32); }
#pragma unroll
    for (int c = 0; c < 8; ++c) acc = __builtin_amdgcn_mfma_f32_16x16x32_bf16(bf[c], af[c], acc, 0, 0, 0);
  }
  const int m = m0 + li, n = n0 + 4 * g;
  const float* gt = (const float*)(P.ws + WS_MOD) + (l * 3 + 2) * 6144 + 2048;
  const f32x4 xv = *(const f32x4*)(P.ctx + (size_t)(m - NLAT) * D + n), gv = *(const f32x4*)(gt + n);
  *(f32x4*)(XR + (size_t)m * D + n) = xv + gv * acc;
}
__device__ __forceinline__ void phaseC(unsigned char* lds, const Params& P, int l) {
  const bf16* Y = (const bf16*)P.out;
  const bf16* Wt = (const bf16*)(P.ws + WS_WO) + (size_t)l * 1024 * 1024;
  float* XR = (float*)(P.ws + WS_XR);
  EpiOutProj E{l == 0 ? P.x : XR, l == 0 ? P.ctx : XR + (size_t)NLAT * D, (const float*)(P.ws + WS_MOD) + l * 3 * 6144, XR};
  const int nitem = NLAT / 256 * 4;
  bool staged = false;
#pragma unroll 1
  for (int round = 0; round * (int)gridDim.x < nitem; ++round) {
    const int v = xcd_vidx(round);
    if (v >= nitem) continue;
    const int vn = xcd_vidx(round + 1);
    const bool hn = vn < nitem;
    ARowLinear ar{Y, 1024, (v >> 2) * 256}, arn{Y, 1024, (hn ? vn >> 2 : 0) * 256};
    gemm8_tile(lds, ar, Wt, 1024, (v >> 2) * 256, (v & 3) * 256, E); (void)arn; (void)hn;
    staged = false;
  }
  if (l == 0) {
#pragma unroll 1
    for (int it = blockIdx.x; it < 256; it += gridDim.x) pc_small_item(P, l, it);
  }
}

__device__ __forceinline__ void phaseD(unsigned char* lds, const Params& P, int l) {
  const int tid = get_tid(), lane = tid & 63, w = tid >> 6, g = lane >> 4, li = lane & 15;
  const float* XR = (const float*)(P.ws + WS_XR);
  bf16* H2 = (bf16*)(P.ws + WS_R1);
  int* cnt = (int*)(P.ws + WS_CNT) + l * 16;
  int* list = (int*)(P.ws + WS_LIST) + (size_t)l * 16 * NROWS;
  float* gatew = (float*)(P.ws + WS_GATEW);
  float* part = (float*)lds;
  float* ssqp = part + 2048;
  float* rsl = ssqp + 128;
  int* hist = (int*)(rsl + 64);
  const int nitems = (l == 0 ? NROWS : NLAT) / 64;
  const int rgp = w >> 1, kh = w & 1;
#pragma unroll 1
  for (int it = blockIdx.x; it < nitems; it += gridDim.x) {
    const int r0 = it * 64, seg = r0 < NSEQ ? 0 : (r0 < NLAT ? 1 : 2);
    const float* wr = (const float*)(P.ws + WS_WR) + (size_t)(l * 3 + seg) * 16384;
    const float* xrow = XR + (size_t)(r0 + rgp * 16 + li) * D + 512 * kh + 4 * g;
    const float* wp0 = wr + (size_t)(512 * kh + 4 * g) * 16 + li;
    if (tid < 32) hist[tid] = 0;
    f32x4 acc = {0.f, 0.f, 0.f, 0.f}; float ssq = 0.f;
#pragma unroll 1
    for (int cb = 0; cb < 32; cb += 8) {
      f32x4 xv[8]; float bw[8][4];
#pragma unroll
      for (int c = 0; c < 8; ++c) {
        xv[c] = *(const f32x4*)(xrow + 16 * (cb + c));
        const float* wp = wp0 + (cb + c) * 256;
        bw[c][0] = wp[0]; bw[c][1] = wp[16]; bw[c][2] = wp[32]; bw[c][3] = wp[48];
      }
#pragma unroll
      for (int c = 0; c < 8; ++c) {
        ssq += xv[c][0] * xv[c][0] + xv[c][1] * xv[c][1] + xv[c][2] * xv[c][2] + xv[c][3] * xv[c][3];
        acc = __builtin_amdgcn_mfma_f32_16x16x4f32(xv[c][0], bw[c][0], acc, 0, 0, 0);
        acc = __builtin_amdgcn_mfma_f32_16x16x4f32(xv[c][1], bw[c][1], acc, 0, 0, 0);
        acc = __builtin_amdgcn_mfma_f32_16x16x4f32(xv[c][2], bw[c][2], acc, 0, 0, 0);
        acc = __builtin_amdgcn_mfma_f32_16x16x4f32(xv[c][3], bw[c][3], acc, 0, 0, 0);
      }
    }
    ssq += __shfl_xor(ssq, 16); ssq += __shfl_xor(ssq, 32);
#pragma unroll
    for (int j = 0; j < 4; ++j) part[(w * 16 + 4 * g + j) * 16 + li] = acc[j];
    if (g == 0) ssqp[w * 16 + li] = ssq;
    __syncthreads();
    int e1 = 0, e2 = 0, q1 = 0, q2 = 0; float g1 = 0.f, g2 = 0.f;
    if (tid < 64) {
      const int rg2 = tid >> 4, rr = tid & 15;
      const float ss = ssqp[(2 * rg2) * 16 + rr] + ssqp[(2 * rg2 + 1) * 16 + rr];
      const float rs = rsqrtf(ss * (1.f / 1024.f) + EPS);
      rsl[tid] = rs;
      const float* cr = (const float*)(P.ws + WS_CR) + (l * 3 + seg) * 16;
      float lg[16]; float mx = -1e30f;
#pragma unroll
      for (int e = 0; e < 16; ++e) { lg[e] = rs * (part[((2 * rg2) * 16 + rr) * 16 + e] + part[((2 * rg2 + 1) * 16 + rr) * 16 + e]) + cr[e]; mx = fmaxf(mx, lg[e]); }
#pragma unroll
      for (int e = 0; e < 16; ++e) lg[e] = expf(lg[e] - mx);
      float best = -1.f; int bg = 0; float b0 = 0.f, b1 = 0.f, b2 = 0.f, b3 = 0.f;
#pragma unroll
      for (int gi = 0; gi < 4; ++gi) {
        const float a0 = lg[4 * gi], a1 = lg[4 * gi + 1], a2 = lg[4 * gi + 2], a3 = lg[4 * gi + 3];
        const float sc = fmaxf(fmaxf(fmaxf(a0 + a1, a0 + a2), fmaxf(a0 + a3, a1 + a2)), fmaxf(a1 + a3, a2 + a3));
        if (sc > best) { best = sc; bg = gi; b0 = a0; b1 = a1; b2 = a2; b3 = a3; }
      }
      int i1 = 0; float v1 = b0;
      if (b1 > v1) { v1 = b1; i1 = 1; } if (b2 > v1) { v1 = b2; i1 = 2; } if (b3 > v1) { v1 = b3; i1 = 3; }
      int i2 = -1; float v2 = -1.f;
      if (i1 != 0 && b0 > v2) { v2 = b0; i2 = 0; } if (i1 != 1 && b1 > v2) { v2 = b1; i2 = 1; } if (i1 != 2 && b2 > v2) { v2 = b2; i2 = 2; } if (i1 != 3 && b3 > v2) { v2 = b3; i2 = 3; }
      const float inv = 1.f / (v1 + v2);
      e1 = bg * 4 + i1; e2 = bg * 4 + i2; g1 = v1 * inv; g2 = v2 * inv;
      q1 = atomicAdd(&hist[e1], 1); q2 = atomicAdd(&hist[e2], 1);
    }
    __syncthreads();
    if (tid < 16) hist[16 + tid] = atomicAdd(&cnt[tid], hist[tid]);
    __syncthreads();
    if (tid < 64) {
      const int row = r0 + tid;
      list[(size_t)e1 * NROWS + hist[16 + e1] + q1] = row * 2; gatew[row * 2] = g1;
      list[(size_t)e2 * NROWS + hist[16 + e2] + q2] = row * 2 + 1; gatew[row * 2 + 1] = g2;
    }
    {
      const float* m = (const float*)(P.ws + WS_MOD) + (l * 3 + seg) * 6144;
      f32x4 gs[4], sh[4];
#pragma unroll
      for (int j = 0; j < 4; ++j) { const int k = 4 * lane + 256 * j; gs[j] = *(const f32x4*)(P.n2g + l * 1024 + k) * (*(const f32x4*)(m + 4096 + k) + 1.f); sh[j] = *(const f32x4*)(m + 3072 + k); }
#pragma unroll 1
      for (int q = 0; q < 8; q += 4) {
        f32x4 xx[4][4];
#pragma unroll
        for (int u = 0; u < 4; ++u)
#pragma unroll
          for (int j = 0; j < 4; ++j) xx[u][j] = *(const f32x4*)(XR + (size_t)(r0 + 8 * w + q + u) * D + 4 * lane + 256 * j);
#pragma unroll
        for (int u = 0; u < 4; ++u) {
          const int rr = 8 * w + q + u; const float rs = rsl[rr]; bf16* hp = H2 + (size_t)(r0 + rr) * D;
#pragma unroll
          for (int j = 0; j < 4; ++j) { const f32x4 o = xx[u][j] * rs * gs[j] + sh[j]; u32x2 ov; ov.x = pk2(o[0], o[1]); ov.y = pk2(o[2], o[3]); *(u32x2*)(hp + 4 * lane + 256 * j) = ov; }
        }
      }
    }
    __syncthreads();
  }
}

__device__ __forceinline__ void phaseEF(unsigned char* lds, const Params& P, int l, bool down) {
  const int* cnt = (const int*)(P.ws + WS_CNT) + l * 16;
  const int* list = (const int*)(P.ws + WS_LIST) + (size_t)l * 16 * NROWS;
  int total = 0;
#pragma unroll 1
  for (int e = 0; e < 16; ++e) total += (cnt[e] + 127) >> 7;
  total *= 4;
  bf16* act = (bf16*)(P.ws + WS_Z + Z_ACT);
  bool staged = false;
  int it = xcd_vidx(0);
#define MOE_LOOKUP(IT, E_, MT_, NT_, CE_, SB_) do { const int ti_ = (IT) >> 2; NT_ = (IT) & 3; int tb_ = 0; E_ = 0; SB_ = 0; CE_ = cnt[0]; \
    _Pragma("unroll 1") for (int q_ = 0; q_ < 15; ++q_) { const int ntq_ = (CE_ + 127) >> 7; if (ti_ >= tb_ + ntq_) { tb_ += ntq_; SB_ += CE_; E_ = q_ + 1; CE_ = cnt[q_ + 1]; } else break; } MT_ = ti_ - tb_; } while (0)
#pragma unroll 1
  for (int round = 0; round * (int)gridDim.x < total; ++round) {
    if (it >= total) { it = xcd_vidx(round + 1); continue; }
    int e, mt, nt, ce, sb; MOE_LOOKUP(it, e, mt, nt, ce, sb);
    const int itn = xcd_vidx(round + 1);
    const bool hn = itn < total;
    int en = 0, mtn = 0, ntn = 0, cen = 1, sbn = 0;
    if (hn) MOE_LOOKUP(itn, en, mtn, ntn, cen, sbn);
    const int nvalid = (ce - mt * 128) < 128 ? (ce - mt * 128) : 128, nvalidn = (cen - mtn * 128) < 128 ? (cen - mtn * 128) : 128;
    const int slot0 = sb + mt * 128, slot0n = sbn + mtn * 128;
    const int* lst = list + (size_t)e * NROWS + mt * 128; const int* lstn = list + (size_t)en * NROWS + mtn * 128;
    if (!down) {
      ARowGather ar{(const bf16*)(P.ws + WS_R1), lst, nvalid}, arn{(const bf16*)(P.ws + WS_R1), lstn, nvalidn};
      EpiMoeUp E{act, slot0, nvalid};
      const bf16* W = (const bf16*)(P.ws + WS_W13) + (size_t)(l * 16) * 1024 * 1024;
      gemm_tile<4, 4>(lds, ar, W + (size_t)e * 1024 * 1024, 1024, 0, nt * 256, E, staged, hn, &arn, W + (size_t)en * 1024 * 1024, ntn * 256);
    } else {
      ARowAct ar{act, slot0}, arn{act, slot0n};
      EpiMoeDown E{lst, (const float*)(P.ws + WS_GATEW), (bf16*)(P.ws + WS_R1), (bf16*)(P.ws + WS_Z + Z_YM1), nvalid};
      const bf16* W = (const bf16*)(P.ws + WS_W2) + (size_t)(l * 16) * 1024 * 512;
      gemm_tile<4, 4>(lds, ar, W + (size_t)e * 1024 * 512, 512, 0, nt * 256, E, staged, hn, &arn, W + (size_t)en * 1024 * 512, ntn * 256);
    }
    staged = hn; it = itn;
  }
#undef MOE_LOOKUP
}

__device__ __forceinline__ void phaseG(const Params& P, int l) {
  const int tid = get_tid(), lane = tid & 63, w = tid >> 6;
  float* XR = (float*)(P.ws + WS_XR);
  const bf16* Y0 = (const bf16*)(P.ws + WS_R1); const bf16* Y1 = (const bf16*)(P.ws + WS_Z + Z_YM1);
  const float* mod = (const float*)(P.ws + WS_MOD);
  const int nrows = l == 0 ? NROWS : NLAT;
#pragma unroll 1
  for (int it = blockIdx.x; it < nrows / 16; it += gridDim.x) {
    const int row0 = it * 16 + 2 * w, seg = row0 < NSEQ ? 0 : (row0 < NLAT ? 1 : 2);
    const float* gt2 = mod + (l * 3 + seg) * 6144 + 5120;
    f32x4 x1[2][4]; u32x2 ya[2][4], yb[2][4];
#pragma unroll
    for (int u = 0; u < 2; ++u)
#pragma unroll
      for (int j = 0; j < 4; ++j) { const size_t o = (size_t)(row0 + u) * D + 4 * lane + 256 * j; x1[u][j] = *(const f32x4*)(XR + o); ya[u][j] = *(const u32x2*)(Y0 + o); yb[u][j] = *(const u32x2*)(Y1 + o); }
    f32x4 gv[4];
#pragma unroll
    for (int j = 0; j < 4; ++j) gv[j] = *(const f32x4*)(gt2 + 4 * lane + 256 * j);
#pragma unroll
    for (int u = 0; u < 2; ++u) {
      const int row = row0 + u;
      f32x4 xv[4]; float ss = 0.f;
#pragma unroll
      for (int j = 0; j < 4; ++j) {
        const u32x2 a = ya[u][j], b = yb[u][j];
        f32x4 m; m[0] = bflo(a.x) + bflo(b.x); m[1] = bfhi(a.x) + bfhi(b.x); m[2] = bflo(a.y) + bflo(b.y); m[3] = bfhi(a.y) + bfhi(b.y);
        xv[j] = x1[u][j] + gv[j] * m;
        ss += xv[j][0] * xv[j][0] + xv[j][1] * xv[j][1] + xv[j][2] * xv[j][2] + xv[j][3] * xv[j][3];
      }
      ss = wsum(ss);
      if (l == 0) {
        const float* sc1 = mod + (1 * 3 + seg) * 6144 + 1024;
        bf16* xb = (bf16*)(P.ws + WS_R1) + (size_t)row * D;
        if (lane == 0) ((float*)(P.ws + WS_RSS))[row] = ss;
#pragma unroll
        for (int j = 0; j < 4; ++j) {
          const int k = 4 * lane + 256 * j;
          *(f32x4*)(XR + (size_t)row * D + k) = xv[j];
          const f32x4 gg = *(const f32x4*)(P.n1g + 1024 + k), sc = *(const f32x4*)(sc1 + k);
          const f32x4 o = xv[j] * gg * (sc + 1.f);
          u32x2 ov; ov.x = pk2(o[0], o[1]); ov.y = pk2(o[2], o[3]); *(u32x2*)(xb + k) = ov;
        }
      } else {
        const float rs = rsqrtf(ss * (1.f / 1024.f) + EPS);
#pragma unroll
        for (int j = 0; j < 4; ++j) {
          const int k = 4 * lane + 256 * j;
          const f32x4 gg = *(const f32x4*)(P.final_g + k);
          *(f32x4*)(P.out + (size_t)row * D + k) = xv[j] * rs * gg;
        }
      }
    }
  }
}

#define XB_TMO      128
#define XB_XCNT(j)  (256  + 64 * (j))
#define XB_XSUB(j)  (1280 + 64 * (j))
#define XB_XGEN(j)  (2304 + 64 * (j))
#define XB_TOP      3328
#define XB_TOPGEN   3392
#define XB_SPIN_CAP (1u << 20)
__device__ __forceinline__ unsigned xb_ld(unsigned* p)              { return __hip_atomic_load(p, __ATOMIC_RELAXED, __HIP_MEMORY_SCOPE_AGENT); }
__device__ __forceinline__ unsigned xb_add(unsigned* p, unsigned v) { return __hip_atomic_fetch_add(p, v, __ATOMIC_RELAXED, __HIP_MEMORY_SCOPE_AGENT); }
__device__ __forceinline__ unsigned xb_xcc_id() { return (unsigned)__builtin_amdgcn_s_getreg((3 << 11) | 20) & 0xFu; }
#define XB_SPIN(cond, bar) do { unsigned _sp = 0; while (cond) { __builtin_amdgcn_s_sleep(1); \
    if ((++_sp & 255u) == 0u) { if (xb_ld(&(bar)[XB_TMO])) break; if (_sp > XB_SPIN_CAP) { atomicAdd(&(bar)[XB_TMO], 1u); break; } } } } while (0)
struct XBar { unsigned* bar; unsigned* st; };
__device__ __forceinline__ void xbar_init(XBar& b, unsigned* bar, unsigned* st) {
  b.bar = bar; b.st = st;
  if (threadIdx.x == 0) { st[0] = 0u; st[1] = 0u; (void)xb_add(&bar[XB_XCNT(xb_xcc_id())], 1u); }
}
__device__ __forceinline__ void xbar_sync(XBar& b) {
  asm volatile("s_waitcnt vmcnt(0)" ::: "memory");
  __syncthreads();
  if (threadIdx.x == 0) {
    unsigned* bar = b.bar;
    const unsigned x = xb_xcc_id();
    __builtin_amdgcn_s_waitcnt(0);
    unsigned nloc = b.st[0], nx = b.st[1];
    if (nloc == 0u) {
      const unsigned G = gridDim.x; unsigned sum, cnt, mine, sp = 0u;
      for (;;) {
        sum = 0u; cnt = 0u; mine = 0u;
#pragma unroll
        for (unsigned j = 0; j < 16; ++j) { const unsigned c = xb_ld(&bar[XB_XCNT(j)]); sum += c; cnt += (c > 0u) ? 1u : 0u; mine = (j == x) ? c : mine; }
        if (sum == G) break;
        __builtin_amdgcn_s_sleep(1);
        if ((++sp & 255u) == 0u) { if (xb_ld(&bar[XB_TMO])) break; if (sp > XB_SPIN_CAP) { atomicAdd(&bar[XB_TMO], 1u); break; } }
      }
      nloc = mine > 0u ? mine : 1u; nx = cnt > 0u ? cnt : 1u;
      b.st[0] = nloc; b.st[1] = nx;
    }
    const unsigned old = xb_add(&bar[XB_XSUB(x)], 1u);
    const unsigned gen = old / nloc;
    if (old + 1u == (gen + 1u) * nloc) {
      __builtin_amdgcn_fence(__ATOMIC_RELEASE, "agent");
      asm volatile("s_waitcnt vmcnt(0)" ::: "memory");
      const unsigned og = xb_add(&bar[XB_TOP], 1u);
      const unsigned tg = og / nx;
      if (og + 1u == (tg + 1u) * nx) xb_add(&bar[XB_TOPGEN], 1u);
      else XB_SPIN(xb_ld(&bar[XB_TOPGEN]) == tg, bar);
      __builtin_amdgcn_fence(__ATOMIC_ACQUIRE, "agent");
      xb_add(&bar[XB_XGEN(x)], 1u);
      asm volatile("s_waitcnt vmcnt(0)" ::: "memory");
    } else {
      XB_SPIN(xb_ld(&bar[XB_XGEN(x)]) == gen, bar);
      __builtin_amdgcn_fence(__ATOMIC_ACQUIRE, "agent");
      asm volatile("s_waitcnt vmcnt(0)" ::: "memory");
    }
  }
  __syncthreads();
}

__global__ void __launch_bounds__(NTHR, 2) fwd_mega(Params P) {
  extern __shared__ __attribute__((aligned(16))) unsigned char lds[];
  cg::grid_group grid = cg::this_grid();
  XBar xb; xbar_init(xb, (unsigned*)(P.ws + WS_BAR), (unsigned*)(lds + LDS_BARW));
#define GSYNC() xbar_sync(xb)
  phase0(lds, P);
  VM_WAIT(); __syncthreads(); grid.sync();
  phase1(lds, P); GSYNC();
#pragma unroll 1
  for (int l = 0; l < 2; ++l) {
    phaseA(lds, P, l); GSYNC();
    phaseB(lds, P, l); GSYNC();
    phaseB2(P, l); GSYNC();
    phaseB3(lds, P, l); GSYNC();
    phaseC(lds, P, l); GSYNC();
    phaseD(lds, P, l); GSYNC();
    phaseEF(lds, P, l, false); GSYNC();
    phaseEF(lds, P, l, true); GSYNC();
    phaseG(P, l);
    if (l == 0) GSYNC();
  }
#undef GSYNC
}

extern "C" void kernel_launch(void* const* d_in, const int* in_sizes, int n_in, void* d_out, int out_size, void* d_ws, size_t ws_size, hipStream_t stream) {
  static int grid_blocks = 0;
  if (!grid_blocks) {
    int dev = 0, cus = 0, per_cu = 0;
    (void)hipGetDevice(&dev);
    (void)hipDeviceGetAttribute(&cus, hipDeviceAttributeMultiprocessorCount, dev);
    (void)hipFuncSetAttribute((const void*)fwd_mega, hipFuncAttributeMaxDynamicSharedMemorySize, LDS_BYTES);
    (void)hipOccupancyMaxActiveBlocksPerMultiprocessor(&per_cu, fwd_mega, NTHR, LDS_BYTES);
    if (per_cu > 1) per_cu = 1;
    if (per_cu < 1) per_cu = 1;
    grid_blocks = cus * per_cu;
    if (ws_size < WS_END) fprintf(stderr, "kernel_launch: workspace too small: %zu < %zu\n", ws_size, (size_t)WS_END);
  }
  (void)hipMemsetAsync(d_ws, 0, WS_ZERO_BYTES, stream);
  Params p{};
  const float** pp = (const float**)&p;
  for (int i = 0; i < 21; ++i) pp[i] = (const float*)d_in[i];
  p.out = (float*)d_out; p.ws = (unsigned char*)d_ws;
  void* args[] = {&p};
  hipError_t e = hipLaunchCooperativeKernel((void*)fwd_mega, dim3(grid_blocks), dim3(NTHR), args, LDS_BYTES, stream);
  if (e != hipSuccess) fprintf(stderr, "cooperative launch failed: %s (grid %d)\n", hipGetErrorString(e), grid_blocks);
}
```

```cpp
#include <hip/hip_runtime.h>
#include <hip/hip_cooperative_groups.h>
#include <cstdio>
#include <cstdint>
namespace cg = cooperative_groups;

typedef unsigned short bf16;
typedef short bf16x8 __attribute__((ext_vector_type(8)));
typedef short s16x4 __attribute__((ext_vector_type(4)));
typedef float f32x4 __attribute__((ext_vector_type(4)));
typedef float f32x2 __attribute__((ext_vector_type(2)));
typedef unsigned u32x4 __attribute__((ext_vector_type(4)));
typedef unsigned u32x2 __attribute__((ext_vector_type(2)));
typedef __bf16 bf2_t __attribute__((ext_vector_type(2)));
#define LAS __attribute__((address_space(3)))
constexpr int NTHR = 512;
constexpr int LDS_BYTES = 147456 + 64;
constexpr int LDS_BARW = 147456;
constexpr int LDS_MISC = 131072;

constexpr int D = 1024, NSEQ = 8192, CL = 256, NT_TOK = NSEQ + CL, NLAT = 2 * NSEQ, NROWS = NLAT + 2 * CL;
constexpr int INC = 2944, NSLOT = 46;
constexpr float EPS = 1e-6f;
constexpr float LOG2E = 1.4426950408889634f;
constexpr float QSCALE = 0.125f * LOG2E;
constexpr int S_AQ = 0, S_AK = 6, S_AV = 8, S_NQ = 10, S_NK = 14, S_NV = 18, S_RQ = 22, S_RK = 28, S_RV = 34, S_RG = 40;

constexpr size_t WS_BAR = 0;
constexpr size_t WS_CNT = 16384;
constexpr size_t WS_ZERO_BYTES = 16384 + 4096;
constexpr size_t WS_MOD = WS_ZERO_BYTES;
constexpr size_t WS_BIAS = WS_MOD + 2 * 3 * 6144 * 4;
constexpr size_t WS_ROPE = WS_BIAS + 2 * 3 * 2944 * 4;
constexpr size_t WS_RSS = WS_ROPE + 128 * 16 * 2 * 4;
constexpr size_t WS_WR = WS_RSS + 16896 * 4;
constexpr size_t WS_CR = WS_WR + 2 * 3 * 1024 * 16 * 4;
constexpr size_t WS_GATEW = WS_CR + 4096;
constexpr size_t WS_LIST = WS_GATEW + 16896 * 2 * 4;
constexpr size_t WS_WIN = (WS_LIST + (size_t)2 * 16 * 16896 * 4 + 4095) / 4096 * 4096;
constexpr size_t WS_WO = WS_WIN + (size_t)2 * 2944 * 1024 * 2;
constexpr size_t WS_W13 = WS_WO + (size_t)2 * 1024 * 1024 * 2;
constexpr size_t WS_W2 = WS_W13 + (size_t)32 * 1024 * 1024 * 2;
constexpr size_t WS_XR = WS_W2 + (size_t)32 * 1024 * 512 * 2;
constexpr size_t WS_R1 = WS_XR + (size_t)NROWS * 1024 * 4;
constexpr size_t WS_Z = WS_R1 + (size_t)NROWS * 1024 * 2;
constexpr size_t WS_END = WS_Z + (size_t)2 * NSLOT * NT_TOK * 64 * 2;
constexpr size_t S_OFF = (size_t)34 << 20;
constexpr size_t Z_YM1 = 0, Z_ACT = (size_t)NROWS * 1024 * 2;
static_assert(Z_ACT + (size_t)(2 * NROWS + 128) * 512 * 2 <= (size_t)2 * NSLOT * NT_TOK * 64 * 2, "act overlay");
static_assert((size_t)2 * 6 * 2 * 66 * 4096 * 4 <= (size_t)NROWS * 1024 * 2, "U overlay");

struct Params {
  const float *x, *c, *ctx, *c_ctx, *w_ada, *b_ada, *n1g, *n2g, *w_in, *qg, *kg, *rpb, *ret_decay, *mix_g, *w_out, *w_router, *b_router, *w1, *w3, *w2, *final_g;
  float* out; unsigned char* ws;
};

__device__ __forceinline__ unsigned pk2(float lo, float hi) { f32x2 v = {lo, hi}; bf2_t b = __builtin_convertvector(v, bf2_t); return __builtin_bit_cast(unsigned, b); }
__device__ __forceinline__ float bflo(unsigned u) { return __builtin_bit_cast(float, u << 16); }
__device__ __forceinline__ float bfhi(unsigned u) { return __builtin_bit_cast(float, u & 0xffff0000u); }
__device__ __forceinline__ float wsum(float v) {
#pragma unroll
  for (int o = 1; o < 64; o <<= 1) v += __shfl_xor(v, o);
  return v;
}
__device__ __forceinline__ float silu_f(float v) { return v / (1.f + __expf(-v)); }
__device__ __forceinline__ int lds_swz(int row, int chunk) { return row * 128 + ((chunk ^ ((row >> 1) & 7)) << 4); }
#define VM_WAIT() asm volatile("s_waitcnt vmcnt(0)" ::: "memory")
__device__ __forceinline__ int get_tid() { int t = threadIdx.x; asm volatile("" : "+v"(t)); return t; }

template <int R, int NW>
__device__ __forceinline__ void stage_rows(unsigned char* lds, int dst, const bf16* src, int ld, int wl, int lane) {
#pragma unroll
  for (int i = 0; i < R / (8 * NW); ++i) {
    const int q = wl + NW * i, row = q * 8 + (lane >> 3), ch = (lane & 7) ^ ((row >> 1) & 7);
    __builtin_amdgcn_global_load_lds((const void*)(src + (size_t)row * ld + ch * 8), (LAS void*)(lds + dst + q * 1024), 16, 0, 0);
  }
}
#define VMCNT(n) asm volatile("s_waitcnt vmcnt(" #n ")" ::: "memory")
#define LGKM0() asm volatile("s_waitcnt lgkmcnt(0)" ::: "memory")
#define RAW_BAR() __builtin_amdgcn_s_barrier()
__device__ __forceinline__ bf16x8 lds_frag(const unsigned char* lds, int off) { return *(const bf16x8*)(lds + off); }
__device__ __forceinline__ bf16x8 lds_tr2(unsigned char* lds, int off0, int off1) {
  s16x4 a = __builtin_amdgcn_ds_read_tr16_b64_v4i16((LAS s16x4*)(lds + off0));
  s16x4 b = __builtin_amdgcn_ds_read_tr16_b64_v4i16((LAS s16x4*)(lds + off1));
  return __builtin_shufflevector(a, b, 0, 1, 2, 3, 4, 5, 6, 7);
}

template <int MT, int NT, int ST> struct GStep {
  static __device__ __forceinline__ void run(f32x4 (&acc)[MT][NT], bf16x8 (&W0)[NT], bf16x8 (&W1)[NT], bf16x8 (&X)[2 * MT], const unsigned char* base, int xoff, int woff) {
    constexpr int S = 2 * MT, kk = ST / MT, mt = ST % MT;
#pragma unroll
    for (int nt = 0; nt < NT; ++nt) acc[mt][nt] = __builtin_amdgcn_mfma_f32_16x16x32_bf16(kk ? W1[nt] : W0[nt], X[ST], acc[mt][nt], 0, 0, 0);
    __builtin_amdgcn_sched_group_barrier(0x008, NT, 0);
    if constexpr (ST + 2 < S) { constexpr int k2 = (ST + 2) / MT, m2 = (ST + 2) % MT; X[ST + 2] = lds_frag(base, (xoff + m2 * 2048) ^ (k2 << 6)); }
    if constexpr (ST < NT) W1[ST] = lds_frag(base, (woff + ST * 2048) ^ 64);
    constexpr int nds = (ST + 2 < S ? 1 : 0) + (ST < NT ? 1 : 0);
    if constexpr (nds > 0) __builtin_amdgcn_sched_group_barrier(0x100, nds, 0);
    if constexpr (ST + 1 < S) GStep<MT, NT, ST + 1>::run(acc, W0, W1, X, base, xoff, woff);
  }
};

template <int MT, int NT, class ARow, class Epi>
__device__ __forceinline__ void gemm_tile(unsigned char* lds, const ARow& arow, const bf16* __restrict__ Bt, int K, int m0, int n0, const Epi& epi,
                                          bool staged0 = false, bool hasnext = false, const ARow* narow = nullptr, const bf16* nBt = nullptr, int nn0 = 0) {
  const int tid = get_tid(), lane = tid & 63, w = __builtin_amdgcn_readfirstlane(tid >> 6);
  const int wr = w >> 2, wc = w & 3, g = lane >> 4, li = lane & 15;
  constexpr int NA = MT / 2, NB = NT;
  const bf16* ap[NA]; const bf16* bp[NB];
#pragma unroll
  for (int i = 0; i < NA; ++i) { const int q = w + 8 * i, row = q * 8 + (lane >> 3), ch = (lane & 7) ^ ((row >> 1) & 7); ap[i] = arow(row) + ch * 8; }
#pragma unroll
  for (int i = 0; i < NB; ++i) { const int q = w + 8 * i, row = q * 8 + (lane >> 3), ch = (lane & 7) ^ ((row >> 1) & 7); bp[i] = Bt + (size_t)(n0 + row) * K + ch * 8; }
  f32x4 acc[MT][NT];
#pragma unroll
  for (int a = 0; a < MT; ++a)
#pragma unroll
    for (int b = 0; b < NT; ++b) acc[a][b] = (f32x4){0.f, 0.f, 0.f, 0.f};
  const int f = (li >> 1) & 7;
  const int xoff = (wr * (MT * 16) + li) * 128 + ((g ^ f) << 4);
  const int woff = 32768 + (wc * (NT * 16) + li) * 128 + ((g ^ f) << 4);
  const int nk = K >> 6;
#define GT_STAGE(s, k0) do { _Pragma("unroll") for (int i = 0; i < NA; ++i) \
    __builtin_amdgcn_global_load_lds((const void*)(ap[i] + (k0)), (LAS void*)(lds + (s) * 65536 + (w + 8 * i) * 1024), 16, 0, 0); \
    _Pragma("unroll") for (int i = 0; i < NB; ++i) \
    __builtin_amdgcn_global_load_lds((const void*)(bp[i] + (k0)), (LAS void*)(lds + (s) * 65536 + 32768 + (w + 8 * i) * 1024), 16, 0, 0); } while (0)
  if (!staged0) GT_STAGE(0, 0);
  VM_WAIT(); __syncthreads();
  for (int t = 0; t < nk; ++t) {
    const int s = t & 1;
    if (t + 1 < nk) GT_STAGE(s ^ 1, (t + 1) * 64);
    const unsigned char* base = lds + s * 65536;
    {
      bf16x8 W0[NT], W1[NT], X[2 * MT];
#pragma unroll
      for (int nt = 0; nt < NT; ++nt) W0[nt] = lds_frag(base, woff + nt * 2048);
      X[0] = lds_frag(base, xoff); X[1] = lds_frag(base, xoff + 2048);
      __builtin_amdgcn_sched_group_barrier(0x100, NT + 2, 0);
      GStep<MT, NT, 0>::run(acc, W0, W1, X, base, xoff, woff);
    }
    VM_WAIT(); __syncthreads();
  }
  if (hasnext) {
#pragma unroll
    for (int i = 0; i < NA; ++i) { const int q = w + 8 * i, row = q * 8 + (lane >> 3), ch = (lane & 7) ^ ((row >> 1) & 7); ap[i] = (*narow)(row) + ch * 8; }
#pragma unroll
    for (int i = 0; i < NB; ++i) { const int q = w + 8 * i, row = q * 8 + (lane >> 3), ch = (lane & 7) ^ ((row >> 1) & 7); bp[i] = nBt + (size_t)(nn0 + row) * K + ch * 8; }
    GT_STAGE(0, 0);
  }
#undef GT_STAGE
  epi(acc, m0 + wr * (MT * 16), n0 + wc * (NT * 16), g, li);
}


namespace g8 {
constexpr int HT_B = 128 * 64 * 2;
__device__ __forceinline__ int lds_byte(int r, int c) { const int st = (r >> 4) * 2 + (c >> 5), rr = r & 15, cc = c & 31, ob = rr * 64 + cc * 2; return st * 1024 + (ob ^ (((ob >> 9) & 1) << 5)); }
__device__ __forceinline__ void stage_rc(int b, int& R, int& C) { const int st = b / 1024, sb = b % 1024, swz = sb ^ (((sb >> 9) & 1) << 5); R = (st >> 1) * 16 + swz / 64; C = (st & 1) * 32 + (swz % 64) / 2; }
}
template <class ARow, class Epi>
__device__ __forceinline__ void gemm8_tile(unsigned char* lds, const ARow& arow, const bf16* __restrict__ Bt, int K, int m0, int n0, const Epi& epi) {
  using namespace g8;
  const int tid = get_tid(), lane = tid & 63, wid = __builtin_amdgcn_readfirstlane(tid >> 6), wr = wid >> 2, wc = wid & 3, fr = lane & 15, fq = lane >> 4;
  const char* abase = (const char*)arow(0);
  const char* bbase = (const char*)(Bt + (size_t)n0 * K);
  unsigned oa[2][2], ob[2][2];
#pragma unroll
  for (int i = 0; i < 2; ++i) {
    int R, C; stage_rc(tid * 16 + i * 8192, R, C);
    const int ra = (R >> 6) * 128 + ((R >> 4) & 3) * 16 + (R & 15);
    const int rb = (R >> 5) * 64 + ((R >> 4) & 1) * 16 + (R & 15);
#pragma unroll
    for (int hh = 0; hh < 2; ++hh) { oa[hh][i] = (unsigned)((ra + hh * 64) * K + C) * 2u; ob[hh][i] = (unsigned)((rb + hh * 32) * K + C) * 2u; }
  }
#define G8_SA(b, h) (((b) * 2 + (h)) * HT_B)
#define G8_SB(b, h) ((4 + (b) * 2 + (h)) * HT_B)
#define G8_STAGE(bufoff, BASE, O2, kt) do { _Pragma("unroll") for (int _i = 0; _i < 2; ++_i) \
    __builtin_amdgcn_global_load_lds((const void*)((BASE) + (O2)[_i] + (unsigned)(kt) * 128u), (LAS void*)(lds + (bufoff) + wid * 1024 + _i * 8192), 16, 0, 0); } while (0)
  const int aoff = lds_byte(wr * 64 + fr, fq * 8), boff = lds_byte(wc * 32 + fr, fq * 8);
#define G8_LDA(dst, b, h) do { _Pragma("unroll") for (int m = 0; m < 4; ++m) _Pragma("unroll") for (int k = 0; k < 2; ++k) dst[m][k] = *(const bf16x8*)(lds + G8_SA(b, h) + aoff + m * 2048 + k * 1024); } while (0)
#define G8_LDB(dst, b, h) do { _Pragma("unroll") for (int n = 0; n < 2; ++n) _Pragma("unroll") for (int k = 0; k < 2; ++k) dst[n][k] = *(const bf16x8*)(lds + G8_SB(b, h) + boff + n * 2048 + k * 1024); } while (0)
#define G8_MMA(ai, bj, At_, Bt_) do { __builtin_amdgcn_s_setprio(1); _Pragma("unroll") for (int m = 0; m < 4; ++m) _Pragma("unroll") for (int n = 0; n < 2; ++n) _Pragma("unroll") for (int k = 0; k < 2; ++k) \
    acc[(ai) * 4 + m][(bj) * 2 + n] = __builtin_amdgcn_mfma_f32_16x16x32_bf16(Bt_[n][k], At_[m][k], acc[(ai) * 4 + m][(bj) * 2 + n], 0, 0, 0); __builtin_amdgcn_s_setprio(0); } while (0)
#define G8_WV(n) asm volatile("s_waitcnt vmcnt(" #n ")" ::: "memory")
#define G8_WL(n) asm volatile("s_waitcnt lgkmcnt(" #n ")" ::: "memory")
#define G8_BAR __builtin_amdgcn_s_barrier()
#define G8_SCHED __builtin_amdgcn_sched_barrier(0)
  f32x4 acc[8][4];
#pragma unroll
  for (int a = 0; a < 8; ++a)
#pragma unroll
    for (int b = 0; b < 4; ++b) acc[a][b] = (f32x4){0.f, 0.f, 0.f, 0.f};
  bf16x8 At[4][2], B0[2][2], B1[2][2];
  const int nt = K >> 6;
  G8_STAGE(G8_SB(0, 0), bbase, ob[0], 0); G8_STAGE(G8_SA(0, 0), abase, oa[0], 0);
  G8_STAGE(G8_SB(0, 1), bbase, ob[1], 0); G8_STAGE(G8_SA(0, 1), abase, oa[1], 0);
  if (wr == 1) G8_BAR;
  G8_WV(4); G8_BAR;
  G8_STAGE(G8_SB(1, 0), bbase, ob[0], 1); G8_STAGE(G8_SA(1, 0), abase, oa[0], 1); G8_STAGE(G8_SB(1, 1), bbase, ob[1], 1);
  G8_WV(6); G8_BAR;
#pragma unroll 1
  for (int t = 0; t < nt - 2; t += 2) {
    G8_LDB(B0, 0, 0); G8_SCHED; G8_LDA(At, 0, 0); G8_STAGE(G8_SA(1, 1), abase, oa[1], t + 1);
    G8_WL(8); G8_BAR; G8_WL(0); G8_MMA(0, 0, At, B0); G8_BAR; G8_SCHED;
    G8_LDB(B1, 0, 1); G8_STAGE(G8_SB(0, 0), bbase, ob[0], t + 2);
    G8_BAR; G8_WL(0); G8_MMA(0, 1, At, B1); G8_BAR;
    G8_LDA(At, 0, 1); G8_STAGE(G8_SA(0, 0), abase, oa[0], t + 2);
    G8_BAR; G8_WL(0); G8_MMA(1, 0, At, B0); G8_BAR; G8_SCHED;
    G8_STAGE(G8_SB(0, 1), bbase, ob[1], t + 2);
    G8_WV(6); G8_BAR; G8_MMA(1, 1, At, B1); G8_BAR;
    G8_LDB(B0, 1, 0); G8_SCHED; G8_LDA(At, 1, 0); G8_STAGE(G8_SA(0, 1), abase, oa[1], t + 2);
    G8_WL(8); G8_BAR; G8_WL(0); G8_MMA(0, 0, At, B0); G8_BAR; G8_SCHED;
    G8_LDB(B1, 1, 1); G8_STAGE(G8_SB(1, 0), bbase, ob[0], t + 3);
    G8_BAR; G8_WL(0); G8_MMA(0, 1, At, B1); G8_BAR;
    G8_LDA(At, 1, 1); G8_STAGE(G8_SA(1, 0), abase, oa[0], t + 3);
    G8_BAR; G8_WL(0); G8_MMA(1, 0, At, B0); G8_BAR; G8_SCHED;
    G8_STAGE(G8_SB(1, 1), bbase, ob[1], t + 3);
    G8_WV(6); G8_BAR; G8_MMA(1, 1, At, B1); G8_BAR;
  }
  { G8_LDB(B0, 0, 0); G8_LDA(At, 0, 0); G8_STAGE(G8_SA(1, 1), abase, oa[1], nt - 1);
    G8_BAR; G8_WL(0); G8_MMA(0, 0, At, B0); G8_BAR;
    G8_LDB(B1, 0, 1); G8_BAR; G8_WL(0); G8_MMA(0, 1, At, B1); G8_BAR;
    G8_LDA(At, 0, 1); G8_WV(4); G8_BAR; G8_WL(0); G8_MMA(1, 0, At, B0); G8_MMA(1, 1, At, B1); G8_BAR; }
  { G8_LDB(B0, 1, 0); G8_LDA(At, 1, 0); G8_WV(2); G8_BAR; G8_WL(0); G8_MMA(0, 0, At, B0); G8_BAR;
    G8_LDB(B1, 1, 1); G8_WV(0); G8_BAR; G8_WL(0); G8_MMA(0, 1, At, B1); G8_BAR;
    G8_LDA(At, 1, 1); G8_BAR; G8_WL(0); G8_MMA(1, 0, At, B0); G8_MMA(1, 1, At, B1); G8_BAR; }
  if (wr == 0) G8_BAR;
#undef G8_SA
#undef G8_SB
#undef G8_STAGE
#undef G8_LDA
#undef G8_LDB
#undef G8_MMA
#undef G8_WV
#undef G8_WL
#undef G8_BAR
#undef G8_SCHED
  epi(acc, m0 + wr * 128, n0 + wc * 64, fq, fr);
  __syncthreads();
}

struct ARowLinear { const bf16* A; int K; int m0; __device__ __forceinline__ const bf16* operator()(int r) const { return A + (size_t)(m0 + r) * K; } };

template <int MT, int NT>
struct EpiInProj {
  const float* rowss; const float* biasp; const float* qg; const float* kg; const float* rope  ; bf16* Z;
  __device__ __forceinline__ void operator()(f32x4 (&acc)[MT][NT], int mw, int nw, int g, int li) const {
    int b, seg, tokbase; bool latent;
    if (mw < NLAT) { b = mw >> 13; seg = b; tokbase = (mw & 8191); latent = true; }
    else { const int mc = mw - NLAT; b = mc >> 8; seg = 2; tokbase = NSEQ + (mc & 255); latent = false; }
    const int s = nw >> 6, coff = nw & 63;
    bf16* zb = Z + ((size_t)(b * NSLOT + s) * NT_TOK) * 64 + coff;
    float rss[MT];
#pragma unroll
    for (int mt = 0; mt < MT; ++mt) rss[mt] = rowss[mw + mt * 16 + li];
    f32x4 bv[NT], gvv[NT];
#pragma unroll
    for (int nt = 0; nt < NT; ++nt) bv[nt] = *(const f32x4*)(biasp + seg * INC + nw + nt * 16 + 4 * g);
    if (NT == 4 && s < 8) {
      const float* gn = (s < 6) ? qg : kg;
#pragma unroll
      for (int nt = 0; nt < NT; ++nt) gvv[nt] = *(const f32x4*)(gn + nt * 16 + 4 * g);
    } else {
#pragma unroll
      for (int nt = 0; nt < NT; ++nt) gvv[nt] = (f32x4){1.f, 1.f, 1.f, 1.f};
    }
#pragma unroll
    for (int mt = 0; mt < MT; ++mt) {
      const int tok = tokbase + mt * 16 + li;
      const float irms = rsqrtf(rss[mt] * (1.f / 1024.f) + EPS);
      f32x4 v[NT];
#pragma unroll
      for (int nt = 0; nt < NT; ++nt) v[nt] = acc[mt][nt] * irms + bv[nt];
      if constexpr (NT == 4) {
        if (s < 8) {
          float ss = 0.f;
#pragma unroll
          for (int nt = 0; nt < 4; ++nt) ss += v[nt][0] * v[nt][0] + v[nt][1] * v[nt][1] + v[nt][2] * v[nt][2] + v[nt][3] * v[nt][3];
          ss += __shfl_xor(ss, 16); ss += __shfl_xor(ss, 32);
          const float r = rsqrtf(ss * (1.f / 64.f) + EPS) * (s < 6 ? QSCALE : 1.f);
#pragma unroll
          for (int nt = 0; nt < 4; ++nt) v[nt] = v[nt] * r * gvv[nt];
          if (latent) {
            const int pr = tok >> 6, pc = tok & 63;
            const f32x4 r0 = *(const f32x4*)(rope + (pr * 16 + 4 * g) * 2), r1 = *(const f32x4*)(rope + (pr * 16 + 4 * g) * 2 + 4);
            const f32x4 c0 = *(const f32x4*)(rope + (pc * 16 + 4 * g) * 2), c1 = *(const f32x4*)(rope + (pc * 16 + 4 * g) * 2 + 4);
            const float cr_[4] = {r0[0], r0[2], r1[0], r1[2]}, sr_[4] = {r0[1], r0[3], r1[1], r1[3]};
            const float cc_[4] = {c0[0], c0[2], c1[0], c1[2]}, sc_[4] = {c0[1], c0[3], c1[1], c1[3]};
#pragma unroll
            for (int j = 0; j < 4; ++j) {
              const float t1 = v[0][j], t2 = v[1][j]; v[0][j] = t1 * cr_[j] - t2 * sr_[j]; v[1][j] = t2 * cr_[j] + t1 * sr_[j];
              const float u1 = v[2][j], u2 = v[3][j]; v[2][j] = u1 * cc_[j] - u2 * sc_[j]; v[3][j] = u2 * cc_[j] + u1 * sc_[j];
            }
          }
        }
      }
      if (s >= S_NQ && s < S_NK) {
#pragma unroll
        for (int nt = 0; nt < NT; ++nt) v[nt] = v[nt] * QSCALE;
      } else if (s >= S_RK && s < S_RV) {
#pragma unroll
        for (int nt = 0; nt < NT; ++nt) v[nt] = v[nt] * 0.125f;
      } else if (s >= S_RG) {
#pragma unroll
        for (int nt = 0; nt < NT; ++nt)
#pragma unroll
          for (int j = 0; j < 4; ++j) v[nt][j] = silu_f(v[nt][j]);
      }
#pragma unroll
      for (int nt = 0; nt < NT; ++nt) { u32x2 o; o.x = pk2(v[nt][0], v[nt][1]); o.y = pk2(v[nt][2], v[nt][3]); *(u32x2*)(zb + (size_t)tok * 64 + nt * 16 + 4 * g) = o; }
    }
  }
};

struct EpiOutProj {
  const float* xlat; const float* xctx; const float* mod; float* XR;
  __device__ __forceinline__ void operator()(f32x4 (&acc)[8][4], int mw, int nw, int g, int li) const {
    const int seg = (mw < NLAT) ? (mw >> 13) : 2;
    const float* gt = mod + seg * 6144 + 2048;
    f32x4 gv[4];
#pragma unroll
    for (int nt = 0; nt < 4; ++nt) gv[nt] = *(const f32x4*)(gt + nw + nt * 16 + 4 * g);
    const float* xbase = (mw < NLAT) ? (xlat + (size_t)mw * D) : (xctx + (size_t)(mw - NLAT) * D);
#pragma unroll
    for (int mb = 0; mb < 8; mb += 2) {
      f32x4 xv[2][4];
#pragma unroll
      for (int u = 0; u < 2; ++u)
#pragma unroll
        for (int nt = 0; nt < 4; ++nt) xv[u][nt] = __builtin_nontemporal_load((const f32x4*)(xbase + (size_t)((mb + u) * 16 + li) * D + nw + nt * 16 + 4 * g));
#pragma unroll
      for (int u = 0; u < 2; ++u)
#pragma unroll
        for (int nt = 0; nt < 4; ++nt) *(f32x4*)(XR + (size_t)(mw + (mb + u) * 16 + li) * D + nw + nt * 16 + 4 * g) = xv[u][nt] + gv[nt] * acc[mb + u][nt];
    }
  }
};

struct EpiMoeUp {
  bf16* act; int slot0; int nvalid;
  __device__ __forceinline__ void operator()(f32x4 (&acc)[4][4], int mw, int nw, int g, int li) const {
#pragma unroll
    for (int mt = 0; mt < 4; ++mt) {
      const int r = mw + mt * 16 + li;
      if (r < nvalid) {
#pragma unroll
        for (int u = 0; u < 2; ++u) {
          const int hid = (nw >> 1) + u * 16 + 4 * g;
          const f32x4 a1 = acc[mt][2 * u], a3 = acc[mt][2 * u + 1];
          u32x2 o; o.x = pk2(silu_f(a1[0]) * a3[0], silu_f(a1[1]) * a3[1]); o.y = pk2(silu_f(a1[2]) * a3[2], silu_f(a1[3]) * a3[3]);
          *(u32x2*)(act + (size_t)(slot0 + r) * 512 + hid) = o;
        }
      }
    }
  }
};

struct EpiMoeDown {
  const int* list; const float* gatew; bf16* ym0; bf16* ym1; int nvalid;
  __device__ __forceinline__ void operator()(f32x4 (&acc)[4][4], int mw, int nw, int g, int li) const {
    int ent[4]; float gw[4];
#pragma unroll
    for (int mt = 0; mt < 4; ++mt) { const int r = mw + mt * 16 + li; ent[mt] = list[r < nvalid ? r : nvalid - 1]; }
#pragma unroll
    for (int mt = 0; mt < 4; ++mt) gw[mt] = gatew[ent[mt]];
#pragma unroll
    for (int mt = 0; mt < 4; ++mt) {
      const int r = mw + mt * 16 + li;
      if (r < nvalid) {
        bf16* y = ((ent[mt] & 1) ? ym1 : ym0) + (size_t)(ent[mt] >> 1) * D;
#pragma unroll
        for (int nt = 0; nt < 4; ++nt) {
          const int n = nw + nt * 16 + 4 * g;
          u32x2 o; o.x = pk2(acc[mt][nt][0] * gw[mt], acc[mt][nt][1] * gw[mt]); o.y = pk2(acc[mt][nt][2] * gw[mt], acc[mt][nt][3] * gw[mt]);
          *(u32x2*)(y + n) = o;
        }
      }
    }
  }
};

struct ARowGather { const bf16* H; const int* list; int nvalid; __device__ __forceinline__ const bf16* operator()(int r) const { const int rr = r < nvalid ? r : nvalid - 1; return H + (size_t)(list[rr] >> 1) * D; } };
struct ARowAct { const bf16* act; int slot0; __device__ __forceinline__ const bf16* operator()(int r) const { int s = slot0 + r; s = s < 2 * NROWS ? s : 2 * NROWS - 1; return act + (size_t)s * 512; } };

template <int NQB, bool NAM, int NW>
__device__ __forceinline__ void attn_item(unsigned char* lds, int gb, int wl, int lane, const bf16* zb, int sq0, int sk, int sv, int qtok0, int lat0, int nlat, int ntiles,
                                          int drbase, bf16* Y, size_t yrow0, int ycol0, const float* mixg) {
  const int g = lane >> 4, li = lane & 15;
  const int qtok = qtok0 + 16 * wl + li;
  bf16x8 qf[NQB][2];
#pragma unroll
  for (int qb = 0; qb < NQB; ++qb)
#pragma unroll
    for (int kk = 0; kk < 2; ++kk) qf[qb][kk] = *(const bf16x8*)(zb + ((size_t)(sq0 + qb) * NT_TOK + qtok) * 64 + kk * 32 + g * 8);
  const bf16* kbp = zb + (size_t)sk * NT_TOK * 64;
  const bf16* vbp = zb + (size_t)sv * NT_TOK * 64;
  f32x4 O[4][NQB], L[NQB];
  const bf16x8 ones = {0x3f80, 0x3f80, 0x3f80, 0x3f80, 0x3f80, 0x3f80, 0x3f80, 0x3f80};
#pragma unroll
  for (int qb = 0; qb < NQB; ++qb) { L[qb] = (f32x4){0.f, 0.f, 0.f, 0.f};
#pragma unroll
    for (int db = 0; db < 4; ++db) O[db][qb] = (f32x4){0.f, 0.f, 0.f, 0.f}; }
  const int f = (li >> 1) & 7;
  const int koff = li * 128 + ((g ^ f) << 4);
  const int q_ = li >> 2, p_ = li & 3, fv = (2 * g + (q_ >> 1)) & 7;
  const int voff = (4 * g + q_) * 128 + (p_ & 1) * 8;
  const float* rpbt = (const float*)(lds + gb + 49152);
  const int qc = 16 * wl + li;
  int cs = qc - 8; cs = cs < 0 ? 0 : (cs > 48 ? 48 : cs);
#define AT_TOK(t) ((t) < nlat ? lat0 + 64 * (t) : NSEQ + 64 * ((t) - nlat))
#define AT_STAGE(t, bi) do { const int tk_ = AT_TOK(t); stage_rows<64, NW>(lds, gb + (bi) * 16384, kbp + (size_t)tk_ * 64, 64, wl, lane); \
                             stage_rows<64, NW>(lds, gb + (bi) * 16384 + 8192, vbp + (size_t)tk_ * 64, 64, wl, lane); } while (0)
#define AT_WAIT1() do { if (NW == 8) VMCNT(2); else VMCNT(4); } while (0)
  AT_STAGE(0, 0);
  if (ntiles > 1) { AT_STAGE(1, 1); AT_WAIT1(); } else { VMCNT(0); }
  RAW_BAR();
  int cur = 0;
  for (int t = 0; t < ntiles; ++t) {
    const int kb_off = gb + cur * 16384, vb_off = kb_off + 8192;
    const int pfb = cur == 0 ? 2 : cur - 1;
    if (t + 2 < ntiles) AT_STAGE(t + 2, pfb);
#pragma unroll
    for (int ks = 0; ks < 2; ++ks) {
      f32x4 s[2][NQB];
#pragma unroll
      for (int h2 = 0; h2 < 2; ++h2) {
#pragma unroll
        for (int qb = 0; qb < NQB; ++qb) s[h2][qb] = (f32x4){0.f, 0.f, 0.f, 0.f};
#pragma unroll
        for (int kk = 0; kk < 2; ++kk) {
          const bf16x8 kf = lds_frag(lds, kb_off + (((2 * ks + h2) * 2048 + koff) ^ (kk << 6)));
#pragma unroll
          for (int qb = 0; qb < NQB; ++qb) s[h2][qb] = __builtin_amdgcn_mfma_f32_16x16x32_bf16(kf, qf[qb][kk], s[h2][qb], 0, 0, 0);
        }
      }
      bf16x8 pf[NQB];
#pragma unroll
      for (int qb = 0; qb < NQB; ++qb) {
        float p[8];
#pragma unroll
        for (int h2 = 0; h2 < 2; ++h2)
#pragma unroll
          for (int j = 0; j < 4; ++j) {
            float x = s[h2][qb][j];
            if (NAM) {
              if (t < nlat) {
                const int kc = (2 * ks + h2) * 16 + 4 * g + j;
                const bool valid = (kc >= cs) && (kc < cs + 16);
                int dc = kc - qc + 15; dc = dc < 0 ? 0 : (dc > 30 ? 30 : dc);
                x += rpbt[(drbase + t) * 31 + dc];
                x = valid ? x : -1e30f;
              }
            }
            const float e = __builtin_amdgcn_exp2f(x);
            p[h2 * 4 + j] = e;
          }
        u32x4 pw; pw.x = pk2(p[0], p[1]); pw.y = pk2(p[2], p[3]); pw.z = pk2(p[4], p[5]); pw.w = pk2(p[6], p[7]);
        pf[qb] = __builtin_bit_cast(bf16x8, pw);
        L[qb] = __builtin_amdgcn_mfma_f32_16x16x32_bf16(ones, pf[qb], L[qb], 0, 0, 0);
      }
#pragma unroll
      for (int db = 0; db < 4; ++db) {
        const int a0 = vb_off + ks * 4096 + voff + (((db * 2 + (p_ >> 1)) ^ fv) << 4);
        const bf16x8 vf = lds_tr2(lds, a0, a0 + 2048);
#pragma unroll
        for (int qb = 0; qb < NQB; ++qb) O[db][qb] = __builtin_amdgcn_mfma_f32_16x16x32_bf16(vf, pf[qb], O[db][qb], 0, 0, 0);
      }
    }
    if (t + 2 < ntiles) { AT_WAIT1(); } else { VMCNT(0); }
    LGKM0(); RAW_BAR();
    cur = cur == 2 ? 0 : cur + 1;
  }
#undef AT_TOK
#undef AT_STAGE
#undef AT_WAIT1
#pragma unroll
  for (int qb = 0; qb < NQB; ++qb) {
    const float inv = 1.f / L[qb][0];
    float ss = 0.f;
#pragma unroll
    for (int db = 0; db < 4; ++db) { O[db][qb] = O[db][qb] * inv; ss += O[db][qb][0] * O[db][qb][0] + O[db][qb][1] * O[db][qb][1] + O[db][qb][2] * O[db][qb][2] + O[db][qb][3] * O[db][qb][3]; }
    ss += __shfl_xor(ss, 16); ss += __shfl_xor(ss, 32);
    const float r = rsqrtf(ss * (1.f / 64.f) + EPS);
    bf16* yp = Y + (yrow0 + 16 * wl + li) * D + ycol0 + qb * 64;
#pragma unroll
    for (int db = 0; db < 4; ++db) {
      const f32x4 gv = *(const f32x4*)(mixg + ycol0 + qb * 64 + db * 16 + 4 * g);
      const f32x4 y = O[db][qb] * r * gv;
      u32x2 o; o.x = pk2(y[0], y[1]); o.y = pk2(y[2], y[3]);
      *(u32x2*)(yp + db * 16 + 4 * g) = o;
    }
  }
}

__device__ __forceinline__ void ret_u_item(unsigned char* lds, int gb, int tg, const bf16* zb, int h, int c, float lgf2, float lgb2, float* Uf, float* Ub) {
  const int lane = tg & 63, w = __builtin_amdgcn_readfirstlane(tg >> 6), g = lane >> 4, li = lane & 15;
  const int tok0 = c < 2 ? NSEQ + 128 * c : 128 * (c - 2);
  const bf16* kp = zb + ((size_t)(S_RK + h) * NT_TOK + tok0) * 64;
  const bf16* vp = zb + ((size_t)(S_RV + h) * NT_TOK + tok0) * 64;
  stage_rows<128, 4>(lds, gb, kp, 64, w, lane);
  {
    const int row = tg >> 1, half = tg & 1;
    const float wf = __builtin_amdgcn_exp2f(lgf2 * (float)(127 - row)), wb = __builtin_amdgcn_exp2f(lgb2 * (float)row);
#pragma unroll
    for (int c4 = 0; c4 < 4; ++c4) {
      const int chunk = half * 4 + c4;
      const u32x4 v = *(const u32x4*)(vp + (size_t)row * 64 + chunk * 8);
      u32x4 of, ob;
#pragma unroll
      for (int i = 0; i < 4; ++i) { const float lo = bflo(v[i]), hi = bfhi(v[i]); of[i] = pk2(lo * wf, hi * wf); ob[i] = pk2(lo * wb, hi * wb); }
      *(u32x4*)(lds + gb + 16384 + lds_swz(row, chunk)) = of;
      *(u32x4*)(lds + gb + 32768 + lds_swz(row, chunk)) = ob;
    }
  }
  VM_WAIT(); __syncthreads();
  const int q_ = li >> 2, p_ = li & 3, fv = (2 * g + (q_ >> 1)) & 7;
  const int toff = gb + (4 * g + q_) * 128 + (p_ & 1) * 8;
  f32x4 acc[2][4];
#pragma unroll
  for (int d_ = 0; d_ < 2; ++d_)
#pragma unroll
    for (int eb = 0; eb < 4; ++eb) acc[d_][eb] = (f32x4){0.f, 0.f, 0.f, 0.f};
#pragma unroll
  for (int ks = 0; ks < 4; ++ks) {
    const int a0 = ks * 4096 + toff + (((w * 2 + (p_ >> 1)) ^ fv) << 4);
    const bf16x8 kf = lds_tr2(lds, a0, a0 + 2048);
#pragma unroll
    for (int eb = 0; eb < 4; ++eb) {
      const int b0 = ks * 4096 + toff + (((eb * 2 + (p_ >> 1)) ^ fv) << 4);
      const bf16x8 vf = lds_tr2(lds, 16384 + b0, 16384 + b0 + 2048);
      const bf16x8 vb = lds_tr2(lds, 32768 + b0, 32768 + b0 + 2048);
      acc[0][eb] = __builtin_amdgcn_mfma_f32_16x16x32_bf16(kf, vf, acc[0][eb], 0, 0, 0);
      acc[1][eb] = __builtin_amdgcn_mfma_f32_16x16x32_bf16(kf, vb, acc[1][eb], 0, 0, 0);
    }
  }
#pragma unroll
  for (int eb = 0; eb < 4; ++eb) {
    *(f32x4*)(Uf + (eb * 16 + li) * 64 + w * 16 + 4 * g) = acc[0][eb];
    *(f32x4*)(Ub + (eb * 16 + li) * 64 + w * 16 + 4 * g) = acc[1][eb];
  }
  __syncthreads();
}

__device__ __forceinline__ void ret_out_item(unsigned char* lds, int gb, int tg, const bf16* zb, int h, int c, float lgf2, float lgb2, const float* Sf, const float* Sb,
                                             bf16* Y, size_t yrow0, const float* mixg) {
  const int lane = tg & 63, w = __builtin_amdgcn_readfirstlane(tg >> 6), g = lane >> 4, li = lane & 15;
  const int tok0 = c < 2 ? NSEQ + 128 * c : 128 * (c - 2);
  const bf16* qp = zb + ((size_t)(S_RQ + h) * NT_TOK + tok0) * 64;
  const bf16* kp = zb + ((size_t)(S_RK + h) * NT_TOK + tok0) * 64;
  const bf16* vp = zb + ((size_t)(S_RV + h) * NT_TOK + tok0) * 64;
  const bf16* gp = zb + ((size_t)(S_RG + h) * NT_TOK + tok0) * 64;
  stage_rows<128, 4>(lds, gb, kp, 64, w, lane);
  stage_rows<128, 4>(lds, gb + 16384, vp, 64, w, lane);
  {
    const int e = tg >> 2, dq = tg & 3;
#pragma unroll
    for (int hh = 0; hh < 2; ++hh) {
      const f32x4 a0 = *(const f32x4*)(Sf + e * 64 + dq * 16 + hh * 8), a1 = *(const f32x4*)(Sf + e * 64 + dq * 16 + hh * 8 + 4);
      const f32x4 b0 = *(const f32x4*)(Sb + e * 64 + dq * 16 + hh * 8), b1 = *(const f32x4*)(Sb + e * 64 + dq * 16 + hh * 8 + 4);
      u32x4 oa, ob; oa.x = pk2(a0[0], a0[1]); oa.y = pk2(a0[2], a0[3]); oa.z = pk2(a1[0], a1[1]); oa.w = pk2(a1[2], a1[3]);
      ob.x = pk2(b0[0], b0[1]); ob.y = pk2(b0[2], b0[3]); ob.z = pk2(b1[0], b1[1]); ob.w = pk2(b1[2], b1[3]);
      *(u32x4*)(lds + gb + 32768 + lds_swz(e, dq * 2 + hh)) = oa;
      *(u32x4*)(lds + gb + 40960 + lds_swz(e, dq * 2 + hh)) = ob;
    }
  }
  bf16x8 qf[2][2];
#pragma unroll
  for (int ib = 0; ib < 2; ++ib)
#pragma unroll
    for (int kk = 0; kk < 2; ++kk) qf[ib][kk] = *(const bf16x8*)(qp + (size_t)(32 * w + 16 * ib + li) * 64 + kk * 32 + g * 8);
  VM_WAIT(); __syncthreads();
  const int f = (li >> 1) & 7;
  const int koff = gb + li * 128 + ((g ^ f) << 4);
  const int q_ = li >> 2, p_ = li & 3, fv = (2 * g + (q_ >> 1)) & 7;
  const int voff = gb + 16384 + (4 * g + q_) * 128 + (p_ & 1) * 8;
  f32x4 O[4][2], CF[4][2], CB[4][2];
#pragma unroll
  for (int eb = 0; eb < 4; ++eb)
#pragma unroll
    for (int ib = 0; ib < 2; ++ib) { O[eb][ib] = (f32x4){0.f, 0.f, 0.f, 0.f}; CF[eb][ib] = O[eb][ib]; CB[eb][ib] = O[eb][ib]; }
#pragma unroll
  for (int ks = 0; ks < 4; ++ks) {
    f32x4 s[2][2];
#pragma unroll
    for (int h2 = 0; h2 < 2; ++h2) {
      s[h2][0] = (f32x4){0.f, 0.f, 0.f, 0.f}; s[h2][1] = s[h2][0];
#pragma unroll
      for (int kk = 0; kk < 2; ++kk) {
        const bf16x8 kf = lds_frag(lds, ((2 * ks + h2) * 2048 + koff) ^ (kk << 6));
        s[h2][0] = __builtin_amdgcn_mfma_f32_16x16x32_bf16(kf, qf[0][kk], s[h2][0], 0, 0, 0);
        s[h2][1] = __builtin_amdgcn_mfma_f32_16x16x32_bf16(kf, qf[1][kk], s[h2][1], 0, 0, 0);
      }
    }
    bf16x8 pf[2];
#pragma unroll
    for (int ib = 0; ib < 2; ++ib) {
      const int i = 32 * w + 16 * ib + li;
      float p[8];
#pragma unroll
      for (int h2 = 0; h2 < 2; ++h2)
#pragma unroll
        for (int j = 0; j < 4; ++j) {
          const int jj = (2 * ks + h2) * 16 + 4 * g + j, df = i - jj;
          const float dw = df > 0 ? __builtin_amdgcn_exp2f(lgf2 * (float)df) : (df < 0 ? __builtin_amdgcn_exp2f(lgb2 * (float)(-df)) : 2.f);
          p[h2 * 4 + j] = s[h2][ib][j] * dw;
        }
      u32x4 pw; pw.x = pk2(p[0], p[1]); pw.y = pk2(p[2], p[3]); pw.z = pk2(p[4], p[5]); pw.w = pk2(p[6], p[7]);
      pf[ib] = __builtin_bit_cast(bf16x8, pw);
    }
#pragma unroll
    for (int eb = 0; eb < 4; ++eb) {
      const int a0 = voff + ks * 4096 + (((eb * 2 + (p_ >> 1)) ^ fv) << 4);
      const bf16x8 vf = lds_tr2(lds, a0, a0 + 2048);
      O[eb][0] = __builtin_amdgcn_mfma_f32_16x16x32_bf16(vf, pf[0], O[eb][0], 0, 0, 0);
      O[eb][1] = __builtin_amdgcn_mfma_f32_16x16x32_bf16(vf, pf[1], O[eb][1], 0, 0, 0);
    }
  }
#pragma unroll
  for (int kk = 0; kk < 2; ++kk)
#pragma unroll
    for (int eb = 0; eb < 4; ++eb) {
      const bf16x8 sf = lds_frag(lds, 32768 + ((eb * 2048 + koff) ^ (kk << 6)));
      const bf16x8 sb = lds_frag(lds, 40960 + ((eb * 2048 + koff) ^ (kk << 6)));
#pragma unroll
      for (int ib = 0; ib < 2; ++ib) {
        CF[eb][ib] = __builtin_amdgcn_mfma_f32_16x16x32_bf16(sf, qf[ib][kk], CF[eb][ib], 0, 0, 0);
        CB[eb][ib] = __builtin_amdgcn_mfma_f32_16x16x32_bf16(sb, qf[ib][kk], CB[eb][ib], 0, 0, 0);
      }
    }
#pragma unroll
  for (int ib = 0; ib < 2; ++ib) {
    const int i = 32 * w + 16 * ib + li;
    const float xf = __builtin_amdgcn_exp2f(lgf2 * (float)(i + 1)), xb = __builtin_amdgcn_exp2f(lgb2 * (float)(128 - i));
    float ss = 0.f;
#pragma unroll
    for (int eb = 0; eb < 4; ++eb) { O[eb][ib] = O[eb][ib] + CF[eb][ib] * xf + CB[eb][ib] * xb; ss += O[eb][ib][0] * O[eb][ib][0] + O[eb][ib][1] * O[eb][ib][1] + O[eb][ib][2] * O[eb][ib][2] + O[eb][ib][3] * O[eb][ib][3]; }
    ss += __shfl_xor(ss, 16); ss += __shfl_xor(ss, 32);
    const float r = rsqrtf(ss * (1.f / 64.f) + EPS);
    bf16* yp = Y + (yrow0 + i) * D + 640 + h * 64;
#pragma unroll
    for (int eb = 0; eb < 4; ++eb) {
      const f32x4 gv = *(const f32x4*)(mixg + 640 + h * 64 + eb * 16 + 4 * g);
      const u32x2 gg = *(const u32x2*)(gp + (size_t)i * 64 + eb * 16 + 4 * g);
      const f32x4 y = O[eb][ib] * r * gv;
      u32x2 o; o.x = pk2(y[0] * bflo(gg.x), y[1] * bfhi(gg.x)); o.y = pk2(y[2] * bflo(gg.y), y[3] * bfhi(gg.y));
      *(u32x2*)(yp + eb * 16 + 4 * g) = o;
    }
  }
  __syncthreads();
}

__device__ __forceinline__ float log_sigmoid_f(float x) { return x >= 0.f ? -log1pf(expf(-x)) : x - log1pf(expf(x)); }

__device__ __forceinline__ void p0_mod_item(unsigned char* lds, const Params& P, int item) {
  const int l = item / 96, chunk = item % 96, tid = get_tid(), ks = tid >> 4, cg4 = tid & 15;
  float* red = (float*)lds;
  float* sil = (float*)(lds + 32768);
#pragma unroll
  for (int i = 0; i < 2; ++i) { const int k = tid + 512 * i; sil[k] = silu_f(P.c[k]); sil[1024 + k] = silu_f(P.c[1024 + k]); sil[2048 + k] = silu_f(P.c_ctx[k]); }
  __syncthreads();
  const float* wa = P.w_ada + (size_t)l * 1024 * 6144 + chunk * 64 + cg4 * 4;
  f32x4 a0 = {0.f, 0.f, 0.f, 0.f}, a1 = a0, a2 = a0;
#pragma unroll 16
  for (int i = 0; i < 32; ++i) {
    const int k = ks * 32 + i;
    const f32x4 wv = __builtin_nontemporal_load((const f32x4*)(wa + (size_t)k * 6144));
    a0 += wv * sil[k]; a1 += wv * sil[1024 + k]; a2 += wv * sil[2048 + k];
  }
  *(f32x4*)(red + (ks * 3 + 0) * 64 + cg4 * 4) = a0; *(f32x4*)(red + (ks * 3 + 1) * 64 + cg4 * 4) = a1; *(f32x4*)(red + (ks * 3 + 2) * 64 + cg4 * 4) = a2;
  __syncthreads();
  if (tid < 192) {
    const int seg = tid >> 6, col = tid & 63; float s = P.b_ada[l * 6144 + chunk * 64 + col];
#pragma unroll
    for (int k2 = 0; k2 < 32; ++k2) s += red[(k2 * 3 + seg) * 64 + col];
    ((float*)(P.ws + WS_MOD))[(l * 3 + seg) * 6144 + chunk * 64 + col] = s;
  }
  __syncthreads();
}

__device__ __forceinline__ void p0_tr_item(unsigned char* lds, const float* src, int srcN, int k0, int n0, bf16* dst, int dstK, int mode) {
  float* tile = (float*)lds;
  const int tid = get_tid();
  f32x4 v[8];
#pragma unroll
  for (int ps = 0; ps < 8; ++ps) v[ps] = __builtin_nontemporal_load((const f32x4*)(src + (size_t)(k0 + (tid >> 5) + 16 * ps) * srcN + n0 + (tid & 31) * 4));
#pragma unroll
  for (int ps = 0; ps < 8; ++ps) { float* tp = tile + ((tid >> 5) + 16 * ps) * 129 + (tid & 31) * 4; tp[0] = v[ps][0]; tp[1] = v[ps][1]; tp[2] = v[ps][2]; tp[3] = v[ps][3]; }
  __syncthreads();
  const int n = tid >> 2, kc = tid & 3, ncol = n0 + n;
  int row = ncol;
  if (mode) row = (ncol >> 4) * 32 + (ncol & 15) + (mode == 2 ? 16 : 0);
  bf16* dp = dst + (size_t)row * dstK + k0 + kc * 32;
  const float* tp = tile + (kc * 32) * 129 + n;
#pragma unroll
  for (int q = 0; q < 4; ++q) {
    u32x4 o;
#pragma unroll
    for (int i = 0; i < 4; ++i) o[i] = pk2(tp[(q * 8 + 2 * i) * 129], tp[(q * 8 + 2 * i + 1) * 129]);
    *(u32x4*)(dp + q * 8) = o;
  }
  __syncthreads();
}

constexpr int P0_MOD = 192, P0_MISC = 1, P0_WIN = 2 * 8 * 23, P0_WO = 2 * 8 * 8, P0_W1 = 32 * 32, P0_W2 = 32 * 32;
constexpr int P0_ITEMS = P0_MOD + P0_MISC + P0_WIN + P0_WO + 2 * P0_W1 + P0_W2;

__device__ __forceinline__ void phase0(unsigned char* lds, const Params& P) {
#pragma unroll 1
  for (int it = blockIdx.x; it < P0_ITEMS; it += gridDim.x) {
    int r = it;
    if (r < P0_MOD) { p0_mod_item(lds, P, r); continue; } r -= P0_MOD;
    if (r < P0_MISC) {
      const int tid = get_tid();
      float* rope = (float*)(P.ws + WS_ROPE);
      for (int e = tid; e < 2048; e += NTHR) { const int pos = e >> 4, f = e & 15; const float inv = powf(10000.f, -(float)f / 16.f); const float ang = (float)pos * inv; rope[e * 2] = cosf(ang); rope[e * 2 + 1] = sinf(ang); }
      continue;
    } r -= P0_MISC;
    const float* src; int srcN, k0, n0, dstK, mode; bf16* dst;
    if (r < P0_WIN) { const int l = r / 184, q = r % 184, kt = q / 23, nt = q % 23;
      src = P.w_in + (size_t)l * 1024 * INC; srcN = INC; k0 = kt * 128; n0 = nt * 128; dst = (bf16*)(P.ws + WS_WIN) + (size_t)l * INC * 1024; dstK = 1024; mode = 0; }
    else if (r < P0_WIN + P0_WO) { const int r2 = r - P0_WIN, l = r2 / 64, q = r2 % 64, kt = q / 8, nt = q % 8;
      src = P.w_out + (size_t)l * 1024 * 1024; srcN = 1024; k0 = kt * 128; n0 = nt * 128; dst = (bf16*)(P.ws + WS_WO) + (size_t)l * 1024 * 1024; dstK = 1024; mode = 0; }
    else if (r < P0_WIN + P0_WO + 2 * P0_W1) { const int r2 = r - P0_WIN - P0_WO, which = r2 / P0_W1, q2 = r2 % P0_W1, le = q2 / 32, q = q2 % 32, kt = q / 4, nt = q % 4;
      src = (which ? P.w3 : P.w1) + (size_t)le * 1024 * 512; srcN = 512; k0 = kt * 128; n0 = nt * 128; dst = (bf16*)(P.ws + WS_W13) + (size_t)le * 1024 * 1024; dstK = 1024; mode = which ? 2 : 1; }
    else { const int r2 = r - P0_WIN - P0_WO - 2 * P0_W1, le = r2 / 32, q = r2 % 32, kt = q / 8, nt = q % 8;
      src = P.w2 + (size_t)le * 512 * 1024; srcN = 1024; k0 = kt * 128; n0 = nt * 128; dst = (bf16*)(P.ws + WS_W2) + (size_t)le * 1024 * 512; dstK = 512; mode = 0; }
    p0_tr_item(lds, src, srcN, k0, n0, dst, dstK, mode);
  }
}

constexpr int P1_XB = NROWS / 16, P1_BIAS = 2 * INC / 8, P1_WR = 6, P1_ITEMS = P1_XB + P1_BIAS + P1_WR;
__device__ __forceinline__ void phase1(unsigned char* lds, const Params& P) {
  const int tid = get_tid(), lane = tid & 63, w = tid >> 6;
  const float* mod = (const float*)(P.ws + WS_MOD);
#pragma unroll 1
  for (int it = blockIdx.x; it < P1_ITEMS; it += gridDim.x) {
    int r = it;
    if (r < P1_XB) {
      f32x4 v[2][4];
#pragma unroll
      for (int u = 0; u < 2; ++u) { const int row = r * 16 + 2 * w + u; const float* xr = row < NLAT ? P.x + (size_t)row * D : P.ctx + (size_t)(row - NLAT) * D;
#pragma unroll
        for (int j = 0; j < 4; ++j) v[u][j] = __builtin_nontemporal_load((const f32x4*)(xr + 4 * lane + 256 * j)); }
      const int row0 = r * 16 + 2 * w, seg = row0 < NSEQ ? 0 : (row0 < NLAT ? 1 : 2);
      const float* sc1 = mod + (0 * 3 + seg) * 6144 + 1024;
      f32x4 gs[4];
#pragma unroll
      for (int j = 0; j < 4; ++j) { const int k = 4 * lane + 256 * j; gs[j] = *(const f32x4*)(P.n1g + k) * (*(const f32x4*)(sc1 + k) + 1.f); }
#pragma unroll
      for (int u = 0; u < 2; ++u) {
        const int row = row0 + u; bf16* xb = (bf16*)(P.ws + WS_R1) + (size_t)row * D; float ss = 0.f;
#pragma unroll
        for (int j = 0; j < 4; ++j) { const f32x4 x = v[u][j]; ss += x[0] * x[0] + x[1] * x[1] + x[2] * x[2] + x[3] * x[3]; const f32x4 o = x * gs[j]; u32x2 ov; ov.x = pk2(o[0], o[1]); ov.y = pk2(o[2], o[3]); *(u32x2*)(xb + 4 * lane + 256 * j) = ov; }
        ss = wsum(ss);
        if (lane == 0) ((float*)(P.ws + WS_RSS))[row] = ss;
      }
      continue;
    } r -= P1_XB;
    if (r < P1_BIAS) {
      const int idx = r * 8 + w, l = idx / INC, n = idx % INC;
      const bf16* wrow = (const bf16*)(P.ws + WS_WIN) + ((size_t)l * INC + n) * 1024 + lane * 16;
      const u32x4 w0 = *(const u32x4*)wrow, w1 = *(const u32x4*)(wrow + 8);
      float wv[16];
#pragma unroll
      for (int i = 0; i < 4; ++i) { wv[2 * i] = bflo(w0[i]); wv[2 * i + 1] = bfhi(w0[i]); wv[8 + 2 * i] = bflo(w1[i]); wv[8 + 2 * i + 1] = bfhi(w1[i]); }
#pragma unroll
      for (int seg = 0; seg < 3; ++seg) {
        const float* sh = mod + (l * 3 + seg) * 6144 + lane * 16; float a = 0.f;
#pragma unroll
        for (int i = 0; i < 16; ++i) a += wv[i] * sh[i];
        a = wsum(a);
        if (lane == 0) ((float*)(P.ws + WS_BIAS))[(l * 3 + seg) * INC + n] = a;
      }
      continue;
    } r -= P1_BIAS;
    { const int l = r / 3, seg = r % 3;
      const float* m = mod + (l * 3 + seg) * 6144;
      float* wr = (float*)(P.ws + WS_WR) + (size_t)(l * 3 + seg) * 16384;
      for (int e = tid; e < 16384; e += NTHR) { const int k = e >> 4; wr[e] = P.n2g[l * 1024 + k] * (1.f + m[4096 + k]) * P.w_router[e]; }
      const int ex = tid & 15, ks = tid >> 4; float a = 0.f;
      for (int i = 0; i < 32; ++i) { const int k = ks * 32 + i; a += m[3072 + k] * P.w_router[k * 16 + ex]; }
      float* red = (float*)lds; red[ks * 16 + ex] = a; __syncthreads();
      if (tid < 16) { float s = P.b_router[tid]; for (int k2 = 0; k2 < 32; ++k2) s += red[k2 * 16 + tid]; ((float*)(P.ws + WS_CR))[(l * 3 + seg) * 16 + tid] = s; }
      __syncthreads();
    }
  }
}

__device__ __forceinline__ int xcd_vidx(int round) {
  const int G = gridDim.x, b = blockIdx.x;
  return (G & 7) == 0 ? round * G + (b & 7) * (G >> 3) + (b >> 3) : round * G + b;
}

__device__ __forceinline__ void phaseA(unsigned char* lds, const Params& P, int l) {
  const bf16* XB = (const bf16*)(P.ws + WS_R1);
  const bf16* Wt = (const bf16*)(P.ws + WS_WIN) + (size_t)l * INC * 1024;
  { const int tid = get_tid(); const f32x4* s4 = (const f32x4*)(P.ws + WS_ROPE); f32x4* d4 = (f32x4*)(lds + LDS_MISC);
    for (int e = tid; e < 1024; e += NTHR) d4[e] = s4[e];
    __syncthreads(); }
  const float* ropel = (const float*)(lds + LDS_MISC);
  EpiInProj<8, 4> E4{(const float*)(P.ws + WS_RSS), (const float*)(P.ws + WS_BIAS) + l * 3 * INC, P.qg + l * 64, P.kg + l * 64, ropel, (bf16*)(P.ws + WS_Z)};
  EpiInProj<8, 2> E2{(const float*)(P.ws + WS_RSS), (const float*)(P.ws + WS_BIAS) + l * 3 * INC, P.qg + l * 64, P.kg + l * 64, ropel, (bf16*)(P.ws + WS_Z)};
  constexpr int NFULL = 66 * 11, NITEM = NFULL + 33;
  bool staged = false;
#pragma unroll 1
  for (int round = 0; round * (int)gridDim.x < NITEM; ++round) {
    const int v = xcd_vidx(round);
    if (v >= NITEM) continue;
    if (v < NFULL) {
      const int m = v / 11, n = v % 11;
      const int vn = xcd_vidx(round + 1);
      const bool hn = vn < NFULL;
      ARowLinear ar{XB, 1024, m * 256}, arn{XB, 1024, (hn ? vn / 11 : 0) * 256};
      gemm8_tile(lds, ar, Wt, 1024, m * 256, n * 256, E4); (void)arn; (void)hn;
      staged = false;
    } else {
      const int m2 = (v - NFULL) * 2;
#pragma unroll 1
      for (int h = 0; h < 2; ++h) { ARowLinear ar{XB, 1024, (m2 + h) * 256}; gemm_tile<8, 2>(lds, ar, Wt, 1024, (m2 + h) * 256, 2816, E2); }
      staged = false;
    }
  }
}

__device__ __forceinline__ void phaseB(unsigned char* lds, const Params& P, int l) {
  const bool ctxout = (l == 0);
  const bf16* Z = (const bf16*)(P.ws + WS_Z);
  bf16* Y = (bf16*)P.out;
  const float* mixg = P.mix_g + l * 1024;
  const int tid = get_tid(), lane = tid & 63, w = __builtin_amdgcn_readfirstlane(tid >> 6), grp = w >> 2, wl4 = w & 3, tg = tid & 255, G = gridDim.x;
  { const int n = 256 + (ctxout ? 8 : 0);
#pragma unroll 1
    for (int r = blockIdx.x; r < n; r += G) {
      int b, kvh, qtok0, nlat, ntiles; size_t yrow0;
      if (r < 256) { b = r >> 7; kvh = (r >> 6) & 1; const int qt = r & 63; qtok0 = qt * 128; nlat = 128; ntiles = 132; yrow0 = (size_t)b * NSEQ + qt * 128; }
      else { const int q = r - 256; b = q >> 2; kvh = (q >> 1) & 1; const int qt = q & 1; qtok0 = NSEQ + qt * 128; nlat = 0; ntiles = 4; yrow0 = (size_t)NLAT + b * CL + qt * 128; }
      attn_item<3, false, 8>(lds, 0, w, lane, Z + (size_t)b * NSLOT * NT_TOK * 64, S_AQ + kvh * 3, S_AK + kvh, S_AV + kvh, qtok0, 0, nlat, ntiles, 0, Y, yrow0, kvh * 192, mixg);
    }
  }
  { const int n = 1024 + (ctxout ? 32 : 0);
    int start = (int)blockIdx.x - 8; if (start < 0) start += G;
#pragma unroll 1
    for (int pr = start; pr * 2 < n; pr += G) {
      const int r = pr * 2 + grp;
      int b, h, qtok0, lat0, nlat, ntiles, drbase; size_t yrow0;
      if (r < 1024) { b = r >> 9; h = (r >> 7) & 3; const int row = r & 127; int rs = row - 4; rs = rs < 0 ? 0 : (rs > 120 ? 120 : rs);
        qtok0 = row * 64; lat0 = rs * 64; nlat = 8; ntiles = 12; drbase = rs - row + 7; yrow0 = (size_t)b * NSEQ + row * 64; }
      else { const int q = r - 1024; b = q >> 4; h = (q >> 2) & 3; const int qt = q & 3; qtok0 = NSEQ + qt * 64; lat0 = 0; nlat = 0; ntiles = 4; drbase = 0; yrow0 = (size_t)NLAT + b * CL + qt * 64; }
      float* rp = (float*)(lds + grp * 65536 + 49152);
      const float* src = P.rpb + ((size_t)l * 4 + h) * 465;
      for (int e = tg; e < 465; e += 256) rp[e] = src[e] * LOG2E;
      __syncthreads();
      attn_item<1, true, 4>(lds, grp * 65536, wl4, lane, Z + (size_t)b * NSLOT * NT_TOK * 64, S_NQ + h, S_NK + h, S_NV + h, qtok0, lat0, nlat, ntiles, drbase, Y, yrow0, 384 + h * 64, mixg);
    }
  }
  { int start = (int)blockIdx.x - 40; if (start < 0) start += G;
#pragma unroll 1
    for (int pr = start; pr * 2 < 2 * 6 * 66; pr += G) {
      const int r = pr * 2 + grp;
      const int b = r / 396, q = r % 396, h = q / 66, c = q % 66;
      const float lgf2 = log_sigmoid_f(P.ret_decay[(l * 2 + 0) * 6 + h]) * LOG2E, lgb2 = log_sigmoid_f(P.ret_decay[(l * 2 + 1) * 6 + h]) * LOG2E;
      float* U = (float*)(P.ws + WS_R1);
      ret_u_item(lds, grp * 65536, tg, Z + (size_t)b * NSLOT * NT_TOK * 64, h, c, lgf2, lgb2, U + ((size_t)((b * 6 + h) * 2 + 0) * 66 + c) * 4096, U + ((size_t)((b * 6 + h) * 2 + 1) * 66 + c) * 4096);
    }
  }
}

__device__ __forceinline__ void phaseB2(const Params& P, int l) {
  const float* U = (const float*)(P.ws + WS_R1);
#pragma unroll 1
  for (int it = blockIdx.x; it < 192; it += gridDim.x) {
    const int seq = it >> 3, off = (it & 7) * 512 + get_tid();
    const int dir = seq & 1, h = (seq >> 1) % 6;
    const float lg = log_sigmoid_f(P.ret_decay[(l * 2 + dir) * 6 + h]);
    const float decay = expf(128.f * lg);
    const float* base = U + (size_t)seq * 66 * 4096 + off;
    float* sbase = (float*)((unsigned char*)P.out + S_OFF) + (size_t)seq * 66 * 4096 + off;
    float u[66];
    if (dir == 0) {
#pragma unroll
      for (int st = 0; st < 66; ++st) u[st] = __builtin_nontemporal_load(base + (size_t)st * 4096);
      float s = 0.f;
#pragma unroll
      for (int st = 0; st < 66; ++st) { sbase[(size_t)st * 4096] = s; s = s * decay + u[st]; }
    } else {
#pragma unroll
      for (int st = 0; st < 66; ++st) { const int c = st < 2 ? 1 - st : 67 - st; u[st] = __builtin_nontemporal_load(base + (size_t)c * 4096); }
      float s = 0.f;
#pragma unroll
      for (int st = 0; st < 66; ++st) { const int c = st < 2 ? 1 - st : 67 - st; sbase[(size_t)c * 4096] = s; s = s * decay + u[st]; }
    }
  }
}

__device__ __forceinline__ void phaseB3(unsigned char* lds, const Params& P, int l) {
  const bf16* Z = (const bf16*)(P.ws + WS_Z);
  bf16* Y = (bf16*)P.out;
  const float* mixg = P.mix_g + l * 1024;
  const float* U = (const float*)((const unsigned char*)P.out + S_OFF);
  const int tid = get_tid(), grp = __builtin_amdgcn_readfirstlane(tid >> 8), tg = tid & 255;
  const int cpb = (l == 0) ? 66 : 64, total = 2 * 6 * cpb;
#pragma unroll 1
  for (int pr = blockIdx.x; pr * 2 < total; pr += gridDim.x) {
    const int it = pr * 2 + grp;
    const int b = it / (6 * cpb), q = it % (6 * cpb), h = q / cpb, c = (q % cpb) + (66 - cpb);
    const float lgf2 = log_sigmoid_f(P.ret_decay[(l * 2 + 0) * 6 + h]) * LOG2E, lgb2 = log_sigmoid_f(P.ret_decay[(l * 2 + 1) * 6 + h]) * LOG2E;
    const size_t yrow0 = c < 2 ? (size_t)NLAT + b * CL + 128 * c : (size_t)b * NSEQ + 128 * (c - 2);
    ret_out_item(lds, grp * 65536, tg, Z + (size_t)b * NSLOT * NT_TOK * 64, h, c, lgf2, lgb2, U + ((size_t)((b * 6 + h) * 2 + 0) * 66 + c) * 4096, U + ((size_t)((b * 6 + h) * 2 + 1) * 66 + c) * 4096, Y, yrow0, mixg);
  }
}

__device__ __forceinline__ void pc_small_item(const Params& P, int l, int item) {
  const int tid = get_tid(), lane = tid & 63, w = tid >> 6, g = lane >> 4, li = lane & 15;
  const bf16* Y = (const bf16*)P.out;
  const bf16* Wt = (const bf16*)(P.ws + WS_WO) + (size_t)l * 1024 * 1024;
  float* XR = (float*)(P.ws + WS_XR);
  const int mb = item >> 5, nb = item & 31;
  const int m0 = NLAT + mb * 64 + (w >> 1) * 16, n0 = nb * 32 + (w & 1) * 16;
  const bf16* ar = Y + (size_t)(m0 + li) * D + g * 8;
  const bf16* br = Wt + (size_t)(n0 + li) * D + g * 8;
  f32x4 acc = {0.f, 0.f, 0.f, 0.f};
#pragma unroll 1
  for (int kb = 0; kb < 32; kb += 8) {
    bf16x8 af[8], bf[8];
#pragma unroll
    for (int c = 0; c < 8; ++c) { af[c] = *(const bf16x8*)(ar + (kb + c) * 32); bf[c] = *(const bf16x8*)(br + (kb + c) * 32); }
#pragma unroll
    for (int c = 0; c < 8; ++c) acc = __builtin_amdgcn_mfma_f32_16x16x32_bf16(bf[c], af[c], acc, 0, 0, 0);
  }
  const int m = m0 + li, n = n0 + 4 * g;
  const float* gt = (const float*)(P.ws + WS_MOD) + (l * 3 + 2) * 6144 + 2048;
  const f32x4 xv = *(const f32x4*)(P.ctx + (size_t)(m - NLAT) * D + n), gv = *(const f32x4*)(gt + n);
  *(f32x4*)(XR + (size_t)m * D + n) = xv + gv * acc;
}
__device__ __forceinline__ void phaseC(unsigned char* lds, const Params& P, int l) {
  const bf16* Y = (const bf16*)P.out;
  const bf16* Wt = (const bf16*)(P.ws + WS_WO) + (size_t)l * 1024 * 1024;
  float* XR = (float*)(P.ws + WS_XR);
  EpiOutProj E{l == 0 ? P.x : XR, l == 0 ? P.ctx : XR + (size_t)NLAT * D, (const float*)(P.ws + WS_MOD) + l * 3 * 6144, XR};
  const int nitem = NLAT / 256 * 4;
  bool staged = false;
#pragma unroll 1
  for (int round = 0; round * (int)gridDim.x < nitem; ++round) {
    const int v = xcd_vidx(round);
    if (v >= nitem) continue;
    const int vn = xcd_vidx(round + 1);
    const bool hn = vn < nitem;
    ARowLinear ar{Y, 1024, (v >> 2) * 256}, arn{Y, 1024, (hn ? vn >> 2 : 0) * 256};
    gemm8_tile(lds, ar, Wt, 1024, (v >> 2) * 256, (v & 3) * 256, E); (void)arn; (void)hn;
    staged = false;
  }
  if (l == 0) {
#pragma unroll 1
    for (int it = blockIdx.x; it < 256; it += gridDim.x) pc_small_item(P, l, it);
  }
}

__device__ __forceinline__ void phaseD(unsigned char* lds, const Params& P, int l) {
  const int tid = get_tid(), lane = tid & 63, w = tid >> 6, g = lane >> 4, li = lane & 15;
  const float* XR = (const float*)(P.ws + WS_XR);
  bf16* H2 = (bf16*)(P.ws + WS_R1);
  int* cnt = (int*)(P.ws + WS_CNT) + l * 16;
  int* list = (int*)(P.ws + WS_LIST) + (size_t)l * 16 * NROWS;
  float* gatew = (float*)(P.ws + WS_GATEW);
  float* part = (float*)lds;
  float* ssqp = part + 2048;
  float* rsl = ssqp + 128;
  int* hist = (int*)(rsl + 64);
  const int nitems = (l == 0 ? NROWS : NLAT) / 64;
  const int rgp = w >> 1, kh = w & 1;
#pragma unroll 1
  for (int it = blockIdx.x; it < nitems; it += gridDim.x) {
    const int r0 = it * 64, seg = r0 < NSEQ ? 0 : (r0 < NLAT ? 1 : 2);
    const float* wr = (const float*)(P.ws + WS_WR) + (size_t)(l * 3 + seg) * 16384;
    const float* xrow = XR + (size_t)(r0 + rgp * 16 + li) * D + 512 * kh + 4 * g;
    const float* wp0 = wr + (size_t)(512 * kh + 4 * g) * 16 + li;
    if (tid < 32) hist[tid] = 0;
    f32x4 acc = {0.f, 0.f, 0.f, 0.f}; float ssq = 0.f;
#pragma unroll 1
    for (int cb = 0; cb < 32; cb += 8) {
      f32x4 xv[8]; float bw[8][4];
#pragma unroll
      for (int c = 0; c < 8; ++c) {
        xv[c] = *(const f32x4*)(xrow + 16 * (cb + c));
        const float* wp = wp0 + (cb + c) * 256;
        bw[c][0] = wp[0]; bw[c][1] = wp[16]; bw[c][2] = wp[32]; bw[c][3] = wp[48];
      }
#pragma unroll
      for (int c = 0; c < 8; ++c) {
        ssq += xv[c][0] * xv[c][0] + xv[c][1] * xv[c][1] + xv[c][2] * xv[c][2] + xv[c][3] * xv[c][3];
        acc = __builtin_amdgcn_mfma_f32_16x16x4f32(xv[c][0], bw[c][0], acc, 0, 0, 0);
        acc = __builtin_amdgcn_mfma_f32_16x16x4f32(xv[c][1], bw[c][1], acc, 0, 0, 0);
        acc = __builtin_amdgcn_mfma_f32_16x16x4f32(xv[c][2], bw[c][2], acc, 0, 0, 0);
        acc = __builtin_amdgcn_mfma_f32_16x16x4f32(xv[c][3], bw[c][3], acc, 0, 0, 0);
      }
    }
    ssq += __shfl_xor(ssq, 16); ssq += __shfl_xor(ssq, 32);
#pragma unroll
    for (int j = 0; j < 4; ++j) part[(w * 16 + 4 * g + j) * 16 + li] = acc[j];
    if (g == 0) ssqp[w * 16 + li] = ssq;
    __syncthreads();
    int e1 = 0, e2 = 0, q1 = 0, q2 = 0; float g1 = 0.f, g2 = 0.f;
    if (tid < 64) {
      const int rg2 = tid >> 4, rr = tid & 15;
      const float ss = ssqp[(2 * rg2) * 16 + rr] + ssqp[(2 * rg2 + 1) * 16 + rr];
      const float rs = rsqrtf(ss * (1.f / 1024.f) + EPS);
      rsl[tid] = rs;
      const float* cr = (const float*)(P.ws + WS_CR) + (l * 3 + seg) * 16;
      float lg[16]; float mx = -1e30f;
#pragma unroll
      for (int e = 0; e < 16; ++e) { lg[e] = rs * (part[((2 * rg2) * 16 + rr) * 16 + e] + part[((2 * rg2 + 1) * 16 + rr) * 16 + e]) + cr[e]; mx = fmaxf(mx, lg[e]); }
#pragma unroll
      for (int e = 0; e < 16; ++e) lg[e] = expf(lg[e] - mx);
      float best = -1.f; int bg = 0; float b0 = 0.f, b1 = 0.f, b2 = 0.f, b3 = 0.f;
#pragma unroll
      for (int gi = 0; gi < 4; ++gi) {
        const float a0 = lg[4 * gi], a1 = lg[4 * gi + 1], a2 = lg[4 * gi + 2], a3 = lg[4 * gi + 3];
        const float sc = fmaxf(fmaxf(fmaxf(a0 + a1, a0 + a2), fmaxf(a0 + a3, a1 + a2)), fmaxf(a1 + a3, a2 + a3));
        if (sc > best) { best = sc; bg = gi; b0 = a0; b1 = a1; b2 = a2; b3 = a3; }
      }
      int i1 = 0; float v1 = b0;
      if (b1 > v1) { v1 = b1; i1 = 1; } if (b2 > v1) { v1 = b2; i1 = 2; } if (b3 > v1) { v1 = b3; i1 = 3; }
      int i2 = -1; float v2 = -1.f;
      if (i1 != 0 && b0 > v2) { v2 = b0; i2 = 0; } if (i1 != 1 && b1 > v2) { v2 = b1; i2 = 1; } if (i1 != 2 && b2 > v2) { v2 = b2; i2 = 2; } if (i1 != 3 && b3 > v2) { v2 = b3; i2 = 3; }
      const float inv = 1.f / (v1 + v2);
      e1 = bg * 4 + i1; e2 = bg * 4 + i2; g1 = v1 * inv; g2 = v2 * inv;
      q1 = atomicAdd(&hist[e1], 1); q2 = atomicAdd(&hist[e2], 1);
    }
    __syncthreads();
    if (tid < 16) hist[16 + tid] = atomicAdd(&cnt[tid], hist[tid]);
    __syncthreads();
    if (tid < 64) {
      const int row = r0 + tid;
      list[(size_t)e1 * NROWS + hist[16 + e1] + q1] = row * 2; gatew[row * 2] = g1;
      list[(size_t)e2 * NROWS + hist[16 + e2] + q2] = row * 2 + 1; gatew[row * 2 + 1] = g2;
    }
    {
      const float* m = (const float*)(P.ws + WS_MOD) + (l * 3 + seg) * 6144;
      f32x4 gs[4], sh[4];
#pragma unroll
      for (int j = 0; j < 4; ++j) { const int k = 4 * lane + 256 * j; gs[j] = *(const f32x4*)(P.n2g + l * 1024 + k) * (*(const f32x4*)(m + 4096 + k) + 1.f); sh[j] = *(const f32x4*)(m + 3072 + k); }
#pragma unroll 1
      for (int q = 0; q < 8; q += 4) {
        f32x4 xx[4][4];
#pragma unroll
        for (int u = 0; u < 4; ++u)
#pragma unroll
          for (int j = 0; j < 4; ++j) xx[u][j] = *(const f32x4*)(XR + (size_t)(r0 + 8 * w + q + u) * D + 4 * lane + 256 * j);
#pragma unroll
        for (int u = 0; u < 4; ++u) {
          const int rr = 8 * w + q + u; const float rs = rsl[rr]; bf16* hp = H2 + (size_t)(r0 + rr) * D;
#pragma unroll
          for (int j = 0; j < 4; ++j) { const f32x4 o = xx[u][j] * rs * gs[j] + sh[j]; u32x2 ov; ov.x = pk2(o[0], o[1]); ov.y = pk2(o[2], o[3]); *(u32x2*)(hp + 4 * lane + 256 * j) = ov; }
        }
      }
    }
    __syncthreads();
  }
}

__device__ __forceinline__ void phaseEF(unsigned char* lds, const Params& P, int l, bool down) {
  const int* cnt = (const int*)(P.ws + WS_CNT) + l * 16;
  const int* list = (const int*)(P.ws + WS_LIST) + (size_t)l * 16 * NROWS;
  int total = 0;
#pragma unroll 1
  for (int e = 0; e < 16; ++e) total += (cnt[e] + 127) >> 7;
  total *= 4;
  bf16* act = (bf16*)(P.ws + WS_Z + Z_ACT);
  bool staged = false;
  int it = xcd_vidx(0);
#define MOE_LOOKUP(IT, E_, MT_, NT_, CE_, SB_) do { const int ti_ = (IT) >> 2; NT_ = (IT) & 3; int tb_ = 0; E_ = 0; SB_ = 0; CE_ = cnt[0]; \
    _Pragma("unroll 1") for (int q_ = 0; q_ < 15; ++q_) { const int ntq_ = (CE_ + 127) >> 7; if (ti_ >= tb_ + ntq_) { tb_ += ntq_; SB_ += CE_; E_ = q_ + 1; CE_ = cnt[q_ + 1]; } else break; } MT_ = ti_ - tb_; } while (0)
#pragma unroll 1
  for (int round = 0; round * (int)gridDim.x < total; ++round) {
    if (it >= total) { it = xcd_vidx(round + 1); continue; }
    int e, mt, nt, ce, sb; MOE_LOOKUP(it, e, mt, nt, ce, sb);
    const int itn = xcd_vidx(round + 1);
    const bool hn = itn < total;
    int en = 0, mtn = 0, ntn = 0, cen = 1, sbn = 0;
    if (hn) MOE_LOOKUP(itn, en, mtn, ntn, cen, sbn);
    const int nvalid = (ce - mt * 128) < 128 ? (ce - mt * 128) : 128, nvalidn = (cen - mtn * 128) < 128 ? (cen - mtn * 128) : 128;
    const int slot0 = sb + mt * 128, slot0n = sbn + mtn * 128;
    const int* lst = list + (size_t)e * NROWS + mt * 128; const int* lstn = list + (size_t)en * NROWS + mtn * 128;
    if (!down) {
      ARowGather ar{(const bf16*)(P.ws + WS_R1), lst, nvalid}, arn{(const bf16*)(P.ws + WS_R1), lstn, nvalidn};
      EpiMoeUp E{act, slot0, nvalid};
      const bf16* W = (const bf16*)(P.ws + WS_W13) + (size_t)(l * 16) * 1024 * 1024;
      gemm_tile<4, 4>(lds, ar, W + (size_t)e * 1024 * 1024, 1024, 0, nt * 256, E, staged, hn, &arn, W + (size_t)en * 1024 * 1024, ntn * 256);
    } else {
      ARowAct ar{act, slot0}, arn{act, slot0n};
      EpiMoeDown E{lst, (const float*)(P.ws + WS_GATEW), (bf16*)(P.ws + WS_R1), (bf16*)(P.ws + WS_Z + Z_YM1), nvalid};
      const bf16* W = (const bf16*)(P.ws + WS_W2) + (size_t)(l * 16) * 1024 * 512;
      gemm_tile<4, 4>(lds, ar, W + (size_t)e * 1024 * 512, 512, 0, nt * 256, E, staged, hn, &arn, W + (size_t)en * 1024 * 512, ntn * 256);
    }
    staged = hn; it = itn;
  }
#undef MOE_LOOKUP
}

__device__ __forceinline__ void phaseG(const Params& P, int l) {
  const int tid = get_tid(), lane = tid & 63, w = tid >> 6;
  float* XR = (float*)(P.ws + WS_XR);
  const bf16* Y0 = (const bf16*)(P.ws + WS_R1); const bf16* Y1 = (const bf16*)(P.ws + WS_Z + Z_YM1);
  const float* mod = (const float*)(P.ws + WS_MOD);
  const int nrows = l == 0 ? NROWS : NLAT;
#pragma unroll 1
  for (int it = blockIdx.x; it < nrows / 16; it += gridDim.x) {
    const int row0 = it * 16 + 2 * w, seg = row0 < NSEQ ? 0 : (row0 < NLAT ? 1 : 2);
    const float* gt2 = mod + (l * 3 + seg) * 6144 + 5120;
    f32x4 x1[2][4]; u32x2 ya[2][4], yb[2][4];
#pragma unroll
    for (int u = 0; u < 2; ++u)
#pragma unroll
      for (int j = 0; j < 4; ++j) { const size_t o = (size_t)(row0 + u) * D + 4 * lane + 256 * j; x1[u][j] = __builtin_nontemporal_load((const f32x4*)(XR + o)); ya[u][j] = __builtin_nontemporal_load((const u32x2*)(Y0 + o)); yb[u][j] = __builtin_nontemporal_load((const u32x2*)(Y1 + o)); }
    f32x4 gv[4];
#pragma unroll
    for (int j = 0; j < 4; ++j) gv[j] = *(const f32x4*)(gt2 + 4 * lane + 256 * j);
#pragma unroll
    for (int u = 0; u < 2; ++u) {
      const int row = row0 + u;
      f32x4 xv[4]; float ss = 0.f;
#pragma unroll
      for (int j = 0; j < 4; ++j) {
        const u32x2 a = ya[u][j], b = yb[u][j];
        f32x4 m; m[0] = bflo(a.x) + bflo(b.x); m[1] = bfhi(a.x) + bfhi(b.x); m[2] = bflo(a.y) + bflo(b.y); m[3] = bfhi(a.y) + bfhi(b.y);
        xv[j] = x1[u][j] + gv[j] * m;
        ss += xv[j][0] * xv[j][0] + xv[j][1] * xv[j][1] + xv[j][2] * xv[j][2] + xv[j][3] * xv[j][3];
      }
      ss = wsum(ss);
      if (l == 0) {
        const float* sc1 = mod + (1 * 3 + seg) * 6144 + 1024;
        bf16* xb = (bf16*)(P.ws + WS_R1) + (size_t)row * D;
        if (lane == 0) ((float*)(P.ws + WS_RSS))[row] = ss;
#pragma unroll
        for (int j = 0; j < 4; ++j) {
          const int k = 4 * lane + 256 * j;
          *(f32x4*)(XR + (size_t)row * D + k) = xv[j];
          const f32x4 gg = *(const f32x4*)(P.n1g + 1024 + k), sc = *(const f32x4*)(sc1 + k);
          const f32x4 o = xv[j] * gg * (sc + 1.f);
          u32x2 ov; ov.x = pk2(o[0], o[1]); ov.y = pk2(o[2], o[3]); *(u32x2*)(xb + k) = ov;
        }
      } else {
        const float rs = rsqrtf(ss * (1.f / 1024.f) + EPS);
#pragma unroll
        for (int j = 0; j < 4; ++j) {
          const int k = 4 * lane + 256 * j;
          const f32x4 gg = *(const f32x4*)(P.final_g + k);
          __builtin_nontemporal_store(xv[j] * rs * gg, (f32x4*)(P.out + (size_t)row * D + k));
        }
      }
    }
  }
}

#define XB_TMO      128
#define XB_XCNT(j)  (256  + 64 * (j))
#define XB_XSUB(j)  (1280 + 64 * (j))
#define XB_XGEN(j)  (2304 + 64 * (j))
#define XB_TOP      3328
#define XB_TOPGEN   3392
#define XB_SPIN_CAP (1u << 20)
__device__ __forceinline__ unsigned xb_ld(unsigned* p)              { return __hip_atomic_load(p, __ATOMIC_RELAXED, __HIP_MEMORY_SCOPE_AGENT); }
__device__ __forceinline__ unsigned xb_add(unsigned* p, unsigned v) { return __hip_atomic_fetch_add(p, v, __ATOMIC_RELAXED, __HIP_MEMORY_SCOPE_AGENT); }
__device__ __forceinline__ unsigned xb_xcc_id() { return (unsigned)__builtin_amdgcn_s_getreg((3 << 11) | 20) & 0xFu; }
#define XB_SPIN(cond, bar) do { unsigned _sp = 0; while (cond) { __builtin_amdgcn_s_sleep(1); \
    if ((++_sp & 255u) == 0u) { if (xb_ld(&(bar)[XB_TMO])) break; if (_sp > XB_SPIN_CAP) { atomicAdd(&(bar)[XB_TMO], 1u); break; } } } } while (0)
struct XBar { unsigned* bar; unsigned* st; };
__device__ __forceinline__ void xbar_init(XBar& b, unsigned* bar, unsigned* st) {
  b.bar = bar; b.st = st;
  if (threadIdx.x == 0) { st[0] = 0u; st[1] = 0u; (void)xb_add(&bar[XB_XCNT(xb_xcc_id())], 1u); }
}
__device__ __forceinline__ void xbar_sync(XBar& b) {
  asm volatile("s_waitcnt vmcnt(0)" ::: "memory");
  __syncthreads();
  if (threadIdx.x == 0) {
    unsigned* bar = b.bar;
    const unsigned x = xb_xcc_id();
    __builtin_amdgcn_s_waitcnt(0);
    unsigned nloc = b.st[0], nx = b.st[1];
    if (nloc == 0u) {
      const unsigned G = gridDim.x; unsigned sum, cnt, mine, sp = 0u;
      for (;;) {
        sum = 0u; cnt = 0u; mine = 0u;
#pragma unroll
        for (unsigned j = 0; j < 16; ++j) { const unsigned c = xb_ld(&bar[XB_XCNT(j)]); sum += c; cnt += (c > 0u) ? 1u : 0u; mine = (j == x) ? c : mine; }
        if (sum == G) break;
        __builtin_amdgcn_s_sleep(1);
        if ((++sp & 255u) == 0u) { if (xb_ld(&bar[XB_TMO])) break; if (sp > XB_SPIN_CAP) { atomicAdd(&bar[XB_TMO], 1u); break; } }
      }
      nloc = mine > 0u ? mine : 1u; nx = cnt > 0u ? cnt : 1u;
      b.st[0] = nloc; b.st[1] = nx;
    }
    const unsigned old = xb_add(&bar[XB_XSUB(x)], 1u);
    const unsigned gen = old / nloc;
    if (old + 1u == (gen + 1u) * nloc) {
      __builtin_amdgcn_fence(__ATOMIC_RELEASE, "agent");
      asm volatile("s_waitcnt vmcnt(0)" ::: "memory");
      const unsigned og = xb_add(&bar[XB_TOP], 1u);
      const unsigned tg = og / nx;
      if (og + 1u == (tg + 1u) * nx) xb_add(&bar[XB_TOPGEN], 1u);
      else XB_SPIN(xb_ld(&bar[XB_TOPGEN]) == tg, bar);
      __builtin_amdgcn_fence(__ATOMIC_ACQUIRE, "agent");
      xb_add(&bar[XB_XGEN(x)], 1u);
      asm volatile("s_waitcnt vmcnt(0)" ::: "memory");
    } else {
      XB_SPIN(xb_ld(&bar[XB_XGEN(x)]) == gen, bar);
      __builtin_amdgcn_fence(__ATOMIC_ACQUIRE, "agent");
      asm volatile("s_waitcnt vmcnt(0)" ::: "memory");
    }
  }
  __syncthreads();
}

__global__ void __launch_bounds__(NTHR, 2) fwd_mega(Params P) {
  extern __shared__ __attribute__((aligned(16))) unsigned char lds[];
  cg::grid_group grid = cg::this_grid();
  XBar xb; xbar_init(xb, (unsigned*)(P.ws + WS_BAR), (unsigned*)(lds + LDS_BARW));
#define GSYNC() xbar_sync(xb)
  phase0(lds, P);
  VM_WAIT(); __syncthreads(); grid.sync();
  phase1(lds, P); GSYNC();
#pragma unroll 1
  for (int l = 0; l < 2; ++l) {
    phaseA(lds, P, l); GSYNC();
    phaseB(lds, P, l); GSYNC();
    phaseB2(P, l); GSYNC();
    phaseB3(lds, P, l); GSYNC();
    phaseC(lds, P, l); GSYNC();
    phaseD(lds, P, l); GSYNC();
    phaseEF(lds, P, l, false); GSYNC();
    phaseEF(lds, P, l, true); GSYNC();
    phaseG(P, l);
    if (l == 0) GSYNC();
  }
#undef GSYNC
}

extern "C" void kernel_launch(void* const* d_in, const int* in_sizes, int n_in, void* d_out, int out_size, void* d_ws, size_t ws_size, hipStream_t stream) {
  static int grid_blocks = 0;
  if (!grid_blocks) {
    int dev = 0, cus = 0, per_cu = 0;
    (void)hipGetDevice(&dev);
    (void)hipDeviceGetAttribute(&cus, hipDeviceAttributeMultiprocessorCount, dev);
    (void)hipFuncSetAttribute((const void*)fwd_mega, hipFuncAttributeMaxDynamicSharedMemorySize, LDS_BYTES);
    (void)hipOccupancyMaxActiveBlocksPerMultiprocessor(&per_cu, fwd_mega, NTHR, LDS_BYTES);
    if (per_cu > 1) per_cu = 1;
    if (per_cu < 1) per_cu = 1;
    grid_blocks = cus * per_cu;
    if (ws_size < WS_END) fprintf(stderr, "kernel_launch: workspace too small: %zu < %zu\n", ws_size, (size_t)WS_END);
  }
  (void)hipMemsetAsync(d_ws, 0, WS_ZERO_BYTES, stream);
  Params p{};
  const float** pp = (const float**)&p;
  for (int i = 0; i < 21; ++i) pp[i] = (const float*)d_in[i];
  p.out = (float*)d_out; p.ws = (unsigned char*)d_ws;
  void* args[] = {&p};
  hipError_t e = hipLaunchCooperativeKernel((void*)fwd_mega, dim3(grid_blocks), dim3(NTHR), args, LDS_BYTES, stream);
  if (e != hipSuccess) fprintf(stderr, "cooperative launch failed: %s (grid %d)\n", hipGetErrorString(e), grid_blocks);
}
```

```cpp
#include <hip/hip_runtime.h>
#include <hip/hip_cooperative_groups.h>
#include <cstdio>
#include <cstdint>
namespace cg = cooperative_groups;

typedef unsigned short bf16;
typedef short bf16x8 __attribute__((ext_vector_type(8)));
typedef short s16x4 __attribute__((ext_vector_type(4)));
typedef float f32x4 __attribute__((ext_vector_type(4)));
typedef float f32x2 __attribute__((ext_vector_type(2)));
typedef unsigned u32x4 __attribute__((ext_vector_type(4)));
typedef unsigned u32x2 __attribute__((ext_vector_type(2)));
typedef __bf16 bf2_t __attribute__((ext_vector_type(2)));
#define LAS __attribute__((address_space(3)))
constexpr int NTHR = 512;
constexpr int LDS_BYTES = 147456 + 64;
constexpr int LDS_BARW = 147456;
constexpr int LDS_MISC = 131072;

constexpr int D = 1024, NSEQ = 8192, CL = 256, NT_TOK = NSEQ + CL, NLAT = 2 * NSEQ, NROWS = NLAT + 2 * CL;
constexpr int INC = 2944, NSLOT = 46;
constexpr float EPS = 1e-6f;
constexpr float LOG2E = 1.4426950408889634f;
constexpr float QSCALE = 0.125f * LOG2E;
constexpr int S_AQ = 0, S_AK = 6, S_AV = 8, S_NQ = 10, S_NK = 14, S_NV = 18, S_RQ = 22, S_RK = 28, S_RV = 34, S_RG = 40;

constexpr size_t WS_BAR = 0;
constexpr size_t WS_CNT = 16384;
constexpr size_t WS_ZERO_BYTES = 16384 + 4096;
constexpr size_t WS_MOD = WS_ZERO_BYTES;
constexpr size_t WS_BIAS = WS_MOD + 2 * 3 * 6144 * 4;
constexpr size_t WS_ROPE = WS_BIAS + 2 * 3 * 2944 * 4;
constexpr size_t WS_RSS = WS_ROPE + 128 * 16 * 2 * 4;
constexpr size_t WS_WR = WS_RSS + 16896 * 4;
constexpr size_t WS_CR = WS_WR + 2 * 3 * 1024 * 16 * 4;
constexpr size_t WS_GATEW = WS_CR + 4096;
constexpr size_t WS_LIST = WS_GATEW + 16896 * 2 * 4;
constexpr size_t WS_WIN = (WS_LIST + (size_t)2 * 16 * 16896 * 4 + 4095) / 4096 * 4096;
constexpr size_t WS_WO = WS_WIN + (size_t)2 * 2944 * 1024 * 2;
constexpr size_t WS_W13 = WS_WO + (size_t)2 * 1024 * 1024 * 2;
constexpr size_t WS_W2 = WS_W13 + (size_t)32 * 1024 * 1024 * 2;
constexpr size_t WS_XR = WS_W2 + (size_t)32 * 1024 * 512 * 2;
constexpr size_t WS_R1 = WS_XR + (size_t)NROWS * 1024 * 4;
constexpr size_t WS_Z = WS_R1 + (size_t)NROWS * 1024 * 2;
constexpr size_t WS_END = WS_Z + (size_t)2 * NSLOT * NT_TOK * 64 * 2;
constexpr size_t S_OFF = (size_t)34 << 20;
constexpr size_t Z_YM1 = 0, Z_ACT = (size_t)NROWS * 1024 * 2;
static_assert(Z_ACT + (size_t)(2 * NROWS + 128) * 512 * 2 <= (size_t)2 * NSLOT * NT_TOK * 64 * 2, "act overlay");
static_assert((size_t)2 * 6 * 2 * 66 * 4096 * 4 <= (size_t)NROWS * 1024 * 2, "U overlay");

struct Params {
  const float *x, *c, *ctx, *c_ctx, *w_ada, *b_ada, *n1g, *n2g, *w_in, *qg, *kg, *rpb, *ret_decay, *mix_g, *w_out, *w_router, *b_router, *w1, *w3, *w2, *final_g;
  float* out; unsigned char* ws;
};

__device__ __forceinline__ unsigned pk2(float lo, float hi) { f32x2 v = {lo, hi}; bf2_t b = __builtin_convertvector(v, bf2_t); return __builtin_bit_cast(unsigned, b); }
__device__ __forceinline__ float bflo(unsigned u) { return __builtin_bit_cast(float, u << 16); }
__device__ __forceinline__ float bfhi(unsigned u) { return __builtin_bit_cast(float, u & 0xffff0000u); }
__device__ __forceinline__ float wsum(float v) {
#pragma unroll
  for (int o = 1; o < 64; o <<= 1) v += __shfl_xor(v, o);
  return v;
}
__device__ __forceinline__ float silu_f(float v) { return v / (1.f + __expf(-v)); }
__device__ __forceinline__ int lds_swz(int row, int chunk) { return row * 128 + ((chunk ^ ((row >> 1) & 7)) << 4); }
#define VM_WAIT() asm volatile("s_waitcnt vmcnt(0)" ::: "memory")
__device__ __forceinline__ int get_tid() { int t = threadIdx.x; asm volatile("" : "+v"(t)); return t; }

template <int R, int NW>
__device__ __forceinline__ void stage_rows(unsigned char* lds, int dst, const bf16* src, int ld, int wl, int lane) {
#pragma unroll
  for (int i = 0; i < R / (8 * NW); ++i) {
    const int q = wl + NW * i, row = q * 8 + (lane >> 3), ch = (lane & 7) ^ ((row >> 1) & 7);
    __builtin_amdgcn_global_load_lds((const void*)(src + (size_t)row * ld + ch * 8), (LAS void*)(lds + dst + q * 1024), 16, 0, 0);
  }
}
#define VMCNT(n) asm volatile("s_waitcnt vmcnt(" #n ")" ::: "memory")
#define LGKM0() asm volatile("s_waitcnt lgkmcnt(0)" ::: "memory")
#define RAW_BAR() __builtin_amdgcn_s_barrier()
__device__ __forceinline__ bf16x8 lds_frag(const unsigned char* lds, int off) { return *(const bf16x8*)(lds + off); }
__device__ __forceinline__ bf16x8 lds_tr2(unsigned char* lds, int off0, int off1) {
  s16x4 a = __builtin_amdgcn_ds_read_tr16_b64_v4i16((LAS s16x4*)(lds + off0));
  s16x4 b = __builtin_amdgcn_ds_read_tr16_b64_v4i16((LAS s16x4*)(lds + off1));
  return __builtin_shufflevector(a, b, 0, 1, 2, 3, 4, 5, 6, 7);
}

template <int MT, int NT, int ST> struct GStep {
  static __device__ __forceinline__ void run(f32x4 (&acc)[MT][NT], bf16x8 (&W0)[NT], bf16x8 (&W1)[NT], bf16x8 (&X)[2 * MT], const unsigned char* base, int xoff, int woff) {
    constexpr int S = 2 * MT, kk = ST / MT, mt = ST % MT;
#pragma unroll
    for (int nt = 0; nt < NT; ++nt) acc[mt][nt] = __builtin_amdgcn_mfma_f32_16x16x32_bf16(kk ? W1[nt] : W0[nt], X[ST], acc[mt][nt], 0, 0, 0);
    __builtin_amdgcn_sched_group_barrier(0x008, NT, 0);
    if constexpr (ST + 2 < S) { constexpr int k2 = (ST + 2) / MT, m2 = (ST + 2) % MT; X[ST + 2] = lds_frag(base, (xoff + m2 * 2048) ^ (k2 << 6)); }
    if constexpr (ST < NT) W1[ST] = lds_frag(base, (woff + ST * 2048) ^ 64);
    constexpr int nds = (ST + 2 < S ? 1 : 0) + (ST < NT ? 1 : 0);
    if constexpr (nds > 0) __builtin_amdgcn_sched_group_barrier(0x100, nds, 0);
    if constexpr (ST + 1 < S) GStep<MT, NT, ST + 1>::run(acc, W0, W1, X, base, xoff, woff);
  }
};

template <int MT, int NT, class ARow, class Epi>
__device__ __forceinline__ void gemm_tile(unsigned char* lds, const ARow& arow, const bf16* __restrict__ Bt, int K, int m0, int n0, const Epi& epi,
                                          bool staged0 = false, bool hasnext = false, const ARow* narow = nullptr, const bf16* nBt = nullptr, int nn0 = 0) {
  const int tid = get_tid(), lane = tid & 63, w = __builtin_amdgcn_readfirstlane(tid >> 6);
  const int wr = w >> 2, wc = w & 3, g = lane >> 4, li = lane & 15;
  constexpr int NA = MT / 2, NB = NT;
  const bf16* ap[NA]; const bf16* bp[NB];
#pragma unroll
  for (int i = 0; i < NA; ++i) { const int q = w + 8 * i, row = q * 8 + (lane >> 3), ch = (lane & 7) ^ ((row >> 1) & 7); ap[i] = arow(row) + ch * 8; }
#pragma unroll
  for (int i = 0; i < NB; ++i) { const int q = w + 8 * i, row = q * 8 + (lane >> 3), ch = (lane & 7) ^ ((row >> 1) & 7); bp[i] = Bt + (size_t)(n0 + row) * K + ch * 8; }
  f32x4 acc[MT][NT];
#pragma unroll
  for (int a = 0; a < MT; ++a)
#pragma unroll
    for (int b = 0; b < NT; ++b) acc[a][b] = (f32x4){0.f, 0.f, 0.f, 0.f};
  const int f = (li >> 1) & 7;
  const int xoff = (wr * (MT * 16) + li) * 128 + ((g ^ f) << 4);
  const int woff = 32768 + (wc * (NT * 16) + li) * 128 + ((g ^ f) << 4);
  const int nk = K >> 6;
#define GT_STAGE(s, k0) do { _Pragma("unroll") for (int i = 0; i < NA; ++i) \
    __builtin_amdgcn_global_load_lds((const void*)(ap[i] + (k0)), (LAS void*)(lds + (s) * 65536 + (w + 8 * i) * 1024), 16, 0, 0); \
    _Pragma("unroll") for (int i = 0; i < NB; ++i) \
    __builtin_amdgcn_global_load_lds((const void*)(bp[i] + (k0)), (LAS void*)(lds + (s) * 65536 + 32768 + (w + 8 * i) * 1024), 16, 0, 0); } while (0)
  if (!staged0) GT_STAGE(0, 0);
  VM_WAIT(); __syncthreads();
  for (int t = 0; t < nk; ++t) {
    const int s = t & 1;
    if (t + 1 < nk) GT_STAGE(s ^ 1, (t + 1) * 64);
    const unsigned char* base = lds + s * 65536;
    {
      bf16x8 W0[NT], W1[NT], X[2 * MT];
#pragma unroll
      for (int nt = 0; nt < NT; ++nt) W0[nt] = lds_frag(base, woff + nt * 2048);
      X[0] = lds_frag(base, xoff); X[1] = lds_frag(base, xoff + 2048);
      __builtin_amdgcn_sched_group_barrier(0x100, NT + 2, 0);
      GStep<MT, NT, 0>::run(acc, W0, W1, X, base, xoff, woff);
    }
    VM_WAIT(); __syncthreads();
  }
  if (hasnext) {
#pragma unroll
    for (int i = 0; i < NA; ++i) { const int q = w + 8 * i, row = q * 8 + (lane >> 3), ch = (lane & 7) ^ ((row >> 1) & 7); ap[i] = (*narow)(row) + ch * 8; }
#pragma unroll
    for (int i = 0; i < NB; ++i) { const int q = w + 8 * i, row = q * 8 + (lane >> 3), ch = (lane & 7) ^ ((row >> 1) & 7); bp[i] = nBt + (size_t)(nn0 + row) * K + ch * 8; }
    GT_STAGE(0, 0);
  }
#undef GT_STAGE
  epi(acc, m0 + wr * (MT * 16), n0 + wc * (NT * 16), g, li);
}


namespace g8 {
constexpr int HT_B = 128 * 64 * 2;
__device__ __forceinline__ int lds_byte(int r, int c) { const int st = (r >> 4) * 2 + (c >> 5), rr = r & 15, cc = c & 31, ob = rr * 64 + cc * 2; return st * 1024 + (ob ^ (((ob >> 9) & 1) << 5)); }
__device__ __forceinline__ void stage_rc(int b, int& R, int& C) { const int st = b / 1024, sb = b % 1024, swz = sb ^ (((sb >> 9) & 1) << 5); R = (st >> 1) * 16 + swz / 64; C = (st & 1) * 32 + (swz % 64) / 2; }
}
template <class ARow, class Epi>
__device__ __forceinline__ void gemm8_tile(unsigned char* lds, const ARow& arow, const bf16* __restrict__ Bt, int K, int m0, int n0, const Epi& epi) {
  using namespace g8;
  const int tid = get_tid(), lane = tid & 63, wid = __builtin_amdgcn_readfirstlane(tid >> 6), wr = wid >> 2, wc = wid & 3, fr = lane & 15, fq = lane >> 4;
  const char* abase = (const char*)arow(0);
  const char* bbase = (const char*)(Bt + (size_t)n0 * K);
  unsigned oa[2][2], ob[2][2];
#pragma unroll
  for (int i = 0; i < 2; ++i) {
    int R, C; stage_rc(tid * 16 + i * 8192, R, C);
    const int ra = (R >> 6) * 128 + ((R >> 4) & 3) * 16 + (R & 15);
    const int rb = (R >> 5) * 64 + ((R >> 4) & 1) * 16 + (R & 15);
#pragma unroll
    for (int hh = 0; hh < 2; ++hh) { oa[hh][i] = (unsigned)((ra + hh * 64) * K + C) * 2u; ob[hh][i] = (unsigned)((rb + hh * 32) * K + C) * 2u; }
  }
#define G8_SA(b, h) (((b) * 2 + (h)) * HT_B)
#define G8_SB(b, h) ((4 + (b) * 2 + (h)) * HT_B)
#define G8_STAGE(bufoff, BASE, O2, kt) do { _Pragma("unroll") for (int _i = 0; _i < 2; ++_i) \
    __builtin_amdgcn_global_load_lds((const void*)((BASE) + (O2)[_i] + (unsigned)(kt) * 128u), (LAS void*)(lds + (bufoff) + wid * 1024 + _i * 8192), 16, 0, 0); } while (0)
  const int aoff = lds_byte(wr * 64 + fr, fq * 8), boff = lds_byte(wc * 32 + fr, fq * 8);
#define G8_LDA(dst, b, h) do { _Pragma("unroll") for (int m = 0; m < 4; ++m) _Pragma("unroll") for (int k = 0; k < 2; ++k) dst[m][k] = *(const bf16x8*)(lds + G8_SA(b, h) + aoff + m * 2048 + k * 1024); } while (0)
#define G8_LDB(dst, b, h) do { _Pragma("unroll") for (int n = 0; n < 2; ++n) _Pragma("unroll") for (int k = 0; k < 2; ++k) dst[n][k] = *(const bf16x8*)(lds + G8_SB(b, h) + boff + n * 2048 + k * 1024); } while (0)
#define G8_MMA(ai, bj, At_, Bt_) do { __builtin_amdgcn_s_setprio(1); _Pragma("unroll") for (int m = 0; m < 4; ++m) _Pragma("unroll") for (int n = 0; n < 2; ++n) _Pragma("unroll") for (int k = 0; k < 2; ++k) \
    acc[(ai) * 4 + m][(bj) * 2 + n] = __builtin_amdgcn_mfma_f32_16x16x32_bf16(Bt_[n][k], At_[m][k], acc[(ai) * 4 + m][(bj) * 2 + n], 0, 0, 0); __builtin_amdgcn_s_setprio(0); } while (0)
#define G8_WV(n) asm volatile("s_waitcnt vmcnt(" #n ")" ::: "memory")
#define G8_WL(n) asm volatile("s_waitcnt lgkmcnt(" #n ")" ::: "memory")
#define G8_BAR __builtin_amdgcn_s_barrier()
#define G8_SCHED __builtin_amdgcn_sched_barrier(0)
  f32x4 acc[8][4];
#pragma unroll
  for (int a = 0; a < 8; ++a)
#pragma unroll
    for (int b = 0; b < 4; ++b) acc[a][b] = (f32x4){0.f, 0.f, 0.f, 0.f};
  bf16x8 At[4][2], B0[2][2], B1[2][2];
  const int nt = K >> 6;
  G8_STAGE(G8_SB(0, 0), bbase, ob[0], 0); G8_STAGE(G8_SA(0, 0), abase, oa[0], 0);
  G8_STAGE(G8_SB(0, 1), bbase, ob[1], 0); G8_STAGE(G8_SA(0, 1), abase, oa[1], 0);
  if (wr == 1) G8_BAR;
  G8_WV(4); G8_BAR;
  G8_STAGE(G8_SB(1, 0), bbase, ob[0], 1); G8_STAGE(G8_SA(1, 0), abase, oa[0], 1); G8_STAGE(G8_SB(1, 1), bbase, ob[1], 1);
  G8_WV(6); G8_BAR;
#pragma unroll 1
  for (int t = 0; t < nt - 2; t += 2) {
    G8_LDB(B0, 0, 0); G8_SCHED; G8_LDA(At, 0, 0); G8_STAGE(G8_SA(1, 1), abase, oa[1], t + 1);
    G8_WL(8); G8_BAR; G8_WL(0); G8_MMA(0, 0, At, B0); G8_BAR; G8_SCHED;
    G8_LDB(B1, 0, 1); G8_STAGE(G8_SB(0, 0), bbase, ob[0], t + 2);
    G8_BAR; G8_WL(0); G8_MMA(0, 1, At, B1); G8_BAR;
    G8_LDA(At, 0, 1); G8_STAGE(G8_SA(0, 0), abase, oa[0], t + 2);
    G8_BAR; G8_WL(0); G8_MMA(1, 0, At, B0); G8_BAR; G8_SCHED;
    G8_STAGE(G8_SB(0, 1), bbase, ob[1], t + 2);
    G8_WV(6); G8_BAR; G8_MMA(1, 1, At, B1); G8_BAR;
    G8_LDB(B0, 1, 0); G8_SCHED; G8_LDA(At, 1, 0); G8_STAGE(G8_SA(0, 1), abase, oa[1], t + 2);
    G8_WL(8); G8_BAR; G8_WL(0); G8_MMA(0, 0, At, B0); G8_BAR; G8_SCHED;
    G8_LDB(B1, 1, 1); G8_STAGE(G8_SB(1, 0), bbase, ob[0], t + 3);
    G8_BAR; G8_WL(0); G8_MMA(0, 1, At, B1); G8_BAR;
    G8_LDA(At, 1, 1); G8_STAGE(G8_SA(1, 0), abase, oa[0], t + 3);
    G8_BAR; G8_WL(0); G8_MMA(1, 0, At, B0); G8_BAR; G8_SCHED;
    G8_STAGE(G8_SB(1, 1), bbase, ob[1], t + 3);
    G8_WV(6); G8_BAR; G8_MMA(1, 1, At, B1); G8_BAR;
  }
  { G8_LDB(B0, 0, 0); G8_LDA(At, 0, 0); G8_STAGE(G8_SA(1, 1), abase, oa[1], nt - 1);
    G8_BAR; G8_WL(0); G8_MMA(0, 0, At, B0); G8_BAR;
    G8_LDB(B1, 0, 1); G8_BAR; G8_WL(0); G8_MMA(0, 1, At, B1); G8_BAR;
    G8_LDA(At, 0, 1); G8_WV(4); G8_BAR; G8_WL(0); G8_MMA(1, 0, At, B0); G8_MMA(1, 1, At, B1); G8_BAR; }
  { G8_LDB(B0, 1, 0); G8_LDA(At, 1, 0); G8_WV(2); G8_BAR; G8_WL(0); G8_MMA(0, 0, At, B0); G8_BAR;
    G8_LDB(B1, 1, 1); G8_WV(0); G8_BAR; G8_WL(0); G8_MMA(0, 1, At, B1); G8_BAR;
    G8_LDA(At, 1, 1); G8_BAR; G8_WL(0); G8_MMA(1, 0, At, B0); G8_MMA(1, 1, At, B1); G8_BAR; }
  if (wr == 0) G8_BAR;
#undef G8_SA
#undef G8_SB
#undef G8_STAGE
#undef G8_LDA
#undef G8_LDB
#undef G8_MMA
#undef G8_WV
#undef G8_WL
#undef G8_BAR
#undef G8_SCHED
  epi(acc, m0 + wr * 128, n0 + wc * 64, fq, fr);
  __syncthreads();
}

struct ARowLinear { const bf16* A; int K; int m0; __device__ __forceinline__ const bf16* operator()(int r) const { return A + (size_t)(m0 + r) * K; } };

template <int MT, int NT>
struct EpiInProj {
  const float* rowss; const float* biasp; const float* qg; const float* kg; const float* rope  ; bf16* Z;
  __device__ __forceinline__ void operator()(f32x4 (&acc)[MT][NT], int mw, int nw, int g, int li) const {
    int b, seg, tokbase; bool latent;
    if (mw < NLAT) { b = mw >> 13; seg = b; tokbase = (mw & 8191); latent = true; }
    else { const int mc = mw - NLAT; b = mc >> 8; seg = 2; tokbase = NSEQ + (mc & 255); latent = false; }
    const int s = nw >> 6, coff = nw & 63;
    bf16* zb = Z + ((size_t)(b * NSLOT + s) * NT_TOK) * 64 + coff;
    float rss[MT];
#pragma unroll
    for (int mt = 0; mt < MT; ++mt) rss[mt] = rowss[mw + mt * 16 + li];
    f32x4 bv[NT], gvv[NT];
#pragma unroll
    for (int nt = 0; nt < NT; ++nt) bv[nt] = *(const f32x4*)(biasp + seg * INC + nw + nt * 16 + 4 * g);
    if (NT == 4 && s < 8) {
      const float* gn = (s < 6) ? qg : kg;
#pragma unroll
      for (int nt = 0; nt < NT; ++nt) gvv[nt] = *(const f32x4*)(gn + nt * 16 + 4 * g);
    } else {
#pragma unroll
      for (int nt = 0; nt < NT; ++nt) gvv[nt] = (f32x4){1.f, 1.f, 1.f, 1.f};
    }
#pragma unroll
    for (int mt = 0; mt < MT; ++mt) {
      const int tok = tokbase + mt * 16 + li;
      const float irms = rsqrtf(rss[mt] * (1.f / 1024.f) + EPS);
      f32x4 v[NT];
#pragma unroll
      for (int nt = 0; nt < NT; ++nt) v[nt] = acc[mt][nt] * irms + bv[nt];
      if constexpr (NT == 4) {
        if (s < 8) {
          float ss = 0.f;
#pragma unroll
          for (int nt = 0; nt < 4; ++nt) ss += v[nt][0] * v[nt][0] + v[nt][1] * v[nt][1] + v[nt][2] * v[nt][2] + v[nt][3] * v[nt][3];
          ss += __shfl_xor(ss, 16); ss += __shfl_xor(ss, 32);
          const float r = rsqrtf(ss * (1.f / 64.f) + EPS) * (s < 6 ? QSCALE : 1.f);
#pragma unroll
          for (int nt = 0; nt < 4; ++nt) v[nt] = v[nt] * r * gvv[nt];
          if (latent) {
            const int pr = tok >> 6, pc = tok & 63;
            const f32x4 r0 = *(const f32x4*)(rope + (pr * 16 + 4 * g) * 2), r1 = *(const f32x4*)(rope + (pr * 16 + 4 * g) * 2 + 4);
            const f32x4 c0 = *(const f32x4*)(rope + (pc * 16 + 4 * g) * 2), c1 = *(const f32x4*)(rope + (pc * 16 + 4 * g) * 2 + 4);
            const float cr_[4] = {r0[0], r0[2], r1[0], r1[2]}, sr_[4] = {r0[1], r0[3], r1[1], r1[3]};
            const float cc_[4] = {c0[0], c0[2], c1[0], c1[2]}, sc_[4] = {c0[1], c0[3], c1[1], c1[3]};
#pragma unroll
            for (int j = 0; j < 4; ++j) {
              const float t1 = v[0][j], t2 = v[1][j]; v[0][j] = t1 * cr_[j] - t2 * sr_[j]; v[1][j] = t2 * cr_[j] + t1 * sr_[j];
              const float u1 = v[2][j], u2 = v[3][j]; v[2][j] = u1 * cc_[j] - u2 * sc_[j]; v[3][j] = u2 * cc_[j] + u1 * sc_[j];
            }
          }
        }
      }
      if (s >= S_NQ && s < S_NK) {
#pragma unroll
        for (int nt = 0; nt < NT; ++nt) v[nt] = v[nt] * QSCALE;
      } else if (s >= S_RK && s < S_RV) {
#pragma unroll
        for (int nt = 0; nt < NT; ++nt) v[nt] = v[nt] * 0.125f;
      } else if (s >= S_RG) {
#pragma unroll
        for (int nt = 0; nt < NT; ++nt)
#pragma unroll
          for (int j = 0; j < 4; ++j) v[nt][j] = silu_f(v[nt][j]);
      }
#pragma unroll
      for (int nt = 0; nt < NT; ++nt) { u32x2 o; o.x = pk2(v[nt][0], v[nt][1]); o.y = pk2(v[nt][2], v[nt][3]); *(u32x2*)(zb + (size_t)tok * 64 + nt * 16 + 4 * g) = o; }
    }
  }
};

struct EpiOutProj {
  const float* xlat; const float* xctx; const float* mod; float* XR;
  __device__ __forceinline__ void operator()(f32x4 (&acc)[8][4], int mw, int nw, int g, int li) const {
    const int seg = (mw < NLAT) ? (mw >> 13) : 2;
    const float* gt = mod + seg * 6144 + 2048;
    f32x4 gv[4];
#pragma unroll
    for (int nt = 0; nt < 4; ++nt) gv[nt] = *(const f32x4*)(gt + nw + nt * 16 + 4 * g);
    const float* xbase = (mw < NLAT) ? (xlat + (size_t)mw * D) : (xctx + (size_t)(mw - NLAT) * D);
#pragma unroll
    for (int mb = 0; mb < 8; mb += 2) {
      f32x4 xv[2][4];
#pragma unroll
      for (int u = 0; u < 2; ++u)
#pragma unroll
        for (int nt = 0; nt < 4; ++nt) xv[u][nt] = __builtin_nontemporal_load((const f32x4*)(xbase + (size_t)((mb + u) * 16 + li) * D + nw + nt * 16 + 4 * g));
#pragma unroll
      for (int u = 0; u < 2; ++u)
#pragma unroll
        for (int nt = 0; nt < 4; ++nt) *(f32x4*)(XR + (size_t)(mw + (mb + u) * 16 + li) * D + nw + nt * 16 + 4 * g) = xv[u][nt] + gv[nt] * acc[mb + u][nt];
    }
  }
};

template <int MT> struct EpiMoeUpT {
  bf16* act; int slot0; int nvalid;
  __device__ __forceinline__ void operator()(f32x4 (&acc)[MT][4], int mw, int nw, int g, int li) const {
#pragma unroll
    for (int mt = 0; mt < MT; ++mt) {
      const int r = mw + mt * 16 + li;
      if (r < nvalid) {
#pragma unroll
        for (int u = 0; u < 2; ++u) {
          const int hid = (nw >> 1) + u * 16 + 4 * g;
          const f32x4 a1 = acc[mt][2 * u], a3 = acc[mt][2 * u + 1];
          u32x2 o; o.x = pk2(silu_f(a1[0]) * a3[0], silu_f(a1[1]) * a3[1]); o.y = pk2(silu_f(a1[2]) * a3[2], silu_f(a1[3]) * a3[3]);
          *(u32x2*)(act + (size_t)(slot0 + r) * 512 + hid) = o;
        }
      }
    }
  }
};

template <int MT> struct EpiMoeDownT {
  const int* list; const float* gatew; bf16* ym0; bf16* ym1; int nvalid;
  __device__ __forceinline__ void operator()(f32x4 (&acc)[MT][4], int mw, int nw, int g, int li) const {
#pragma unroll
    for (int mb = 0; mb < MT; mb += 4) {
      int ent[4]; float gw[4];
#pragma unroll
      for (int mt = 0; mt < 4; ++mt) { const int r = mw + (mb + mt) * 16 + li; ent[mt] = list[r < nvalid ? r : nvalid - 1]; }
#pragma unroll
      for (int mt = 0; mt < 4; ++mt) gw[mt] = gatew[ent[mt]];
#pragma unroll
      for (int mt = 0; mt < 4; ++mt) {
        const int r = mw + (mb + mt) * 16 + li;
        if (r < nvalid) {
          bf16* y = ((ent[mt] & 1) ? ym1 : ym0) + (size_t)(ent[mt] >> 1) * D;
#pragma unroll
          for (int nt = 0; nt < 4; ++nt) {
            const int n = nw + nt * 16 + 4 * g;
            u32x2 o; o.x = pk2(acc[mb + mt][nt][0] * gw[mt], acc[mb + mt][nt][1] * gw[mt]); o.y = pk2(acc[mb + mt][nt][2] * gw[mt], acc[mb + mt][nt][3] * gw[mt]);
            *(u32x2*)(y + n) = o;
          }
        }
      }
    }
  }
};
typedef EpiMoeUpT<4> EpiMoeUp; typedef EpiMoeDownT<4> EpiMoeDown;

template <class Src, bool GATHER = false>
__device__ __forceinline__ void gemm8_stream(unsigned char* lds, const Src& src) {
  using namespace g8;
  const int nunit = src.count();
  if (nunit <= 0) return;
  const int tid = get_tid(), lane = tid & 63, wid = __builtin_amdgcn_readfirstlane(tid >> 6), wr = wid >> 2, wc = wid & 3, fr = lane & 15, fq = lane >> 4;
  const int K = src.K(), nt = K >> 6;
  unsigned oa[2][2], noa[2][2], ob[2][2];
#pragma unroll
  for (int i = 0; i < 2; ++i) {
    int R, C; stage_rc(tid * 16 + i * 8192, R, C);
    const int ra = (R >> 6) * 128 + ((R >> 4) & 3) * 16 + (R & 15);
    const int rb = (R >> 5) * 64 + ((R >> 4) & 1) * 16 + (R & 15);
#pragma unroll
    for (int hh = 0; hh < 2; ++hh) {
      if constexpr (GATHER) oa[hh][i] = src.aoff(0, ra + hh * 64) + (unsigned)C * 2u; else oa[hh][i] = (unsigned)((ra + hh * 64) * K + C) * 2u;
      noa[hh][i] = oa[hh][i];
      ob[hh][i] = (unsigned)((rb + hh * 32) * K + C) * 2u;
    }
  }
#define G8_SA(b, h) (((b) * 2 + (h)) * HT_B)
#define G8_SB(b, h) ((4 + (b) * 2 + (h)) * HT_B)
#define G8_STAGE(bufoff, BASE, O2, kt) do { _Pragma("unroll") for (int _i = 0; _i < 2; ++_i) \
    __builtin_amdgcn_global_load_lds((const void*)((BASE) + (O2)[_i] + (unsigned)(kt) * 128u), (LAS void*)(lds + (bufoff) + wid * 1024 + _i * 8192), 16, 0, 0); } while (0)
  const int aoff = lds_byte(wr * 64 + fr, fq * 8), boff = lds_byte(wc * 32 + fr, fq * 8);
#define G8_LDA(dst, b, h) do { _Pragma("unroll") for (int m = 0; m < 4; ++m) _Pragma("unroll") for (int k = 0; k < 2; ++k) dst[m][k] = *(const bf16x8*)(lds + G8_SA(b, h) + aoff + m * 2048 + k * 1024); } while (0)
#define G8_LDB(dst, b, h) do { _Pragma("unroll") for (int n = 0; n < 2; ++n) _Pragma("unroll") for (int k = 0; k < 2; ++k) dst[n][k] = *(const bf16x8*)(lds + G8_SB(b, h) + boff + n * 2048 + k * 1024); } while (0)
#define G8_MMA(ai, bj, At_, Bt_) do { __builtin_amdgcn_s_setprio(1); _Pragma("unroll") for (int m = 0; m < 4; ++m) _Pragma("unroll") for (int n = 0; n < 2; ++n) _Pragma("unroll") for (int k = 0; k < 2; ++k) \
    acc[(ai) * 4 + m][(bj) * 2 + n] = __builtin_amdgcn_mfma_f32_16x16x32_bf16(Bt_[n][k], At_[m][k], acc[(ai) * 4 + m][(bj) * 2 + n], 0, 0, 0); __builtin_amdgcn_s_setprio(0); } while (0)
#define G8_WV(n) asm volatile("s_waitcnt vmcnt(" #n ")" ::: "memory")
#define G8_WL(n) asm volatile("s_waitcnt lgkmcnt(" #n ")" ::: "memory")
#define G8_BAR __builtin_amdgcn_s_barrier()
#define G8_SCHED __builtin_amdgcn_sched_barrier(0)
  f32x4 acc[8][4];
  bf16x8 At[4][2], B0[2][2], B1[2][2];
  const char* ab = (const char*)src.abase(0); const char* bb = (const char*)src.bbase(0);
  G8_STAGE(G8_SB(0, 0), bb, ob[0], 0); G8_STAGE(G8_SB(0, 1), bb, ob[1], 0); G8_STAGE(G8_SA(0, 0), ab, oa[0], 0); G8_STAGE(G8_SA(0, 1), ab, oa[1], 0);
  if (wr == 1) G8_BAR;
  G8_WV(2); G8_BAR;
  G8_STAGE(G8_SB(1, 0), bb, ob[0], 1); G8_STAGE(G8_SA(1, 0), ab, oa[0], 1); G8_STAGE(G8_SB(1, 1), bb, ob[1], 1);
  G8_WV(6); G8_BAR;
#pragma unroll 1
  for (int u = 0; u < nunit; ++u) {
    const bool has_next = u + 1 < nunit;
    const char* nab = has_next ? (const char*)src.abase(u + 1) : ab; const char* nbb = has_next ? (const char*)src.bbase(u + 1) : bb;
    if constexpr (GATHER) {
#pragma unroll
      for (int i = 0; i < 2; ++i)
#pragma unroll
        for (int hh = 0; hh < 2; ++hh) { int R, C; stage_rc(get_tid() * 16 + i * 8192, R, C); const int ra = (R >> 6) * 128 + ((R >> 4) & 3) * 16 + (R & 15);
          noa[hh][i] = has_next ? src.aoff(u + 1, ra + hh * 64) + (unsigned)C * 2u : oa[hh][i]; }
    }
#pragma unroll
    for (int a = 0; a < 8; ++a)
#pragma unroll
      for (int b = 0; b < 4; ++b) acc[a][b] = (f32x4){0.f, 0.f, 0.f, 0.f};
#pragma unroll 1
    for (int t = 0; t < nt; t += 2) {
      const bool lastit = (t == nt - 2);
      const char* a2 = lastit ? nab : ab; const char* b2 = lastit ? nbb : bb;
      const int k2 = lastit ? 0 : t + 2, k3 = lastit ? 1 : t + 3;
      unsigned oa2[2][2];
#pragma unroll
      for (int i = 0; i < 2; ++i)
#pragma unroll
        for (int hh = 0; hh < 2; ++hh) oa2[hh][i] = (GATHER && lastit) ? noa[hh][i] : oa[hh][i];
      G8_LDB(B0, 0, 0); G8_LDB(B1, 0, 1); G8_SCHED; G8_LDA(At, 0, 0); G8_STAGE(G8_SA(1, 1), ab, oa[1], t + 1);
      G8_WV(8); G8_WL(0); G8_BAR; G8_MMA(0, 0, At, B0); G8_MMA(0, 1, At, B1); G8_BAR; G8_SCHED;
      G8_LDA(At, 0, 1); G8_STAGE(G8_SB(0, 0), b2, ob[0], k2); G8_STAGE(G8_SB(0, 1), b2, ob[1], k2); G8_STAGE(G8_SA(0, 0), a2, oa2[0], k2);
      G8_WV(8); G8_WL(0); G8_BAR; G8_MMA(1, 0, At, B0); G8_MMA(1, 1, At, B1); G8_BAR; G8_SCHED;
      G8_LDB(B0, 1, 0); G8_LDB(B1, 1, 1); G8_SCHED; G8_LDA(At, 1, 0); G8_STAGE(G8_SA(0, 1), a2, oa2[1], k2);
      G8_WV(8); G8_WL(0); G8_BAR; G8_MMA(0, 0, At, B0); G8_MMA(0, 1, At, B1); G8_BAR; G8_SCHED;
      G8_LDA(At, 1, 1); G8_STAGE(G8_SB(1, 0), b2, ob[0], k3); G8_STAGE(G8_SB(1, 1), b2, ob[1], k3); G8_STAGE(G8_SA(1, 0), a2, oa2[0], k3);
      G8_WV(8); G8_WL(0); G8_BAR; G8_MMA(1, 0, At, B0); G8_MMA(1, 1, At, B1); G8_BAR; G8_SCHED;
    }
    if (wr == 0) G8_BAR;
    src.epi(u)(acc, src.mrow(u) + wr * 128, src.ncol(u) + wc * 64, fq, fr);
    if (!has_next) break;
    ab = nab; bb = nbb;
    if (GATHER) {
#pragma unroll
      for (int i = 0; i < 2; ++i)
#pragma unroll
        for (int hh = 0; hh < 2; ++hh) oa[hh][i] = noa[hh][i];
    }
    if (wr == 1) G8_BAR;
  }
  G8_WV(0);
  G8_BAR;
#undef G8_SA
#undef G8_SB
#undef G8_STAGE
#undef G8_LDA
#undef G8_LDB
#undef G8_MMA
#undef G8_WV
#undef G8_WL
#undef G8_BAR
#undef G8_SCHED
  __syncthreads();
}

struct SrcA8 {
  const bf16* XB; const bf16* Wt; const EpiInProj<8, 4>* E; int c0, G, n;
  __device__ __forceinline__ int count() const { return n; }
  __device__ __forceinline__ int K() const { return 1024; }
  __device__ __forceinline__ const bf16* abase(int j) const { const int v = j * G + c0; return XB + (size_t)((v / 11) * 256) * 1024; }
  __device__ __forceinline__ const bf16* bbase(int j) const { const int v = j * G + c0; return Wt + (size_t)((v % 11) * 256) * 1024; }
  __device__ __forceinline__ const EpiInProj<8, 4>& epi(int) const { return *E; }
  __device__ __forceinline__ int mrow(int j) const { return ((j * G + c0) / 11) * 256; }
  __device__ __forceinline__ int ncol(int j) const { return ((j * G + c0) % 11) * 256; }
};
struct SrcC8 {
  const bf16* Y; const bf16* Wt; const struct EpiOutProj* E; int c0, G, n;
  __device__ __forceinline__ int count() const { return n; }
  __device__ __forceinline__ int K() const { return 1024; }
  __device__ __forceinline__ const bf16* abase(int j) const { const int v = j * G + c0; return Y + (size_t)((v >> 2) * 256) * 1024; }
  __device__ __forceinline__ const bf16* bbase(int j) const { const int v = j * G + c0; return Wt + (size_t)((v & 3) * 256) * 1024; }
  __device__ __forceinline__ const EpiOutProj& epi(int) const { return *E; }
  __device__ __forceinline__ int mrow(int j) const { return ((j * G + c0) >> 2) * 256; }
  __device__ __forceinline__ int ncol(int j) const { return ((j * G + c0) & 3) * 256; }
};


struct MoeU { int e, row0, nvalid, nt, slot0; };
struct SrcUp8 {
  const MoeU* d; const bf16* H; const int* list; const bf16* W; bf16* act; int n;
  __device__ __forceinline__ int count() const { return n; }
  __device__ __forceinline__ int K() const { return 1024; }
  __device__ __forceinline__ const bf16* abase(int) const { return H; }
  __device__ __forceinline__ unsigned aoff(int u, int r) const { const MoeU t = d[u]; const int rr = r < t.nvalid ? r : t.nvalid - 1; return (unsigned)(list[(size_t)t.e * NROWS + t.row0 + rr] >> 1) * 2048u; }
  __device__ __forceinline__ const bf16* bbase(int u) const { const MoeU t = d[u]; return W + (size_t)t.e * 1024 * 1024 + (size_t)(t.nt * 256) * 1024; }
  __device__ __forceinline__ EpiMoeUpT<8> epi(int u) const { const MoeU t = d[u]; return EpiMoeUpT<8>{act, t.slot0, t.nvalid}; }
  __device__ __forceinline__ int mrow(int) const { return 0; }
  __device__ __forceinline__ int ncol(int u) const { return d[u].nt * 256; }
};
struct SrcDown8 {
  const MoeU* d; const bf16* act; const int* list; const bf16* W; const float* gatew; bf16* ym0; bf16* ym1; int n;
  __device__ __forceinline__ int count() const { return n; }
  __device__ __forceinline__ int K() const { return 512; }
  __device__ __forceinline__ const bf16* abase(int u) const { return act + (size_t)d[u].slot0 * 512; }
  __device__ __forceinline__ const bf16* bbase(int u) const { const MoeU t = d[u]; return W + (size_t)t.e * 1024 * 512 + (size_t)(t.nt * 256) * 512; }
  __device__ __forceinline__ EpiMoeDownT<8> epi(int u) const { const MoeU t = d[u]; return EpiMoeDownT<8>{list + (size_t)t.e * NROWS + t.row0, gatew, ym0, ym1, t.nvalid}; }
  __device__ __forceinline__ int mrow(int) const { return 0; }
  __device__ __forceinline__ int ncol(int u) const { return d[u].nt * 256; }
};

struct ARowGather { const bf16* H; const int* list; int nvalid; __device__ __forceinline__ const bf16* operator()(int r) const { const int rr = r < nvalid ? r : nvalid - 1; return H + (size_t)(list[rr] >> 1) * D; } };
struct ARowAct { const bf16* act; int slot0; __device__ __forceinline__ const bf16* operator()(int r) const { int s = slot0 + r; s = s < 2 * NROWS ? s : 2 * NROWS - 1; return act + (size_t)s * 512; } };

template <int NQB, bool NAM, int NW>
__device__ __forceinline__ void attn_item(unsigned char* lds, int gb, int wl, int lane, const bf16* zb, int sq0, int sk, int sv, int qtok0, int lat0, int nlat, int ntiles,
                                          int drbase, bf16* Y, size_t yrow0, int ycol0, const float* mixg) {
  const int g = lane >> 4, li = lane & 15;
  const int qtok = qtok0 + 16 * wl + li;
  bf16x8 qf[NQB][2];
#pragma unroll
  for (int qb = 0; qb < NQB; ++qb)
#pragma unroll
    for (int kk = 0; kk < 2; ++kk) qf[qb][kk] = *(const bf16x8*)(zb + ((size_t)(sq0 + qb) * NT_TOK + qtok) * 64 + kk * 32 + g * 8);
  const bf16* kbp = zb + (size_t)sk * NT_TOK * 64;
  const bf16* vbp = zb + (size_t)sv * NT_TOK * 64;
  f32x4 O[4][NQB], L[NQB];
  const bf16x8 ones = {0x3f80, 0x3f80, 0x3f80, 0x3f80, 0x3f80, 0x3f80, 0x3f80, 0x3f80};
#pragma unroll
  for (int qb = 0; qb < NQB; ++qb) { L[qb] = (f32x4){0.f, 0.f, 0.f, 0.f};
#pragma unroll
    for (int db = 0; db < 4; ++db) O[db][qb] = (f32x4){0.f, 0.f, 0.f, 0.f}; }
  const int f = (li >> 1) & 7;
  const int koff = li * 128 + ((g ^ f) << 4);
  const int q_ = li >> 2, p_ = li & 3, fv = (2 * g + (q_ >> 1)) & 7;
  const int voff = (4 * g + q_) * 128 + (p_ & 1) * 8;
  const float* rpbt = (const float*)(lds + gb + 49152);
  const int qc = 16 * wl + li;
  int cs = qc - 8; cs = cs < 0 ? 0 : (cs > 48 ? 48 : cs);
#define AT_TOK(t) ((t) < nlat ? lat0 + 64 * (t) : NSEQ + 64 * ((t) - nlat))
#define AT_STAGE(t, bi) do { const int tk_ = AT_TOK(t); stage_rows<64, NW>(lds, gb + (bi) * 16384, kbp + (size_t)tk_ * 64, 64, wl, lane); \
                             stage_rows<64, NW>(lds, gb + (bi) * 16384 + 8192, vbp + (size_t)tk_ * 64, 64, wl, lane); } while (0)
#define AT_WAIT1() do { if (NW == 8) VMCNT(2); else VMCNT(4); } while (0)
  AT_STAGE(0, 0);
  if (ntiles > 1) { AT_STAGE(1, 1); AT_WAIT1(); } else { VMCNT(0); }
  RAW_BAR();
  int cur = 0;
  for (int t = 0; t < ntiles; ++t) {
    const int kb_off = gb + cur * 16384, vb_off = kb_off + 8192;
    const int pfb = cur == 0 ? 2 : cur - 1;
    if (t + 2 < ntiles) AT_STAGE(t + 2, pfb);
#pragma unroll
    for (int ks = 0; ks < 2; ++ks) {
      f32x4 s[2][NQB];
#pragma unroll
      for (int h2 = 0; h2 < 2; ++h2) {
#pragma unroll
        for (int qb = 0; qb < NQB; ++qb) s[h2][qb] = (f32x4){0.f, 0.f, 0.f, 0.f};
#pragma unroll
        for (int kk = 0; kk < 2; ++kk) {
          const bf16x8 kf = lds_frag(lds, kb_off + (((2 * ks + h2) * 2048 + koff) ^ (kk << 6)));
#pragma unroll
          for (int qb = 0; qb < NQB; ++qb) s[h2][qb] = __builtin_amdgcn_mfma_f32_16x16x32_bf16(kf, qf[qb][kk], s[h2][qb], 0, 0, 0);
        }
      }
      bf16x8 pf[NQB];
#pragma unroll
      for (int qb = 0; qb < NQB; ++qb) {
        float p[8];
#pragma unroll
        for (int h2 = 0; h2 < 2; ++h2)
#pragma unroll
          for (int j = 0; j < 4; ++j) {
            float x = s[h2][qb][j];
            if (NAM) {
              if (t < nlat) {
                const int kc = (2 * ks + h2) * 16 + 4 * g + j;
                const bool valid = (kc >= cs) && (kc < cs + 16);
                int dc = kc - qc + 15; dc = dc < 0 ? 0 : (dc > 30 ? 30 : dc);
                x += rpbt[(drbase + t) * 31 + dc];
                x = valid ? x : -1e30f;
              }
            }
            const float e = __builtin_amdgcn_exp2f(x);
            p[h2 * 4 + j] = e;
          }
        u32x4 pw; pw.x = pk2(p[0], p[1]); pw.y = pk2(p[2], p[3]); pw.z = pk2(p[4], p[5]); pw.w = pk2(p[6], p[7]);
        pf[qb] = __builtin_bit_cast(bf16x8, pw);
        L[qb] = __builtin_amdgcn_mfma_f32_16x16x32_bf16(ones, pf[qb], L[qb], 0, 0, 0);
      }
#pragma unroll
      for (int db = 0; db < 4; ++db) {
        const int a0 = vb_off + ks * 4096 + voff + (((db * 2 + (p_ >> 1)) ^ fv) << 4);
        const bf16x8 vf = lds_tr2(lds, a0, a0 + 2048);
#pragma unroll
        for (int qb = 0; qb < NQB; ++qb) O[db][qb] = __builtin_amdgcn_mfma_f32_16x16x32_bf16(vf, pf[qb], O[db][qb], 0, 0, 0);
      }
    }
    if (t + 2 < ntiles) { AT_WAIT1(); } else { VMCNT(0); }
    LGKM0(); RAW_BAR();
    cur = cur == 2 ? 0 : cur + 1;
  }
#undef AT_TOK
#undef AT_STAGE
#undef AT_WAIT1
#pragma unroll
  for (int qb = 0; qb < NQB; ++qb) {
    const float inv = 1.f / L[qb][0];
    float ss = 0.f;
#pragma unroll
    for (int db = 0; db < 4; ++db) { O[db][qb] = O[db][qb] * inv; ss += O[db][qb][0] * O[db][qb][0] + O[db][qb][1] * O[db][qb][1] + O[db][qb][2] * O[db][qb][2] + O[db][qb][3] * O[db][qb][3]; }
    ss += __shfl_xor(ss, 16); ss += __shfl_xor(ss, 32);
    const float r = rsqrtf(ss * (1.f / 64.f) + EPS);
    bf16* yp = Y + (yrow0 + 16 * wl + li) * D + ycol0 + qb * 64;
#pragma unroll
    for (int db = 0; db < 4; ++db) {
      const f32x4 gv = *(const f32x4*)(mixg + ycol0 + qb * 64 + db * 16 + 4 * g);
      const f32x4 y = O[db][qb] * r * gv;
      u32x2 o; o.x = pk2(y[0], y[1]); o.y = pk2(y[2], y[3]);
      *(u32x2*)(yp + db * 16 + 4 * g) = o;
    }
  }
}

__device__ __forceinline__ void ret_u_item(unsigned char* lds, int gb, int tg, const bf16* zb, int h, int c, float lgf2, float lgb2, float* Uf, float* Ub) {
  const int lane = tg & 63, w = __builtin_amdgcn_readfirstlane(tg >> 6), g = lane >> 4, li = lane & 15;
  const int tok0 = c < 2 ? NSEQ + 128 * c : 128 * (c - 2);
  const bf16* kp = zb + ((size_t)(S_RK + h) * NT_TOK + tok0) * 64;
  const bf16* vp = zb + ((size_t)(S_RV + h) * NT_TOK + tok0) * 64;
  stage_rows<128, 4>(lds, gb, kp, 64, w, lane);
  {
    const int row = tg >> 1, half = tg & 1;
    const float wf = __builtin_amdgcn_exp2f(lgf2 * (float)(127 - row)), wb = __builtin_amdgcn_exp2f(lgb2 * (float)row);
#pragma unroll
    for (int c4 = 0; c4 < 4; ++c4) {
      const int chunk = half * 4 + c4;
      const u32x4 v = *(const u32x4*)(vp + (size_t)row * 64 + chunk * 8);
      u32x4 of, ob;
#pragma unroll
      for (int i = 0; i < 4; ++i) { const float lo = bflo(v[i]), hi = bfhi(v[i]); of[i] = pk2(lo * wf, hi * wf); ob[i] = pk2(lo * wb, hi * wb); }
      *(u32x4*)(lds + gb + 16384 + lds_swz(row, chunk)) = of;
      *(u32x4*)(lds + gb + 32768 + lds_swz(row, chunk)) = ob;
    }
  }
  VM_WAIT(); __syncthreads();
  const int q_ = li >> 2, p_ = li & 3, fv = (2 * g + (q_ >> 1)) & 7;
  const int toff = gb + (4 * g + q_) * 128 + (p_ & 1) * 8;
  f32x4 acc[2][4];
#pragma unroll
  for (int d_ = 0; d_ < 2; ++d_)
#pragma unroll
    for (int eb = 0; eb < 4; ++eb) acc[d_][eb] = (f32x4){0.f, 0.f, 0.f, 0.f};
#pragma unroll
  for (int ks = 0; ks < 4; ++ks) {
    const int a0 = ks * 4096 + toff + (((w * 2 + (p_ >> 1)) ^ fv) << 4);
    const bf16x8 kf = lds_tr2(lds, a0, a0 + 2048);
#pragma unroll
    for (int eb = 0; eb < 4; ++eb) {
      const int b0 = ks * 4096 + toff + (((eb * 2 + (p_ >> 1)) ^ fv) << 4);
      const bf16x8 vf = lds_tr2(lds, 16384 + b0, 16384 + b0 + 2048);
      const bf16x8 vb = lds_tr2(lds, 32768 + b0, 32768 + b0 + 2048);
      acc[0][eb] = __builtin_amdgcn_mfma_f32_16x16x32_bf16(kf, vf, acc[0][eb], 0, 0, 0);
      acc[1][eb] = __builtin_amdgcn_mfma_f32_16x16x32_bf16(kf, vb, acc[1][eb], 0, 0, 0);
    }
  }
#pragma unroll
  for (int eb = 0; eb < 4; ++eb) {
    *(f32x4*)(Uf + (eb * 16 + li) * 64 + w * 16 + 4 * g) = acc[0][eb];
    *(f32x4*)(Ub + (eb * 16 + li) * 64 + w * 16 + 4 * g) = acc[1][eb];
  }
  __syncthreads();
}

__device__ __forceinline__ void ret_out_item(unsigned char* lds, int gb, int tg, const bf16* zb, int h, int c, float lgf2, float lgb2, const float* Sf, const float* Sb,
                                             bf16* Y, size_t yrow0, const float* mixg) {
  const int lane = tg & 63, w = __builtin_amdgcn_readfirstlane(tg >> 6), g = lane >> 4, li = lane & 15;
  const int tok0 = c < 2 ? NSEQ + 128 * c : 128 * (c - 2);
  const bf16* qp = zb + ((size_t)(S_RQ + h) * NT_TOK + tok0) * 64;
  const bf16* kp = zb + ((size_t)(S_RK + h) * NT_TOK + tok0) * 64;
  const bf16* vp = zb + ((size_t)(S_RV + h) * NT_TOK + tok0) * 64;
  const bf16* gp = zb + ((size_t)(S_RG + h) * NT_TOK + tok0) * 64;
  stage_rows<128, 4>(lds, gb, kp, 64, w, lane);
  stage_rows<128, 4>(lds, gb + 16384, vp, 64, w, lane);
  {
    const int e = tg >> 2, dq = tg & 3;
#pragma unroll
    for (int hh = 0; hh < 2; ++hh) {
      const f32x4 a0 = *(const f32x4*)(Sf + e * 64 + dq * 16 + hh * 8), a1 = *(const f32x4*)(Sf + e * 64 + dq * 16 + hh * 8 + 4);
      const f32x4 b0 = *(const f32x4*)(Sb + e * 64 + dq * 16 + hh * 8), b1 = *(const f32x4*)(Sb + e * 64 + dq * 16 + hh * 8 + 4);
      u32x4 oa, ob; oa.x = pk2(a0[0], a0[1]); oa.y = pk2(a0[2], a0[3]); oa.z = pk2(a1[0], a1[1]); oa.w = pk2(a1[2], a1[3]);
      ob.x = pk2(b0[0], b0[1]); ob.y = pk2(b0[2], b0[3]); ob.z = pk2(b1[0], b1[1]); ob.w = pk2(b1[2], b1[3]);
      *(u32x4*)(lds + gb + 32768 + lds_swz(e, dq * 2 + hh)) = oa;
      *(u32x4*)(lds + gb + 40960 + lds_swz(e, dq * 2 + hh)) = ob;
    }
  }
  bf16x8 qf[2][2];
#pragma unroll
  for (int ib = 0; ib < 2; ++ib)
#pragma unroll
    for (int kk = 0; kk < 2; ++kk) qf[ib][kk] = *(const bf16x8*)(qp + (size_t)(32 * w + 16 * ib + li) * 64 + kk * 32 + g * 8);
  VM_WAIT(); __syncthreads();
  const int f = (li >> 1) & 7;
  const int koff = gb + li * 128 + ((g ^ f) << 4);
  const int q_ = li >> 2, p_ = li & 3, fv = (2 * g + (q_ >> 1)) & 7;
  const int voff = gb + 16384 + (4 * g + q_) * 128 + (p_ & 1) * 8;
  f32x4 O[4][2], CF[4][2], CB[4][2];
#pragma unroll
  for (int eb = 0; eb < 4; ++eb)
#pragma unroll
    for (int ib = 0; ib < 2; ++ib) { O[eb][ib] = (f32x4){0.f, 0.f, 0.f, 0.f}; CF[eb][ib] = O[eb][ib]; CB[eb][ib] = O[eb][ib]; }
#pragma unroll
  for (int ks = 0; ks < 4; ++ks) {
    f32x4 s[2][2];
#pragma unroll
    for (int h2 = 0; h2 < 2; ++h2) {
      s[h2][0] = (f32x4){0.f, 0.f, 0.f, 0.f}; s[h2][1] = s[h2][0];
#pragma unroll
      for (int kk = 0; kk < 2; ++kk) {
        const bf16x8 kf = lds_frag(lds, ((2 * ks + h2) * 2048 + koff) ^ (kk << 6));
        s[h2][0] = __builtin_amdgcn_mfma_f32_16x16x32_bf16(kf, qf[0][kk], s[h2][0], 0, 0, 0);
        s[h2][1] = __builtin_amdgcn_mfma_f32_16x16x32_bf16(kf, qf[1][kk], s[h2][1], 0, 0, 0);
      }
    }
    bf16x8 pf[2];
#pragma unroll
    for (int ib = 0; ib < 2; ++ib) {
      const int i = 32 * w + 16 * ib + li;
      float p[8];
#pragma unroll
      for (int h2 = 0; h2 < 2; ++h2)
#pragma unroll
        for (int j = 0; j < 4; ++j) {
          const int jj = (2 * ks + h2) * 16 + 4 * g + j, df = i - jj;
          const float dw = df > 0 ? __builtin_amdgcn_exp2f(lgf2 * (float)df) : (df < 0 ? __builtin_amdgcn_exp2f(lgb2 * (float)(-df)) : 2.f);
          p[h2 * 4 + j] = s[h2][ib][j] * dw;
        }
      u32x4 pw; pw.x = pk2(p[0], p[1]); pw.y = pk2(p[2], p[3]); pw.z = pk2(p[4], p[5]); pw.w = pk2(p[6], p[7]);
      pf[ib] = __builtin_bit_cast(bf16x8, pw);
    }
#pragma unroll
    for (int eb = 0; eb < 4; ++eb) {
      const int a0 = voff + ks * 4096 + (((eb * 2 + (p_ >> 1)) ^ fv) << 4);
      const bf16x8 vf = lds_tr2(lds, a0, a0 + 2048);
      O[eb][0] = __builtin_amdgcn_mfma_f32_16x16x32_bf16(vf, pf[0], O[eb][0], 0, 0, 0);
      O[eb][1] = __builtin_amdgcn_mfma_f32_16x16x32_bf16(vf, pf[1], O[eb][1], 0, 0, 0);
    }
  }
#pragma unroll
  for (int kk = 0; kk < 2; ++kk)
#pragma unroll
    for (int eb = 0; eb < 4; ++eb) {
      const bf16x8 sf = lds_frag(lds, 32768 + ((eb * 2048 + koff) ^ (kk << 6)));
      const bf16x8 sb = lds_frag(lds, 40960 + ((eb * 2048 + koff) ^ (kk << 6)));
#pragma unroll
      for (int ib = 0; ib < 2; ++ib) {
        CF[eb][ib] = __builtin_amdgcn_mfma_f32_16x16x32_bf16(sf, qf[ib][kk], CF[eb][ib], 0, 0, 0);
        CB[eb][ib] = __builtin_amdgcn_mfma_f32_16x16x32_bf16(sb, qf[ib][kk], CB[eb][ib], 0, 0, 0);
      }
    }
#pragma unroll
  for (int ib = 0; ib < 2; ++ib) {
    const int i = 32 * w + 16 * ib + li;
    const float xf = __builtin_amdgcn_exp2f(lgf2 * (float)(i + 1)), xb = __builtin_amdgcn_exp2f(lgb2 * (float)(128 - i));
    float ss = 0.f;
#pragma unroll
    for (int eb = 0; eb < 4; ++eb) { O[eb][ib] = O[eb][ib] + CF[eb][ib] * xf + CB[eb][ib] * xb; ss += O[eb][ib][0] * O[eb][ib][0] + O[eb][ib][1] * O[eb][ib][1] + O[eb][ib][2] * O[eb][ib][2] + O[eb][ib][3] * O[eb][ib][3]; }
    ss += __shfl_xor(ss, 16); ss += __shfl_xor(ss, 32);
    const float r = rsqrtf(ss * (1.f / 64.f) + EPS);
    bf16* yp = Y + (yrow0 + i) * D + 640 + h * 64;
#pragma unroll
    for (int eb = 0; eb < 4; ++eb) {
      const f32x4 gv = *(const f32x4*)(mixg + 640 + h * 64 + eb * 16 + 4 * g);
      const u32x2 gg = *(const u32x2*)(gp + (size_t)i * 64 + eb * 16 + 4 * g);
      const f32x4 y = O[eb][ib] * r * gv;
      u32x2 o; o.x = pk2(y[0] * bflo(gg.x), y[1] * bfhi(gg.x)); o.y = pk2(y[2] * bflo(gg.y), y[3] * bfhi(gg.y));
      *(u32x2*)(yp + eb * 16 + 4 * g) = o;
    }
  }
  __syncthreads();
}

__device__ __forceinline__ float log_sigmoid_f(float x) { return x >= 0.f ? -log1pf(expf(-x)) : x - log1pf(expf(x)); }

__device__ __forceinline__ void p0_mod_item(unsigned char* lds, const Params& P, int item) {
  const int l = item / 96, chunk = item % 96, tid = get_tid(), ks = tid >> 4, cg4 = tid & 15;
  float* red = (float*)lds;
  float* sil = (float*)(lds + 32768);
#pragma unroll
  for (int i = 0; i < 2; ++i) { const int k = tid + 512 * i; sil[k] = silu_f(P.c[k]); sil[1024 + k] = silu_f(P.c[1024 + k]); sil[2048 + k] = silu_f(P.c_ctx[k]); }
  __syncthreads();
  const float* wa = P.w_ada + (size_t)l * 1024 * 6144 + chunk * 64 + cg4 * 4;
  f32x4 a0 = {0.f, 0.f, 0.f, 0.f}, a1 = a0, a2 = a0;
#pragma unroll 16
  for (int i = 0; i < 32; ++i) {
    const int k = ks * 32 + i;
    const f32x4 wv = __builtin_nontemporal_load((const f32x4*)(wa + (size_t)k * 6144));
    a0 += wv * sil[k]; a1 += wv * sil[1024 + k]; a2 += wv * sil[2048 + k];
  }
  *(f32x4*)(red + (ks * 3 + 0) * 64 + cg4 * 4) = a0; *(f32x4*)(red + (ks * 3 + 1) * 64 + cg4 * 4) = a1; *(f32x4*)(red + (ks * 3 + 2) * 64 + cg4 * 4) = a2;
  __syncthreads();
  if (tid < 192) {
    const int seg = tid >> 6, col = tid & 63; float s = P.b_ada[l * 6144 + chunk * 64 + col];
#pragma unroll
    for (int k2 = 0; k2 < 32; ++k2) s += red[(k2 * 3 + seg) * 64 + col];
    ((float*)(P.ws + WS_MOD))[(l * 3 + seg) * 6144 + chunk * 64 + col] = s;
  }
  __syncthreads();
}

__device__ __forceinline__ void p0_tr_item(unsigned char* lds, const float* src, int srcN, int k0, int n0, bf16* dst, int dstK, int mode) {
  float* tile = (float*)lds;
  const int tid = get_tid();
  f32x4 v[8];
#pragma unroll
  for (int ps = 0; ps < 8; ++ps) v[ps] = __builtin_nontemporal_load((const f32x4*)(src + (size_t)(k0 + (tid >> 5) + 16 * ps) * srcN + n0 + (tid & 31) * 4));
#pragma unroll
  for (int ps = 0; ps < 8; ++ps) { float* tp = tile + ((tid >> 5) + 16 * ps) * 129 + (tid & 31) * 4; tp[0] = v[ps][0]; tp[1] = v[ps][1]; tp[2] = v[ps][2]; tp[3] = v[ps][3]; }
  __syncthreads();
  const int n = tid >> 2, kc = tid & 3, ncol = n0 + n;
  int row = ncol;
  if (mode) row = (ncol >> 4) * 32 + (ncol & 15) + (mode == 2 ? 16 : 0);
  bf16* dp = dst + (size_t)row * dstK + k0 + kc * 32;
  const float* tp = tile + (kc * 32) * 129 + n;
#pragma unroll
  for (int q = 0; q < 4; ++q) {
    u32x4 o;
#pragma unroll
    for (int i = 0; i < 4; ++i) o[i] = pk2(tp[(q * 8 + 2 * i) * 129], tp[(q * 8 + 2 * i + 1) * 129]);
    *(u32x4*)(dp + q * 8) = o;
  }
  __syncthreads();
}

constexpr int P0_MOD = 192, P0_MISC = 1, P0_WIN = 2 * 8 * 23, P0_WO = 2 * 8 * 8, P0_W1 = 32 * 32, P0_W2 = 32 * 32;
constexpr int P0_ITEMS = P0_MOD + P0_MISC + P0_WIN + P0_WO + 2 * P0_W1 + P0_W2;

__device__ __forceinline__ void phase0(unsigned char* lds, const Params& P) {
#pragma unroll 1
  for (int it = blockIdx.x; it < P0_ITEMS; it += gridDim.x) {
    int r = it;
    if (r < P0_MOD) { p0_mod_item(lds, P, r); continue; } r -= P0_MOD;
    if (r < P0_MISC) {
      const int tid = get_tid();
      float* rope = (float*)(P.ws + WS_ROPE);
      for (int e = tid; e < 2048; e += NTHR) { const int pos = e >> 4, f = e & 15; const float inv = powf(10000.f, -(float)f / 16.f); const float ang = (float)pos * inv; rope[e * 2] = cosf(ang); rope[e * 2 + 1] = sinf(ang); }
      continue;
    } r -= P0_MISC;
    const float* src; int srcN, k0, n0, dstK, mode; bf16* dst;
    if (r < P0_WIN) { const int l = r / 184, q = r % 184, kt = q / 23, nt = q % 23;
      src = P.w_in + (size_t)l * 1024 * INC; srcN = INC; k0 = kt * 128; n0 = nt * 128; dst = (bf16*)(P.ws + WS_WIN) + (size_t)l * INC * 1024; dstK = 1024; mode = 0; }
    else if (r < P0_WIN + P0_WO) { const int r2 = r - P0_WIN, l = r2 / 64, q = r2 % 64, kt = q / 8, nt = q % 8;
      src = P.w_out + (size_t)l * 1024 * 1024; srcN = 1024; k0 = kt * 128; n0 = nt * 128; dst = (bf16*)(P.ws + WS_WO) + (size_t)l * 1024 * 1024; dstK = 1024; mode = 0; }
    else if (r < P0_WIN + P0_WO + 2 * P0_W1) { const int r2 = r - P0_WIN - P0_WO, which = r2 / P0_W1, q2 = r2 % P0_W1, le = q2 / 32, q = q2 % 32, kt = q / 4, nt = q % 4;
      src = (which ? P.w3 : P.w1) + (size_t)le * 1024 * 512; srcN = 512; k0 = kt * 128; n0 = nt * 128; dst = (bf16*)(P.ws + WS_W13) + (size_t)le * 1024 * 1024; dstK = 1024; mode = which ? 2 : 1; }
    else { const int r2 = r - P0_WIN - P0_WO - 2 * P0_W1, le = r2 / 32, q = r2 % 32, kt = q / 8, nt = q % 8;
      src = P.w2 + (size_t)le * 512 * 1024; srcN = 1024; k0 = kt * 128; n0 = nt * 128; dst = (bf16*)(P.ws + WS_W2) + (size_t)le * 1024 * 512; dstK = 512; mode = 0; }
    p0_tr_item(lds, src, srcN, k0, n0, dst, dstK, mode);
  }
}

constexpr int P1_XB = NROWS / 16, P1_BIAS = 2 * INC / 8, P1_WR = 6, P1_ITEMS = P1_XB + P1_BIAS + P1_WR;
__device__ __forceinline__ void phase1(unsigned char* lds, const Params& P) {
  const int tid = get_tid(), lane = tid & 63, w = tid >> 6;
  const float* mod = (const float*)(P.ws + WS_MOD);
#pragma unroll 1
  for (int it = blockIdx.x; it < P1_ITEMS; it += gridDim.x) {
    int r = it;
    if (r < P1_XB) {
      f32x4 v[2][4];
#pragma unroll
      for (int u = 0; u < 2; ++u) { const int row = r * 16 + 2 * w + u; const float* xr = row < NLAT ? P.x + (size_t)row * D : P.ctx + (size_t)(row - NLAT) * D;
#pragma unroll
        for (int j = 0; j < 4; ++j) v[u][j] = __builtin_nontemporal_load((const f32x4*)(xr + 4 * lane + 256 * j)); }
      const int row0 = r * 16 + 2 * w, seg = row0 < NSEQ ? 0 : (row0 < NLAT ? 1 : 2);
      const float* sc1 = mod + (0 * 3 + seg) * 6144 + 1024;
      f32x4 gs[4];
#pragma unroll
      for (int j = 0; j < 4; ++j) { const int k = 4 * lane + 256 * j; gs[j] = *(const f32x4*)(P.n1g + k) * (*(const f32x4*)(sc1 + k) + 1.f); }
#pragma unroll
      for (int u = 0; u < 2; ++u) {
        const int row = row0 + u; bf16* xb = (bf16*)(P.ws + WS_R1) + (size_t)row * D; float ss = 0.f;
#pragma unroll
        for (int j = 0; j < 4; ++j) { const f32x4 x = v[u][j]; ss += x[0] * x[0] + x[1] * x[1] + x[2] * x[2] + x[3] * x[3]; const f32x4 o = x * gs[j]; u32x2 ov; ov.x = pk2(o[0], o[1]); ov.y = pk2(o[2], o[3]); *(u32x2*)(xb + 4 * lane + 256 * j) = ov; }
        ss = wsum(ss);
        if (lane == 0) ((float*)(P.ws + WS_RSS))[row] = ss;
      }
      continue;
    } r -= P1_XB;
    if (r < P1_BIAS) {
      const int idx = r * 8 + w, l = idx / INC, n = idx % INC;
      const bf16* wrow = (const bf16*)(P.ws + WS_WIN) + ((size_t)l * INC + n) * 1024 + lane * 16;
      const u32x4 w0 = *(const u32x4*)wrow, w1 = *(const u32x4*)(wrow + 8);
      float wv[16];
#pragma unroll
      for (int i = 0; i < 4; ++i) { wv[2 * i] = bflo(w0[i]); wv[2 * i + 1] = bfhi(w0[i]); wv[8 + 2 * i] = bflo(w1[i]); wv[8 + 2 * i + 1] = bfhi(w1[i]); }
#pragma unroll
      for (int seg = 0; seg < 3; ++seg) {
        const float* sh = mod + (l * 3 + seg) * 6144 + lane * 16; float a = 0.f;
#pragma unroll
        for (int i = 0; i < 16; ++i) a += wv[i] * sh[i];
        a = wsum(a);
        if (lane == 0) ((float*)(P.ws + WS_BIAS))[(l * 3 + seg) * INC + n] = a;
      }
      continue;
    } r -= P1_BIAS;
    { const int l = r / 3, seg = r % 3;
      const float* m = mod + (l * 3 + seg) * 6144;
      float* wr = (float*)(P.ws + WS_WR) + (size_t)(l * 3 + seg) * 16384;
      for (int e = tid; e < 16384; e += NTHR) { const int k = e >> 4; wr[e] = P.n2g[l * 1024 + k] * (1.f + m[4096 + k]) * P.w_router[e]; }
      const int ex = tid & 15, ks = tid >> 4; float a = 0.f;
      for (int i = 0; i < 32; ++i) { const int k = ks * 32 + i; a += m[3072 + k] * P.w_router[k * 16 + ex]; }
      float* red = (float*)lds; red[ks * 16 + ex] = a; __syncthreads();
      if (tid < 16) { float s = P.b_router[tid]; for (int k2 = 0; k2 < 32; ++k2) s += red[k2 * 16 + tid]; ((float*)(P.ws + WS_CR))[(l * 3 + seg) * 16 + tid] = s; }
      __syncthreads();
    }
  }
}

__device__ __forceinline__ int xcd_vidx(int round) {
  const int G = gridDim.x, b = blockIdx.x;
  return (G & 7) == 0 ? round * G + (b & 7) * (G >> 3) + (b >> 3) : round * G + b;
}

__device__ __forceinline__ void phaseA(unsigned char* lds, const Params& P, int l) {
  const bf16* XB = (const bf16*)(P.ws + WS_R1);
  const bf16* Wt = (const bf16*)(P.ws + WS_WIN) + (size_t)l * INC * 1024;
  { const int tid = get_tid(); const f32x4* s4 = (const f32x4*)(P.ws + WS_ROPE); f32x4* d4 = (f32x4*)(lds + LDS_MISC);
    for (int e = tid; e < 1024; e += NTHR) d4[e] = s4[e];
    __syncthreads(); }
  const float* ropel = (const float*)(lds + LDS_MISC);
  EpiInProj<8, 4> E4{(const float*)(P.ws + WS_RSS), (const float*)(P.ws + WS_BIAS) + l * 3 * INC, P.qg + l * 64, P.kg + l * 64, ropel, (bf16*)(P.ws + WS_Z)};
  EpiInProj<8, 2> E2{(const float*)(P.ws + WS_RSS), (const float*)(P.ws + WS_BIAS) + l * 3 * INC, P.qg + l * 64, P.kg + l * 64, ropel, (bf16*)(P.ws + WS_Z)};
  constexpr int NFULL = 66 * 11, NITEM = NFULL + 33;
  const int c0 = xcd_vidx(0), G = gridDim.x;
  const int nfull = c0 < NFULL ? (NFULL - c0 + G - 1) / G : 0;
  { SrcA8 S{XB, Wt, &E4, c0, G, nfull};
    gemm8_stream(lds, S); }
#pragma unroll 1
  for (int v = c0 + nfull * G; v < NITEM; v += G) {
    if (v < NFULL) continue;
    const int m2 = (v - NFULL) * 2;
#pragma unroll 1
    for (int h = 0; h < 2; ++h) { ARowLinear ar{XB, 1024, (m2 + h) * 256}; gemm_tile<8, 2>(lds, ar, Wt, 1024, (m2 + h) * 256, 2816, E2); }
  }
}

__device__ __forceinline__ void phaseB(unsigned char* lds, const Params& P, int l) {
  const bool ctxout = (l == 0);
  const bf16* Z = (const bf16*)(P.ws + WS_Z);
  bf16* Y = (bf16*)P.out;
  const float* mixg = P.mix_g + l * 1024;
  const int tid = get_tid(), lane = tid & 63, w = __builtin_amdgcn_readfirstlane(tid >> 6), grp = w >> 2, wl4 = w & 3, tg = tid & 255, G = gridDim.x;
  { const int n = 256 + (ctxout ? 8 : 0);
#pragma unroll 1
    for (int r = blockIdx.x; r < n; r += G) {
      int b, kvh, qtok0, nlat, ntiles; size_t yrow0;
      if (r < 256) { b = r >> 7; kvh = (r >> 6) & 1; const int qt = r & 63; qtok0 = qt * 128; nlat = 128; ntiles = 132; yrow0 = (size_t)b * NSEQ + qt * 128; }
      else { const int q = r - 256; b = q >> 2; kvh = (q >> 1) & 1; const int qt = q & 1; qtok0 = NSEQ + qt * 128; nlat = 0; ntiles = 4; yrow0 = (size_t)NLAT + b * CL + qt * 128; }
      attn_item<3, false, 8>(lds, 0, w, lane, Z + (size_t)b * NSLOT * NT_TOK * 64, S_AQ + kvh * 3, S_AK + kvh, S_AV + kvh, qtok0, 0, nlat, ntiles, 0, Y, yrow0, kvh * 192, mixg);
    }
  }
  { const int n = 1024 + (ctxout ? 32 : 0);
    int start = (int)blockIdx.x - 8; if (start < 0) start += G;
#pragma unroll 1
    for (int pr = start; pr * 2 < n; pr += G) {
      const int r = pr * 2 + grp;
      int b, h, qtok0, lat0, nlat, ntiles, drbase; size_t yrow0;
      if (r < 1024) { b = r >> 9; h = (r >> 7) & 3; const int row = r & 127; int rs = row - 4; rs = rs < 0 ? 0 : (rs > 120 ? 120 : rs);
        qtok0 = row * 64; lat0 = rs * 64; nlat = 8; ntiles = 12; drbase = rs - row + 7; yrow0 = (size_t)b * NSEQ + row * 64; }
      else { const int q = r - 1024; b = q >> 4; h = (q >> 2) & 3; const int qt = q & 3; qtok0 = NSEQ + qt * 64; lat0 = 0; nlat = 0; ntiles = 4; drbase = 0; yrow0 = (size_t)NLAT + b * CL + qt * 64; }
      float* rp = (float*)(lds + grp * 65536 + 49152);
      const float* src = P.rpb + ((size_t)l * 4 + h) * 465;
      for (int e = tg; e < 465; e += 256) rp[e] = src[e] * LOG2E;
      __syncthreads();
      attn_item<1, true, 4>(lds, grp * 65536, wl4, lane, Z + (size_t)b * NSLOT * NT_TOK * 64, S_NQ + h, S_NK + h, S_NV + h, qtok0, lat0, nlat, ntiles, drbase, Y, yrow0, 384 + h * 64, mixg);
    }
  }
  { int start = (int)blockIdx.x - 40; if (start < 0) start += G;
#pragma unroll 1
    for (int pr = start; pr * 2 < 2 * 6 * 66; pr += G) {
      const int r = pr * 2 + grp;
      const int b = r / 396, q = r % 396, h = q / 66, c = q % 66;
      const float lgf2 = log_sigmoid_f(P.ret_decay[(l * 2 + 0) * 6 + h]) * LOG2E, lgb2 = log_sigmoid_f(P.ret_decay[(l * 2 + 1) * 6 + h]) * LOG2E;
      float* U = (float*)(P.ws + WS_R1);
      ret_u_item(lds, grp * 65536, tg, Z + (size_t)b * NSLOT * NT_TOK * 64, h, c, lgf2, lgb2, U + ((size_t)((b * 6 + h) * 2 + 0) * 66 + c) * 4096, U + ((size_t)((b * 6 + h) * 2 + 1) * 66 + c) * 4096);
    }
  }
}

__device__ __forceinline__ void phaseB2(const Params& P, int l) {
  const float* U = (const float*)(P.ws + WS_R1);
#pragma unroll 1
  for (int it = blockIdx.x; it < 192; it += gridDim.x) {
    const int seq = it >> 3, off = (it & 7) * 512 + get_tid();
    const int dir = seq & 1, h = (seq >> 1) % 6;
    const float lg = log_sigmoid_f(P.ret_decay[(l * 2 + dir) * 6 + h]);
    const float decay = expf(128.f * lg);
    const float* base = U + (size_t)seq * 66 * 4096 + off;
    float* sbase = (float*)((unsigned char*)P.out + S_OFF) + (size_t)seq * 66 * 4096 + off;
    float u[66];
    if (dir == 0) {
#pragma unroll
      for (int st = 0; st < 66; ++st) u[st] = __builtin_nontemporal_load(base + (size_t)st * 4096);
      float s = 0.f;
#pragma unroll
      for (int st = 0; st < 66; ++st) { sbase[(size_t)st * 4096] = s; s = s * decay + u[st]; }
    } else {
#pragma unroll
      for (int st = 0; st < 66; ++st) { const int c = st < 2 ? 1 - st : 67 - st; u[st] = __builtin_nontemporal_load(base + (size_t)c * 4096); }
      float s = 0.f;
#pragma unroll
      for (int st = 0; st < 66; ++st) { const int c = st < 2 ? 1 - st : 67 - st; sbase[(size_t)c * 4096] = s; s = s * decay + u[st]; }
    }
  }
}

__device__ __forceinline__ void phaseB3(unsigned char* lds, const Params& P, int l) {
  const bf16* Z = (const bf16*)(P.ws + WS_Z);
  bf16* Y = (bf16*)P.out;
  const float* mixg = P.mix_g + l * 1024;
  const float* U = (const float*)((const unsigned char*)P.out + S_OFF);
  const int tid = get_tid(), grp = __builtin_amdgcn_readfirstlane(tid >> 8), tg = tid & 255;
  const int cpb = (l == 0) ? 66 : 64, total = 2 * 6 * cpb;
#pragma unroll 1
  for (int pr = blockIdx.x; pr * 2 < total; pr += gridDim.x) {
    const int it = pr * 2 + grp;
    const int b = it / (6 * cpb), q = it % (6 * cpb), h = q / cpb, c = (q % cpb) + (66 - cpb);
    const float lgf2 = log_sigmoid_f(P.ret_decay[(l * 2 + 0) * 6 + h]) * LOG2E, lgb2 = log_sigmoid_f(P.ret_decay[(l * 2 + 1) * 6 + h]) * LOG2E;
    const size_t yrow0 = c < 2 ? (size_t)NLAT + b * CL + 128 * c : (size_t)b * NSEQ + 128 * (c - 2);
    ret_out_item(lds, grp * 65536, tg, Z + (size_t)b * NSLOT * NT_TOK * 64, h, c, lgf2, lgb2, U + ((size_t)((b * 6 + h) * 2 + 0) * 66 + c) * 4096, U + ((size_t)((b * 6 + h) * 2 + 1) * 66 + c) * 4096, Y, yrow0, mixg);
  }
}

__device__ __forceinline__ void pc_small_item(const Params& P, int l, int item) {
  const int tid = get_tid(), lane = tid & 63, w = tid >> 6, g = lane >> 4, li = lane & 15;
  const bf16* Y = (const bf16*)P.out;
  const bf16* Wt = (const bf16*)(P.ws + WS_WO) + (size_t)l * 1024 * 1024;
  float* XR = (float*)(P.ws + WS_XR);
  const int mb = item >> 5, nb = item & 31;
  const int m0 = NLAT + mb * 64 + (w >> 1) * 16, n0 = nb * 32 + (w & 1) * 16;
  const bf16* ar = Y + (size_t)(m0 + li) * D + g * 8;
  const bf16* br = Wt + (size_t)(n0 + li) * D + g * 8;
  f32x4 acc = {0.f, 0.f, 0.f, 0.f};
#pragma unroll 1
  for (int kb = 0; kb < 32; kb += 8) {
    bf16x8 af[8], bf[8];
#pragma unroll
    for (int c = 0; c < 8; ++c) { af[c] = *(const bf16x8*)(ar + (kb + c) * 32); bf[c] = *(const bf16x8*)(br + (kb + c) * 32); }
#pragma unroll
    for (int c = 0; c < 8; ++c) acc = __builtin_amdgcn_mfma_f32_16x16x32_bf16(bf[c], af[c], acc, 0, 0, 0);
  }
  const int m = m0 + li, n = n0 + 4 * g;
  const float* gt = (const float*)(P.ws + WS_MOD) + (l * 3 + 2) * 6144 + 2048;
  const f32x4 xv = *(const f32x4*)(P.ctx + (size_t)(m - NLAT) * D + n), gv = *(const f32x4*)(gt + n);
  *(f32x4*)(XR + (size_t)m * D + n) = xv + gv * acc;
}
__device__ __forceinline__ void phaseC(unsigned char* lds, const Params& P, int l) {
  const bf16* Y = (const bf16*)P.out;
  const bf16* Wt = (const bf16*)(P.ws + WS_WO) + (size_t)l * 1024 * 1024;
  float* XR = (float*)(P.ws + WS_XR);
  EpiOutProj E{l == 0 ? P.x : XR, l == 0 ? P.ctx : XR + (size_t)NLAT * D, (const float*)(P.ws + WS_MOD) + l * 3 * 6144, XR};
  const int nitem = NLAT / 256 * 4;
  { const int c0 = xcd_vidx(0), G = gridDim.x;
    SrcC8 S{Y, Wt, &E, c0, G, c0 < nitem ? (nitem - c0 + G - 1) / G : 0};
    gemm8_stream(lds, S); }
  if (l == 0) {
#pragma unroll 1
    for (int it = blockIdx.x; it < 256; it += gridDim.x) pc_small_item(P, l, it);
  }
}

__device__ __forceinline__ void phaseD(unsigned char* lds, const Params& P, int l) {
  const int tid = get_tid(), lane = tid & 63, w = tid >> 6, g = lane >> 4, li = lane & 15;
  const float* XR = (const float*)(P.ws + WS_XR);
  bf16* H2 = (bf16*)(P.ws + WS_R1);
  int* cnt = (int*)(P.ws + WS_CNT) + l * 16;
  int* list = (int*)(P.ws + WS_LIST) + (size_t)l * 16 * NROWS;
  float* gatew = (float*)(P.ws + WS_GATEW);
  float* part = (float*)lds;
  float* ssqp = part + 2048;
  float* rsl = ssqp + 128;
  int* hist = (int*)(rsl + 64);
  const int nitems = (l == 0 ? NROWS : NLAT) / 64;
  const int rgp = w >> 1, kh = w & 1;
#pragma unroll 1
  for (int it = blockIdx.x; it < nitems; it += gridDim.x) {
    const int r0 = it * 64, seg = r0 < NSEQ ? 0 : (r0 < NLAT ? 1 : 2);
    const float* wr = (const float*)(P.ws + WS_WR) + (size_t)(l * 3 + seg) * 16384;
    const float* xrow = XR + (size_t)(r0 + rgp * 16 + li) * D + 512 * kh + 4 * g;
    const float* wp0 = wr + (size_t)(512 * kh + 4 * g) * 16 + li;
    if (tid < 32) hist[tid] = 0;
    f32x4 acc = {0.f, 0.f, 0.f, 0.f}; float ssq = 0.f;
#pragma unroll 1
    for (int cb = 0; cb < 32; cb += 8) {
      f32x4 xv[8]; float bw[8][4];
#pragma unroll
      for (int c = 0; c < 8; ++c) {
        xv[c] = *(const f32x4*)(xrow + 16 * (cb + c));
        const float* wp = wp0 + (cb + c) * 256;
        bw[c][0] = wp[0]; bw[c][1] = wp[16]; bw[c][2] = wp[32]; bw[c][3] = wp[48];
      }
#pragma unroll
      for (int c = 0; c < 8; ++c) {
        ssq += xv[c][0] * xv[c][0] + xv[c][1] * xv[c][1] + xv[c][2] * xv[c][2] + xv[c][3] * xv[c][3];
        acc = __builtin_amdgcn_mfma_f32_16x16x4f32(xv[c][0], bw[c][0], acc, 0, 0, 0);
        acc = __builtin_amdgcn_mfma_f32_16x16x4f32(xv[c][1], bw[c][1], acc, 0, 0, 0);
        acc = __builtin_amdgcn_mfma_f32_16x16x4f32(xv[c][2], bw[c][2], acc, 0, 0, 0);
        acc = __builtin_amdgcn_mfma_f32_16x16x4f32(xv[c][3], bw[c][3], acc, 0, 0, 0);
      }
    }
    ssq += __shfl_xor(ssq, 16); ssq += __shfl_xor(ssq, 32);
#pragma unroll
    for (int j = 0; j < 4; ++j) part[(w * 16 + 4 * g + j) * 16 + li] = acc[j];
    if (g == 0) ssqp[w * 16 + li] = ssq;
    __syncthreads();
    int e1 = 0, e2 = 0, q1 = 0, q2 = 0; float g1 = 0.f, g2 = 0.f;
    if (tid < 64) {
      const int rg2 = tid >> 4, rr = tid & 15;
      const float ss = ssqp[(2 * rg2) * 16 + rr] + ssqp[(2 * rg2 + 1) * 16 + rr];
      const float rs = rsqrtf(ss * (1.f / 1024.f) + EPS);
      rsl[tid] = rs;
      const float* cr = (const float*)(P.ws + WS_CR) + (l * 3 + seg) * 16;
      float lg[16]; float mx = -1e30f;
#pragma unroll
      for (int e = 0; e < 16; ++e) { lg[e] = rs * (part[((2 * rg2) * 16 + rr) * 16 + e] + part[((2 * rg2 + 1) * 16 + rr) * 16 + e]) + cr[e]; mx = fmaxf(mx, lg[e]); }
#pragma unroll
      for (int e = 0; e < 16; ++e) lg[e] = expf(lg[e] - mx);
      float best = -1.f; int bg = 0; float b0 = 0.f, b1 = 0.f, b2 = 0.f, b3 = 0.f;
#pragma unroll
      for (int gi = 0; gi < 4; ++gi) {
        const float a0 = lg[4 * gi], a1 = lg[4 * gi + 1], a2 = lg[4 * gi + 2], a3 = lg[4 * gi + 3];
        const float sc = fmaxf(fmaxf(fmaxf(a0 + a1, a0 + a2), fmaxf(a0 + a3, a1 + a2)), fmaxf(a1 + a3, a2 + a3));
        if (sc > best) { best = sc; bg = gi; b0 = a0; b1 = a1; b2 = a2; b3 = a3; }
      }
      int i1 = 0; float v1 = b0;
      if (b1 > v1) { v1 = b1; i1 = 1; } if (b2 > v1) { v1 = b2; i1 = 2; } if (b3 > v1) { v1 = b3; i1 = 3; }
      int i2 = -1; float v2 = -1.f;
      if (i1 != 0 && b0 > v2) { v2 = b0; i2 = 0; } if (i1 != 1 && b1 > v2) { v2 = b1; i2 = 1; } if (i1 != 2 && b2 > v2) { v2 = b2; i2 = 2; } if (i1 != 3 && b3 > v2) { v2 = b3; i2 = 3; }
      const float inv = 1.f / (v1 + v2);
      e1 = bg * 4 + i1; e2 = bg * 4 + i2; g1 = v1 * inv; g2 = v2 * inv;
      q1 = atomicAdd(&hist[e1], 1); q2 = atomicAdd(&hist[e2], 1);
    }
    __syncthreads();
    if (tid < 16) hist[16 + tid] = atomicAdd(&cnt[tid], hist[tid]);
    __syncthreads();
    if (tid < 64) {
      const int row = r0 + tid;
      list[(size_t)e1 * NROWS + hist[16 + e1] + q1] = row * 2; gatew[row * 2] = g1;
      list[(size_t)e2 * NROWS + hist[16 + e2] + q2] = row * 2 + 1; gatew[row * 2 + 1] = g2;
    }
    {
      const float* m = (const float*)(P.ws + WS_MOD) + (l * 3 + seg) * 6144;
      f32x4 gs[4], sh[4];
#pragma unroll
      for (int j = 0; j < 4; ++j) { const int k = 4 * lane + 256 * j; gs[j] = *(const f32x4*)(P.n2g + l * 1024 + k) * (*(const f32x4*)(m + 4096 + k) + 1.f); sh[j] = *(const f32x4*)(m + 3072 + k); }
#pragma unroll 1
      for (int q = 0; q < 8; q += 4) {
        f32x4 xx[4][4];
#pragma unroll
        for (int u = 0; u < 4; ++u)
#pragma unroll
          for (int j = 0; j < 4; ++j) xx[u][j] = *(const f32x4*)(XR + (size_t)(r0 + 8 * w + q + u) * D + 4 * lane + 256 * j);
#pragma unroll
        for (int u = 0; u < 4; ++u) {
          const int rr = 8 * w + q + u; const float rs = rsl[rr]; bf16* hp = H2 + (size_t)(r0 + rr) * D;
#pragma unroll
          for (int j = 0; j < 4; ++j) { const f32x4 o = xx[u][j] * rs * gs[j] + sh[j]; u32x2 ov; ov.x = pk2(o[0], o[1]); ov.y = pk2(o[2], o[3]); *(u32x2*)(hp + 4 * lane + 256 * j) = ov; }
        }
      }
    }
    __syncthreads();
  }
}

__device__ __forceinline__ void phaseEF(unsigned char* lds, const Params& P, int l, bool down) {
  const int* cnt = (const int*)(P.ws + WS_CNT) + l * 16;
  const int* list = (const int*)(P.ws + WS_LIST) + (size_t)l * 16 * NROWS;
  bf16* act = (bf16*)(P.ws + WS_Z + Z_ACT);
  MoeU* desc = (MoeU*)(lds + LDS_MISC);
  int* dn = (int*)(lds + LDS_MISC + 1024);
  const int c0 = xcd_vidx(0), G = gridDim.x;
  { const int j = get_tid();
    if (j < 8) {
      int NF = 0, NH = 0;
#pragma unroll 1
      for (int e = 0; e < 16; ++e) { const int c = cnt[e], rem = c & 255; NF += ((c >> 8) + (rem > 128 ? 1 : 0)) * 4; NH += (rem >= 1 && rem <= 128) ? 4 : 0; }
      const int v = j * G + c0;
      int e = 0, sb = 0, base = 0; MoeU t{0, 0, 0, 0, 0}; int kind = 0;
      if (v < NF) {
#pragma unroll 1
        for (e = 0; e < 16; ++e) { const int c = cnt[e], rem = c & 255, fu = ((c >> 8) + (rem > 128 ? 1 : 0)) * 4; if (v < base + fu) { const int k = v - base, mt = k >> 2; int nv = c - mt * 256; nv = nv < 256 ? nv : 256;
            t = MoeU{e, mt * 256, nv, k & 3, sb + mt * 256}; kind = 1; break; } base += fu; sb += c; }
      } else if (v < NF + NH) {
        const int vh = v - NF;
#pragma unroll 1
        for (e = 0; e < 16; ++e) { const int c = cnt[e], rem = c & 255, hv = (rem >= 1 && rem <= 128) ? 4 : 0; if (vh < base + hv) { const int k = vh - base, r0 = (c >> 8) * 256;
            t = MoeU{e, r0, rem, k & 3, sb + r0}; kind = 2; break; } base += hv; sb += c; }
      }
      desc[j] = t; dn[j] = kind;
    }
    __syncthreads(); }
  int nf = 0, nh = 0;
#pragma unroll
  for (int j = 0; j < 8; ++j) { nf += dn[j] == 1 ? 1 : 0; nh += dn[j] == 2 ? 1 : 0; }
  if (!down) {
    SrcUp8 S{desc, (const bf16*)(P.ws + WS_R1), list, (const bf16*)(P.ws + WS_W13) + (size_t)(l * 16) * 1024 * 1024, act, nf};
    gemm8_stream<SrcUp8, true>(lds, S);
  } else {
    SrcDown8 S{desc, act, list, (const bf16*)(P.ws + WS_W2) + (size_t)(l * 16) * 1024 * 512, (const float*)(P.ws + WS_GATEW), (bf16*)(P.ws + WS_R1), (bf16*)(P.ws + WS_Z + Z_YM1), nf};
    gemm8_stream<SrcDown8, false>(lds, S);
  }
#pragma unroll 1
  for (int j = nf; j < nf + nh; ++j) {
    const MoeU t = desc[j];
    const int* lst = list + (size_t)t.e * NROWS + t.row0;
    if (!down) {
      ARowGather ar{(const bf16*)(P.ws + WS_R1), lst, t.nvalid};
      EpiMoeUp E{act, t.slot0, t.nvalid};
      gemm_tile<4, 4>(lds, ar, (const bf16*)(P.ws + WS_W13) + (size_t)(l * 16 + t.e) * 1024 * 1024, 1024, 0, t.nt * 256, E);
    } else {
      ARowAct ar{act, t.slot0};
      EpiMoeDown E{lst, (const float*)(P.ws + WS_GATEW), (bf16*)(P.ws + WS_R1), (bf16*)(P.ws + WS_Z + Z_YM1), t.nvalid};
      gemm_tile<4, 4>(lds, ar, (const bf16*)(P.ws + WS_W2) + (size_t)(l * 16 + t.e) * 1024 * 512, 512, 0, t.nt * 256, E);
    }
  }
  __syncthreads();
}

__device__ __forceinline__ void phaseG(const Params& P, int l) {
  const int tid = get_tid(), lane = tid & 63, w = tid >> 6;
  float* XR = (float*)(P.ws + WS_XR);
  const bf16* Y0 = (const bf16*)(P.ws + WS_R1); const bf16* Y1 = (const bf16*)(P.ws + WS_Z + Z_YM1);
  const float* mod = (const float*)(P.ws + WS_MOD);
  const int nrows = l == 0 ? NROWS : NLAT;
#pragma unroll 1
  for (int it = blockIdx.x; it < nrows / 16; it += gridDim.x) {
    const int row0 = it * 16 + 2 * w, seg = row0 < NSEQ ? 0 : (row0 < NLAT ? 1 : 2);
    const float* gt2 = mod + (l * 3 + seg) * 6144 + 5120;
    f32x4 x1[2][4]; u32x2 ya[2][4], yb[2][4];
#pragma unroll
    for (int u = 0; u < 2; ++u)
#pragma unroll
      for (int j = 0; j < 4; ++j) { const size_t o = (size_t)(row0 + u) * D + 4 * lane + 256 * j; x1[u][j] = __builtin_nontemporal_load((const f32x4*)(XR + o)); ya[u][j] = __builtin_nontemporal_load((const u32x2*)(Y0 + o)); yb[u][j] = __builtin_nontemporal_load((const u32x2*)(Y1 + o)); }
    f32x4 gv[4];
#pragma unroll
    for (int j = 0; j < 4; ++j) gv[j] = *(const f32x4*)(gt2 + 4 * lane + 256 * j);
#pragma unroll
    for (int u = 0; u < 2; ++u) {
      const int row = row0 + u;
      f32x4 xv[4]; float ss = 0.f;
#pragma unroll
      for (int j = 0; j < 4; ++j) {
        const u32x2 a = ya[u][j], b = yb[u][j];
        f32x4 m; m[0] = bflo(a.x) + bflo(b.x); m[1] = bfhi(a.x) + bfhi(b.x); m[2] = bflo(a.y) + bflo(b.y); m[3] = bfhi(a.y) + bfhi(b.y);
        xv[j] = x1[u][j] + gv[j] * m;
        ss += xv[j][0] * xv[j][0] + xv[j][1] * xv[j][1] + xv[j][2] * xv[j][2] + xv[j][3] * xv[j][3];
      }
      ss = wsum(ss);
      if (l == 0) {
        const float* sc1 = mod + (1 * 3 + seg) * 6144 + 1024;
        bf16* xb = (bf16*)(P.ws + WS_R1) + (size_t)row * D;
        if (lane == 0) ((float*)(P.ws + WS_RSS))[row] = ss;
#pragma unroll
        for (int j = 0; j < 4; ++j) {
          const int k = 4 * lane + 256 * j;
          *(f32x4*)(XR + (size_t)row * D + k) = xv[j];
          const f32x4 gg = *(const f32x4*)(P.n1g + 1024 + k), sc = *(const f32x4*)(sc1 + k);
          const f32x4 o = xv[j] * gg * (sc + 1.f);
          u32x2 ov; ov.x = pk2(o[0], o[1]); ov.y = pk2(o[2], o[3]); *(u32x2*)(xb + k) = ov;
        }
      } else {
        const float rs = rsqrtf(ss * (1.f / 1024.f) + EPS);
#pragma unroll
        for (int j = 0; j < 4; ++j) {
          const int k = 4 * lane + 256 * j;
          const f32x4 gg = *(const f32x4*)(P.final_g + k);
          __builtin_nontemporal_store(xv[j] * rs * gg, (f32x4*)(P.out + (size_t)row * D + k));
        }
      }
    }
  }
}

#define XB_TMO      128
#define XB_XCNT(j)  (256  + 64 * (j))
#define XB_XSUB(j)  (1280 + 64 * (j))
#define XB_XGEN(j)  (2304 + 64 * (j))
#define XB_TOP      3328
#define XB_TOPGEN   3392
#define XB_SPIN_CAP (1u << 20)
__device__ __forceinline__ unsigned xb_ld(unsigned* p)              { return __hip_atomic_load(p, __ATOMIC_RELAXED, __HIP_MEMORY_SCOPE_AGENT); }
__device__ __forceinline__ unsigned xb_add(unsigned* p, unsigned v) { return __hip_atomic_fetch_add(p, v, __ATOMIC_RELAXED, __HIP_MEMORY_SCOPE_AGENT); }
__device__ __forceinline__ unsigned xb_xcc_id() { return (unsigned)__builtin_amdgcn_s_getreg((3 << 11) | 20) & 0xFu; }
#define XB_SPIN(cond, bar) do { unsigned _sp = 0; while (cond) { __builtin_amdgcn_s_sleep(1); \
    if ((++_sp & 255u) == 0u) { if (xb_ld(&(bar)[XB_TMO])) break; if (_sp > XB_SPIN_CAP) { atomicAdd(&(bar)[XB_TMO], 1u); break; } } } } while (0)
struct XBar { unsigned* bar; unsigned* st; };
__device__ __forceinline__ void xbar_init(XBar& b, unsigned* bar, unsigned* st) {
  b.bar = bar; b.st = st;
  if (threadIdx.x == 0) { st[0] = 0u; st[1] = 0u; (void)xb_add(&bar[XB_XCNT(xb_xcc_id())], 1u); }
}
__device__ __forceinline__ void xbar_sync(XBar& b) {
  asm volatile("s_waitcnt vmcnt(0)" ::: "memory");
  __syncthreads();
  if (threadIdx.x == 0) {
    unsigned* bar = b.bar;
    const unsigned x = xb_xcc_id();
    __builtin_amdgcn_s_waitcnt(0);
    unsigned nloc = b.st[0], nx = b.st[1];
    if (nloc == 0u) {
      const unsigned G = gridDim.x; unsigned sum, cnt, mine, sp = 0u;
      for (;;) {
        sum = 0u; cnt = 0u; mine = 0u;
#pragma unroll
        for (unsigned j = 0; j < 16; ++j) { const unsigned c = xb_ld(&bar[XB_XCNT(j)]); sum += c; cnt += (c > 0u) ? 1u : 0u; mine = (j == x) ? c : mine; }
        if (sum == G) break;
        __builtin_amdgcn_s_sleep(1);
        if ((++sp & 255u) == 0u) { if (xb_ld(&bar[XB_TMO])) break; if (sp > XB_SPIN_CAP) { atomicAdd(&bar[XB_TMO], 1u); break; } }
      }
      nloc = mine > 0u ? mine : 1u; nx = cnt > 0u ? cnt : 1u;
      b.st[0] = nloc; b.st[1] = nx;
    }
    const unsigned old = xb_add(&bar[XB_XSUB(x)], 1u);
    const unsigned gen = old / nloc;
    if (old + 1u == (gen + 1u) * nloc) {
      __builtin_amdgcn_fence(__ATOMIC_RELEASE, "agent");
      asm volatile("s_waitcnt vmcnt(0)" ::: "memory");
      const unsigned og = xb_add(&bar[XB_TOP], 1u);
      const unsigned tg = og / nx;
      if (og + 1u == (tg + 1u) * nx) xb_add(&bar[XB_TOPGEN], 1u);
      else XB_SPIN(xb_ld(&bar[XB_TOPGEN]) == tg, bar);
      __builtin_amdgcn_fence(__ATOMIC_ACQUIRE, "agent");
      xb_add(&bar[XB_XGEN(x)], 1u);
      asm volatile("s_waitcnt vmcnt(0)" ::: "memory");
    } else {
      XB_SPIN(xb_ld(&bar[XB_XGEN(x)]) == gen, bar);
      __builtin_amdgcn_fence(__ATOMIC_ACQUIRE, "agent");
      asm volatile("s_waitcnt vmcnt(0)" ::: "memory");
    }
  }
  __syncthreads();
}

__global__ void __launch_bounds__(NTHR, 2) fwd_mega(Params P) {
  extern __shared__ __attribute__((aligned(16))) unsigned char lds[];
  cg::grid_group grid = cg::this_grid();
  XBar xb; xbar_init(xb, (unsigned*)(P.ws + WS_BAR), (unsigned*)(lds + LDS_BARW));
#define GSYNC() xbar_sync(xb)
  phase0(lds, P);
  VM_WAIT(); __syncthreads(); grid.sync();
  phase1(lds, P); GSYNC();
#pragma unroll 1
  for (int l = 0; l < 2; ++l) {
    phaseA(lds, P, l); GSYNC();
    phaseB(lds, P, l); GSYNC();
    phaseB2(P, l); GSYNC();
    phaseB3(lds, P, l); GSYNC();
    phaseC(lds, P, l); GSYNC();
    phaseD(lds, P, l); GSYNC();
    phaseEF(lds, P, l, false); GSYNC();
    phaseEF(lds, P, l, true); GSYNC();
    phaseG(P, l);
    if (l == 0) GSYNC();
  }
#undef GSYNC
}

extern "C" void kernel_launch(void* const* d_in, const int* in_sizes, int n_in, void* d_out, int out_size, void* d_ws, size_t ws_size, hipStream_t stream) {
  static int grid_blocks = 0;
  if (!grid_blocks) {
    int dev = 0, cus = 0, per_cu = 0;
    (void)hipGetDevice(&dev);
    (void)hipDeviceGetAttribute(&cus, hipDeviceAttributeMultiprocessorCount, dev);
    (void)hipFuncSetAttribute((const void*)fwd_mega, hipFuncAttributeMaxDynamicSharedMemorySize, LDS_BYTES);
    (void)hipOccupancyMaxActiveBlocksPerMultiprocessor(&per_cu, fwd_mega, NTHR, LDS_BYTES);
    if (per_cu > 1) per_cu = 1;
    if (per_cu < 1) per_cu = 1;
    grid_blocks = cus * per_cu;
    if (ws_size < WS_END) fprintf(stderr, "kernel_launch: workspace too small: %zu < %zu\n", ws_size, (size_t)WS_END);
  }
  (void)hipMemsetAsync(d_ws, 0, WS_ZERO_BYTES, stream);
  Params p{};
  const float** pp = (const float**)&p;
  for (int i = 0; i < 21; ++i) pp[i] = (const float*)d_in[i];
  p.out = (float*)d_out; p.ws = (unsigned char*)d_ws;
  void* args[] = {&p};
  hipError_t e = hipLaunchCooperativeKernel((void*)fwd_mega, dim3(grid_blocks), dim3(NTHR), args, LDS_BYTES, stream);
  if (e != hipSuccess) fprintf(stderr, "cooperative launch failed: %s (grid %d)\n", hipGetErrorString(e), grid_blocks);
}
```

```cpp
#include <hip/hip_runtime.h>
#include <hip/hip_cooperative_groups.h>
#include <cstdio>
#include <cstdint>
namespace cg = cooperative_groups;

typedef unsigned short bf16;
typedef short bf16x8 __attribute__((ext_vector_type(8)));
typedef short s16x4 __attribute__((ext_vector_type(4)));
typedef float f32x4 __attribute__((ext_vector_type(4)));
typedef float f32x2 __attribute__((ext_vector_type(2)));
typedef unsigned u32x4 __attribute__((ext_vector_type(4)));
typedef unsigned u32x2 __attribute__((ext_vector_type(2)));
typedef __bf16 bf2_t __attribute__((ext_vector_type(2)));
#define LAS __attribute__((address_space(3)))
constexpr int NTHR = 512;
constexpr int LDS_BYTES = 147456 + 64;
constexpr int LDS_BARW = 147456;
constexpr int LDS_MISC = 131072;

constexpr int D = 1024, NSEQ = 8192, CL = 256, NT_TOK = NSEQ + CL, NLAT = 2 * NSEQ, NROWS = NLAT + 2 * CL;
constexpr int INC = 2944, NSLOT = 46;
constexpr float EPS = 1e-6f;
constexpr float LOG2E = 1.4426950408889634f;
constexpr float QSCALE = 0.125f * LOG2E;
constexpr int S_AQ = 0, S_AK = 6, S_AV = 8, S_NQ = 10, S_NK = 14, S_NV = 18, S_RQ = 22, S_RK = 28, S_RV = 34, S_RG = 40;

constexpr size_t WS_BAR = 0;
constexpr size_t WS_CNT = 16384;
constexpr size_t WS_ZERO_BYTES = 16384 + 4096;
constexpr size_t WS_MOD = WS_ZERO_BYTES;
constexpr size_t WS_BIAS = WS_MOD + 2 * 3 * 6144 * 4;
constexpr size_t WS_ROPE = WS_BIAS + 2 * 3 * 2944 * 4;
constexpr size_t WS_RSS = WS_ROPE + 128 * 16 * 2 * 4;
constexpr size_t WS_WR = WS_RSS + 16896 * 4;
constexpr size_t WS_CR = WS_WR + 2 * 3 * 1024 * 16 * 4;
constexpr size_t WS_GATEW = WS_CR + 4096;
constexpr size_t WS_LIST = WS_GATEW + 16896 * 2 * 4;
constexpr size_t WS_WIN = (WS_LIST + (size_t)2 * 16 * 16896 * 4 + 4095) / 4096 * 4096;
constexpr size_t WS_WO = WS_WIN + (size_t)2 * 2944 * 1024 * 2;
constexpr size_t WS_W13 = WS_WO + (size_t)2 * 1024 * 1024 * 2;
constexpr size_t WS_W2 = WS_W13 + (size_t)32 * 1024 * 1024 * 2;
constexpr size_t WS_XR = WS_W2 + (size_t)32 * 1024 * 512 * 2;
constexpr size_t WS_R1 = WS_XR + (size_t)NROWS * 1024 * 4;
constexpr size_t WS_Z = WS_R1 + (size_t)NROWS * 1024 * 2;
constexpr size_t WS_END = WS_Z + (size_t)2 * NSLOT * NT_TOK * 64 * 2;
constexpr size_t S_OFF = (size_t)34 << 20;
constexpr size_t Z_YM1 = 0, Z_ACT = (size_t)NROWS * 1024 * 2;
static_assert(Z_ACT + (size_t)(2 * NROWS + 128) * 512 * 2 <= (size_t)2 * NSLOT * NT_TOK * 64 * 2, "act overlay");
static_assert((size_t)2 * 6 * 2 * 66 * 4096 * 4 <= (size_t)NROWS * 1024 * 2, "U overlay");

struct Params {
  const float *x, *c, *ctx, *c_ctx, *w_ada, *b_ada, *n1g, *n2g, *w_in, *qg, *kg, *rpb, *ret_decay, *mix_g, *w_out, *w_router, *b_router, *w1, *w3, *w2, *final_g;
  float* out; unsigned char* ws;
};

__device__ __forceinline__ unsigned pk2(float lo, float hi) { f32x2 v = {lo, hi}; bf2_t b = __builtin_convertvector(v, bf2_t); return __builtin_bit_cast(unsigned, b); }
__device__ __forceinline__ float bflo(unsigned u) { return __builtin_bit_cast(float, u << 16); }
__device__ __forceinline__ float bfhi(unsigned u) { return __builtin_bit_cast(float, u & 0xffff0000u); }
__device__ __forceinline__ float wsum(float v) {
#pragma unroll
  for (int o = 1; o < 64; o <<= 1) v += __shfl_xor(v, o);
  return v;
}
__device__ __forceinline__ float silu_f(float v) { return v / (1.f + __expf(-v)); }
__device__ __forceinline__ int lds_swz(int row, int chunk) { return row * 128 + ((chunk ^ ((row >> 1) & 7)) << 4); }
#define VM_WAIT() asm volatile("s_waitcnt vmcnt(0)" ::: "memory")
__device__ __forceinline__ int get_tid() { int t = threadIdx.x; asm volatile("" : "+v"(t)); return t; }

template <int R, int NW>
__device__ __forceinline__ void stage_rows(unsigned char* lds, int dst, const bf16* src, int ld, int wl, int lane) {
#pragma unroll
  for (int i = 0; i < R / (8 * NW); ++i) {
    const int q = wl + NW * i, row = q * 8 + (lane >> 3), ch = (lane & 7) ^ ((row >> 1) & 7);
    __builtin_amdgcn_global_load_lds((const void*)(src + (size_t)row * ld + ch * 8), (LAS void*)(lds + dst + q * 1024), 16, 0, 0);
  }
}
#define VMCNT(n) asm volatile("s_waitcnt vmcnt(" #n ")" ::: "memory")
#define LGKM0() asm volatile("s_waitcnt lgkmcnt(0)" ::: "memory")
#define RAW_BAR() __builtin_amdgcn_s_barrier()
__device__ __forceinline__ bf16x8 lds_frag(const unsigned char* lds, int off) { return *(const bf16x8*)(lds + off); }
__device__ __forceinline__ bf16x8 lds_tr2(unsigned char* lds, int off0, int off1) {
  s16x4 a = __builtin_amdgcn_ds_read_tr16_b64_v4i16((LAS s16x4*)(lds + off0));
  s16x4 b = __builtin_amdgcn_ds_read_tr16_b64_v4i16((LAS s16x4*)(lds + off1));
  return __builtin_shufflevector(a, b, 0, 1, 2, 3, 4, 5, 6, 7);
}

template <int MT, int NT, int ST> struct GStep {
  static __device__ __forceinline__ void run(f32x4 (&acc)[MT][NT], bf16x8 (&W0)[NT], bf16x8 (&W1)[NT], bf16x8 (&X)[2 * MT], const unsigned char* base, int xoff, int woff) {
    constexpr int S = 2 * MT, kk = ST / MT, mt = ST % MT;
#pragma unroll
    for (int nt = 0; nt < NT; ++nt) acc[mt][nt] = __builtin_amdgcn_mfma_f32_16x16x32_bf16(kk ? W1[nt] : W0[nt], X[ST], acc[mt][nt], 0, 0, 0);
    __builtin_amdgcn_sched_group_barrier(0x008, NT, 0);
    if constexpr (ST + 2 < S) { constexpr int k2 = (ST + 2) / MT, m2 = (ST + 2) % MT; X[ST + 2] = lds_frag(base, (xoff + m2 * 2048) ^ (k2 << 6)); }
    if constexpr (ST < NT) W1[ST] = lds_frag(base, (woff + ST * 2048) ^ 64);
    constexpr int nds = (ST + 2 < S ? 1 : 0) + (ST < NT ? 1 : 0);
    if constexpr (nds > 0) __builtin_amdgcn_sched_group_barrier(0x100, nds, 0);
    if constexpr (ST + 1 < S) GStep<MT, NT, ST + 1>::run(acc, W0, W1, X, base, xoff, woff);
  }
};

template <int MT, int NT, class ARow, class Epi>
__device__ __forceinline__ void gemm_tile(unsigned char* lds, const ARow& arow, const bf16* __restrict__ Bt, int K, int m0, int n0, const Epi& epi,
                                          bool staged0 = false, bool hasnext = false, const ARow* narow = nullptr, const bf16* nBt = nullptr, int nn0 = 0) {
  const int tid = get_tid(), lane = tid & 63, w = __builtin_amdgcn_readfirstlane(tid >> 6);
  const int wr = w >> 2, wc = w & 3, g = lane >> 4, li = lane & 15;
  constexpr int NA = MT / 2, NB = NT;
  const bf16* ap[NA]; const bf16* bp[NB];
#pragma unroll
  for (int i = 0; i < NA; ++i) { const int q = w + 8 * i, row = q * 8 + (lane >> 3), ch = (lane & 7) ^ ((row >> 1) & 7); ap[i] = arow(row) + ch * 8; }
#pragma unroll
  for (int i = 0; i < NB; ++i) { const int q = w + 8 * i, row = q * 8 + (lane >> 3), ch = (lane & 7) ^ ((row >> 1) & 7); bp[i] = Bt + (size_t)(n0 + row) * K + ch * 8; }
  f32x4 acc[MT][NT];
#pragma unroll
  for (int a = 0; a < MT; ++a)
#pragma unroll
    for (int b = 0; b < NT; ++b) acc[a][b] = (f32x4){0.f, 0.f, 0.f, 0.f};
  const int f = (li >> 1) & 7;
  const int xoff = (wr * (MT * 16) + li) * 128 + ((g ^ f) << 4);
  const int woff = 32768 + (wc * (NT * 16) + li) * 128 + ((g ^ f) << 4);
  const int nk = K >> 6;
#define GT_STAGE(s, k0) do { _Pragma("unroll") for (int i = 0; i < NA; ++i) \
    __builtin_amdgcn_global_load_lds((const void*)(ap[i] + (k0)), (LAS void*)(lds + (s) * 65536 + (w + 8 * i) * 1024), 16, 0, 0); \
    _Pragma("unroll") for (int i = 0; i < NB; ++i) \
    __builtin_amdgcn_global_load_lds((const void*)(bp[i] + (k0)), (LAS void*)(lds + (s) * 65536 + 32768 + (w + 8 * i) * 1024), 16, 0, 0); } while (0)
  if (!staged0) GT_STAGE(0, 0);
  VM_WAIT(); __syncthreads();
  for (int t = 0; t < nk; ++t) {
    const int s = t & 1;
    if (t + 1 < nk) GT_STAGE(s ^ 1, (t + 1) * 64);
    const unsigned char* base = lds + s * 65536;
    {
      bf16x8 W0[NT], W1[NT], X[2 * MT];
#pragma unroll
      for (int nt = 0; nt < NT; ++nt) W0[nt] = lds_frag(base, woff + nt * 2048);
      X[0] = lds_frag(base, xoff); X[1] = lds_frag(base, xoff + 2048);
      __builtin_amdgcn_sched_group_barrier(0x100, NT + 2, 0);
      GStep<MT, NT, 0>::run(acc, W0, W1, X, base, xoff, woff);
    }
    VM_WAIT(); __syncthreads();
  }
  if (hasnext) {
#pragma unroll
    for (int i = 0; i < NA; ++i) { const int q = w + 8 * i, row = q * 8 + (lane >> 3), ch = (lane & 7) ^ ((row >> 1) & 7); ap[i] = (*narow)(row) + ch * 8; }
#pragma unroll
    for (int i = 0; i < NB; ++i) { const int q = w + 8 * i, row = q * 8 + (lane >> 3), ch = (lane & 7) ^ ((row >> 1) & 7); bp[i] = nBt + (size_t)(nn0 + row) * K + ch * 8; }
    GT_STAGE(0, 0);
  }
#undef GT_STAGE
  epi(acc, m0 + wr * (MT * 16), n0 + wc * (NT * 16), g, li);
}


namespace g8 {
constexpr int HT_B = 128 * 64 * 2;
__device__ __forceinline__ int lds_byte(int r, int c) { const int st = (r >> 4) * 2 + (c >> 5), rr = r & 15, cc = c & 31, ob = rr * 64 + cc * 2; return st * 1024 + (ob ^ (((ob >> 9) & 1) << 5)); }
__device__ __forceinline__ void stage_rc(int b, int& R, int& C) { const int st = b / 1024, sb = b % 1024, swz = sb ^ (((sb >> 9) & 1) << 5); R = (st >> 1) * 16 + swz / 64; C = (st & 1) * 32 + (swz % 64) / 2; }
}
template <class ARow, class Epi>
__device__ __forceinline__ void gemm8_tile(unsigned char* lds, const ARow& arow, const bf16* __restrict__ Bt, int K, int m0, int n0, const Epi& epi) {
  using namespace g8;
  const int tid = get_tid(), lane = tid & 63, wid = __builtin_amdgcn_readfirstlane(tid >> 6), wr = wid >> 2, wc = wid & 3, fr = lane & 15, fq = lane >> 4;
  const char* abase = (const char*)arow(0);
  const char* bbase = (const char*)(Bt + (size_t)n0 * K);
  unsigned oa[2][2], ob[2][2];
#pragma unroll
  for (int i = 0; i < 2; ++i) {
    int R, C; stage_rc(tid * 16 + i * 8192, R, C);
    const int ra = (R >> 6) * 128 + ((R >> 4) & 3) * 16 + (R & 15);
    const int rb = (R >> 5) * 64 + ((R >> 4) & 1) * 16 + (R & 15);
#pragma unroll
    for (int hh = 0; hh < 2; ++hh) { oa[hh][i] = (unsigned)((ra + hh * 64) * K + C) * 2u; ob[hh][i] = (unsigned)((rb + hh * 32) * K + C) * 2u; }
  }
#define G8_SA(b, h) (((b) * 2 + (h)) * HT_B)
#define G8_SB(b, h) ((4 + (b) * 2 + (h)) * HT_B)
#define G8_STAGE(bufoff, BASE, O2, kt) do { _Pragma("unroll") for (int _i = 0; _i < 2; ++_i) \
    __builtin_amdgcn_global_load_lds((const void*)((BASE) + (O2)[_i] + (unsigned)(kt) * 128u), (LAS void*)(lds + (bufoff) + wid * 1024 + _i * 8192), 16, 0, 0); } while (0)
  const int aoff = lds_byte(wr * 64 + fr, fq * 8), boff = lds_byte(wc * 32 + fr, fq * 8);
#define G8_LDA(dst, b, h) do { _Pragma("unroll") for (int m = 0; m < 4; ++m) _Pragma("unroll") for (int k = 0; k < 2; ++k) dst[m][k] = *(const bf16x8*)(lds + G8_SA(b, h) + aoff + m * 2048 + k * 1024); } while (0)
#define G8_LDB(dst, b, h) do { _Pragma("unroll") for (int n = 0; n < 2; ++n) _Pragma("unroll") for (int k = 0; k < 2; ++k) dst[n][k] = *(const bf16x8*)(lds + G8_SB(b, h) + boff + n * 2048 + k * 1024); } while (0)
#define G8_MMA(ai, bj, At_, Bt_) do { __builtin_amdgcn_s_setprio(1); _Pragma("unroll") for (int m = 0; m < 4; ++m) _Pragma("unroll") for (int n = 0; n < 2; ++n) _Pragma("unroll") for (int k = 0; k < 2; ++k) \
    acc[(ai) * 4 + m][(bj) * 2 + n] = __builtin_amdgcn_mfma_f32_16x16x32_bf16(Bt_[n][k], At_[m][k], acc[(ai) * 4 + m][(bj) * 2 + n], 0, 0, 0); __builtin_amdgcn_s_setprio(0); } while (0)
#define G8_WV(n) asm volatile("s_waitcnt vmcnt(" #n ")" ::: "memory")
#define G8_WL(n) asm volatile("s_waitcnt lgkmcnt(" #n ")" ::: "memory")
#define G8_BAR __builtin_amdgcn_s_barrier()
#define G8_SCHED __builtin_amdgcn_sched_barrier(0)
  f32x4 acc[8][4];
#pragma unroll
  for (int a = 0; a < 8; ++a)
#pragma unroll
    for (int b = 0; b < 4; ++b) acc[a][b] = (f32x4){0.f, 0.f, 0.f, 0.f};
  bf16x8 At[4][2], B0[2][2], B1[2][2];
  const int nt = K >> 6;
  G8_STAGE(G8_SB(0, 0), bbase, ob[0], 0); G8_STAGE(G8_SA(0, 0), abase, oa[0], 0);
  G8_STAGE(G8_SB(0, 1), bbase, ob[1], 0); G8_STAGE(G8_SA(0, 1), abase, oa[1], 0);
  if (wr == 1) G8_BAR;
  G8_WV(4); G8_BAR;
  G8_STAGE(G8_SB(1, 0), bbase, ob[0], 1); G8_STAGE(G8_SA(1, 0), abase, oa[0], 1); G8_STAGE(G8_SB(1, 1), bbase, ob[1], 1);
  G8_WV(6); G8_BAR;
#pragma unroll 1
  for (int t = 0; t < nt - 2; t += 2) {
    G8_LDB(B0, 0, 0); G8_SCHED; G8_LDA(At, 0, 0); G8_STAGE(G8_SA(1, 1), abase, oa[1], t + 1);
    G8_WL(8); G8_BAR; G8_WL(0); G8_MMA(0, 0, At, B0); G8_BAR; G8_SCHED;
    G8_LDB(B1, 0, 1); G8_STAGE(G8_SB(0, 0), bbase, ob[0], t + 2);
    G8_BAR; G8_WL(0); G8_MMA(0, 1, At, B1); G8_BAR;
    G8_LDA(At, 0, 1); G8_STAGE(G8_SA(0, 0), abase, oa[0], t + 2);
    G8_BAR; G8_WL(0); G8_MMA(1, 0, At, B0); G8_BAR; G8_SCHED;
    G8_STAGE(G8_SB(0, 1), bbase, ob[1], t + 2);
    G8_WV(6); G8_BAR; G8_MMA(1, 1, At, B1); G8_BAR;
    G8_LDB(B0, 1, 0); G8_SCHED; G8_LDA(At, 1, 0); G8_STAGE(G8_SA(0, 1), abase, oa[1], t + 2);
    G8_WL(8); G8_BAR; G8_WL(0); G8_MMA(0, 0, At, B0); G8_BAR; G8_SCHED;
    G8_LDB(B1, 1, 1); G8_STAGE(G8_SB(1, 0), bbase, ob[0], t + 3);
    G8_BAR; G8_WL(0); G8_MMA(0, 1, At, B1); G8_BAR;
    G8_LDA(At, 1, 1); G8_STAGE(G8_SA(1, 0), abase, oa[0], t + 3);
    G8_BAR; G8_WL(0); G8_MMA(1, 0, At, B0); G8_BAR; G8_SCHED;
    G8_STAGE(G8_SB(1, 1), bbase, ob[1], t + 3);
    G8_WV(6); G8_BAR; G8_MMA(1, 1, At, B1); G8_BAR;
  }
  { G8_LDB(B0, 0, 0); G8_LDA(At, 0, 0); G8_STAGE(G8_SA(1, 1), abase, oa[1], nt - 1);
    G8_BAR; G8_WL(0); G8_MMA(0, 0, At, B0); G8_BAR;
    G8_LDB(B1, 0, 1); G8_BAR; G8_WL(0); G8_MMA(0, 1, At, B1); G8_BAR;
    G8_LDA(At, 0, 1); G8_WV(4); G8_BAR; G8_WL(0); G8_MMA(1, 0, At, B0); G8_MMA(1, 1, At, B1); G8_BAR; }
  { G8_LDB(B0, 1, 0); G8_LDA(At, 1, 0); G8_WV(2); G8_BAR; G8_WL(0); G8_MMA(0, 0, At, B0); G8_BAR;
    G8_LDB(B1, 1, 1); G8_WV(0); G8_BAR; G8_WL(0); G8_MMA(0, 1, At, B1); G8_BAR;
    G8_LDA(At, 1, 1); G8_BAR; G8_WL(0); G8_MMA(1, 0, At, B0); G8_MMA(1, 1, At, B1); G8_BAR; }
  if (wr == 0) G8_BAR;
#undef G8_SA
#undef G8_SB
#undef G8_STAGE
#undef G8_LDA
#undef G8_LDB
#undef G8_MMA
#undef G8_WV
#undef G8_WL
#undef G8_BAR
#undef G8_SCHED
  epi(acc, m0 + wr * 128, n0 + wc * 64, fq, fr);
  __syncthreads();
}

struct ARowLinear { const bf16* A; int K; int m0; __device__ __forceinline__ const bf16* operator()(int r) const { return A + (size_t)(m0 + r) * K; } };

template <int MT, int NT>
struct EpiInProj {
  const float* rowss; const float* biasp; const float* qg; const float* kg; const float* rope  ; bf16* Z;
  __device__ __forceinline__ void operator()(f32x4 (&acc)[MT][NT], int mw, int nw, int g, int li) const {
    int b, seg, tokbase; bool latent;
    if (mw < NLAT) { b = mw >> 13; seg = b; tokbase = (mw & 8191); latent = true; }
    else { const int mc = mw - NLAT; b = mc >> 8; seg = 2; tokbase = NSEQ + (mc & 255); latent = false; }
    const int s = nw >> 6, coff = nw & 63;
    bf16* zb = Z + ((size_t)(b * NSLOT + s) * NT_TOK) * 64 + coff;
    float rss[MT];
#pragma unroll
    for (int mt = 0; mt < MT; ++mt) rss[mt] = rowss[mw + mt * 16 + li];
    f32x4 bv[NT], gvv[NT];
#pragma unroll
    for (int nt = 0; nt < NT; ++nt) bv[nt] = *(const f32x4*)(biasp + seg * INC + nw + nt * 16 + 4 * g);
    if (NT == 4 && s < 8) {
      const float* gn = (s < 6) ? qg : kg;
#pragma unroll
      for (int nt = 0; nt < NT; ++nt) gvv[nt] = *(const f32x4*)(gn + nt * 16 + 4 * g);
    } else {
#pragma unroll
      for (int nt = 0; nt < NT; ++nt) gvv[nt] = (f32x4){1.f, 1.f, 1.f, 1.f};
    }
#pragma unroll
    for (int mt = 0; mt < MT; ++mt) {
      const int tok = tokbase + mt * 16 + li;
      const float irms = rsqrtf(rss[mt] * (1.f / 1024.f) + EPS);
      f32x4 v[NT];
#pragma unroll
      for (int nt = 0; nt < NT; ++nt) v[nt] = acc[mt][nt] * irms + bv[nt];
      if constexpr (NT == 4) {
        if (s < 8) {
          float ss = 0.f;
#pragma unroll
          for (int nt = 0; nt < 4; ++nt) ss += v[nt][0] * v[nt][0] + v[nt][1] * v[nt][1] + v[nt][2] * v[nt][2] + v[nt][3] * v[nt][3];
          ss += __shfl_xor(ss, 16); ss += __shfl_xor(ss, 32);
          const float r = rsqrtf(ss * (1.f / 64.f) + EPS) * (s < 6 ? QSCALE : 1.f);
#pragma unroll
          for (int nt = 0; nt < 4; ++nt) v[nt] = v[nt] * r * gvv[nt];
          if (latent) {
            const int pr = tok >> 6, pc = tok & 63;
            const f32x4 r0 = *(const f32x4*)(rope + (pr * 16 + 4 * g) * 2), r1 = *(const f32x4*)(rope + (pr * 16 + 4 * g) * 2 + 4);
            const f32x4 c0 = *(const f32x4*)(rope + (pc * 16 + 4 * g) * 2), c1 = *(const f32x4*)(rope + (pc * 16 + 4 * g) * 2 + 4);
            const float cr_[4] = {r0[0], r0[2], r1[0], r1[2]}, sr_[4] = {r0[1], r0[3], r1[1], r1[3]};
            const float cc_[4] = {c0[0], c0[2], c1[0], c1[2]}, sc_[4] = {c0[1], c0[3], c1[1], c1[3]};
#pragma unroll
            for (int j = 0; j < 4; ++j) {
              const float t1 = v[0][j], t2 = v[1][j]; v[0][j] = t1 * cr_[j] - t2 * sr_[j]; v[1][j] = t2 * cr_[j] + t1 * sr_[j];
              const float u1 = v[2][j], u2 = v[3][j]; v[2][j] = u1 * cc_[j] - u2 * sc_[j]; v[3][j] = u2 * cc_[j] + u1 * sc_[j];
            }
          }
        }
      }
      if (s >= S_NQ && s < S_NK) {
#pragma unroll
        for (int nt = 0; nt < NT; ++nt) v[nt] = v[nt] * QSCALE;
      } else if (s >= S_RK && s < S_RV) {
#pragma unroll
        for (int nt = 0; nt < NT; ++nt) v[nt] = v[nt] * 0.125f;
      } else if (s >= S_RG) {
#pragma unroll
        for (int nt = 0; nt < NT; ++nt)
#pragma unroll
          for (int j = 0; j < 4; ++j) v[nt][j] = silu_f(v[nt][j]);
      }
#pragma unroll
      for (int nt = 0; nt < NT; ++nt) { u32x2 o; o.x = pk2(v[nt][0], v[nt][1]); o.y = pk2(v[nt][2], v[nt][3]); *(u32x2*)(zb + (size_t)tok * 64 + nt * 16 + 4 * g) = o; }
    }
  }
};

struct EpiOutProj {
  const float* xlat; const float* xctx; const float* mod; float* XR;
  __device__ __forceinline__ void operator()(f32x4 (&acc)[8][4], int mw, int nw, int g, int li) const {
    const int seg = (mw < NLAT) ? (mw >> 13) : 2;
    const float* gt = mod + seg * 6144 + 2048;
    f32x4 gv[4];
#pragma unroll
    for (int nt = 0; nt < 4; ++nt) gv[nt] = *(const f32x4*)(gt + nw + nt * 16 + 4 * g);
    const float* xbase = (mw < NLAT) ? (xlat + (size_t)mw * D) : (xctx + (size_t)(mw - NLAT) * D);
#pragma unroll
    for (int mb = 0; mb < 8; mb += 2) {
      f32x4 xv[2][4];
#pragma unroll
      for (int u = 0; u < 2; ++u)
#pragma unroll
        for (int nt = 0; nt < 4; ++nt) xv[u][nt] = __builtin_nontemporal_load((const f32x4*)(xbase + (size_t)((mb + u) * 16 + li) * D + nw + nt * 16 + 4 * g));
#pragma unroll
      for (int u = 0; u < 2; ++u)
#pragma unroll
        for (int nt = 0; nt < 4; ++nt) *(f32x4*)(XR + (size_t)(mw + (mb + u) * 16 + li) * D + nw + nt * 16 + 4 * g) = xv[u][nt] + gv[nt] * acc[mb + u][nt];
    }
  }
};

template <int MT> struct EpiMoeUpT {
  bf16* act; int slot0; int nvalid;
  __device__ __forceinline__ void operator()(f32x4 (&acc)[MT][4], int mw, int nw, int g, int li) const {
#pragma unroll
    for (int mt = 0; mt < MT; ++mt) {
      const int r = mw + mt * 16 + li;
      if (r < nvalid) {
#pragma unroll
        for (int u = 0; u < 2; ++u) {
          const int hid = (nw >> 1) + u * 16 + 4 * g;
          const f32x4 a1 = acc[mt][2 * u], a3 = acc[mt][2 * u + 1];
          u32x2 o; o.x = pk2(silu_f(a1[0]) * a3[0], silu_f(a1[1]) * a3[1]); o.y = pk2(silu_f(a1[2]) * a3[2], silu_f(a1[3]) * a3[3]);
          *(u32x2*)(act + (size_t)(slot0 + r) * 512 + hid) = o;
        }
      }
    }
  }
};

template <int MT> struct EpiMoeDownT {
  const int* list; const float* gatew; bf16* ym0; bf16* ym1; int nvalid;
  __device__ __forceinline__ void operator()(f32x4 (&acc)[MT][4], int mw, int nw, int g, int li) const {
#pragma unroll
    for (int mb = 0; mb < MT; mb += 4) {
      int ent[4]; float gw[4];
#pragma unroll
      for (int mt = 0; mt < 4; ++mt) { const int r = mw + (mb + mt) * 16 + li; ent[mt] = list[r < nvalid ? r : nvalid - 1]; }
#pragma unroll
      for (int mt = 0; mt < 4; ++mt) gw[mt] = gatew[ent[mt]];
#pragma unroll
      for (int mt = 0; mt < 4; ++mt) {
        const int r = mw + (mb + mt) * 16 + li;
        if (r < nvalid) {
          bf16* y = ((ent[mt] & 1) ? ym1 : ym0) + (size_t)(ent[mt] >> 1) * D;
#pragma unroll
          for (int nt = 0; nt < 4; ++nt) {
            const int n = nw + nt * 16 + 4 * g;
            u32x2 o; o.x = pk2(acc[mb + mt][nt][0] * gw[mt], acc[mb + mt][nt][1] * gw[mt]); o.y = pk2(acc[mb + mt][nt][2] * gw[mt], acc[mb + mt][nt][3] * gw[mt]);
            *(u32x2*)(y + n) = o;
          }
        }
      }
    }
  }
};
typedef EpiMoeUpT<4> EpiMoeUp; typedef EpiMoeDownT<4> EpiMoeDown;

template <class Src, bool GATHER = false>
__device__ __forceinline__ void gemm8_stream(unsigned char* lds, const Src& src) {
  using namespace g8;
  const int nunit = src.count();
  if (nunit <= 0) return;
  const int tid = get_tid(), lane = tid & 63, wid = __builtin_amdgcn_readfirstlane(tid >> 6), wr = wid >> 2, wc = wid & 3, fr = lane & 15, fq = lane >> 4;
  const int K = src.K(), nt = K >> 6;
  unsigned oa[2][2], noa[2][2], ob[2][2];
#pragma unroll
  for (int i = 0; i < 2; ++i) {
    int R, C; stage_rc(tid * 16 + i * 8192, R, C);
    const int ra = (R >> 6) * 128 + ((R >> 4) & 3) * 16 + (R & 15);
    const int rb = (R >> 5) * 64 + ((R >> 4) & 1) * 16 + (R & 15);
#pragma unroll
    for (int hh = 0; hh < 2; ++hh) {
      if constexpr (GATHER) oa[hh][i] = src.aoff(0, ra + hh * 64) + (unsigned)C * 2u; else oa[hh][i] = (unsigned)((ra + hh * 64) * K + C) * 2u;
      noa[hh][i] = oa[hh][i];
      ob[hh][i] = (unsigned)((rb + hh * 32) * K + C) * 2u;
    }
  }
#define G8_SA(b, h) (((b) * 2 + (h)) * HT_B)
#define G8_SB(b, h) ((4 + (b) * 2 + (h)) * HT_B)
#define G8_STAGE(bufoff, BASE, O2, kt) do { _Pragma("unroll") for (int _i = 0; _i < 2; ++_i) \
    __builtin_amdgcn_global_load_lds((const void*)((BASE) + (O2)[_i] + (unsigned)(kt) * 128u), (LAS void*)(lds + (bufoff) + wid * 1024 + _i * 8192), 16, 0, 0); } while (0)
  const int aoff = lds_byte(wr * 64 + fr, fq * 8), boff = lds_byte(wc * 32 + fr, fq * 8);
#define G8_LDA(dst, b, h) do { _Pragma("unroll") for (int m = 0; m < 4; ++m) _Pragma("unroll") for (int k = 0; k < 2; ++k) dst[m][k] = *(const bf16x8*)(lds + G8_SA(b, h) + aoff + m * 2048 + k * 1024); } while (0)
#define G8_LDB(dst, b, h) do { _Pragma("unroll") for (int n = 0; n < 2; ++n) _Pragma("unroll") for (int k = 0; k < 2; ++k) dst[n][k] = *(const bf16x8*)(lds + G8_SB(b, h) + boff + n * 2048 + k * 1024); } while (0)
#define G8_MMA(ai, bj, At_, Bt_) do { __builtin_amdgcn_s_setprio(1); _Pragma("unroll") for (int m = 0; m < 4; ++m) _Pragma("unroll") for (int n = 0; n < 2; ++n) _Pragma("unroll") for (int k = 0; k < 2; ++k) \
    acc[(ai) * 4 + m][(bj) * 2 + n] = __builtin_amdgcn_mfma_f32_16x16x32_bf16(Bt_[n][k], At_[m][k], acc[(ai) * 4 + m][(bj) * 2 + n], 0, 0, 0); __builtin_amdgcn_s_setprio(0); } while (0)
#define G8_WV(n) asm volatile("s_waitcnt vmcnt(" #n ")" ::: "memory")
#define G8_WL(n) asm volatile("s_waitcnt lgkmcnt(" #n ")" ::: "memory")
#define G8_BAR __builtin_amdgcn_s_barrier()
#define G8_SCHED __builtin_amdgcn_sched_barrier(0)
  f32x4 acc[8][4];
  bf16x8 At[4][2], B0[2][2], B1[2][2];
  const char* ab = (const char*)src.abase(0); const char* bb = (const char*)src.bbase(0);
  G8_STAGE(G8_SB(0, 0), bb, ob[0], 0); G8_STAGE(G8_SB(0, 1), bb, ob[1], 0); G8_STAGE(G8_SA(0, 0), ab, oa[0], 0); G8_STAGE(G8_SA(0, 1), ab, oa[1], 0);
  if (wr == 1) G8_BAR;
  G8_WV(2); G8_BAR;
  G8_STAGE(G8_SB(1, 0), bb, ob[0], 1); G8_STAGE(G8_SA(1, 0), ab, oa[0], 1); G8_STAGE(G8_SB(1, 1), bb, ob[1], 1);
  G8_WV(6); G8_BAR;
#pragma unroll 1
  for (int u = 0; u < nunit; ++u) {
    const bool has_next = u + 1 < nunit;
    const char* nab = has_next ? (const char*)src.abase(u + 1) : ab; const char* nbb = has_next ? (const char*)src.bbase(u + 1) : bb;
    if constexpr (GATHER) {
#pragma unroll
      for (int i = 0; i < 2; ++i)
#pragma unroll
        for (int hh = 0; hh < 2; ++hh) { int R, C; stage_rc(get_tid() * 16 + i * 8192, R, C); const int ra = (R >> 6) * 128 + ((R >> 4) & 3) * 16 + (R & 15);
          noa[hh][i] = has_next ? src.aoff(u + 1, ra + hh * 64) + (unsigned)C * 2u : oa[hh][i]; }
    }
#pragma unroll
    for (int a = 0; a < 8; ++a)
#pragma unroll
      for (int b = 0; b < 4; ++b) acc[a][b] = (f32x4){0.f, 0.f, 0.f, 0.f};
#pragma unroll 1
    for (int t = 0; t < nt; t += 2) {
      const bool lastit = (t == nt - 2);
      const char* a2 = lastit ? nab : ab; const char* b2 = lastit ? nbb : bb;
      const int k2 = lastit ? 0 : t + 2, k3 = lastit ? 1 : t + 3;
      unsigned oa2[2][2];
#pragma unroll
      for (int i = 0; i < 2; ++i)
#pragma unroll
        for (int hh = 0; hh < 2; ++hh) oa2[hh][i] = (GATHER && lastit) ? noa[hh][i] : oa[hh][i];
      G8_LDB(B0, 0, 0); G8_LDB(B1, 0, 1); G8_SCHED; G8_LDA(At, 0, 0); G8_STAGE(G8_SA(1, 1), ab, oa[1], t + 1);
      G8_WV(8); G8_WL(0); G8_BAR; G8_MMA(0, 0, At, B0); G8_MMA(0, 1, At, B1); G8_BAR; G8_SCHED;
      G8_LDA(At, 0, 1); G8_STAGE(G8_SB(0, 0), b2, ob[0], k2); G8_STAGE(G8_SB(0, 1), b2, ob[1], k2); G8_STAGE(G8_SA(0, 0), a2, oa2[0], k2);
      G8_WV(8); G8_WL(0); G8_BAR; G8_MMA(1, 0, At, B0); G8_MMA(1, 1, At, B1); G8_BAR; G8_SCHED;
      G8_LDB(B0, 1, 0); G8_LDB(B1, 1, 1); G8_SCHED; G8_LDA(At, 1, 0); G8_STAGE(G8_SA(0, 1), a2, oa2[1], k2);
      G8_WV(8); G8_WL(0); G8_BAR; G8_MMA(0, 0, At, B0); G8_MMA(0, 1, At, B1); G8_BAR; G8_SCHED;
      G8_LDA(At, 1, 1); G8_STAGE(G8_SB(1, 0), b2, ob[0], k3); G8_STAGE(G8_SB(1, 1), b2, ob[1], k3); G8_STAGE(G8_SA(1, 0), a2, oa2[0], k3);
      G8_WV(8); G8_WL(0); G8_BAR; G8_MMA(1, 0, At, B0); G8_MMA(1, 1, At, B1); G8_BAR; G8_SCHED;
    }
    if (wr == 0) G8_BAR;
    src.epi(u)(acc, src.mrow(u) + wr * 128, src.ncol(u) + wc * 64, fq, fr);
    if (!has_next) break;
    ab = nab; bb = nbb;
    if (GATHER) {
#pragma unroll
      for (int i = 0; i < 2; ++i)
#pragma unroll
        for (int hh = 0; hh < 2; ++hh) oa[hh][i] = noa[hh][i];
    }
    if (wr == 1) G8_BAR;
  }
  G8_WV(0);
  G8_BAR;
#undef G8_SA
#undef G8_SB
#undef G8_STAGE
#undef G8_LDA
#undef G8_LDB
#undef G8_MMA
#undef G8_WV
#undef G8_WL
#undef G8_BAR
#undef G8_SCHED
  __syncthreads();
}

struct SrcA8 {
  const bf16* XB; const bf16* Wt; const EpiInProj<8, 4>* E; int c0, G, n;
  __device__ __forceinline__ int count() const { return n; }
  __device__ __forceinline__ int K() const { return 1024; }
  __device__ __forceinline__ const bf16* abase(int j) const { const int v = j * G + c0; return XB + (size_t)((v / 11) * 256) * 1024; }
  __device__ __forceinline__ const bf16* bbase(int j) const { const int v = j * G + c0; return Wt + (size_t)((v % 11) * 256) * 1024; }
  __device__ __forceinline__ const EpiInProj<8, 4>& epi(int) const { return *E; }
  __device__ __forceinline__ int mrow(int j) const { return ((j * G + c0) / 11) * 256; }
  __device__ __forceinline__ int ncol(int j) const { return ((j * G + c0) % 11) * 256; }
};
struct SrcC8 {
  const bf16* Y; const bf16* Wt; const struct EpiOutProj* E; int c0, G, n;
  __device__ __forceinline__ int count() const { return n; }
  __device__ __forceinline__ int K() const { return 1024; }
  __device__ __forceinline__ const bf16* abase(int j) const { const int v = j * G + c0; return Y + (size_t)((v >> 2) * 256) * 1024; }
  __device__ __forceinline__ const bf16* bbase(int j) const { const int v = j * G + c0; return Wt + (size_t)((v & 3) * 256) * 1024; }
  __device__ __forceinline__ const EpiOutProj& epi(int) const { return *E; }
  __device__ __forceinline__ int mrow(int j) const { return ((j * G + c0) >> 2) * 256; }
  __device__ __forceinline__ int ncol(int j) const { return ((j * G + c0) & 3) * 256; }
};


struct MoeU { int e, row0, nvalid, nt, slot0; };
struct SrcUp8 {
  const MoeU* d; const bf16* H; const int* list; const bf16* W; bf16* act; int n;
  __device__ __forceinline__ int count() const { return n; }
  __device__ __forceinline__ int K() const { return 1024; }
  __device__ __forceinline__ const bf16* abase(int) const { return H; }
  __device__ __forceinline__ unsigned aoff(int u, int r) const { const MoeU t = d[u]; const int rr = r < t.nvalid ? r : t.nvalid - 1; return (unsigned)(list[(size_t)t.e * NROWS + t.row0 + rr] >> 1) * 2048u; }
  __device__ __forceinline__ const bf16* bbase(int u) const { const MoeU t = d[u]; return W + (size_t)t.e * 1024 * 1024 + (size_t)(t.nt * 256) * 1024; }
  __device__ __forceinline__ EpiMoeUpT<8> epi(int u) const { const MoeU t = d[u]; return EpiMoeUpT<8>{act, t.slot0, t.nvalid}; }
  __device__ __forceinline__ int mrow(int) const { return 0; }
  __device__ __forceinline__ int ncol(int u) const { return d[u].nt * 256; }
};
struct SrcDown8 {
  const MoeU* d; const bf16* act; const int* list; const bf16* W; const float* gatew; bf16* ym0; bf16* ym1; int n;
  __device__ __forceinline__ int count() const { return n; }
  __device__ __forceinline__ int K() const { return 512; }
  __device__ __forceinline__ const bf16* abase(int u) const { return act + (size_t)d[u].slot0 * 512; }
  __device__ __forceinline__ const bf16* bbase(int u) const { const MoeU t = d[u]; return W + (size_t)t.e * 1024 * 512 + (size_t)(t.nt * 256) * 512; }
  __device__ __forceinline__ EpiMoeDownT<8> epi(int u) const { const MoeU t = d[u]; return EpiMoeDownT<8>{list + (size_t)t.e * NROWS + t.row0, gatew, ym0, ym1, t.nvalid}; }
  __device__ __forceinline__ int mrow(int) const { return 0; }
  __device__ __forceinline__ int ncol(int u) const { return d[u].nt * 256; }
};

struct ARowGather { const bf16* H; const int* list; int nvalid; __device__ __forceinline__ const bf16* operator()(int r) const { const int rr = r < nvalid ? r : nvalid - 1; return H + (size_t)(list[rr] >> 1) * D; } };
struct ARowAct { const bf16* act; int slot0; __device__ __forceinline__ const bf16* operator()(int r) const { int s = slot0 + r; s = s < 2 * NROWS ? s : 2 * NROWS - 1; return act + (size_t)s * 512; } };

template <int NQB, bool NAM, int NW>
__device__ __forceinline__ void attn_item(unsigned char* lds, int gb, int wl, int lane, const bf16* zb, int sq0, int sk, int sv, int qtok0, int lat0, int nlat, int ntiles,
                                          int drbase, bf16* Y, size_t yrow0, int ycol0, const float* mixg) {
  const int g = lane >> 4, li = lane & 15;
  const int qtok = qtok0 + 16 * wl + li;
  bf16x8 qf[NQB][2];
#pragma unroll
  for (int qb = 0; qb < NQB; ++qb)
#pragma unroll
    for (int kk = 0; kk < 2; ++kk) qf[qb][kk] = *(const bf16x8*)(zb + ((size_t)(sq0 + qb) * NT_TOK + qtok) * 64 + kk * 32 + g * 8);
  const bf16* kbp = zb + (size_t)sk * NT_TOK * 64;
  const bf16* vbp = zb + (size_t)sv * NT_TOK * 64;
  f32x4 O[4][NQB], L[NQB];
  const bf16x8 ones = {0x3f80, 0x3f80, 0x3f80, 0x3f80, 0x3f80, 0x3f80, 0x3f80, 0x3f80};
#pragma unroll
  for (int qb = 0; qb < NQB; ++qb) { L[qb] = (f32x4){0.f, 0.f, 0.f, 0.f};
#pragma unroll
    for (int db = 0; db < 4; ++db) O[db][qb] = (f32x4){0.f, 0.f, 0.f, 0.f}; }
  const int f = (li >> 1) & 7;
  const int koff = li * 128 + ((g ^ f) << 4);
  const int q_ = li >> 2, p_ = li & 3, fv = (2 * g + (q_ >> 1)) & 7;
  const int voff = (4 * g + q_) * 128 + (p_ & 1) * 8;
  const float* rpbt = (const float*)(lds + gb + 49152);
  const int qc = 16 * wl + li;
  int cs = qc - 8; cs = cs < 0 ? 0 : (cs > 48 ? 48 : cs);
#define AT_TOK(t) ((t) < nlat ? lat0 + 64 * (t) : NSEQ + 64 * ((t) - nlat))
#define AT_STAGE(t, bi) do { const int tk_ = AT_TOK(t); stage_rows<64, NW>(lds, gb + (bi) * 16384, kbp + (size_t)tk_ * 64, 64, wl, lane); \
                             stage_rows<64, NW>(lds, gb + (bi) * 16384 + 8192, vbp + (size_t)tk_ * 64, 64, wl, lane); } while (0)
#define AT_WAIT1() do { if (NW == 8) VMCNT(2); else VMCNT(4); } while (0)
  AT_STAGE(0, 0);
  if (ntiles > 1) { AT_STAGE(1, 1); AT_WAIT1(); } else { VMCNT(0); }
  RAW_BAR();
  int cur = 0;
  for (int t = 0; t < ntiles; ++t) {
    const int kb_off = gb + cur * 16384, vb_off = kb_off + 8192;
    const int pfb = cur == 0 ? 2 : cur - 1;
    if (t + 2 < ntiles) AT_STAGE(t + 2, pfb);
#pragma unroll
    for (int ks = 0; ks < 2; ++ks) {
      f32x4 s[2][NQB];
#pragma unroll
      for (int h2 = 0; h2 < 2; ++h2) {
#pragma unroll
        for (int qb = 0; qb < NQB; ++qb) s[h2][qb] = (f32x4){0.f, 0.f, 0.f, 0.f};
#pragma unroll
        for (int kk = 0; kk < 2; ++kk) {
          const bf16x8 kf = lds_frag(lds, kb_off + (((2 * ks + h2) * 2048 + koff) ^ (kk << 6)));
#pragma unroll
          for (int qb = 0; qb < NQB; ++qb) s[h2][qb] = __builtin_amdgcn_mfma_f32_16x16x32_bf16(kf, qf[qb][kk], s[h2][qb], 0, 0, 0);
        }
      }
      bf16x8 pf[NQB];
#pragma unroll
      for (int qb = 0; qb < NQB; ++qb) {
        float p[8];
#pragma unroll
        for (int h2 = 0; h2 < 2; ++h2)
#pragma unroll
          for (int j = 0; j < 4; ++j) {
            float x = s[h2][qb][j];
            if (NAM) {
              if (t < nlat) {
                const int kc = (2 * ks + h2) * 16 + 4 * g + j;
                const bool valid = (kc >= cs) && (kc < cs + 16);
                int dc = kc - qc + 15; dc = dc < 0 ? 0 : (dc > 30 ? 30 : dc);
                x += rpbt[(drbase + t) * 31 + dc];
                x = valid ? x : -1e30f;
              }
            }
            const float e = __builtin_amdgcn_exp2f(x);
            p[h2 * 4 + j] = e;
          }
        u32x4 pw; pw.x = pk2(p[0], p[1]); pw.y = pk2(p[2], p[3]); pw.z = pk2(p[4], p[5]); pw.w = pk2(p[6], p[7]);
        pf[qb] = __builtin_bit_cast(bf16x8, pw);
        L[qb] = __builtin_amdgcn_mfma_f32_16x16x32_bf16(ones, pf[qb], L[qb], 0, 0, 0);
      }
#pragma unroll
      for (int db = 0; db < 4; ++db) {
        const int a0 = vb_off + ks * 4096 + voff + (((db * 2 + (p_ >> 1)) ^ fv) << 4);
        const bf16x8 vf = lds_tr2(lds, a0, a0 + 2048);
#pragma unroll
        for (int qb = 0; qb < NQB; ++qb) O[db][qb] = __builtin_amdgcn_mfma_f32_16x16x32_bf16(vf, pf[qb], O[db][qb], 0, 0, 0);
      }
    }
    if (t + 2 < ntiles) { AT_WAIT1(); } else { VMCNT(0); }
    LGKM0(); RAW_BAR();
    cur = cur == 2 ? 0 : cur + 1;
  }
#undef AT_TOK
#undef AT_STAGE
#undef AT_WAIT1
#pragma unroll
  for (int qb = 0; qb < NQB; ++qb) {
    const float inv = 1.f / L[qb][0];
    float ss = 0.f;
#pragma unroll
    for (int db = 0; db < 4; ++db) { O[db][qb] = O[db][qb] * inv; ss += O[db][qb][0] * O[db][qb][0] + O[db][qb][1] * O[db][qb][1] + O[db][qb][2] * O[db][qb][2] + O[db][qb][3] * O[db][qb][3]; }
    ss += __shfl_xor(ss, 16); ss += __shfl_xor(ss, 32);
    const float r = rsqrtf(ss * (1.f / 64.f) + EPS);
    bf16* yp = Y + (yrow0 + 16 * wl + li) * D + ycol0 + qb * 64;
#pragma unroll
    for (int db = 0; db < 4; ++db) {
      const f32x4 gv = *(const f32x4*)(mixg + ycol0 + qb * 64 + db * 16 + 4 * g);
      const f32x4 y = O[db][qb] * r * gv;
      u32x2 o; o.x = pk2(y[0], y[1]); o.y = pk2(y[2], y[3]);
      *(u32x2*)(yp + db * 16 + 4 * g) = o;
    }
  }
}

__device__ __forceinline__ void ret_u_item(unsigned char* lds, int gb, int tg, const bf16* zb, int h, int c, float lgf2, float lgb2, float* Uf, float* Ub) {
  const int lane = tg & 63, w = __builtin_amdgcn_readfirstlane(tg >> 6), g = lane >> 4, li = lane & 15;
  const int tok0 = c < 2 ? NSEQ + 128 * c : 128 * (c - 2);
  const bf16* kp = zb + ((size_t)(S_RK + h) * NT_TOK + tok0) * 64;
  const bf16* vp = zb + ((size_t)(S_RV + h) * NT_TOK + tok0) * 64;
  stage_rows<128, 4>(lds, gb, kp, 64, w, lane);
  {
    const int row = tg >> 1, half = tg & 1;
    const float wf = __builtin_amdgcn_exp2f(lgf2 * (float)(127 - row)), wb = __builtin_amdgcn_exp2f(lgb2 * (float)row);
#pragma unroll
    for (int c4 = 0; c4 < 4; ++c4) {
      const int chunk = half * 4 + c4;
      const u32x4 v = *(const u32x4*)(vp + (size_t)row * 64 + chunk * 8);
      u32x4 of, ob;
#pragma unroll
      for (int i = 0; i < 4; ++i) { const float lo = bflo(v[i]), hi = bfhi(v[i]); of[i] = pk2(lo * wf, hi * wf); ob[i] = pk2(lo * wb, hi * wb); }
      *(u32x4*)(lds + gb + 16384 + lds_swz(row, chunk)) = of;
      *(u32x4*)(lds + gb + 32768 + lds_swz(row, chunk)) = ob;
    }
  }
  VM_WAIT(); __syncthreads();
  const int q_ = li >> 2, p_ = li & 3, fv = (2 * g + (q_ >> 1)) & 7;
  const int toff = gb + (4 * g + q_) * 128 + (p_ & 1) * 8;
  f32x4 acc[2][4];
#pragma unroll
  for (int d_ = 0; d_ < 2; ++d_)
#pragma unroll
    for (int eb = 0; eb < 4; ++eb) acc[d_][eb] = (f32x4){0.f, 0.f, 0.f, 0.f};
#pragma unroll
  for (int ks = 0; ks < 4; ++ks) {
    const int a0 = ks * 4096 + toff + (((w * 2 + (p_ >> 1)) ^ fv) << 4);
    const bf16x8 kf = lds_tr2(lds, a0, a0 + 2048);
#pragma unroll
    for (int eb = 0; eb < 4; ++eb) {
      const int b0 = ks * 4096 + toff + (((eb * 2 + (p_ >> 1)) ^ fv) << 4);
      const bf16x8 vf = lds_tr2(lds, 16384 + b0, 16384 + b0 + 2048);
      const bf16x8 vb = lds_tr2(lds, 32768 + b0, 32768 + b0 + 2048);
      acc[0][eb] = __builtin_amdgcn_mfma_f32_16x16x32_bf16(kf, vf, acc[0][eb], 0, 0, 0);
      acc[1][eb] = __builtin_amdgcn_mfma_f32_16x16x32_bf16(kf, vb, acc[1][eb], 0, 0, 0);
    }
  }
#pragma unroll
  for (int eb = 0; eb < 4; ++eb) {
    *(f32x4*)(Uf + (eb * 16 + li) * 64 + w * 16 + 4 * g) = acc[0][eb];
    *(f32x4*)(Ub + (eb * 16 + li) * 64 + w * 16 + 4 * g) = acc[1][eb];
  }
  __syncthreads();
}

__device__ __forceinline__ void ret_out_item(unsigned char* lds, int gb, int tg, const bf16* zb, int h, int c, float lgf2, float lgb2, const float* Sf, const float* Sb,
                                             bf16* Y, size_t yrow0, const float* mixg) {
  const int lane = tg & 63, w = __builtin_amdgcn_readfirstlane(tg >> 6), g = lane >> 4, li = lane & 15;
  const int tok0 = c < 2 ? NSEQ + 128 * c : 128 * (c - 2);
  const bf16* qp = zb + ((size_t)(S_RQ + h) * NT_TOK + tok0) * 64;
  const bf16* kp = zb + ((size_t)(S_RK + h) * NT_TOK + tok0) * 64;
  const bf16* vp = zb + ((size_t)(S_RV + h) * NT_TOK + tok0) * 64;
  const bf16* gp = zb + ((size_t)(S_RG + h) * NT_TOK + tok0) * 64;
  stage_rows<128, 4>(lds, gb, kp, 64, w, lane);
  stage_rows<128, 4>(lds, gb + 16384, vp, 64, w, lane);
  {
    const int e = tg >> 2, dq = tg & 3;
#pragma unroll
    for (int hh = 0; hh < 2; ++hh) {
      const f32x4 a0 = *(const f32x4*)(Sf + e * 64 + dq * 16 + hh * 8), a1 = *(const f32x4*)(Sf + e * 64 + dq * 16 + hh * 8 + 4);
      const f32x4 b0 = *(const f32x4*)(Sb + e * 64 + dq * 16 + hh * 8), b1 = *(const f32x4*)(Sb + e * 64 + dq * 16 + hh * 8 + 4);
      u32x4 oa, ob; oa.x = pk2(a0[0], a0[1]); oa.y = pk2(a0[2], a0[3]); oa.z = pk2(a1[0], a1[1]); oa.w = pk2(a1[2], a1[3]);
      ob.x = pk2(b0[0], b0[1]); ob.y = pk2(b0[2], b0[3]); ob.z = pk2(b1[0], b1[1]); ob.w = pk2(b1[2], b1[3]);
      *(u32x4*)(lds + gb + 32768 + lds_swz(e, dq * 2 + hh)) = oa;
      *(u32x4*)(lds + gb + 40960 + lds_swz(e, dq * 2 + hh)) = ob;
    }
  }
  bf16x8 qf[2][2];
#pragma unroll
  for (int ib = 0; ib < 2; ++ib)
#pragma unroll
    for (int kk = 0; kk < 2; ++kk) qf[ib][kk] = *(const bf16x8*)(qp + (size_t)(32 * w + 16 * ib + li) * 64 + kk * 32 + g * 8);
  VM_WAIT(); __syncthreads();
  const int f = (li >> 1) & 7;
  const int koff = gb + li * 128 + ((g ^ f) << 4);
  const int q_ = li >> 2, p_ = li & 3, fv = (2 * g + (q_ >> 1)) & 7;
  const int voff = gb + 16384 + (4 * g + q_) * 128 + (p_ & 1) * 8;
  f32x4 O[4][2], CF[4][2], CB[4][2];
#pragma unroll
  for (int eb = 0; eb < 4; ++eb)
#pragma unroll
    for (int ib = 0; ib < 2; ++ib) { O[eb][ib] = (f32x4){0.f, 0.f, 0.f, 0.f}; CF[eb][ib] = O[eb][ib]; CB[eb][ib] = O[eb][ib]; }
#pragma unroll
  for (int ks = 0; ks < 4; ++ks) {
    f32x4 s[2][2];
#pragma unroll
    for (int h2 = 0; h2 < 2; ++h2) {
      s[h2][0] = (f32x4){0.f, 0.f, 0.f, 0.f}; s[h2][1] = s[h2][0];
#pragma unroll
      for (int kk = 0; kk < 2; ++kk) {
        const bf16x8 kf = lds_frag(lds, ((2 * ks + h2) * 2048 + koff) ^ (kk << 6));
        s[h2][0] = __builtin_amdgcn_mfma_f32_16x16x32_bf16(kf, qf[0][kk], s[h2][0], 0, 0, 0);
        s[h2][1] = __builtin_amdgcn_mfma_f32_16x16x32_bf16(kf, qf[1][kk], s[h2][1], 0, 0, 0);
      }
    }
    bf16x8 pf[2];
#pragma unroll
    for (int ib = 0; ib < 2; ++ib) {
      const int i = 32 * w + 16 * ib + li;
      float p[8];
#pragma unroll
      for (int h2 = 0; h2 < 2; ++h2)
#pragma unroll
        for (int j = 0; j < 4; ++j) {
          const int jj = (2 * ks + h2) * 16 + 4 * g + j, df = i - jj;
          const float dw = df > 0 ? __builtin_amdgcn_exp2f(lgf2 * (float)df) : (df < 0 ? __builtin_amdgcn_exp2f(lgb2 * (float)(-df)) : 2.f);
          p[h2 * 4 + j] = s[h2][ib][j] * dw;
        }
      u32x4 pw; pw.x = pk2(p[0], p[1]); pw.y = pk2(p[2], p[3]); pw.z = pk2(p[4], p[5]); pw.w = pk2(p[6], p[7]);
      pf[ib] = __builtin_bit_cast(bf16x8, pw);
    }
#pragma unroll
    for (int eb = 0; eb < 4; ++eb) {
      const int a0 = voff + ks * 4096 + (((eb * 2 + (p_ >> 1)) ^ fv) << 4);
      const bf16x8 vf = lds_tr2(lds, a0, a0 + 2048);
      O[eb][0] = __builtin_amdgcn_mfma_f32_16x16x32_bf16(vf, pf[0], O[eb][0], 0, 0, 0);
      O[eb][1] = __builtin_amdgcn_mfma_f32_16x16x32_bf16(vf, pf[1], O[eb][1], 0, 0, 0);
    }
  }
#pragma unroll
  for (int kk = 0; kk < 2; ++kk)
#pragma unroll
    for (int eb = 0; eb < 4; ++eb) {
      const bf16x8 sf = lds_frag(lds, 32768 + ((eb * 2048 + koff) ^ (kk << 6)));
      const bf16x8 sb = lds_frag(lds, 40960 + ((eb * 2048 + koff) ^ (kk << 6)));
#pragma unroll
      for (int ib = 0; ib < 2; ++ib) {
        CF[eb][ib] = __builtin_amdgcn_mfma_f32_16x16x32_bf16(sf, qf[ib][kk], CF[eb][ib], 0, 0, 0);
        CB[eb][ib] = __builtin_amdgcn_mfma_f32_16x16x32_bf16(sb, qf[ib][kk], CB[eb][ib], 0, 0, 0);
      }
    }
#pragma unroll
  for (int ib = 0; ib < 2; ++ib) {
    const int i = 32 * w + 16 * ib + li;
    const float xf = __builtin_amdgcn_exp2f(lgf2 * (float)(i + 1)), xb = __builtin_amdgcn_exp2f(lgb2 * (float)(128 - i));
    float ss = 0.f;
#pragma unroll
    for (int eb = 0; eb < 4; ++eb) { O[eb][ib] = O[eb][ib] + CF[eb][ib] * xf + CB[eb][ib] * xb; ss += O[eb][ib][0] * O[eb][ib][0] + O[eb][ib][1] * O[eb][ib][1] + O[eb][ib][2] * O[eb][ib][2] + O[eb][ib][3] * O[eb][ib][3]; }
    ss += __shfl_xor(ss, 16); ss += __shfl_xor(ss, 32);
    const float r = rsqrtf(ss * (1.f / 64.f) + EPS);
    bf16* yp = Y + (yrow0 + i) * D + 640 + h * 64;
#pragma unroll
    for (int eb = 0; eb < 4; ++eb) {
      const f32x4 gv = *(const f32x4*)(mixg + 640 + h * 64 + eb * 16 + 4 * g);
      const u32x2 gg = *(const u32x2*)(gp + (size_t)i * 64 + eb * 16 + 4 * g);
      const f32x4 y = O[eb][ib] * r * gv;
      u32x2 o; o.x = pk2(y[0] * bflo(gg.x), y[1] * bfhi(gg.x)); o.y = pk2(y[2] * bflo(gg.y), y[3] * bfhi(gg.y));
      *(u32x2*)(yp + eb * 16 + 4 * g) = o;
    }
  }
  __syncthreads();
}

__device__ __forceinline__ float log_sigmoid_f(float x) { return x >= 0.f ? -log1pf(expf(-x)) : x - log1pf(expf(x)); }

__device__ __forceinline__ void p0_mod_item(unsigned char* lds, const Params& P, int item) {
  const int l = item / 96, chunk = item % 96, tid = get_tid(), ks = tid >> 4, cg4 = tid & 15;
  float* red = (float*)lds;
  float* sil = (float*)(lds + 32768);
#pragma unroll
  for (int i = 0; i < 2; ++i) { const int k = tid + 512 * i; sil[k] = silu_f(P.c[k]); sil[1024 + k] = silu_f(P.c[1024 + k]); sil[2048 + k] = silu_f(P.c_ctx[k]); }
  __syncthreads();
  const float* wa = P.w_ada + (size_t)l * 1024 * 6144 + chunk * 64 + cg4 * 4;
  f32x4 a0 = {0.f, 0.f, 0.f, 0.f}, a1 = a0, a2 = a0;
#pragma unroll 16
  for (int i = 0; i < 32; ++i) {
    const int k = ks * 32 + i;
    const f32x4 wv = __builtin_nontemporal_load((const f32x4*)(wa + (size_t)k * 6144));
    a0 += wv * sil[k]; a1 += wv * sil[1024 + k]; a2 += wv * sil[2048 + k];
  }
  *(f32x4*)(red + (ks * 3 + 0) * 64 + cg4 * 4) = a0; *(f32x4*)(red + (ks * 3 + 1) * 64 + cg4 * 4) = a1; *(f32x4*)(red + (ks * 3 + 2) * 64 + cg4 * 4) = a2;
  __syncthreads();
  if (tid < 192) {
    const int seg = tid >> 6, col = tid & 63; float s = P.b_ada[l * 6144 + chunk * 64 + col];
#pragma unroll
    for (int k2 = 0; k2 < 32; ++k2) s += red[(k2 * 3 + seg) * 64 + col];
    ((float*)(P.ws + WS_MOD))[(l * 3 + seg) * 6144 + chunk * 64 + col] = s;
  }
  __syncthreads();
}

__device__ __forceinline__ void p0_tr_item(unsigned char* lds, const float* src, int srcN, int k0, int n0, bf16* dst, int dstK, int mode) {
  float* tile = (float*)lds;
  const int tid = get_tid();
  f32x4 v[8];
#pragma unroll
  for (int ps = 0; ps < 8; ++ps) v[ps] = __builtin_nontemporal_load((const f32x4*)(src + (size_t)(k0 + (tid >> 5) + 16 * ps) * srcN + n0 + (tid & 31) * 4));
#pragma unroll
  for (int ps = 0; ps < 8; ++ps) { float* tp = tile + ((tid >> 5) + 16 * ps) * 129 + (tid & 31) * 4; tp[0] = v[ps][0]; tp[1] = v[ps][1]; tp[2] = v[ps][2]; tp[3] = v[ps][3]; }
  __syncthreads();
  const int n = tid >> 2, kc = tid & 3, ncol = n0 + n;
  int row = ncol;
  if (mode) row = (ncol >> 4) * 32 + (ncol & 15) + (mode == 2 ? 16 : 0);
  bf16* dp = dst + (size_t)row * dstK + k0 + kc * 32;
  const float* tp = tile + (kc * 32) * 129 + n;
#pragma unroll
  for (int q = 0; q < 4; ++q) {
    u32x4 o;
#pragma unroll
    for (int i = 0; i < 4; ++i) o[i] = pk2(tp[(q * 8 + 2 * i) * 129], tp[(q * 8 + 2 * i + 1) * 129]);
    *(u32x4*)(dp + q * 8) = o;
  }
  __syncthreads();
}

constexpr int P0_MOD = 192, P0_MISC = 1, P0_WIN = 2 * 8 * 23, P0_WO = 2 * 8 * 8, P0_W1 = 32 * 32, P0_W2 = 32 * 32;
constexpr int P0_ITEMS = P0_MOD + P0_MISC + P0_WIN + P0_WO + 2 * P0_W1 + P0_W2;

__device__ __forceinline__ void phase0(unsigned char* lds, const Params& P) {
#pragma unroll 1
  for (int it = blockIdx.x; it < P0_ITEMS; it += gridDim.x) {
    int r = it;
    if (r < P0_MOD) { p0_mod_item(lds, P, r); continue; } r -= P0_MOD;
    if (r < P0_MISC) {
      const int tid = get_tid();
      float* rope = (float*)(P.ws + WS_ROPE);
      for (int e = tid; e < 2048; e += NTHR) { const int pos = e >> 4, f = e & 15; const float inv = powf(10000.f, -(float)f / 16.f); const float ang = (float)pos * inv; rope[e * 2] = cosf(ang); rope[e * 2 + 1] = sinf(ang); }
      continue;
    } r -= P0_MISC;
    const float* src; int srcN, k0, n0, dstK, mode; bf16* dst;
    if (r < P0_WIN) { const int l = r / 184, q = r % 184, kt = q / 23, nt = q % 23;
      src = P.w_in + (size_t)l * 1024 * INC; srcN = INC; k0 = kt * 128; n0 = nt * 128; dst = (bf16*)(P.ws + WS_WIN) + (size_t)l * INC * 1024; dstK = 1024; mode = 0; }
    else if (r < P0_WIN + P0_WO) { const int r2 = r - P0_WIN, l = r2 / 64, q = r2 % 64, kt = q / 8, nt = q % 8;
      src = P.w_out + (size_t)l * 1024 * 1024; srcN = 1024; k0 = kt * 128; n0 = nt * 128; dst = (bf16*)(P.ws + WS_WO) + (size_t)l * 1024 * 1024; dstK = 1024; mode = 0; }
    else if (r < P0_WIN + P0_WO + 2 * P0_W1) { const int r2 = r - P0_WIN - P0_WO, which = r2 / P0_W1, q2 = r2 % P0_W1, le = q2 / 32, q = q2 % 32, kt = q / 4, nt = q % 4;
      src = (which ? P.w3 : P.w1) + (size_t)le * 1024 * 512; srcN = 512; k0 = kt * 128; n0 = nt * 128; dst = (bf16*)(P.ws + WS_W13) + (size_t)le * 1024 * 1024; dstK = 1024; mode = which ? 2 : 1; }
    else { const int r2 = r - P0_WIN - P0_WO - 2 * P0_W1, le = r2 / 32, q = r2 % 32, kt = q / 8, nt = q % 8;
      src = P.w2 + (size_t)le * 512 * 1024; srcN = 1024; k0 = kt * 128; n0 = nt * 128; dst = (bf16*)(P.ws + WS_W2) + (size_t)le * 1024 * 512; dstK = 512; mode = 0; }
    p0_tr_item(lds, src, srcN, k0, n0, dst, dstK, mode);
  }
}

constexpr int P1_XB = NROWS / 16, P1_BIAS = 2 * INC / 8, P1_WR = 6, P1_ITEMS = P1_XB + P1_BIAS + P1_WR;
__device__ __forceinline__ void phase1(unsigned char* lds, const Params& P) {
  const int tid = get_tid(), lane = tid & 63, w = tid >> 6;
  const float* mod = (const float*)(P.ws + WS_MOD);
#pragma unroll 1
  for (int it = blockIdx.x; it < P1_ITEMS; it += gridDim.x) {
    int r = it;
    if (r < P1_XB) {
      f32x4 v[2][4];
#pragma unroll
      for (int u = 0; u < 2; ++u) { const int row = r * 16 + 2 * w + u; const float* xr = row < NLAT ? P.x + (size_t)row * D : P.ctx + (size_t)(row - NLAT) * D;
#pragma unroll
        for (int j = 0; j < 4; ++j) v[u][j] = __builtin_nontemporal_load((const f32x4*)(xr + 4 * lane + 256 * j)); }
      const int row0 = r * 16 + 2 * w, seg = row0 < NSEQ ? 0 : (row0 < NLAT ? 1 : 2);
      const float* sc1 = mod + (0 * 3 + seg) * 6144 + 1024;
      f32x4 gs[4];
#pragma unroll
      for (int j = 0; j < 4; ++j) { const int k = 4 * lane + 256 * j; gs[j] = *(const f32x4*)(P.n1g + k) * (*(const f32x4*)(sc1 + k) + 1.f); }
#pragma unroll
      for (int u = 0; u < 2; ++u) {
        const int row = row0 + u; bf16* xb = (bf16*)(P.ws + WS_R1) + (size_t)row * D; float ss = 0.f;
#pragma unroll
        for (int j = 0; j < 4; ++j) { const f32x4 x = v[u][j]; ss += x[0] * x[0] + x[1] * x[1] + x[2] * x[2] + x[3] * x[3]; const f32x4 o = x * gs[j]; u32x2 ov; ov.x = pk2(o[0], o[1]); ov.y = pk2(o[2], o[3]); *(u32x2*)(xb + 4 * lane + 256 * j) = ov; }
        ss = wsum(ss);
        if (lane == 0) ((float*)(P.ws + WS_RSS))[row] = ss;
      }
      continue;
    } r -= P1_XB;
    if (r < P1_BIAS) {
      const int idx = r * 8 + w, l = idx / INC, n = idx % INC;
      const bf16* wrow = (const bf16*)(P.ws + WS_WIN) + ((size_t)l * INC + n) * 1024 + lane * 16;
      const u32x4 w0 = *(const u32x4*)wrow, w1 = *(const u32x4*)(wrow + 8);
      float wv[16];
#pragma unroll
      for (int i = 0; i < 4; ++i) { wv[2 * i] = bflo(w0[i]); wv[2 * i + 1] = bfhi(w0[i]); wv[8 + 2 * i] = bflo(w1[i]); wv[8 + 2 * i + 1] = bfhi(w1[i]); }
#pragma unroll
      for (int seg = 0; seg < 3; ++seg) {
        const float* sh = mod + (l * 3 + seg) * 6144 + lane * 16; float a = 0.f;
#pragma unroll
        for (int i = 0; i < 16; ++i) a += wv[i] * sh[i];
        a = wsum(a);
        if (lane == 0) ((float*)(P.ws + WS_BIAS))[(l * 3 + seg) * INC + n] = a;
      }
      continue;
    } r -= P1_BIAS;
    { const int l = r / 3, seg = r % 3;
      const float* m = mod + (l * 3 + seg) * 6144;
      float* wr = (float*)(P.ws + WS_WR) + (size_t)(l * 3 + seg) * 16384;
      for (int e = tid; e < 16384; e += NTHR) { const int k = e >> 4; wr[e] = P.n2g[l * 1024 + k] * (1.f + m[4096 + k]) * P.w_router[e]; }
      const int ex = tid & 15, ks = tid >> 4; float a = 0.f;
      for (int i = 0; i < 32; ++i) { const int k = ks * 32 + i; a += m[3072 + k] * P.w_router[k * 16 + ex]; }
      float* red = (float*)lds; red[ks * 16 + ex] = a; __syncthreads();
      if (tid < 16) { float s = P.b_router[tid]; for (int k2 = 0; k2 < 32; ++k2) s += red[k2 * 16 + tid]; ((float*)(P.ws + WS_CR))[(l * 3 + seg) * 16 + tid] = s; }
      __syncthreads();
    }
  }
}

__device__ __forceinline__ int xcd_vidx(int round) {
  const int G = gridDim.x, b = blockIdx.x;
  return (G & 7) == 0 ? round * G + (b & 7) * (G >> 3) + (b >> 3) : round * G + b;
}

__device__ __forceinline__ void phaseA(unsigned char* lds, const Params& P, int l) {
  const bf16* XB = (const bf16*)(P.ws + WS_R1);
  const bf16* Wt = (const bf16*)(P.ws + WS_WIN) + (size_t)l * INC * 1024;
  { const int tid = get_tid(); const f32x4* s4 = (const f32x4*)(P.ws + WS_ROPE); f32x4* d4 = (f32x4*)(lds + LDS_MISC);
    for (int e = tid; e < 1024; e += NTHR) d4[e] = s4[e];
    __syncthreads(); }
  const float* ropel = (const float*)(lds + LDS_MISC);
  EpiInProj<8, 4> E4{(const float*)(P.ws + WS_RSS), (const float*)(P.ws + WS_BIAS) + l * 3 * INC, P.qg + l * 64, P.kg + l * 64, ropel, (bf16*)(P.ws + WS_Z)};
  EpiInProj<8, 2> E2{(const float*)(P.ws + WS_RSS), (const float*)(P.ws + WS_BIAS) + l * 3 * INC, P.qg + l * 64, P.kg + l * 64, ropel, (bf16*)(P.ws + WS_Z)};
  constexpr int NFULL = 66 * 11, NITEM = NFULL + 33;
  const int c0 = xcd_vidx(0), G = gridDim.x;
  const int nfull = c0 < NFULL ? (NFULL - c0 + G - 1) / G : 0;
  { SrcA8 S{XB, Wt, &E4, c0, G, nfull};
    gemm8_stream(lds, S); }
#pragma unroll 1
  for (int v = c0 + nfull * G; v < NITEM; v += G) {
    if (v < NFULL) continue;
    const int m2 = (v - NFULL) * 2;
#pragma unroll 1
    for (int h = 0; h < 2; ++h) { ARowLinear ar{XB, 1024, (m2 + h) * 256}; gemm_tile<8, 2>(lds, ar, Wt, 1024, (m2 + h) * 256, 2816, E2); }
  }
}

__device__ __forceinline__ void phaseB(unsigned char* lds, const Params& P, int l) {
  const bool ctxout = (l == 0);
  const bf16* Z = (const bf16*)(P.ws + WS_Z);
  bf16* Y = (bf16*)P.out;
  const float* mixg = P.mix_g + l * 1024;
  const int tid = get_tid(), lane = tid & 63, w = __builtin_amdgcn_readfirstlane(tid >> 6), grp = w >> 2, wl4 = w & 3, tg = tid & 255, G = gridDim.x;
  { const int n = 256 + (ctxout ? 8 : 0);
#pragma unroll 1
    for (int r = blockIdx.x; r < n; r += G) {
      int b, kvh, qtok0, nlat, ntiles; size_t yrow0;
      if (r < 256) { b = r >> 7; kvh = (r >> 6) & 1; const int qt = r & 63; qtok0 = qt * 128; nlat = 128; ntiles = 132; yrow0 = (size_t)b * NSEQ + qt * 128; }
      else { const int q = r - 256; b = q >> 2; kvh = (q >> 1) & 1; const int qt = q & 1; qtok0 = NSEQ + qt * 128; nlat = 0; ntiles = 4; yrow0 = (size_t)NLAT + b * CL + qt * 128; }
      attn_item<3, false, 8>(lds, 0, w, lane, Z + (size_t)b * NSLOT * NT_TOK * 64, S_AQ + kvh * 3, S_AK + kvh, S_AV + kvh, qtok0, 0, nlat, ntiles, 0, Y, yrow0, kvh * 192, mixg);
    }
  }
  { const int n = 1024 + (ctxout ? 32 : 0);
    int start = (int)blockIdx.x - 8; if (start < 0) start += G;
#pragma unroll 1
    for (int pr = start; pr * 2 < n; pr += G) {
      const int r = pr * 2 + grp;
      int b, h, qtok0, lat0, nlat, ntiles, drbase; size_t yrow0;
      if (r < 1024) { b = r >> 9; h = (r >> 7) & 3; const int row = r & 127; int rs = row - 4; rs = rs < 0 ? 0 : (rs > 120 ? 120 : rs);
        qtok0 = row * 64; lat0 = rs * 64; nlat = 8; ntiles = 12; drbase = rs - row + 7; yrow0 = (size_t)b * NSEQ + row * 64; }
      else { const int q = r - 1024; b = q >> 4; h = (q >> 2) & 3; const int qt = q & 3; qtok0 = NSEQ + qt * 64; lat0 = 0; nlat = 0; ntiles = 4; drbase = 0; yrow0 = (size_t)NLAT + b * CL + qt * 64; }
      float* rp = (float*)(lds + grp * 65536 + 49152);
      const float* src = P.rpb + ((size_t)l * 4 + h) * 465;
      for (int e = tg; e < 465; e += 256) rp[e] = src[e] * LOG2E;
      __syncthreads();
      attn_item<1, true, 4>(lds, grp * 65536, wl4, lane, Z + (size_t)b * NSLOT * NT_TOK * 64, S_NQ + h, S_NK + h, S_NV + h, qtok0, lat0, nlat, ntiles, drbase, Y, yrow0, 384 + h * 64, mixg);
    }
  }
  { int start = (int)blockIdx.x - 40; if (start < 0) start += G;
#pragma unroll 1
    for (int pr = start; pr * 2 < 2 * 6 * 66; pr += G) {
      const int r = pr * 2 + grp;
      const int b = r / 396, q = r % 396, h = q / 66, c = q % 66;
      const float lgf2 = log_sigmoid_f(P.ret_decay[(l * 2 + 0) * 6 + h]) * LOG2E, lgb2 = log_sigmoid_f(P.ret_decay[(l * 2 + 1) * 6 + h]) * LOG2E;
      float* U = (float*)(P.ws + WS_R1);
      ret_u_item(lds, grp * 65536, tg, Z + (size_t)b * NSLOT * NT_TOK * 64, h, c, lgf2, lgb2, U + ((size_t)((b * 6 + h) * 2 + 0) * 66 + c) * 4096, U + ((size_t)((b * 6 + h) * 2 + 1) * 66 + c) * 4096);
    }
  }
}

__device__ __forceinline__ void phaseB2(const Params& P, int l) {
  const float* U = (const float*)(P.ws + WS_R1);
#pragma unroll 1
  for (int it = blockIdx.x; it < 192; it += gridDim.x) {
    const int seq = it >> 3, off = (it & 7) * 512 + get_tid();
    const int dir = seq & 1, h = (seq >> 1) % 6;
    const float lg = log_sigmoid_f(P.ret_decay[(l * 2 + dir) * 6 + h]);
    const float decay = expf(128.f * lg);
    const float* base = U + (size_t)seq * 66 * 4096 + off;
    float* sbase = (float*)((unsigned char*)P.out + S_OFF) + (size_t)seq * 66 * 4096 + off;
    float u[66];
    if (dir == 0) {
#pragma unroll
      for (int st = 0; st < 66; ++st) u[st] = __builtin_nontemporal_load(base + (size_t)st * 4096);
      float s = 0.f;
#pragma unroll
      for (int st = 0; st < 66; ++st) { sbase[(size_t)st * 4096] = s; s = s * decay + u[st]; }
    } else {
#pragma unroll
      for (int st = 0; st < 66; ++st) { const int c = st < 2 ? 1 - st : 67 - st; u[st] = __builtin_nontemporal_load(base + (size_t)c * 4096); }
      float s = 0.f;
#pragma unroll
      for (int st = 0; st < 66; ++st) { const int c = st < 2 ? 1 - st : 67 - st; sbase[(size_t)c * 4096] = s; s = s * decay + u[st]; }
    }
  }
}

__device__ __forceinline__ void phaseB3(unsigned char* lds, const Params& P, int l) {
  const bf16* Z = (const bf16*)(P.ws + WS_Z);
  bf16* Y = (bf16*)P.out;
  const float* mixg = P.mix_g + l * 1024;
  const float* U = (const float*)((const unsigned char*)P.out + S_OFF);
  const int tid = get_tid(), grp = __builtin_amdgcn_readfirstlane(tid >> 8), tg = tid & 255;
  const int cpb = (l == 0) ? 66 : 64, total = 2 * 6 * cpb;
#pragma unroll 1
  for (int pr = blockIdx.x; pr * 2 < total; pr += gridDim.x) {
    const int it = pr * 2 + grp;
    const int b = it / (6 * cpb), q = it % (6 * cpb), h = q / cpb, c = (q % cpb) + (66 - cpb);
    const float lgf2 = log_sigmoid_f(P.ret_decay[(l * 2 + 0) * 6 + h]) * LOG2E, lgb2 = log_sigmoid_f(P.ret_decay[(l * 2 + 1) * 6 + h]) * LOG2E;
    const size_t yrow0 = c < 2 ? (size_t)NLAT + b * CL + 128 * c : (size_t)b * NSEQ + 128 * (c - 2);
    ret_out_item(lds, grp * 65536, tg, Z + (size_t)b * NSLOT * NT_TOK * 64, h, c, lgf2, lgb2, U + ((size_t)((b * 6 + h) * 2 + 0) * 66 + c) * 4096, U + ((size_t)((b * 6 + h) * 2 + 1) * 66 + c) * 4096, Y, yrow0, mixg);
  }
}

__device__ __forceinline__ void pc_small_item(const Params& P, int l, int item) {
  const int tid = get_tid(), lane = tid & 63, w = tid >> 6, g = lane >> 4, li = lane & 15;
  const bf16* Y = (const bf16*)P.out;
  const bf16* Wt = (const bf16*)(P.ws + WS_WO) + (size_t)l * 1024 * 1024;
  float* XR = (float*)(P.ws + WS_XR);
  const int mb = item >> 5, nb = item & 31;
  const int m0 = NLAT + mb * 64 + (w >> 1) * 16, n0 = nb * 32 + (w & 1) * 16;
  const bf16* ar = Y + (size_t)(m0 + li) * D + g * 8;
  const bf16* br = Wt + (size_t)(n0 + li) * D + g * 8;
  f32x4 acc = {0.f, 0.f, 0.f, 0.f};
#pragma unroll 1
  for (int kb = 0; kb < 32; kb += 8) {
    bf16x8 af[8], bf[8];
#pragma unroll
    for (int c = 0; c < 8; ++c) { af[c] = *(const bf16x8*)(ar + (kb + c) * 32); bf[c] = *(const bf16x8*)(br + (kb + c) * 32); }
#pragma unroll
    for (int c = 0; c < 8; ++c) acc = __builtin_amdgcn_mfma_f32_16x16x32_bf16(bf[c], af[c], acc, 0, 0, 0);
  }
  const int m = m0 + li, n = n0 + 4 * g;
  const float* gt = (const float*)(P.ws + WS_MOD) + (l * 3 + 2) * 6144 + 2048;
  const f32x4 xv = *(const f32x4*)(P.ctx + (size_t)(m - NLAT) * D + n), gv = *(const f32x4*)(gt + n);
  *(f32x4*)(XR + (size_t)m * D + n) = xv + gv * acc;
}
__device__ __forceinline__ void phaseC(unsigned char* lds, const Params& P, int l) {
  const bf16* Y = (const bf16*)P.out;
  const bf16* Wt = (const bf16*)(P.ws + WS_WO) + (size_t)l * 1024 * 1024;
  float* XR = (float*)(P.ws + WS_XR);
  EpiOutProj E{l == 0 ? P.x : XR, l == 0 ? P.ctx : XR + (size_t)NLAT * D, (const float*)(P.ws + WS_MOD) + l * 3 * 6144, XR};
  const int nitem = NLAT / 256 * 4;
  { const int c0 = xcd_vidx(0), G = gridDim.x;
    SrcC8 S{Y, Wt, &E, c0, G, c0 < nitem ? (nitem - c0 + G - 1) / G : 0};
    gemm8_stream(lds, S); }
  if (l == 0) {
#pragma unroll 1
    for (int it = blockIdx.x; it < 256; it += gridDim.x) pc_small_item(P, l, it);
  }
}

__device__ __forceinline__ void phaseD(unsigned char* lds, const Params& P, int l) {
  const int tid = get_tid(), lane = tid & 63, w = tid >> 6, g = lane >> 4, li = lane & 15;
  const float* XR = (const float*)(P.ws + WS_XR);
  bf16* H2 = (bf16*)(P.ws + WS_R1);
  int* cnt = (int*)(P.ws + WS_CNT) + l * 16;
  int* list = (int*)(P.ws + WS_LIST) + (size_t)l * 16 * NROWS;
  float* gatew = (float*)(P.ws + WS_GATEW);
  float* part = (float*)lds;
  float* ssqp = part + 2048;
  float* rsl = ssqp + 128;
  int* hist = (int*)(rsl + 64);
  const int nitems = NLAT / 64 + (l == 0 ? 32 : 0);
  const int rgp = w >> 1, kh = w & 1;
#pragma unroll 1
  for (int it = blockIdx.x; it < nitems; it += gridDim.x) {
    const int nrows = it < NLAT / 64 ? 64 : 16;
    const int r0 = it < NLAT / 64 ? it * 64 : NLAT + (it - NLAT / 64) * 16, seg = r0 < NSEQ ? 0 : (r0 < NLAT ? 1 : 2);
    const bool active = rgp * 16 < nrows;
    const float* wr = (const float*)(P.ws + WS_WR) + (size_t)(l * 3 + seg) * 16384;
    const float* xrow = XR + (size_t)(r0 + (active ? rgp * 16 : 0) + li) * D + 512 * kh + 4 * g;
    const float* wp0 = wr + (size_t)(512 * kh + 4 * g) * 16 + li;
    if (tid < 32) hist[tid] = 0;
    f32x4 acc = {0.f, 0.f, 0.f, 0.f}; float ssq = 0.f;
#pragma unroll 1
    for (int cb = 0; cb < (active ? 32 : 0); cb += 8) {
      f32x4 xv[8]; float bw[8][4];
#pragma unroll
      for (int c = 0; c < 8; ++c) {
        xv[c] = *(const f32x4*)(xrow + 16 * (cb + c));
        const float* wp = wp0 + (cb + c) * 256;
        bw[c][0] = wp[0]; bw[c][1] = wp[16]; bw[c][2] = wp[32]; bw[c][3] = wp[48];
      }
#pragma unroll
      for (int c = 0; c < 8; ++c) {
        ssq += xv[c][0] * xv[c][0] + xv[c][1] * xv[c][1] + xv[c][2] * xv[c][2] + xv[c][3] * xv[c][3];
        acc = __builtin_amdgcn_mfma_f32_16x16x4f32(xv[c][0], bw[c][0], acc, 0, 0, 0);
        acc = __builtin_amdgcn_mfma_f32_16x16x4f32(xv[c][1], bw[c][1], acc, 0, 0, 0);
        acc = __builtin_amdgcn_mfma_f32_16x16x4f32(xv[c][2], bw[c][2], acc, 0, 0, 0);
        acc = __builtin_amdgcn_mfma_f32_16x16x4f32(xv[c][3], bw[c][3], acc, 0, 0, 0);
      }
    }
    ssq += __shfl_xor(ssq, 16); ssq += __shfl_xor(ssq, 32);
#pragma unroll
    for (int j = 0; j < 4; ++j) part[(w * 16 + 4 * g + j) * 16 + li] = acc[j];
    if (g == 0) ssqp[w * 16 + li] = ssq;
    __syncthreads();
    int e1 = 0, e2 = 0, q1 = 0, q2 = 0; float g1 = 0.f, g2 = 0.f;
    if (tid < nrows) {
      const int rg2 = tid >> 4, rr = tid & 15;
      const float ss = ssqp[(2 * rg2) * 16 + rr] + ssqp[(2 * rg2 + 1) * 16 + rr];
      const float rs = rsqrtf(ss * (1.f / 1024.f) + EPS);
      rsl[tid] = rs;
      const float* cr = (const float*)(P.ws + WS_CR) + (l * 3 + seg) * 16;
      float lg[16]; float mx = -1e30f;
#pragma unroll
      for (int e = 0; e < 16; ++e) { lg[e] = rs * (part[((2 * rg2) * 16 + rr) * 16 + e] + part[((2 * rg2 + 1) * 16 + rr) * 16 + e]) + cr[e]; mx = fmaxf(mx, lg[e]); }
#pragma unroll
      for (int e = 0; e < 16; ++e) lg[e] = expf(lg[e] - mx);
      float best = -1.f; int bg = 0; float b0 = 0.f, b1 = 0.f, b2 = 0.f, b3 = 0.f;
#pragma unroll
      for (int gi = 0; gi < 4; ++gi) {
        const float a0 = lg[4 * gi], a1 = lg[4 * gi + 1], a2 = lg[4 * gi + 2], a3 = lg[4 * gi + 3];
        const float sc = fmaxf(fmaxf(fmaxf(a0 + a1, a0 + a2), fmaxf(a0 + a3, a1 + a2)), fmaxf(a1 + a3, a2 + a3));
        if (sc > best) { best = sc; bg = gi; b0 = a0; b1 = a1; b2 = a2; b3 = a3; }
      }
      int i1 = 0; float v1 = b0;
      if (b1 > v1) { v1 = b1; i1 = 1; } if (b2 > v1) { v1 = b2; i1 = 2; } if (b3 > v1) { v1 = b3; i1 = 3; }
      int i2 = -1; float v2 = -1.f;
      if (i1 != 0 && b0 > v2) { v2 = b0; i2 = 0; } if (i1 != 1 && b1 > v2) { v2 = b1; i2 = 1; } if (i1 != 2 && b2 > v2) { v2 = b2; i2 = 2; } if (i1 != 3 && b3 > v2) { v2 = b3; i2 = 3; }
      const float inv = 1.f / (v1 + v2);
      e1 = bg * 4 + i1; e2 = bg * 4 + i2; g1 = v1 * inv; g2 = v2 * inv;
      q1 = atomicAdd(&hist[e1], 1); q2 = atomicAdd(&hist[e2], 1);
    }
    __syncthreads();
    if (tid < 16) hist[16 + tid] = atomicAdd(&cnt[tid], hist[tid]);
    __syncthreads();
    if (tid < nrows) {
      const int row = r0 + tid;
      list[(size_t)e1 * NROWS + hist[16 + e1] + q1] = row * 2; gatew[row * 2] = g1;
      list[(size_t)e2 * NROWS + hist[16 + e2] + q2] = row * 2 + 1; gatew[row * 2 + 1] = g2;
    }
    {
      const float* m = (const float*)(P.ws + WS_MOD) + (l * 3 + seg) * 6144;
      f32x4 gs[4], sh[4];
#pragma unroll
      for (int j = 0; j < 4; ++j) { const int k = 4 * lane + 256 * j; gs[j] = *(const f32x4*)(P.n2g + l * 1024 + k) * (*(const f32x4*)(m + 4096 + k) + 1.f); sh[j] = *(const f32x4*)(m + 3072 + k); }
      const int rpw = nrows >> 3;
#pragma unroll 1
      for (int q = 0; q < rpw; q += 4) {
        f32x4 xx[4][4];
#pragma unroll
        for (int u = 0; u < 4; ++u)
#pragma unroll
          for (int j = 0; j < 4; ++j) { const int rr = w * rpw + (q + u < rpw ? q + u : 0); xx[u][j] = *(const f32x4*)(XR + (size_t)(r0 + rr) * D + 4 * lane + 256 * j); }
#pragma unroll
        for (int u = 0; u < 4; ++u) {
          if (q + u < rpw) {
            const int rr = w * rpw + q + u; const float rs = rsl[rr]; bf16* hp = H2 + (size_t)(r0 + rr) * D;
#pragma unroll
            for (int j = 0; j < 4; ++j) { const f32x4 o = xx[u][j] * rs * gs[j] + sh[j]; u32x2 ov; ov.x = pk2(o[0], o[1]); ov.y = pk2(o[2], o[3]); *(u32x2*)(hp + 4 * lane + 256 * j) = ov; }
          }
        }
      }
    }
    __syncthreads();
  }
}

__device__ __forceinline__ void phaseEF(unsigned char* lds, const Params& P, int l, bool down) {
  const int* cnt = (const int*)(P.ws + WS_CNT) + l * 16;
  const int* list = (const int*)(P.ws + WS_LIST) + (size_t)l * 16 * NROWS;
  bf16* act = (bf16*)(P.ws + WS_Z + Z_ACT);
  MoeU* desc = (MoeU*)(lds + LDS_MISC);
  int* dn = (int*)(lds + LDS_MISC + 1024);
  const int c0 = xcd_vidx(0), G = gridDim.x;
  { const int j = get_tid();
    if (j < 8) {
      int NF = 0, NH = 0;
#pragma unroll 1
      for (int e = 0; e < 16; ++e) { const int c = cnt[e], rem = c & 255; NF += ((c >> 8) + (rem > 128 ? 1 : 0)) * 4; NH += (rem >= 1 && rem <= 128) ? 4 : 0; }
      const int NFA = NF < 2 * G ? NF : 2 * G;
      MoeU t{0, 0, 0, 0, 0}; int kind = 0;
      int v = -1, half = 0;
      if (j < 2) { v = j * G + c0; if (v >= NFA) v = -1; }
      else { const int ub = (j - 2) * G + c0, nsplit = 2 * (NF - NFA);
        if (ub < nsplit) { v = NFA + (ub >> 1); half = ub & 1; kind = 2; } else if (ub < nsplit + NH) { v = NF + (ub - nsplit); kind = 3; } }
      if (v >= 0 && v < NF) {
        int base = 0, sb = 0;
#pragma unroll 1
        for (int e = 0; e < 16; ++e) { const int c = cnt[e], rem = c & 255, fu = ((c >> 8) + (rem > 128 ? 1 : 0)) * 4; if (v < base + fu) { const int k = v - base, mt = k >> 2; int nv = c - mt * 256; nv = nv < 256 ? nv : 256;
            if (kind == 0) { t = MoeU{e, mt * 256, nv, k & 3, sb + mt * 256}; kind = 1; }
            else { int nh2 = nv - 128 * half; nh2 = nh2 < 128 ? nh2 : 128; if (nh2 > 0) t = MoeU{e, mt * 256 + 128 * half, nh2, k & 3, sb + mt * 256 + 128 * half}; else kind = 0; }
            break; } base += fu; sb += c; }
      } else if (kind == 3) {
        const int vh = v - NF; int base = 0, sb = 0; kind = 0;
#pragma unroll 1
        for (int e = 0; e < 16; ++e) { const int c = cnt[e], rem = c & 255, hv = (rem >= 1 && rem <= 128) ? 4 : 0; if (vh < base + hv) { const int k = vh - base, r0 = (c >> 8) * 256;
            t = MoeU{e, r0, rem, k & 3, sb + r0}; kind = 2; break; } base += hv; sb += c; }
      }
      if (kind == 3) kind = 0;
      desc[j] = t; dn[j] = kind;
    }
    __syncthreads(); }
  const int nf = (dn[0] == 1 ? 1 : 0) + (dn[1] == 1 ? 1 : 0);
  if (!down) {
    SrcUp8 S{desc, (const bf16*)(P.ws + WS_R1), list, (const bf16*)(P.ws + WS_W13) + (size_t)(l * 16) * 1024 * 1024, act, nf};
    gemm8_stream<SrcUp8, true>(lds, S);
  } else {
    SrcDown8 S{desc, act, list, (const bf16*)(P.ws + WS_W2) + (size_t)(l * 16) * 1024 * 512, (const float*)(P.ws + WS_GATEW), (bf16*)(P.ws + WS_R1), (bf16*)(P.ws + WS_Z + Z_YM1), nf};
    gemm8_stream<SrcDown8, false>(lds, S);
  }
#pragma unroll 1
  for (int j = 2; j < 8; ++j) {
    if (dn[j] != 2) continue;
    const MoeU t = desc[j];
    const int* lst = list + (size_t)t.e * NROWS + t.row0;
    if (!down) {
      ARowGather ar{(const bf16*)(P.ws + WS_R1), lst, t.nvalid};
      EpiMoeUp E{act, t.slot0, t.nvalid};
      gemm_tile<4, 4>(lds, ar, (const bf16*)(P.ws + WS_W13) + (size_t)(l * 16 + t.e) * 1024 * 1024, 1024, 0, t.nt * 256, E);
    } else {
      ARowAct ar{act, t.slot0};
      EpiMoeDown E{lst, (const float*)(P.ws + WS_GATEW), (bf16*)(P.ws + WS_R1), (bf16*)(P.ws + WS_Z + Z_YM1), t.nvalid};
      gemm_tile<4, 4>(lds, ar, (const bf16*)(P.ws + WS_W2) + (size_t)(l * 16 + t.e) * 1024 * 512, 512, 0, t.nt * 256, E);
    }
  }
  __syncthreads();
}

__device__ __forceinline__ void phaseG(const Params& P, int l) {
  const int tid = get_tid(), lane = tid & 63, w = tid >> 6;
  float* XR = (float*)(P.ws + WS_XR);
  const bf16* Y0 = (const bf16*)(P.ws + WS_R1); const bf16* Y1 = (const bf16*)(P.ws + WS_Z + Z_YM1);
  const float* mod = (const float*)(P.ws + WS_MOD);
  const int nrows = l == 0 ? NROWS : NLAT;
#pragma unroll 1
  for (int it = blockIdx.x; it < nrows / 16; it += gridDim.x) {
    const int row0 = it * 16 + 2 * w, seg = row0 < NSEQ ? 0 : (row0 < NLAT ? 1 : 2);
    const float* gt2 = mod + (l * 3 + seg) * 6144 + 5120;
    f32x4 x1[2][4]; u32x2 ya[2][4], yb[2][4];
#pragma unroll
    for (int u = 0; u < 2; ++u)
#pragma unroll
      for (int j = 0; j < 4; ++j) { const size_t o = (size_t)(row0 + u) * D + 4 * lane + 256 * j; x1[u][j] = __builtin_nontemporal_load((const f32x4*)(XR + o)); ya[u][j] = __builtin_nontemporal_load((const u32x2*)(Y0 + o)); yb[u][j] = __builtin_nontemporal_load((const u32x2*)(Y1 + o)); }
    f32x4 gv[4];
#pragma unroll
    for (int j = 0; j < 4; ++j) gv[j] = *(const f32x4*)(gt2 + 4 * lane + 256 * j);
#pragma unroll
    for (int u = 0; u < 2; ++u) {
      const int row = row0 + u;
      f32x4 xv[4]; float ss = 0.f;
#pragma unroll
      for (int j = 0; j < 4; ++j) {
        const u32x2 a = ya[u][j], b = yb[u][j];
        f32x4 m; m[0] = bflo(a.x) + bflo(b.x); m[1] = bfhi(a.x) + bfhi(b.x); m[2] = bflo(a.y) + bflo(b.y); m[3] = bfhi(a.y) + bfhi(b.y);
        xv[j] = x1[u][j] + gv[j] * m;
        ss += xv[j][0] * xv[j][0] + xv[j][1] * xv[j][1] + xv[j][2] * xv[j][2] + xv[j][3] * xv[j][3];
      }
      ss = wsum(ss);
      if (l == 0) {
        const float* sc1 = mod + (1 * 3 + seg) * 6144 + 1024;
        bf16* xb = (bf16*)(P.ws + WS_R1) + (size_t)row * D;
        if (lane == 0) ((float*)(P.ws + WS_RSS))[row] = ss;
#pragma unroll
        for (int j = 0; j < 4; ++j) {
          const int k = 4 * lane + 256 * j;
          *(f32x4*)(XR + (size_t)row * D + k) = xv[j];
          const f32x4 gg = *(const f32x4*)(P.n1g + 1024 + k), sc = *(const f32x4*)(sc1 + k);
          const f32x4 o = xv[j] * gg * (sc + 1.f);
          u32x2 ov; ov.x = pk2(o[0], o[1]); ov.y = pk2(o[2], o[3]); *(u32x2*)(xb + k) = ov;
        }
      } else {
        const float rs = rsqrtf(ss * (1.f / 1024.f) + EPS);
#pragma unroll
        for (int j = 0; j < 4; ++j) {
          const int k = 4 * lane + 256 * j;
          const f32x4 gg = *(const f32x4*)(P.final_g + k);
          __builtin_nontemporal_store(xv[j] * rs * gg, (f32x4*)(P.out + (size_t)row * D + k));
        }
      }
    }
  }
}

#define XB_TMO      128
#define XB_XCNT(j)  (256  + 64 * (j))
#define XB_XSUB(j)  (1280 + 64 * (j))
#define XB_XGEN(j)  (2304 + 64 * (j))
#define XB_TOP      3328
#define XB_TOPGEN   3392
#define XB_SPIN_CAP (1u << 20)
__device__ __forceinline__ unsigned xb_ld(unsigned* p)              { return __hip_atomic_load(p, __ATOMIC_RELAXED, __HIP_MEMORY_SCOPE_AGENT); }
__device__ __forceinline__ unsigned xb_add(unsigned* p, unsigned v) { return __hip_atomic_fetch_add(p, v, __ATOMIC_RELAXED, __HIP_MEMORY_SCOPE_AGENT); }
__device__ __forceinline__ unsigned xb_xcc_id() { return (unsigned)__builtin_amdgcn_s_getreg((3 << 11) | 20) & 0xFu; }
#define XB_SPIN(cond, bar) do { unsigned _sp = 0; while (cond) { __builtin_amdgcn_s_sleep(1); \
    if ((++_sp & 255u) == 0u) { if (xb_ld(&(bar)[XB_TMO])) break; if (_sp > XB_SPIN_CAP) { atomicAdd(&(bar)[XB_TMO], 1u); break; } } } } while (0)
struct XBar { unsigned* bar; unsigned* st; };
__device__ __forceinline__ void xbar_init(XBar& b, unsigned* bar, unsigned* st) {
  b.bar = bar; b.st = st;
  if (threadIdx.x == 0) { st[0] = 0u; st[1] = 0u; (void)xb_add(&bar[XB_XCNT(xb_xcc_id())], 1u); }
}
__device__ __forceinline__ void xbar_sync(XBar& b) {
  asm volatile("s_waitcnt vmcnt(0)" ::: "memory");
  __syncthreads();
  if (threadIdx.x == 0) {
    unsigned* bar = b.bar;
    const unsigned x = xb_xcc_id();
    __builtin_amdgcn_s_waitcnt(0);
    unsigned nloc = b.st[0], nx = b.st[1];
    if (nloc == 0u) {
      const unsigned G = gridDim.x; unsigned sum, cnt, mine, sp = 0u;
      for (;;) {
        sum = 0u; cnt = 0u; mine = 0u;
#pragma unroll
        for (unsigned j = 0; j < 16; ++j) { const unsigned c = xb_ld(&bar[XB_XCNT(j)]); sum += c; cnt += (c > 0u) ? 1u : 0u; mine = (j == x) ? c : mine; }
        if (sum == G) break;
        __builtin_amdgcn_s_sleep(1);
        if ((++sp & 255u) == 0u) { if (xb_ld(&bar[XB_TMO])) break; if (sp > XB_SPIN_CAP) { atomicAdd(&bar[XB_TMO], 1u); break; } }
      }
      nloc = mine > 0u ? mine : 1u; nx = cnt > 0u ? cnt : 1u;
      b.st[0] = nloc; b.st[1] = nx;
    }
    const unsigned old = xb_add(&bar[XB_XSUB(x)], 1u);
    const unsigned gen = old / nloc;
    if (old + 1u == (gen + 1u) * nloc) {
      __builtin_amdgcn_fence(__ATOMIC_RELEASE, "agent");
      asm volatile("s_waitcnt vmcnt(0)" ::: "memory");
      const unsigned og = xb_add(&bar[XB_TOP], 1u);
      const unsigned tg = og / nx;
      if (og + 1u == (tg + 1u) * nx) xb_add(&bar[XB_TOPGEN], 1u);
      else XB_SPIN(xb_ld(&bar[XB_TOPGEN]) == tg, bar);
      __builtin_amdgcn_fence(__ATOMIC_ACQUIRE, "agent");
      xb_add(&bar[XB_XGEN(x)], 1u);
      asm volatile("s_waitcnt vmcnt(0)" ::: "memory");
    } else {
      XB_SPIN(xb_ld(&bar[XB_XGEN(x)]) == gen, bar);
      __builtin_amdgcn_fence(__ATOMIC_ACQUIRE, "agent");
      asm volatile("s_waitcnt vmcnt(0)" ::: "memory");
    }
  }
  __syncthreads();
}

__global__ void __launch_bounds__(NTHR, 2) fwd_mega(Params P) {
  extern __shared__ __attribute__((aligned(16))) unsigned char lds[];
  cg::grid_group grid = cg::this_grid();
  XBar xb; xbar_init(xb, (unsigned*)(P.ws + WS_BAR), (unsigned*)(lds + LDS_BARW));
#define GSYNC() xbar_sync(xb)
  phase0(lds, P);
  VM_WAIT(); __syncthreads(); grid.sync();
  phase1(lds, P); GSYNC();
#pragma unroll 1
  for (int l = 0; l < 2; ++l) {
    phaseA(lds, P, l); GSYNC();
    phaseB(lds, P, l); GSYNC();
    phaseB2(P, l); GSYNC();
    phaseB3(lds, P, l); GSYNC();
    phaseC(lds, P, l); GSYNC();
    phaseD(lds, P, l); GSYNC();
    phaseEF(lds, P, l, false); GSYNC();
    phaseEF(lds, P, l, true); GSYNC();
    phaseG(P, l);
    if (l == 0) GSYNC();
  }
#undef GSYNC
}

extern "C" void kernel_launch(void* const* d_in, const int* in_sizes, int n_in, void* d_out, int out_size, void* d_ws, size_t ws_size, hipStream_t stream) {
  static int grid_blocks = 0;
  if (!grid_blocks) {
    int dev = 0, cus = 0, per_cu = 0;
    (void)hipGetDevice(&dev);
    (void)hipDeviceGetAttribute(&cus, hipDeviceAttributeMultiprocessorCount, dev);
    (void)hipFuncSetAttribute((const void*)fwd_mega, hipFuncAttributeMaxDynamicSharedMemorySize, LDS_BYTES);
    (void)hipOccupancyMaxActiveBlocksPerMultiprocessor(&per_cu, fwd_mega, NTHR, LDS_BYTES);
    if (per_cu > 1) per_cu = 1;
    if (per_cu < 1) per_cu = 1;
    grid_blocks = cus * per_cu;
    if (ws_size < WS_END) fprintf(stderr, "kernel_launch: workspace too small: %zu < %zu\n", ws_size, (size_t)WS_END);
  }
  (void)hipMemsetAsync(d_ws, 0, WS_ZERO_BYTES, stream);
  Params p{};
  const float** pp = (const float**)&p;
  for (int i = 0; i < 21; ++i) pp[i] = (const float*)d_in[i];
  p.out = (float*)d_out; p.ws = (unsigned char*)d_ws;
  void* args[] = {&p};
  hipError_t e = hipLaunchCooperativeKernel((void*)fwd_mega, dim3(grid_blocks), dim3(NTHR), args, LDS_BYTES, stream);
  if (e != hipSuccess) fprintf(stderr, "cooperative launch failed: %s (grid %d)\n", hipGetErrorString(e), grid_blocks);
}
```

```cpp
#include <hip/hip_runtime.h>
#include <hip/hip_cooperative_groups.h>
#include <cstdio>
#include <cstdint>
namespace cg = cooperative_groups;

typedef unsigned short bf16;
typedef short bf16x8 __attribute__((ext_vector_type(8)));
typedef short s16x4 __attribute__((ext_vector_type(4)));
typedef float f32x4 __attribute__((ext_vector_type(4)));
typedef float f32x2 __attribute__((ext_vector_type(2)));
typedef unsigned u32x4 __attribute__((ext_vector_type(4)));
typedef unsigned u32x2 __attribute__((ext_vector_type(2)));
typedef __bf16 bf2_t __attribute__((ext_vector_type(2)));
#define LAS __attribute__((address_space(3)))
constexpr int NTHR = 512;
constexpr int LDS_BYTES = 147456 + 64;
constexpr int LDS_BARW = 147456;
constexpr int LDS_MISC = 131072;

constexpr int D = 1024, NSEQ = 8192, CL = 256, NT_TOK = NSEQ + CL, NLAT = 2 * NSEQ, NROWS = NLAT + 2 * CL;
constexpr int INC = 2944, NSLOT = 46;
constexpr float EPS = 1e-6f;
constexpr float LOG2E = 1.4426950408889634f;
constexpr float QSCALE = 0.125f * LOG2E;
constexpr int S_AQ = 0, S_AK = 6, S_AV = 8, S_NQ = 10, S_NK = 14, S_NV = 18, S_RQ = 22, S_RK = 28, S_RV = 34, S_RG = 40;

constexpr size_t WS_BAR = 0;
constexpr size_t WS_CNT = 16384;
constexpr size_t WS_ZERO_BYTES = 16384 + 4096;
constexpr size_t WS_MOD = WS_ZERO_BYTES;
constexpr size_t WS_BIAS = WS_MOD + 2 * 3 * 6144 * 4;
constexpr size_t WS_ROPE = WS_BIAS + 2 * 3 * 2944 * 4;
constexpr size_t WS_RSS = WS_ROPE + 128 * 16 * 2 * 4;
constexpr size_t WS_WR = WS_RSS + 16896 * 4;
constexpr size_t WS_CR = WS_WR + 2 * 3 * 1024 * 16 * 4;
constexpr size_t WS_GATEW = WS_CR + 4096;
constexpr size_t WS_LIST = WS_GATEW + 16896 * 2 * 4;
constexpr size_t WS_WIN = (WS_LIST + (size_t)2 * 16 * 16896 * 4 + 4095) / 4096 * 4096;
constexpr size_t WS_WO = WS_WIN + (size_t)2 * 2944 * 1024 * 2;
constexpr size_t WS_W13 = WS_WO + (size_t)2 * 1024 * 1024 * 2;
constexpr size_t WS_W2 = WS_W13 + (size_t)32 * 1024 * 1024 * 2;
constexpr size_t WS_XR = WS_W2 + (size_t)32 * 1024 * 512 * 2;
constexpr size_t WS_R1 = WS_XR + (size_t)NROWS * 1024 * 4;
constexpr size_t WS_Z = WS_R1 + (size_t)NROWS * 1024 * 2;
constexpr size_t WS_END = WS_Z + (size_t)2 * NSLOT * NT_TOK * 64 * 2;
constexpr size_t S_OFF = (size_t)34 << 20;
constexpr size_t Z_YM1 = 0, Z_ACT = (size_t)NROWS * 1024 * 2;
static_assert(Z_ACT + (size_t)(2 * NROWS + 128) * 512 * 2 <= (size_t)2 * NSLOT * NT_TOK * 64 * 2, "act overlay");
static_assert((size_t)2 * 6 * 2 * 66 * 4096 * 4 <= (size_t)NROWS * 1024 * 2, "U overlay");

struct Params {
  const float *x, *c, *ctx, *c_ctx, *w_ada, *b_ada, *n1g, *n2g, *w_in, *qg, *kg, *rpb, *ret_decay, *mix_g, *w_out, *w_router, *b_router, *w1, *w3, *w2, *final_g;
  float* out; unsigned char* ws;
};

__device__ __forceinline__ unsigned pk2(float lo, float hi) { f32x2 v = {lo, hi}; bf2_t b = __builtin_convertvector(v, bf2_t); return __builtin_bit_cast(unsigned, b); }
__device__ __forceinline__ float bflo(unsigned u) { return __builtin_bit_cast(float, u << 16); }
__device__ __forceinline__ float bfhi(unsigned u) { return __builtin_bit_cast(float, u & 0xffff0000u); }
__device__ __forceinline__ float wsum(float v) {
#pragma unroll
  for (int o = 1; o < 64; o <<= 1) v += __shfl_xor(v, o);
  return v;
}
__device__ __forceinline__ float silu_f(float v) { return v * __builtin_amdgcn_rcpf(1.f + __expf(-v)); }
__device__ __forceinline__ int lds_swz(int row, int chunk) { return row * 128 + ((chunk ^ ((row >> 1) & 7)) << 4); }
#define VM_WAIT() asm volatile("s_waitcnt vmcnt(0)" ::: "memory")
__device__ __forceinline__ int get_tid() { int t = threadIdx.x; asm volatile("" : "+v"(t)); return t; }

template <int R, int NW>
__device__ __forceinline__ void stage_rows(unsigned char* lds, int dst, const bf16* src, int ld, int wl, int lane) {
#pragma unroll
  for (int i = 0; i < R / (8 * NW); ++i) {
    const int q = wl + NW * i, row = q * 8 + (lane >> 3), ch = (lane & 7) ^ ((row >> 1) & 7);
    __builtin_amdgcn_global_load_lds((const void*)(src + (size_t)row * ld + ch * 8), (LAS void*)(lds + dst + q * 1024), 16, 0, 0);
  }
}
#define VMCNT(n) asm volatile("s_waitcnt vmcnt(" #n ")" ::: "memory")
#define LGKM0() asm volatile("s_waitcnt lgkmcnt(0)" ::: "memory")
#define RAW_BAR() __builtin_amdgcn_s_barrier()
__device__ __forceinline__ bf16x8 lds_frag(const unsigned char* lds, int off) { return *(const bf16x8*)(lds + off); }
__device__ __forceinline__ bf16x8 lds_tr2(unsigned char* lds, int off0, int off1) {
  s16x4 a = __builtin_amdgcn_ds_read_tr16_b64_v4i16((LAS s16x4*)(lds + off0));
  s16x4 b = __builtin_amdgcn_ds_read_tr16_b64_v4i16((LAS s16x4*)(lds + off1));
  return __builtin_shufflevector(a, b, 0, 1, 2, 3, 4, 5, 6, 7);
}

template <int MT, int NT, int ST> struct GStep {
  static __device__ __forceinline__ void run(f32x4 (&acc)[MT][NT], bf16x8 (&W0)[NT], bf16x8 (&W1)[NT], bf16x8 (&X)[2 * MT], const unsigned char* base, int xoff, int woff) {
    constexpr int S = 2 * MT, kk = ST / MT, mt = ST % MT;
#pragma unroll
    for (int nt = 0; nt < NT; ++nt) acc[mt][nt] = __builtin_amdgcn_mfma_f32_16x16x32_bf16(kk ? W1[nt] : W0[nt], X[ST], acc[mt][nt], 0, 0, 0);
    __builtin_amdgcn_sched_group_barrier(0x008, NT, 0);
    if constexpr (ST + 2 < S) { constexpr int k2 = (ST + 2) / MT, m2 = (ST + 2) % MT; X[ST + 2] = lds_frag(base, (xoff + m2 * 2048) ^ (k2 << 6)); }
    if constexpr (ST < NT) W1[ST] = lds_frag(base, (woff + ST * 2048) ^ 64);
    constexpr int nds = (ST + 2 < S ? 1 : 0) + (ST < NT ? 1 : 0);
    if constexpr (nds > 0) __builtin_amdgcn_sched_group_barrier(0x100, nds, 0);
    if constexpr (ST + 1 < S) GStep<MT, NT, ST + 1>::run(acc, W0, W1, X, base, xoff, woff);
  }
};

template <int MT, int NT, class ARow, class Epi>
__device__ __forceinline__ void gemm_tile(unsigned char* lds, const ARow& arow, const bf16* __restrict__ Bt, int K, int m0, int n0, const Epi& epi,
                                          bool staged0 = false, bool hasnext = false, const ARow* narow = nullptr, const bf16* nBt = nullptr, int nn0 = 0) {
  const int tid = get_tid(), lane = tid & 63, w = __builtin_amdgcn_readfirstlane(tid >> 6);
  const int wr = w >> 2, wc = w & 3, g = lane >> 4, li = lane & 15;
  constexpr int NA = MT / 2, NB = NT;
  const bf16* ap[NA]; const bf16* bp[NB];
#pragma unroll
  for (int i = 0; i < NA; ++i) { const int q = w + 8 * i, row = q * 8 + (lane >> 3), ch = (lane & 7) ^ ((row >> 1) & 7); ap[i] = arow(row) + ch * 8; }
#pragma unroll
  for (int i = 0; i < NB; ++i) { const int q = w + 8 * i, row = q * 8 + (lane >> 3), ch = (lane & 7) ^ ((row >> 1) & 7); bp[i] = Bt + (size_t)(n0 + row) * K + ch * 8; }
  f32x4 acc[MT][NT];
#pragma unroll
  for (int a = 0; a < MT; ++a)
#pragma unroll
    for (int b = 0; b < NT; ++b) acc[a][b] = (f32x4){0.f, 0.f, 0.f, 0.f};
  const int f = (li >> 1) & 7;
  const int xoff = (wr * (MT * 16) + li) * 128 + ((g ^ f) << 4);
  const int woff = 32768 + (wc * (NT * 16) + li) * 128 + ((g ^ f) << 4);
  const int nk = K >> 6;
#define GT_STAGE(s, k0) do { _Pragma("unroll") for (int i = 0; i < NA; ++i) \
    __builtin_amdgcn_global_load_lds((const void*)(ap[i] + (k0)), (LAS void*)(lds + (s) * 65536 + (w + 8 * i) * 1024), 16, 0, 0); \
    _Pragma("unroll") for (int i = 0; i < NB; ++i) \
    __builtin_amdgcn_global_load_lds((const void*)(bp[i] + (k0)), (LAS void*)(lds + (s) * 65536 + 32768 + (w + 8 * i) * 1024), 16, 0, 0); } while (0)
  if (!staged0) GT_STAGE(0, 0);
  VM_WAIT(); __syncthreads();
  for (int t = 0; t < nk; ++t) {
    const int s = t & 1;
    if (t + 1 < nk) GT_STAGE(s ^ 1, (t + 1) * 64);
    const unsigned char* base = lds + s * 65536;
    {
      bf16x8 W0[NT], W1[NT], X[2 * MT];
#pragma unroll
      for (int nt = 0; nt < NT; ++nt) W0[nt] = lds_frag(base, woff + nt * 2048);
      X[0] = lds_frag(base, xoff); X[1] = lds_frag(base, xoff + 2048);
      __builtin_amdgcn_sched_group_barrier(0x100, NT + 2, 0);
      GStep<MT, NT, 0>::run(acc, W0, W1, X, base, xoff, woff);
    }
    VM_WAIT(); __syncthreads();
  }
  if (hasnext) {
#pragma unroll
    for (int i = 0; i < NA; ++i) { const int q = w + 8 * i, row = q * 8 + (lane >> 3), ch = (lane & 7) ^ ((row >> 1) & 7); ap[i] = (*narow)(row) + ch * 8; }
#pragma unroll
    for (int i = 0; i < NB; ++i) { const int q = w + 8 * i, row = q * 8 + (lane >> 3), ch = (lane & 7) ^ ((row >> 1) & 7); bp[i] = nBt + (size_t)(nn0 + row) * K + ch * 8; }
    GT_STAGE(0, 0);
  }
#undef GT_STAGE
  epi(acc, m0 + wr * (MT * 16), n0 + wc * (NT * 16), g, li);
}


namespace g8 {
constexpr int HT_B = 128 * 64 * 2;
__device__ __forceinline__ int lds_byte(int r, int c) { const int st = (r >> 4) * 2 + (c >> 5), rr = r & 15, cc = c & 31, ob = rr * 64 + cc * 2; return st * 1024 + (ob ^ (((ob >> 9) & 1) << 5)); }
__device__ __forceinline__ void stage_rc(int b, int& R, int& C) { const int st = b / 1024, sb = b % 1024, swz = sb ^ (((sb >> 9) & 1) << 5); R = (st >> 1) * 16 + swz / 64; C = (st & 1) * 32 + (swz % 64) / 2; }
}
template <class ARow, class Epi>
__device__ __forceinline__ void gemm8_tile(unsigned char* lds, const ARow& arow, const bf16* __restrict__ Bt, int K, int m0, int n0, const Epi& epi) {
  using namespace g8;
  const int tid = get_tid(), lane = tid & 63, wid = __builtin_amdgcn_readfirstlane(tid >> 6), wr = wid >> 2, wc = wid & 3, fr = lane & 15, fq = lane >> 4;
  const char* abase = (const char*)arow(0);
  const char* bbase = (const char*)(Bt + (size_t)n0 * K);
  unsigned oa[2][2], ob[2][2];
#pragma unroll
  for (int i = 0; i < 2; ++i) {
    int R, C; stage_rc(tid * 16 + i * 8192, R, C);
    const int ra = (R >> 6) * 128 + ((R >> 4) & 3) * 16 + (R & 15);
    const int rb = (R >> 5) * 64 + ((R >> 4) & 1) * 16 + (R & 15);
#pragma unroll
    for (int hh = 0; hh < 2; ++hh) { oa[hh][i] = (unsigned)((ra + hh * 64) * K + C) * 2u; ob[hh][i] = (unsigned)((rb + hh * 32) * K + C) * 2u; }
  }
#define G8_SA(b, h) (((b) * 2 + (h)) * HT_B)
#define G8_SB(b, h) ((4 + (b) * 2 + (h)) * HT_B)
#define G8_STAGE(bufoff, BASE, O2, kt) do { _Pragma("unroll") for (int _i = 0; _i < 2; ++_i) \
    __builtin_amdgcn_global_load_lds((const void*)((BASE) + (O2)[_i] + (unsigned)(kt) * 128u), (LAS void*)(lds + (bufoff) + wid * 1024 + _i * 8192), 16, 0, 0); } while (0)
  const int aoff = lds_byte(wr * 64 + fr, fq * 8), boff = lds_byte(wc * 32 + fr, fq * 8);
#define G8_LDA(dst, b, h) do { _Pragma("unroll") for (int m = 0; m < 4; ++m) _Pragma("unroll") for (int k = 0; k < 2; ++k) dst[m][k] = *(const bf16x8*)(lds + G8_SA(b, h) + aoff + m * 2048 + k * 1024); } while (0)
#define G8_LDB(dst, b, h) do { _Pragma("unroll") for (int n = 0; n < 2; ++n) _Pragma("unroll") for (int k = 0; k < 2; ++k) dst[n][k] = *(const bf16x8*)(lds + G8_SB(b, h) + boff + n * 2048 + k * 1024); } while (0)
#define G8_MMA(ai, bj, At_, Bt_) do { __builtin_amdgcn_s_setprio(1); _Pragma("unroll") for (int m = 0; m < 4; ++m) _Pragma("unroll") for (int n = 0; n < 2; ++n) _Pragma("unroll") for (int k = 0; k < 2; ++k) \
    acc[(ai) * 4 + m][(bj) * 2 + n] = __builtin_amdgcn_mfma_f32_16x16x32_bf16(Bt_[n][k], At_[m][k], acc[(ai) * 4 + m][(bj) * 2 + n], 0, 0, 0); __builtin_amdgcn_s_setprio(0); } while (0)
#define G8_WV(n) asm volatile("s_waitcnt vmcnt(" #n ")" ::: "memory")
#define G8_WL(n) asm volatile("s_waitcnt lgkmcnt(" #n ")" ::: "memory")
#define G8_BAR __builtin_amdgcn_s_barrier()
#define G8_SCHED __builtin_amdgcn_sched_barrier(0)
  f32x4 acc[8][4];
#pragma unroll
  for (int a = 0; a < 8; ++a)
#pragma unroll
    for (int b = 0; b < 4; ++b) acc[a][b] = (f32x4){0.f, 0.f, 0.f, 0.f};
  bf16x8 At[4][2], B0[2][2], B1[2][2];
  const int nt = K >> 6;
  G8_STAGE(G8_SB(0, 0), bbase, ob[0], 0); G8_STAGE(G8_SA(0, 0), abase, oa[0], 0);
  G8_STAGE(G8_SB(0, 1), bbase, ob[1], 0); G8_STAGE(G8_SA(0, 1), abase, oa[1], 0);
  if (wr == 1) G8_BAR;
  G8_WV(4); G8_BAR;
  G8_STAGE(G8_SB(1, 0), bbase, ob[0], 1); G8_STAGE(G8_SA(1, 0), abase, oa[0], 1); G8_STAGE(G8_SB(1, 1), bbase, ob[1], 1);
  G8_WV(6); G8_BAR;
#pragma unroll 1
  for (int t = 0; t < nt - 2; t += 2) {
    G8_LDB(B0, 0, 0); G8_SCHED; G8_LDA(At, 0, 0); G8_STAGE(G8_SA(1, 1), abase, oa[1], t + 1);
    G8_WL(8); G8_BAR; G8_WL(0); G8_MMA(0, 0, At, B0); G8_BAR; G8_SCHED;
    G8_LDB(B1, 0, 1); G8_STAGE(G8_SB(0, 0), bbase, ob[0], t + 2);
    G8_BAR; G8_WL(0); G8_MMA(0, 1, At, B1); G8_BAR;
    G8_LDA(At, 0, 1); G8_STAGE(G8_SA(0, 0), abase, oa[0], t + 2);
    G8_BAR; G8_WL(0); G8_MMA(1, 0, At, B0); G8_BAR; G8_SCHED;
    G8_STAGE(G8_SB(0, 1), bbase, ob[1], t + 2);
    G8_WV(6); G8_BAR; G8_MMA(1, 1, At, B1); G8_BAR;
    G8_LDB(B0, 1, 0); G8_SCHED; G8_LDA(At, 1, 0); G8_STAGE(G8_SA(0, 1), abase, oa[1], t + 2);
    G8_WL(8); G8_BAR; G8_WL(0); G8_MMA(0, 0, At, B0); G8_BAR; G8_SCHED;
    G8_LDB(B1, 1, 1); G8_STAGE(G8_SB(1, 0), bbase, ob[0], t + 3);
    G8_BAR; G8_WL(0); G8_MMA(0, 1, At, B1); G8_BAR;
    G8_LDA(At, 1, 1); G8_STAGE(G8_SA(1, 0), abase, oa[0], t + 3);
    G8_BAR; G8_WL(0); G8_MMA(1, 0, At, B0); G8_BAR; G8_SCHED;
    G8_STAGE(G8_SB(1, 1), bbase, ob[1], t + 3);
    G8_WV(6); G8_BAR; G8_MMA(1, 1, At, B1); G8_BAR;
  }
  { G8_LDB(B0, 0, 0); G8_LDA(At, 0, 0); G8_STAGE(G8_SA(1, 1), abase, oa[1], nt - 1);
    G8_BAR; G8_WL(0); G8_MMA(0, 0, At, B0); G8_BAR;
    G8_LDB(B1, 0, 1); G8_BAR; G8_WL(0); G8_MMA(0, 1, At, B1); G8_BAR;
    G8_LDA(At, 0, 1); G8_WV(4); G8_BAR; G8_WL(0); G8_MMA(1, 0, At, B0); G8_MMA(1, 1, At, B1); G8_BAR; }
  { G8_LDB(B0, 1, 0); G8_LDA(At, 1, 0); G8_WV(2); G8_BAR; G8_WL(0); G8_MMA(0, 0, At, B0); G8_BAR;
    G8_LDB(B1, 1, 1); G8_WV(0); G8_BAR; G8_WL(0); G8_MMA(0, 1, At, B1); G8_BAR;
    G8_LDA(At, 1, 1); G8_BAR; G8_WL(0); G8_MMA(1, 0, At, B0); G8_MMA(1, 1, At, B1); G8_BAR; }
  if (wr == 0) G8_BAR;
#undef G8_SA
#undef G8_SB
#undef G8_STAGE
#undef G8_LDA
#undef G8_LDB
#undef G8_MMA
#undef G8_WV
#undef G8_WL
#undef G8_BAR
#undef G8_SCHED
  epi(acc, m0 + wr * 128, n0 + wc * 64, fq, fr);
  __syncthreads();
}

struct ARowLinear { const bf16* A; int K; int m0; __device__ __forceinline__ const bf16* operator()(int r) const { return A + (size_t)(m0 + r) * K; } };

template <int MT, int NT>
struct EpiInProj {
  const float* rowss; const float* biasp; const float* qg; const float* kg; const float* rope  ; bf16* Z;
  __device__ __forceinline__ void operator()(f32x4 (&acc)[MT][NT], int mw, int nw, int g, int li) const {
    int b, seg, tokbase; bool latent;
    if (mw < NLAT) { b = mw >> 13; seg = b; tokbase = (mw & 8191); latent = true; }
    else { const int mc = mw - NLAT; b = mc >> 8; seg = 2; tokbase = NSEQ + (mc & 255); latent = false; }
    const int s = nw >> 6, coff = nw & 63;
    bf16* zb = Z + ((size_t)(b * NSLOT + s) * NT_TOK) * 64 + coff;
    float rss[MT];
#pragma unroll
    for (int mt = 0; mt < MT; ++mt) rss[mt] = rowss[mw + mt * 16 + li];
    f32x4 bv[NT], gvv[NT];
#pragma unroll
    for (int nt = 0; nt < NT; ++nt) bv[nt] = *(const f32x4*)(biasp + seg * INC + nw + nt * 16 + 4 * g);
    if (NT == 4 && s < 8) {
      const float* gn = (s < 6) ? qg : kg;
#pragma unroll
      for (int nt = 0; nt < NT; ++nt) gvv[nt] = *(const f32x4*)(gn + nt * 16 + 4 * g);
    } else {
#pragma unroll
      for (int nt = 0; nt < NT; ++nt) gvv[nt] = (f32x4){1.f, 1.f, 1.f, 1.f};
    }
#pragma unroll
    for (int mt = 0; mt < MT; ++mt) {
      const int tok = tokbase + mt * 16 + li;
      const float irms = rsqrtf(rss[mt] * (1.f / 1024.f) + EPS);
      f32x4 v[NT];
#pragma unroll
      for (int nt = 0; nt < NT; ++nt) v[nt] = acc[mt][nt] * irms + bv[nt];
      if constexpr (NT == 4) {
        if (s < 8) {
          float ss = 0.f;
#pragma unroll
          for (int nt = 0; nt < 4; ++nt) ss += v[nt][0] * v[nt][0] + v[nt][1] * v[nt][1] + v[nt][2] * v[nt][2] + v[nt][3] * v[nt][3];
          ss += __shfl_xor(ss, 16); ss += __shfl_xor(ss, 32);
          const float r = rsqrtf(ss * (1.f / 64.f) + EPS) * (s < 6 ? QSCALE : 1.f);
#pragma unroll
          for (int nt = 0; nt < 4; ++nt) v[nt] = v[nt] * r * gvv[nt];
          if (latent) {
            const int pr = tok >> 6, pc = tok & 63;
            const f32x4 r0 = *(const f32x4*)(rope + (pr * 16 + 4 * g) * 2), r1 = *(const f32x4*)(rope + (pr * 16 + 4 * g) * 2 + 4);
            const f32x4 c0 = *(const f32x4*)(rope + (pc * 16 + 4 * g) * 2), c1 = *(const f32x4*)(rope + (pc * 16 + 4 * g) * 2 + 4);
            const float cr_[4] = {r0[0], r0[2], r1[0], r1[2]}, sr_[4] = {r0[1], r0[3], r1[1], r1[3]};
            const float cc_[4] = {c0[0], c0[2], c1[0], c1[2]}, sc_[4] = {c0[1], c0[3], c1[1], c1[3]};
#pragma unroll
            for (int j = 0; j < 4; ++j) {
              const float t1 = v[0][j], t2 = v[1][j]; v[0][j] = t1 * cr_[j] - t2 * sr_[j]; v[1][j] = t2 * cr_[j] + t1 * sr_[j];
              const float u1 = v[2][j], u2 = v[3][j]; v[2][j] = u1 * cc_[j] - u2 * sc_[j]; v[3][j] = u2 * cc_[j] + u1 * sc_[j];
            }
          }
        }
      }
      if (s >= S_NQ && s < S_NK) {
#pragma unroll
        for (int nt = 0; nt < NT; ++nt) v[nt] = v[nt] * QSCALE;
      } else if (s >= S_RK && s < S_RV) {
#pragma unroll
        for (int nt = 0; nt < NT; ++nt) v[nt] = v[nt] * 0.125f;
      } else if (s >= S_RG) {
#pragma unroll
        for (int nt = 0; nt < NT; ++nt)
#pragma unroll
          for (int j = 0; j < 4; ++j) v[nt][j] = silu_f(v[nt][j]);
      }
#pragma unroll
      for (int nt = 0; nt < NT; ++nt) { u32x2 o; o.x = pk2(v[nt][0], v[nt][1]); o.y = pk2(v[nt][2], v[nt][3]); *(u32x2*)(zb + (size_t)tok * 64 + nt * 16 + 4 * g) = o; }
    }
  }
};

struct EpiOutProj {
  const float* xlat; const float* xctx; const float* mod; float* XR;
  __device__ __forceinline__ void operator()(f32x4 (&acc)[8][4], int mw, int nw, int g, int li) const {
    const int seg = (mw < NLAT) ? (mw >> 13) : 2;
    const float* gt = mod + seg * 6144 + 2048;
    f32x4 gv[4];
#pragma unroll
    for (int nt = 0; nt < 4; ++nt) gv[nt] = *(const f32x4*)(gt + nw + nt * 16 + 4 * g);
    const float* xbase = (mw < NLAT) ? (xlat + (size_t)mw * D) : (xctx + (size_t)(mw - NLAT) * D);
#pragma unroll
    for (int mb = 0; mb < 8; mb += 2) {
      f32x4 xv[2][4];
#pragma unroll
      for (int u = 0; u < 2; ++u)
#pragma unroll
        for (int nt = 0; nt < 4; ++nt) xv[u][nt] = __builtin_nontemporal_load((const f32x4*)(xbase + (size_t)((mb + u) * 16 + li) * D + nw + nt * 16 + 4 * g));
#pragma unroll
      for (int u = 0; u < 2; ++u)
#pragma unroll
        for (int nt = 0; nt < 4; ++nt) *(f32x4*)(XR + (size_t)(mw + (mb + u) * 16 + li) * D + nw + nt * 16 + 4 * g) = xv[u][nt] + gv[nt] * acc[mb + u][nt];
    }
  }
};

template <int MT> struct EpiMoeUpT {
  bf16* act; int slot0; int nvalid;
  __device__ __forceinline__ void operator()(f32x4 (&acc)[MT][4], int mw, int nw, int g, int li) const {
#pragma unroll
    for (int mt = 0; mt < MT; ++mt) {
      const int r = mw + mt * 16 + li;
      if (r < nvalid) {
#pragma unroll
        for (int u = 0; u < 2; ++u) {
          const int hid = (nw >> 1) + u * 16 + 4 * g;
          const f32x4 a1 = acc[mt][2 * u], a3 = acc[mt][2 * u + 1];
          u32x2 o; o.x = pk2(silu_f(a1[0]) * a3[0], silu_f(a1[1]) * a3[1]); o.y = pk2(silu_f(a1[2]) * a3[2], silu_f(a1[3]) * a3[3]);
          *(u32x2*)(act + (size_t)(slot0 + r) * 512 + hid) = o;
        }
      }
    }
  }
};

template <int MT> struct EpiMoeDownT {
  const int* list; const float* gatew; bf16* ym0; bf16* ym1; int nvalid;
  __device__ __forceinline__ void operator()(f32x4 (&acc)[MT][4], int mw, int nw, int g, int li) const {
#pragma unroll
    for (int mb = 0; mb < MT; mb += 4) {
      int ent[4]; float gw[4];
#pragma unroll
      for (int mt = 0; mt < 4; ++mt) { const int r = mw + (mb + mt) * 16 + li; ent[mt] = list[r < nvalid ? r : nvalid - 1]; }
#pragma unroll
      for (int mt = 0; mt < 4; ++mt) gw[mt] = gatew[ent[mt]];
#pragma unroll
      for (int mt = 0; mt < 4; ++mt) {
        const int r = mw + (mb + mt) * 16 + li;
        if (r < nvalid) {
          bf16* y = ((ent[mt] & 1) ? ym1 : ym0) + (size_t)(ent[mt] >> 1) * D;
#pragma unroll
          for (int nt = 0; nt < 4; ++nt) {
            const int n = nw + nt * 16 + 4 * g;
            u32x2 o; o.x = pk2(acc[mb + mt][nt][0] * gw[mt], acc[mb + mt][nt][1] * gw[mt]); o.y = pk2(acc[mb + mt][nt][2] * gw[mt], acc[mb + mt][nt][3] * gw[mt]);
            *(u32x2*)(y + n) = o;
          }
        }
      }
    }
  }
};
typedef EpiMoeUpT<4> EpiMoeUp; typedef EpiMoeDownT<4> EpiMoeDown;

template <class Src, bool GATHER = false>
__device__ __forceinline__ void gemm8_stream(unsigned char* lds, const Src& src) {
  using namespace g8;
  const int nunit = src.count();
  if (nunit <= 0) return;
  const int tid = get_tid(), lane = tid & 63, wid = __builtin_amdgcn_readfirstlane(tid >> 6), wr = wid >> 2, wc = wid & 3, fr = lane & 15, fq = lane >> 4;
  const int K = src.K(), nt = K >> 6;
  unsigned oa[2][2], noa[2][2], ob[2][2];
#pragma unroll
  for (int i = 0; i < 2; ++i) {
    int R, C; stage_rc(tid * 16 + i * 8192, R, C);
    const int ra = (R >> 6) * 128 + ((R >> 4) & 3) * 16 + (R & 15);
    const int rb = (R >> 5) * 64 + ((R >> 4) & 1) * 16 + (R & 15);
#pragma unroll
    for (int hh = 0; hh < 2; ++hh) {
      if constexpr (GATHER) oa[hh][i] = src.aoff(0, ra + hh * 64) + (unsigned)C * 2u; else oa[hh][i] = (unsigned)((ra + hh * 64) * K + C) * 2u;
      noa[hh][i] = oa[hh][i];
      ob[hh][i] = (unsigned)((rb + hh * 32) * K + C) * 2u;
    }
  }
#define G8_SA(b, h) (((b) * 2 + (h)) * HT_B)
#define G8_SB(b, h) ((4 + (b) * 2 + (h)) * HT_B)
#define G8_STAGE(bufoff, BASE, O2, kt) do { _Pragma("unroll") for (int _i = 0; _i < 2; ++_i) \
    __builtin_amdgcn_global_load_lds((const void*)((BASE) + (O2)[_i] + (unsigned)(kt) * 128u), (LAS void*)(lds + (bufoff) + wid * 1024 + _i * 8192), 16, 0, 0); } while (0)
  const int aoff = lds_byte(wr * 64 + fr, fq * 8), boff = lds_byte(wc * 32 + fr, fq * 8);
#define G8_LDA(dst, b, h) do { _Pragma("unroll") for (int m = 0; m < 4; ++m) _Pragma("unroll") for (int k = 0; k < 2; ++k) dst[m][k] = *(const bf16x8*)(lds + G8_SA(b, h) + aoff + m * 2048 + k * 1024); } while (0)
#define G8_LDB(dst, b, h) do { _Pragma("unroll") for (int n = 0; n < 2; ++n) _Pragma("unroll") for (int k = 0; k < 2; ++k) dst[n][k] = *(const bf16x8*)(lds + G8_SB(b, h) + boff + n * 2048 + k * 1024); } while (0)
#define G8_MMA(ai, bj, At_, Bt_) do { __builtin_amdgcn_s_setprio(1); _Pragma("unroll") for (int m = 0; m < 4; ++m) _Pragma("unroll") for (int n = 0; n < 2; ++n) _Pragma("unroll") for (int k = 0; k < 2; ++k) \
    acc[(ai) * 4 + m][(bj) * 2 + n] = __builtin_amdgcn_mfma_f32_16x16x32_bf16(Bt_[n][k], At_[m][k], acc[(ai) * 4 + m][(bj) * 2 + n], 0, 0, 0); __builtin_amdgcn_s_setprio(0); } while (0)
#define G8_WV(n) asm volatile("s_waitcnt vmcnt(" #n ")" ::: "memory")
#define G8_WL(n) asm volatile("s_waitcnt lgkmcnt(" #n ")" ::: "memory")
#define G8_BAR __builtin_amdgcn_s_barrier()
#define G8_SCHED __builtin_amdgcn_sched_barrier(0)
  f32x4 acc[8][4];
  bf16x8 At[4][2], B0[2][2], B1[2][2];
  const char* ab = (const char*)src.abase(0); const char* bb = (const char*)src.bbase(0);
  G8_STAGE(G8_SB(0, 0), bb, ob[0], 0); G8_STAGE(G8_SB(0, 1), bb, ob[1], 0); G8_STAGE(G8_SA(0, 0), ab, oa[0], 0); G8_STAGE(G8_SA(0, 1), ab, oa[1], 0);
  if (wr == 1) G8_BAR;
  G8_WV(2); G8_BAR;
  G8_STAGE(G8_SB(1, 0), bb, ob[0], 1); G8_STAGE(G8_SA(1, 0), ab, oa[0], 1); G8_STAGE(G8_SB(1, 1), bb, ob[1], 1);
  G8_WV(6); G8_BAR;
#pragma unroll 1
  for (int u = 0; u < nunit; ++u) {
    const bool has_next = u + 1 < nunit;
    const char* nab = has_next ? (const char*)src.abase(u + 1) : ab; const char* nbb = has_next ? (const char*)src.bbase(u + 1) : bb;
    if constexpr (GATHER) {
#pragma unroll
      for (int i = 0; i < 2; ++i)
#pragma unroll
        for (int hh = 0; hh < 2; ++hh) { int R, C; stage_rc(get_tid() * 16 + i * 8192, R, C); const int ra = (R >> 6) * 128 + ((R >> 4) & 3) * 16 + (R & 15);
          noa[hh][i] = has_next ? src.aoff(u + 1, ra + hh * 64) + (unsigned)C * 2u : oa[hh][i]; }
    }
#pragma unroll
    for (int a = 0; a < 8; ++a)
#pragma unroll
      for (int b = 0; b < 4; ++b) acc[a][b] = (f32x4){0.f, 0.f, 0.f, 0.f};
#pragma unroll 1
    for (int t = 0; t < nt; t += 2) {
      const bool lastit = (t == nt - 2);
      const char* a2 = lastit ? nab : ab; const char* b2 = lastit ? nbb : bb;
      const int k2 = lastit ? 0 : t + 2, k3 = lastit ? 1 : t + 3;
      unsigned oa2[2][2];
#pragma unroll
      for (int i = 0; i < 2; ++i)
#pragma unroll
        for (int hh = 0; hh < 2; ++hh) oa2[hh][i] = (GATHER && lastit) ? noa[hh][i] : oa[hh][i];
      G8_LDB(B0, 0, 0); G8_LDB(B1, 0, 1); G8_SCHED; G8_LDA(At, 0, 0); G8_STAGE(G8_SA(1, 1), ab, oa[1], t + 1);
      G8_WV(8); G8_WL(0); G8_BAR; G8_MMA(0, 0, At, B0); G8_MMA(0, 1, At, B1); G8_BAR; G8_SCHED;
      G8_LDA(At, 0, 1); G8_STAGE(G8_SB(0, 0), b2, ob[0], k2); G8_STAGE(G8_SB(0, 1), b2, ob[1], k2); G8_STAGE(G8_SA(0, 0), a2, oa2[0], k2);
      G8_WV(8); G8_WL(0); G8_BAR; G8_MMA(1, 0, At, B0); G8_MMA(1, 1, At, B1); G8_BAR; G8_SCHED;
      G8_LDB(B0, 1, 0); G8_LDB(B1, 1, 1); G8_SCHED; G8_LDA(At, 1, 0); G8_STAGE(G8_SA(0, 1), a2, oa2[1], k2);
      G8_WV(8); G8_WL(0); G8_BAR; G8_MMA(0, 0, At, B0); G8_MMA(0, 1, At, B1); G8_BAR; G8_SCHED;
      G8_LDA(At, 1, 1); G8_STAGE(G8_SB(1, 0), b2, ob[0], k3); G8_STAGE(G8_SB(1, 1), b2, ob[1], k3); G8_STAGE(G8_SA(1, 0), a2, oa2[0], k3);
      G8_WV(8); G8_WL(0); G8_BAR; G8_MMA(1, 0, At, B0); G8_MMA(1, 1, At, B1); G8_BAR; G8_SCHED;
    }
    if (wr == 0) G8_BAR;
    src.epi(u)(acc, src.mrow(u) + wr * 128, src.ncol(u) + wc * 64, fq, fr);
    if (!has_next) break;
    ab = nab; bb = nbb;
    if (GATHER) {
#pragma unroll
      for (int i = 0; i < 2; ++i)
#pragma unroll
        for (int hh = 0; hh < 2; ++hh) oa[hh][i] = noa[hh][i];
    }
    if (wr == 1) G8_BAR;
  }
  G8_WV(0);
  G8_BAR;
#undef G8_SA
#undef G8_SB
#undef G8_STAGE
#undef G8_LDA
#undef G8_LDB
#undef G8_MMA
#undef G8_WV
#undef G8_WL
#undef G8_BAR
#undef G8_SCHED
  __syncthreads();
}

struct SrcA8 {
  const bf16* XB; const bf16* Wt; const EpiInProj<8, 4>* E; int c0, G, n;
  __device__ __forceinline__ int count() const { return n; }
  __device__ __forceinline__ int K() const { return 1024; }
  __device__ __forceinline__ const bf16* abase(int j) const { const int v = j * G + c0; return XB + (size_t)((v / 11) * 256) * 1024; }
  __device__ __forceinline__ const bf16* bbase(int j) const { const int v = j * G + c0; return Wt + (size_t)((v % 11) * 256) * 1024; }
  __device__ __forceinline__ const EpiInProj<8, 4>& epi(int) const { return *E; }
  __device__ __forceinline__ int mrow(int j) const { return ((j * G + c0) / 11) * 256; }
  __device__ __forceinline__ int ncol(int j) const { return ((j * G + c0) % 11) * 256; }
};
struct SrcC8 {
  const bf16* Y; const bf16* Wt; const struct EpiOutProj* E; int c0, G, n;
  __device__ __forceinline__ int count() const { return n; }
  __device__ __forceinline__ int K() const { return 1024; }
  __device__ __forceinline__ const bf16* abase(int j) const { const int v = j * G + c0; return Y + (size_t)((v >> 2) * 256) * 1024; }
  __device__ __forceinline__ const bf16* bbase(int j) const { const int v = j * G + c0; return Wt + (size_t)((v & 3) * 256) * 1024; }
  __device__ __forceinline__ const EpiOutProj& epi(int) const { return *E; }
  __device__ __forceinline__ int mrow(int j) const { return ((j * G + c0) >> 2) * 256; }
  __device__ __forceinline__ int ncol(int j) const { return ((j * G + c0) & 3) * 256; }
};


struct MoeU { int e, row0, nvalid, nt, slot0; };
struct SrcUp8 {
  const MoeU* d; const bf16* H; const int* list; const bf16* W; bf16* act; int n;
  __device__ __forceinline__ int count() const { return n; }
  __device__ __forceinline__ int K() const { return 1024; }
  __device__ __forceinline__ const bf16* abase(int) const { return H; }
  __device__ __forceinline__ unsigned aoff(int u, int r) const { const MoeU t = d[u]; const int rr = r < t.nvalid ? r : t.nvalid - 1; return (unsigned)(list[(size_t)t.e * NROWS + t.row0 + rr] >> 1) * 2048u; }
  __device__ __forceinline__ const bf16* bbase(int u) const { const MoeU t = d[u]; return W + (size_t)t.e * 1024 * 1024 + (size_t)(t.nt * 256) * 1024; }
  __device__ __forceinline__ EpiMoeUpT<8> epi(int u) const { const MoeU t = d[u]; return EpiMoeUpT<8>{act, t.slot0, t.nvalid}; }
  __device__ __forceinline__ int mrow(int) const { return 0; }
  __device__ __forceinline__ int ncol(int u) const { return d[u].nt * 256; }
};
struct SrcDown8 {
  const MoeU* d; const bf16* act; const int* list; const bf16* W; const float* gatew; bf16* ym0; bf16* ym1; int n;
  __device__ __forceinline__ int count() const { return n; }
  __device__ __forceinline__ int K() const { return 512; }
  __device__ __forceinline__ const bf16* abase(int u) const { return act + (size_t)d[u].slot0 * 512; }
  __device__ __forceinline__ const bf16* bbase(int u) const { const MoeU t = d[u]; return W + (size_t)t.e * 1024 * 512 + (size_t)(t.nt * 256) * 512; }
  __device__ __forceinline__ EpiMoeDownT<8> epi(int u) const { const MoeU t = d[u]; return EpiMoeDownT<8>{list + (size_t)t.e * NROWS + t.row0, gatew, ym0, ym1, t.nvalid}; }
  __device__ __forceinline__ int mrow(int) const { return 0; }
  __device__ __forceinline__ int ncol(int u) const { return d[u].nt * 256; }
};

struct ARowGather { const bf16* H; const int* list; int nvalid; __device__ __forceinline__ const bf16* operator()(int r) const { const int rr = r < nvalid ? r : nvalid - 1; return H + (size_t)(list[rr] >> 1) * D; } };
struct ARowAct { const bf16* act; int slot0; __device__ __forceinline__ const bf16* operator()(int r) const { int s = slot0 + r; s = s < 2 * NROWS ? s : 2 * NROWS - 1; return act + (size_t)s * 512; } };

template <int NQB, bool NAM, int NW>
__device__ __forceinline__ void attn_item(unsigned char* lds, int gb, int wl, int lane, const bf16* zb, int sq0, int sk, int sv, int qtok0, int lat0, int nlat, int ntiles,
                                          int drbase, bf16* Y, size_t yrow0, int ycol0, const float* mixg) {
  const int g = lane >> 4, li = lane & 15;
  const int qtok = qtok0 + 16 * wl + li;
  bf16x8 qf[NQB][2];
#pragma unroll
  for (int qb = 0; qb < NQB; ++qb)
#pragma unroll
    for (int kk = 0; kk < 2; ++kk) qf[qb][kk] = *(const bf16x8*)(zb + ((size_t)(sq0 + qb) * NT_TOK + qtok) * 64 + kk * 32 + g * 8);
  const bf16* kbp = zb + (size_t)sk * NT_TOK * 64;
  const bf16* vbp = zb + (size_t)sv * NT_TOK * 64;
  f32x4 O[4][NQB], L[NQB];
  const bf16x8 ones = {0x3f80, 0x3f80, 0x3f80, 0x3f80, 0x3f80, 0x3f80, 0x3f80, 0x3f80};
#pragma unroll
  for (int qb = 0; qb < NQB; ++qb) { L[qb] = (f32x4){0.f, 0.f, 0.f, 0.f};
#pragma unroll
    for (int db = 0; db < 4; ++db) O[db][qb] = (f32x4){0.f, 0.f, 0.f, 0.f}; }
  const int f = (li >> 1) & 7;
  const int koff = li * 128 + ((g ^ f) << 4);
  const int q_ = li >> 2, p_ = li & 3, fv = (2 * g + (q_ >> 1)) & 7;
  const int voff = (4 * g + q_) * 128 + (p_ & 1) * 8;
  const float* rpbt = (const float*)(lds + gb + 49152);
  const int qc = 16 * wl + li;
  int cs = qc - 8; cs = cs < 0 ? 0 : (cs > 48 ? 48 : cs);
#define AT_TOK(t) ((t) < nlat ? lat0 + 64 * (t) : NSEQ + 64 * ((t) - nlat))
#define AT_STAGE(t, bi) do { const int tk_ = AT_TOK(t); stage_rows<64, NW>(lds, gb + (bi) * 16384, kbp + (size_t)tk_ * 64, 64, wl, lane); \
                             stage_rows<64, NW>(lds, gb + (bi) * 16384 + 8192, vbp + (size_t)tk_ * 64, 64, wl, lane); } while (0)
#define AT_WAIT1() do { if (NW == 8) VMCNT(2); else VMCNT(4); } while (0)
  AT_STAGE(0, 0);
  if (ntiles > 1) { AT_STAGE(1, 1); AT_WAIT1(); } else { VMCNT(0); }
  RAW_BAR();
  int cur = 0;
  for (int t = 0; t < ntiles; ++t) {
    const int kb_off = gb + cur * 16384, vb_off = kb_off + 8192;
    const int pfb = cur == 0 ? 2 : cur - 1;
    if (t + 2 < ntiles) AT_STAGE(t + 2, pfb);
#pragma unroll
    for (int ks = 0; ks < 2; ++ks) {
      f32x4 s[2][NQB];
#pragma unroll
      for (int h2 = 0; h2 < 2; ++h2) {
#pragma unroll
        for (int qb = 0; qb < NQB; ++qb) s[h2][qb] = (f32x4){0.f, 0.f, 0.f, 0.f};
#pragma unroll
        for (int kk = 0; kk < 2; ++kk) {
          const bf16x8 kf = lds_frag(lds, kb_off + (((2 * ks + h2) * 2048 + koff) ^ (kk << 6)));
#pragma unroll
          for (int qb = 0; qb < NQB; ++qb) s[h2][qb] = __builtin_amdgcn_mfma_f32_16x16x32_bf16(kf, qf[qb][kk], s[h2][qb], 0, 0, 0);
        }
      }
      bf16x8 pf[NQB];
#pragma unroll
      for (int qb = 0; qb < NQB; ++qb) {
        float p[8];
#pragma unroll
        for (int h2 = 0; h2 < 2; ++h2)
#pragma unroll
          for (int j = 0; j < 4; ++j) {
            float x = s[h2][qb][j];
            if (NAM) {
              if (t < nlat) {
                const int kc = (2 * ks + h2) * 16 + 4 * g + j;
                const bool valid = (kc >= cs) && (kc < cs + 16);
                int dc = kc - qc + 15; dc = dc < 0 ? 0 : (dc > 30 ? 30 : dc);
                x += rpbt[(drbase + t) * 31 + dc];
                x = valid ? x : -1e30f;
              }
            }
            const float e = __builtin_amdgcn_exp2f(x);
            p[h2 * 4 + j] = e;
          }
        u32x4 pw; pw.x = pk2(p[0], p[1]); pw.y = pk2(p[2], p[3]); pw.z = pk2(p[4], p[5]); pw.w = pk2(p[6], p[7]);
        pf[qb] = __builtin_bit_cast(bf16x8, pw);
        L[qb] = __builtin_amdgcn_mfma_f32_16x16x32_bf16(ones, pf[qb], L[qb], 0, 0, 0);
      }
#pragma unroll
      for (int db = 0; db < 4; ++db) {
        const int a0 = vb_off + ks * 4096 + voff + (((db * 2 + (p_ >> 1)) ^ fv) << 4);
        const bf16x8 vf = lds_tr2(lds, a0, a0 + 2048);
#pragma unroll
        for (int qb = 0; qb < NQB; ++qb) O[db][qb] = __builtin_amdgcn_mfma_f32_16x16x32_bf16(vf, pf[qb], O[db][qb], 0, 0, 0);
      }
    }
    if (t + 2 < ntiles) { AT_WAIT1(); } else { VMCNT(0); }
    LGKM0(); RAW_BAR();
    cur = cur == 2 ? 0 : cur + 1;
  }
#undef AT_TOK
#undef AT_STAGE
#undef AT_WAIT1
#pragma unroll
  for (int qb = 0; qb < NQB; ++qb) {
    const float inv = 1.f / L[qb][0];
    float ss = 0.f;
#pragma unroll
    for (int db = 0; db < 4; ++db) { O[db][qb] = O[db][qb] * inv; ss += O[db][qb][0] * O[db][qb][0] + O[db][qb][1] * O[db][qb][1] + O[db][qb][2] * O[db][qb][2] + O[db][qb][3] * O[db][qb][3]; }
    ss += __shfl_xor(ss, 16); ss += __shfl_xor(ss, 32);
    const float r = rsqrtf(ss * (1.f / 64.f) + EPS);
    bf16* yp = Y + (yrow0 + 16 * wl + li) * D + ycol0 + qb * 64;
#pragma unroll
    for (int db = 0; db < 4; ++db) {
      const f32x4 gv = *(const f32x4*)(mixg + ycol0 + qb * 64 + db * 16 + 4 * g);
      const f32x4 y = O[db][qb] * r * gv;
      u32x2 o; o.x = pk2(y[0], y[1]); o.y = pk2(y[2], y[3]);
      *(u32x2*)(yp + db * 16 + 4 * g) = o;
    }
  }
}

__device__ __forceinline__ void ret_u_item(unsigned char* lds, int gb, int tg, const bf16* zb, int h, int c, float lgf2, float lgb2, float* Uf, float* Ub) {
  const int lane = tg & 63, w = __builtin_amdgcn_readfirstlane(tg >> 6), g = lane >> 4, li = lane & 15;
  const int tok0 = c < 2 ? NSEQ + 128 * c : 128 * (c - 2);
  const bf16* kp = zb + ((size_t)(S_RK + h) * NT_TOK + tok0) * 64;
  const bf16* vp = zb + ((size_t)(S_RV + h) * NT_TOK + tok0) * 64;
  stage_rows<128, 4>(lds, gb, kp, 64, w, lane);
  {
    const int row = tg >> 1, half = tg & 1;
    const float wf = __builtin_amdgcn_exp2f(lgf2 * (float)(127 - row)), wb = __builtin_amdgcn_exp2f(lgb2 * (float)row);
#pragma unroll
    for (int c4 = 0; c4 < 4; ++c4) {
      const int chunk = half * 4 + c4;
      const u32x4 v = *(const u32x4*)(vp + (size_t)row * 64 + chunk * 8);
      u32x4 of, ob;
#pragma unroll
      for (int i = 0; i < 4; ++i) { const float lo = bflo(v[i]), hi = bfhi(v[i]); of[i] = pk2(lo * wf, hi * wf); ob[i] = pk2(lo * wb, hi * wb); }
      *(u32x4*)(lds + gb + 16384 + lds_swz(row, chunk)) = of;
      *(u32x4*)(lds + gb + 32768 + lds_swz(row, chunk)) = ob;
    }
  }
  VM_WAIT(); __syncthreads();
  const int q_ = li >> 2, p_ = li & 3, fv = (2 * g + (q_ >> 1)) & 7;
  const int toff = gb + (4 * g + q_) * 128 + (p_ & 1) * 8;
  f32x4 acc[2][4];
#pragma unroll
  for (int d_ = 0; d_ < 2; ++d_)
#pragma unroll
    for (int eb = 0; eb < 4; ++eb) acc[d_][eb] = (f32x4){0.f, 0.f, 0.f, 0.f};
#pragma unroll
  for (int ks = 0; ks < 4; ++ks) {
    const int a0 = ks * 4096 + toff + (((w * 2 + (p_ >> 1)) ^ fv) << 4);
    const bf16x8 kf = lds_tr2(lds, a0, a0 + 2048);
#pragma unroll
    for (int eb = 0; eb < 4; ++eb) {
      const int b0 = ks * 4096 + toff + (((eb * 2 + (p_ >> 1)) ^ fv) << 4);
      const bf16x8 vf = lds_tr2(lds, 16384 + b0, 16384 + b0 + 2048);
      const bf16x8 vb = lds_tr2(lds, 32768 + b0, 32768 + b0 + 2048);
      acc[0][eb] = __builtin_amdgcn_mfma_f32_16x16x32_bf16(kf, vf, acc[0][eb], 0, 0, 0);
      acc[1][eb] = __builtin_amdgcn_mfma_f32_16x16x32_bf16(kf, vb, acc[1][eb], 0, 0, 0);
    }
  }
#pragma unroll
  for (int eb = 0; eb < 4; ++eb) {
    *(f32x4*)(Uf + (eb * 16 + li) * 64 + w * 16 + 4 * g) = acc[0][eb];
    *(f32x4*)(Ub + (eb * 16 + li) * 64 + w * 16 + 4 * g) = acc[1][eb];
  }
  __syncthreads();
}

__device__ __forceinline__ void ret_out_item(unsigned char* lds, int gb, int tg, const bf16* zb, int h, int c, float lgf2, float lgb2, const float* Sf, const float* Sb,
                                             bf16* Y, size_t yrow0, const float* mixg) {
  const int lane = tg & 63, w = __builtin_amdgcn_readfirstlane(tg >> 6), g = lane >> 4, li = lane & 15;
  const int tok0 = c < 2 ? NSEQ + 128 * c : 128 * (c - 2);
  const bf16* qp = zb + ((size_t)(S_RQ + h) * NT_TOK + tok0) * 64;
  const bf16* kp = zb + ((size_t)(S_RK + h) * NT_TOK + tok0) * 64;
  const bf16* vp = zb + ((size_t)(S_RV + h) * NT_TOK + tok0) * 64;
  const bf16* gp = zb + ((size_t)(S_RG + h) * NT_TOK + tok0) * 64;
  stage_rows<128, 4>(lds, gb, kp, 64, w, lane);
  stage_rows<128, 4>(lds, gb + 16384, vp, 64, w, lane);
  {
    const int e = tg >> 2, dq = tg & 3;
#pragma unroll
    for (int hh = 0; hh < 2; ++hh) {
      const f32x4 a0 = *(const f32x4*)(Sf + e * 64 + dq * 16 + hh * 8), a1 = *(const f32x4*)(Sf + e * 64 + dq * 16 + hh * 8 + 4);
      const f32x4 b0 = *(const f32x4*)(Sb + e * 64 + dq * 16 + hh * 8), b1 = *(const f32x4*)(Sb + e * 64 + dq * 16 + hh * 8 + 4);
      u32x4 oa, ob; oa.x = pk2(a0[0], a0[1]); oa.y = pk2(a0[2], a0[3]); oa.z = pk2(a1[0], a1[1]); oa.w = pk2(a1[2], a1[3]);
      ob.x = pk2(b0[0], b0[1]); ob.y = pk2(b0[2], b0[3]); ob.z = pk2(b1[0], b1[1]); ob.w = pk2(b1[2], b1[3]);
      *(u32x4*)(lds + gb + 32768 + lds_swz(e, dq * 2 + hh)) = oa;
      *(u32x4*)(lds + gb + 40960 + lds_swz(e, dq * 2 + hh)) = ob;
    }
  }
  bf16x8 qf[2][2];
#pragma unroll
  for (int ib = 0; ib < 2; ++ib)
#pragma unroll
    for (int kk = 0; kk < 2; ++kk) qf[ib][kk] = *(const bf16x8*)(qp + (size_t)(32 * w + 16 * ib + li) * 64 + kk * 32 + g * 8);
  VM_WAIT(); __syncthreads();
  const int f = (li >> 1) & 7;
  const int koff = gb + li * 128 + ((g ^ f) << 4);
  const int q_ = li >> 2, p_ = li & 3, fv = (2 * g + (q_ >> 1)) & 7;
  const int voff = gb + 16384 + (4 * g + q_) * 128 + (p_ & 1) * 8;
  f32x4 O[4][2], CF[4][2], CB[4][2];
#pragma unroll
  for (int eb = 0; eb < 4; ++eb)
#pragma unroll
    for (int ib = 0; ib < 2; ++ib) { O[eb][ib] = (f32x4){0.f, 0.f, 0.f, 0.f}; CF[eb][ib] = O[eb][ib]; CB[eb][ib] = O[eb][ib]; }
#pragma unroll
  for (int ks = 0; ks < 4; ++ks) {
    f32x4 s[2][2];
#pragma unroll
    for (int h2 = 0; h2 < 2; ++h2) {
      s[h2][0] = (f32x4){0.f, 0.f, 0.f, 0.f}; s[h2][1] = s[h2][0];
#pragma unroll
      for (int kk = 0; kk < 2; ++kk) {
        const bf16x8 kf = lds_frag(lds, ((2 * ks + h2) * 2048 + koff) ^ (kk << 6));
        s[h2][0] = __builtin_amdgcn_mfma_f32_16x16x32_bf16(kf, qf[0][kk], s[h2][0], 0, 0, 0);
        s[h2][1] = __builtin_amdgcn_mfma_f32_16x16x32_bf16(kf, qf[1][kk], s[h2][1], 0, 0, 0);
      }
    }
    bf16x8 pf[2];
#pragma unroll
    for (int ib = 0; ib < 2; ++ib) {
      const int i = 32 * w + 16 * ib + li;
      float p[8];
#pragma unroll
      for (int h2 = 0; h2 < 2; ++h2)
#pragma unroll
        for (int j = 0; j < 4; ++j) {
          const int jj = (2 * ks + h2) * 16 + 4 * g + j, df = i - jj;
          const float dw = df > 0 ? __builtin_amdgcn_exp2f(lgf2 * (float)df) : (df < 0 ? __builtin_amdgcn_exp2f(lgb2 * (float)(-df)) : 2.f);
          p[h2 * 4 + j] = s[h2][ib][j] * dw;
        }
      u32x4 pw; pw.x = pk2(p[0], p[1]); pw.y = pk2(p[2], p[3]); pw.z = pk2(p[4], p[5]); pw.w = pk2(p[6], p[7]);
      pf[ib] = __builtin_bit_cast(bf16x8, pw);
    }
#pragma unroll
    for (int eb = 0; eb < 4; ++eb) {
      const int a0 = voff + ks * 4096 + (((eb * 2 + (p_ >> 1)) ^ fv) << 4);
      const bf16x8 vf = lds_tr2(lds, a0, a0 + 2048);
      O[eb][0] = __builtin_amdgcn_mfma_f32_16x16x32_bf16(vf, pf[0], O[eb][0], 0, 0, 0);
      O[eb][1] = __builtin_amdgcn_mfma_f32_16x16x32_bf16(vf, pf[1], O[eb][1], 0, 0, 0);
    }
  }
#pragma unroll
  for (int kk = 0; kk < 2; ++kk)
#pragma unroll
    for (int eb = 0; eb < 4; ++eb) {
      const bf16x8 sf = lds_frag(lds, 32768 + ((eb * 2048 + koff) ^ (kk << 6)));
      const bf16x8 sb = lds_frag(lds, 40960 + ((eb * 2048 + koff) ^ (kk << 6)));
#pragma unroll
      for (int ib = 0; ib < 2; ++ib) {
        CF[eb][ib] = __builtin_amdgcn_mfma_f32_16x16x32_bf16(sf, qf[ib][kk], CF[eb][ib], 0, 0, 0);
        CB[eb][ib] = __builtin_amdgcn_mfma_f32_16x16x32_bf16(sb, qf[ib][kk], CB[eb][ib], 0, 0, 0);
      }
    }
#pragma unroll
  for (int ib = 0; ib < 2; ++ib) {
    const int i = 32 * w + 16 * ib + li;
    const float xf = __builtin_amdgcn_exp2f(lgf2 * (float)(i + 1)), xb = __builtin_amdgcn_exp2f(lgb2 * (float)(128 - i));
    float ss = 0.f;
#pragma unroll
    for (int eb = 0; eb < 4; ++eb) { O[eb][ib] = O[eb][ib] + CF[eb][ib] * xf + CB[eb][ib] * xb; ss += O[eb][ib][0] * O[eb][ib][0] + O[eb][ib][1] * O[eb][ib][1] + O[eb][ib][2] * O[eb][ib][2] + O[eb][ib][3] * O[eb][ib][3]; }
    ss += __shfl_xor(ss, 16); ss += __shfl_xor(ss, 32);
    const float r = rsqrtf(ss * (1.f / 64.f) + EPS);
    bf16* yp = Y + (yrow0 + i) * D + 640 + h * 64;
#pragma unroll
    for (int eb = 0; eb < 4; ++eb) {
      const f32x4 gv = *(const f32x4*)(mixg + 640 + h * 64 + eb * 16 + 4 * g);
      const u32x2 gg = *(const u32x2*)(gp + (size_t)i * 64 + eb * 16 + 4 * g);
      const f32x4 y = O[eb][ib] * r * gv;
      u32x2 o; o.x = pk2(y[0] * bflo(gg.x), y[1] * bfhi(gg.x)); o.y = pk2(y[2] * bflo(gg.y), y[3] * bfhi(gg.y));
      *(u32x2*)(yp + eb * 16 + 4 * g) = o;
    }
  }
  __syncthreads();
}

__device__ __forceinline__ float log_sigmoid_f(float x) { return x >= 0.f ? -log1pf(expf(-x)) : x - log1pf(expf(x)); }

__device__ __forceinline__ void p0_mod_item(unsigned char* lds, const Params& P, int item) {
  const int l = item / 96, chunk = item % 96, tid = get_tid(), ks = tid >> 4, cg4 = tid & 15;
  float* red = (float*)lds;
  float* sil = (float*)(lds + 32768);
#pragma unroll
  for (int i = 0; i < 2; ++i) { const int k = tid + 512 * i; sil[k] = silu_f(P.c[k]); sil[1024 + k] = silu_f(P.c[1024 + k]); sil[2048 + k] = silu_f(P.c_ctx[k]); }
  __syncthreads();
  const float* wa = P.w_ada + (size_t)l * 1024 * 6144 + chunk * 64 + cg4 * 4;
  f32x4 a0 = {0.f, 0.f, 0.f, 0.f}, a1 = a0, a2 = a0;
#pragma unroll 16
  for (int i = 0; i < 32; ++i) {
    const int k = ks * 32 + i;
    const f32x4 wv = __builtin_nontemporal_load((const f32x4*)(wa + (size_t)k * 6144));
    a0 += wv * sil[k]; a1 += wv * sil[1024 + k]; a2 += wv * sil[2048 + k];
  }
  *(f32x4*)(red + (ks * 3 + 0) * 64 + cg4 * 4) = a0; *(f32x4*)(red + (ks * 3 + 1) * 64 + cg4 * 4) = a1; *(f32x4*)(red + (ks * 3 + 2) * 64 + cg4 * 4) = a2;
  __syncthreads();
  if (tid < 192) {
    const int seg = tid >> 6, col = tid & 63; float s = P.b_ada[l * 6144 + chunk * 64 + col];
#pragma unroll
    for (int k2 = 0; k2 < 32; ++k2) s += red[(k2 * 3 + seg) * 64 + col];
    ((float*)(P.ws + WS_MOD))[(l * 3 + seg) * 6144 + chunk * 64 + col] = s;
  }
  __syncthreads();
}

__device__ __forceinline__ void p0_tr_item(unsigned char* lds, const float* src, int srcN, int k0, int n0, bf16* dst, int dstK, int mode) {
  float* tile = (float*)lds;
  const int tid = get_tid();
  f32x4 v[8];
#pragma unroll
  for (int ps = 0; ps < 8; ++ps) v[ps] = __builtin_nontemporal_load((const f32x4*)(src + (size_t)(k0 + (tid >> 5) + 16 * ps) * srcN + n0 + (tid & 31) * 4));
#pragma unroll
  for (int ps = 0; ps < 8; ++ps) { float* tp = tile + ((tid >> 5) + 16 * ps) * 129 + (tid & 31) * 4; tp[0] = v[ps][0]; tp[1] = v[ps][1]; tp[2] = v[ps][2]; tp[3] = v[ps][3]; }
  __syncthreads();
  const int n = tid >> 2, kc = tid & 3, ncol = n0 + n;
  int row = ncol;
  if (mode) row = (ncol >> 4) * 32 + (ncol & 15) + (mode == 2 ? 16 : 0);
  bf16* dp = dst + (size_t)row * dstK + k0 + kc * 32;
  const float* tp = tile + (kc * 32) * 129 + n;
#pragma unroll
  for (int q = 0; q < 4; ++q) {
    u32x4 o;
#pragma unroll
    for (int i = 0; i < 4; ++i) o[i] = pk2(tp[(q * 8 + 2 * i) * 129], tp[(q * 8 + 2 * i + 1) * 129]);
    *(u32x4*)(dp + q * 8) = o;
  }
  __syncthreads();
}

constexpr int P0_MOD = 192, P0_MISC = 1, P0_WIN = 2 * 8 * 23, P0_WO = 2 * 8 * 8, P0_W1 = 32 * 32, P0_W2 = 32 * 32;
constexpr int P0_ITEMS = P0_MOD + P0_MISC + P0_WIN + P0_WO + 2 * P0_W1 + P0_W2;

__device__ __forceinline__ void phase0(unsigned char* lds, const Params& P) {
#pragma unroll 1
  for (int it = blockIdx.x; it < P0_ITEMS; it += gridDim.x) {
    int r = it;
    if (r < P0_MOD) { p0_mod_item(lds, P, r); continue; } r -= P0_MOD;
    if (r < P0_MISC) {
      const int tid = get_tid();
      float* rope = (float*)(P.ws + WS_ROPE);
      for (int e = tid; e < 2048; e += NTHR) { const int pos = e >> 4, f = e & 15; const float inv = powf(10000.f, -(float)f / 16.f); const float ang = (float)pos * inv; rope[e * 2] = cosf(ang); rope[e * 2 + 1] = sinf(ang); }
      continue;
    } r -= P0_MISC;
    const float* src; int srcN, k0, n0, dstK, mode; bf16* dst;
    if (r < P0_WIN) { const int l = r / 184, q = r % 184, kt = q / 23, nt = q % 23;
      src = P.w_in + (size_t)l * 1024 * INC; srcN = INC; k0 = kt * 128; n0 = nt * 128; dst = (bf16*)(P.ws + WS_WIN) + (size_t)l * INC * 1024; dstK = 1024; mode = 0; }
    else if (r < P0_WIN + P0_WO) { const int r2 = r - P0_WIN, l = r2 / 64, q = r2 % 64, kt = q / 8, nt = q % 8;
      src = P.w_out + (size_t)l * 1024 * 1024; srcN = 1024; k0 = kt * 128; n0 = nt * 128; dst = (bf16*)(P.ws + WS_WO) + (size_t)l * 1024 * 1024; dstK = 1024; mode = 0; }
    else if (r < P0_WIN + P0_WO + 2 * P0_W1) { const int r2 = r - P0_WIN - P0_WO, which = r2 / P0_W1, q2 = r2 % P0_W1, le = q2 / 32, q = q2 % 32, kt = q / 4, nt = q % 4;
      src = (which ? P.w3 : P.w1) + (size_t)le * 1024 * 512; srcN = 512; k0 = kt * 128; n0 = nt * 128; dst = (bf16*)(P.ws + WS_W13) + (size_t)le * 1024 * 1024; dstK = 1024; mode = which ? 2 : 1; }
    else { const int r2 = r - P0_WIN - P0_WO - 2 * P0_W1, le = r2 / 32, q = r2 % 32, kt = q / 8, nt = q % 8;
      src = P.w2 + (size_t)le * 512 * 1024; srcN = 1024; k0 = kt * 128; n0 = nt * 128; dst = (bf16*)(P.ws + WS_W2) + (size_t)le * 1024 * 512; dstK = 512; mode = 0; }
    p0_tr_item(lds, src, srcN, k0, n0, dst, dstK, mode);
  }
}

constexpr int P1_XB = NROWS / 16, P1_BIAS = 2 * INC / 8, P1_WR = 6, P1_ITEMS = P1_XB + P1_BIAS + P1_WR;
__device__ __forceinline__ void phase1(unsigned char* lds, const Params& P) {
  const int tid = get_tid(), lane = tid & 63, w = tid >> 6;
  const float* mod = (const float*)(P.ws + WS_MOD);
#pragma unroll 1
  for (int it = blockIdx.x; it < P1_ITEMS; it += gridDim.x) {
    int r = it;
    if (r < P1_XB) {
      f32x4 v[2][4];
#pragma unroll
      for (int u = 0; u < 2; ++u) { const int row = r * 16 + 2 * w + u; const float* xr = row < NLAT ? P.x + (size_t)row * D : P.ctx + (size_t)(row - NLAT) * D;
#pragma unroll
        for (int j = 0; j < 4; ++j) v[u][j] = __builtin_nontemporal_load((const f32x4*)(xr + 4 * lane + 256 * j)); }
      const int row0 = r * 16 + 2 * w, seg = row0 < NSEQ ? 0 : (row0 < NLAT ? 1 : 2);
      const float* sc1 = mod + (0 * 3 + seg) * 6144 + 1024;
      f32x4 gs[4];
#pragma unroll
      for (int j = 0; j < 4; ++j) { const int k = 4 * lane + 256 * j; gs[j] = *(const f32x4*)(P.n1g + k) * (*(const f32x4*)(sc1 + k) + 1.f); }
#pragma unroll
      for (int u = 0; u < 2; ++u) {
        const int row = row0 + u; bf16* xb = (bf16*)(P.ws + WS_R1) + (size_t)row * D; float ss = 0.f;
#pragma unroll
        for (int j = 0; j < 4; ++j) { const f32x4 x = v[u][j]; ss += x[0] * x[0] + x[1] * x[1] + x[2] * x[2] + x[3] * x[3]; const f32x4 o = x * gs[j]; u32x2 ov; ov.x = pk2(o[0], o[1]); ov.y = pk2(o[2], o[3]); *(u32x2*)(xb + 4 * lane + 256 * j) = ov; }
        ss = wsum(ss);
        if (lane == 0) ((float*)(P.ws + WS_RSS))[row] = ss;
      }
      continue;
    } r -= P1_XB;
    if (r < P1_BIAS) {
      const int idx = r * 8 + w, l = idx / INC, n = idx % INC;
      const bf16* wrow = (const bf16*)(P.ws + WS_WIN) + ((size_t)l * INC + n) * 1024 + lane * 16;
      const u32x4 w0 = *(const u32x4*)wrow, w1 = *(const u32x4*)(wrow + 8);
      float wv[16];
#pragma unroll
      for (int i = 0; i < 4; ++i) { wv[2 * i] = bflo(w0[i]); wv[2 * i + 1] = bfhi(w0[i]); wv[8 + 2 * i] = bflo(w1[i]); wv[8 + 2 * i + 1] = bfhi(w1[i]); }
#pragma unroll
      for (int seg = 0; seg < 3; ++seg) {
        const float* sh = mod + (l * 3 + seg) * 6144 + lane * 16; float a = 0.f;
#pragma unroll
        for (int i = 0; i < 16; ++i) a += wv[i] * sh[i];
        a = wsum(a);
        if (lane == 0) ((float*)(P.ws + WS_BIAS))[(l * 3 + seg) * INC + n] = a;
      }
      continue;
    } r -= P1_BIAS;
    { const int l = r / 3, seg = r % 3;
      const float* m = mod + (l * 3 + seg) * 6144;
      float* wr = (float*)(P.ws + WS_WR) + (size_t)(l * 3 + seg) * 16384;
      for (int e = tid; e < 16384; e += NTHR) { const int k = e >> 4; wr[e] = P.n2g[l * 1024 + k] * (1.f + m[4096 + k]) * P.w_router[e]; }
      const int ex = tid & 15, ks = tid >> 4; float a = 0.f;
      for (int i = 0; i < 32; ++i) { const int k = ks * 32 + i; a += m[3072 + k] * P.w_router[k * 16 + ex]; }
      float* red = (float*)lds; red[ks * 16 + ex] = a; __syncthreads();
      if (tid < 16) { float s = P.b_router[tid]; for (int k2 = 0; k2 < 32; ++k2) s += red[k2 * 16 + tid]; ((float*)(P.ws + WS_CR))[(l * 3 + seg) * 16 + tid] = s; }
      __syncthreads();
    }
  }
}

__device__ __forceinline__ int xcd_vidx(int round) {
  const int G = gridDim.x, b = blockIdx.x;
  return (G & 7) == 0 ? round * G + (b & 7) * (G >> 3) + (b >> 3) : round * G + b;
}

__device__ __forceinline__ void phaseA(unsigned char* lds, const Params& P, int l) {
  const bf16* XB = (const bf16*)(P.ws + WS_R1);
  const bf16* Wt = (const bf16*)(P.ws + WS_WIN) + (size_t)l * INC * 1024;
  { const int tid = get_tid(); const f32x4* s4 = (const f32x4*)(P.ws + WS_ROPE); f32x4* d4 = (f32x4*)(lds + LDS_MISC);
    for (int e = tid; e < 1024; e += NTHR) d4[e] = s4[e];
    __syncthreads(); }
  const float* ropel = (const float*)(lds + LDS_MISC);
  EpiInProj<8, 4> E4{(const float*)(P.ws + WS_RSS), (const float*)(P.ws + WS_BIAS) + l * 3 * INC, P.qg + l * 64, P.kg + l * 64, ropel, (bf16*)(P.ws + WS_Z)};
  EpiInProj<8, 2> E2{(const float*)(P.ws + WS_RSS), (const float*)(P.ws + WS_BIAS) + l * 3 * INC, P.qg + l * 64, P.kg + l * 64, ropel, (bf16*)(P.ws + WS_Z)};
  constexpr int NFULL = 66 * 11, NITEM = NFULL + 33;
  const int c0 = xcd_vidx(0), G = gridDim.x;
  const int nfull = c0 < NFULL ? (NFULL - c0 + G - 1) / G : 0;
  { SrcA8 S{XB, Wt, &E4, c0, G, nfull};
    gemm8_stream(lds, S); }
#pragma unroll 1
  for (int v = c0 + nfull * G; v < NITEM; v += G) {
    if (v < NFULL) continue;
    const int m2 = (v - NFULL) * 2;
#pragma unroll 1
    for (int h = 0; h < 2; ++h) { ARowLinear ar{XB, 1024, (m2 + h) * 256}; gemm_tile<8, 2>(lds, ar, Wt, 1024, (m2 + h) * 256, 2816, E2); }
  }
}


__device__ __forceinline__ u32x2 tr_read_asm0(unsigned a) { u32x2 r; asm volatile("ds_read_b64_tr_b16 %0, %1 offset:8192" : "=v"(r) : "v"(a)); return r; }
__device__ __forceinline__ u32x2 tr_read_asm1(unsigned a) { u32x2 r; asm volatile("ds_read_b64_tr_b16 %0, %1 offset:10240" : "=v"(r) : "v"(a)); return r; }
__device__ __forceinline__ u32x2 tr_read_asm2(unsigned a) { u32x2 r; asm volatile("ds_read_b64_tr_b16 %0, %1 offset:12288" : "=v"(r) : "v"(a)); return r; }
__device__ __forceinline__ u32x2 tr_read_asm3(unsigned a) { u32x2 r; asm volatile("ds_read_b64_tr_b16 %0, %1 offset:14336" : "=v"(r) : "v"(a)); return r; }
#define PP_SCHED __builtin_amdgcn_sched_barrier(0)
template <int NQB>
__device__ __forceinline__ void attn_pp_item(unsigned char* lds, int wl, int lane, const bf16* zb, int sq0, int sk, int sv, int qtok0, int nlat, int ntiles,
                                             bf16* Y, size_t yrow0, int ycol0, const float* mixg) {
  const int g = lane >> 4, li = lane & 15, half = wl >> 2;
  const int qtok = qtok0 + 16 * wl + li;
  bf16x8 qf[NQB][2];
#pragma unroll
  for (int qb = 0; qb < NQB; ++qb)
#pragma unroll
    for (int kk = 0; kk < 2; ++kk) qf[qb][kk] = *(const bf16x8*)(zb + ((size_t)(sq0 + qb) * NT_TOK + qtok) * 64 + kk * 32 + g * 8);
  const bf16* kbp = zb + (size_t)sk * NT_TOK * 64;
  const bf16* vbp = zb + (size_t)sv * NT_TOK * 64;
  f32x4 O[4][NQB], L[NQB];
  const bf16x8 ones = {0x3f80, 0x3f80, 0x3f80, 0x3f80, 0x3f80, 0x3f80, 0x3f80, 0x3f80};
#pragma unroll
  for (int qb = 0; qb < NQB; ++qb) { L[qb] = (f32x4){0.f, 0.f, 0.f, 0.f};
#pragma unroll
    for (int db = 0; db < 4; ++db) O[db][qb] = (f32x4){0.f, 0.f, 0.f, 0.f}; }
  const int f = (li >> 1) & 7;
  const int koff = li * 128 + ((g ^ f) << 4);
  const int q_ = li >> 2, p_ = li & 3, fv = (2 * g + (q_ >> 1)) & 7;
  const unsigned lbase = (unsigned)(size_t)(LAS unsigned char*)lds;
  unsigned vo[4];
#pragma unroll
  for (int db = 0; db < 4; ++db) vo[db] = lbase + (4 * g + q_) * 128 + (p_ & 1) * 8 + (((db * 2 + (p_ >> 1)) ^ fv) << 4);
#define PP_TOK(t) ((t) < nlat ? 64 * (t) : NSEQ + 64 * ((t) - nlat))
#define PP_STAGE(t) do { const int tk_ = PP_TOK(t); const int so_ = ((t) & 3) * 16384; stage_rows<64, 8>(lds, so_, kbp + (size_t)tk_ * 64, 64, wl, lane); \
                         stage_rows<64, 8>(lds, so_ + 8192, vbp + (size_t)tk_ * 64, 64, wl, lane); } while (0)
  bf16x8 kf[2][2], pf[NQB];
  u32x2 va[4], vb[4];
  f32x4 s[2][NQB];
#define PP_READK(hh) do { const int so_ = (((hh) >> 1) & 3) * 16384 + ((hh) & 1) * 4096; _Pragma("unroll") for (int h2 = 0; h2 < 2; ++h2) _Pragma("unroll") for (int kk = 0; kk < 2; ++kk) \
                            kf[h2][kk] = lds_frag(lds, so_ + ((h2 * 2048 + koff) ^ (kk << 6))); } while (0)
#define PP_READV(hh) do { const unsigned so_ = (((hh) >> 1) & 3) * 16384; if ((hh) & 1) { _Pragma("unroll") for (int db = 0; db < 4; ++db) { va[db] = tr_read_asm2(vo[db] + so_); vb[db] = tr_read_asm3(vo[db] + so_); } } \
                            else { _Pragma("unroll") for (int db = 0; db < 4; ++db) { va[db] = tr_read_asm0(vo[db] + so_); vb[db] = tr_read_asm1(vo[db] + so_); } } } while (0)
#define PP_SMMA() do { _Pragma("unroll") for (int h2 = 0; h2 < 2; ++h2) _Pragma("unroll") for (int qb = 0; qb < NQB; ++qb) \
                           s[h2][qb] = __builtin_amdgcn_mfma_f32_16x16x32_bf16(kf[h2][0], qf[qb][0], (f32x4){0.f, 0.f, 0.f, 0.f}, 0, 0, 0); \
                         _Pragma("unroll") for (int h2 = 0; h2 < 2; ++h2) _Pragma("unroll") for (int qb = 0; qb < NQB; ++qb) \
                           s[h2][qb] = __builtin_amdgcn_mfma_f32_16x16x32_bf16(kf[h2][1], qf[qb][1], s[h2][qb], 0, 0, 0); } while (0)
#define PP_PV() do { asm volatile("s_waitcnt lgkmcnt(0)" : "+v"(va[0]), "+v"(va[1]), "+v"(va[2]), "+v"(va[3]), "+v"(vb[0]), "+v"(vb[1]), "+v"(vb[2]), "+v"(vb[3]) :: "memory"); \
                       _Pragma("unroll") for (int qb = 0; qb < NQB; ++qb) L[qb] = __builtin_amdgcn_mfma_f32_16x16x32_bf16(ones, pf[qb], L[qb], 0, 0, 0); \
                       _Pragma("unroll") for (int db = 0; db < 4; ++db) { u32x4 vw; vw.x = va[db].x; vw.y = va[db].y; vw.z = vb[db].x; vw.w = vb[db].y; const bf16x8 vf = __builtin_bit_cast(bf16x8, vw); \
                         _Pragma("unroll") for (int qb = 0; qb < NQB; ++qb) O[db][qb] = __builtin_amdgcn_mfma_f32_16x16x32_bf16(vf, pf[qb], O[db][qb], 0, 0, 0); } } while (0)
#define PP_EXP() do { _Pragma("unroll") for (int qb = 0; qb < NQB; ++qb) { u32x4 pw; \
                        pw.x = pk2(__builtin_amdgcn_exp2f(s[0][qb][0]), __builtin_amdgcn_exp2f(s[0][qb][1])); pw.y = pk2(__builtin_amdgcn_exp2f(s[0][qb][2]), __builtin_amdgcn_exp2f(s[0][qb][3])); \
                        pw.z = pk2(__builtin_amdgcn_exp2f(s[1][qb][0]), __builtin_amdgcn_exp2f(s[1][qb][1])); pw.w = pk2(__builtin_amdgcn_exp2f(s[1][qb][2]), __builtin_amdgcn_exp2f(s[1][qb][3])); \
                        pf[qb] = __builtin_bit_cast(bf16x8, pw); } } while (0)
#define PP_BAR() do { PP_SCHED; RAW_BAR(); PP_SCHED; } while (0)
  PP_STAGE(0);
  if (ntiles > 1) PP_STAGE(1);
  if (ntiles > 2) PP_STAGE(2);
  if (ntiles > 2) VMCNT(4); else if (ntiles > 1) VMCNT(2); else VMCNT(0);
  RAW_BAR();
  PP_READK(0);
  if (half) PP_BAR();
  PP_SMMA();
  PP_BAR();
  PP_EXP(); PP_READV(0); PP_READK(1);
  if (ntiles > 2) VMCNT(2); else VMCNT(0);
  PP_BAR();
#pragma unroll 1
  for (int t = 0; t < ntiles; ++t) {
    const int h1 = 2 * t + 1;
    PP_PV(); PP_SMMA();
    PP_BAR();
    PP_EXP(); PP_READV(h1);
    if (t + 1 < ntiles) PP_READK(h1 + 1);
    if (t + 3 < ntiles) PP_STAGE(t + 3);
    PP_BAR();
    if (t + 1 < ntiles) {
      PP_PV(); PP_SMMA();
      PP_BAR();
      PP_EXP(); PP_READV(h1 + 1); PP_READK(h1 + 2);
      if (t + 3 < ntiles) VMCNT(2); else VMCNT(0);
      PP_BAR();
    }
  }
  PP_PV();
  if (!half) PP_BAR();
#undef PP_TOK
#undef PP_STAGE
#pragma unroll
  for (int qb = 0; qb < NQB; ++qb) {
    const float inv = 1.f / L[qb][0];
    float ss = 0.f;
#pragma unroll
    for (int db = 0; db < 4; ++db) { O[db][qb] = O[db][qb] * inv; ss += O[db][qb][0] * O[db][qb][0] + O[db][qb][1] * O[db][qb][1] + O[db][qb][2] * O[db][qb][2] + O[db][qb][3] * O[db][qb][3]; }
    ss += __shfl_xor(ss, 16); ss += __shfl_xor(ss, 32);
    const float r = rsqrtf(ss * (1.f / 64.f) + EPS);
    bf16* yp = Y + (yrow0 + 16 * wl + li) * D + ycol0 + qb * 64;
#pragma unroll
    for (int db = 0; db < 4; ++db) {
      const f32x4 gv = *(const f32x4*)(mixg + ycol0 + qb * 64 + db * 16 + 4 * g);
      const f32x4 y = O[db][qb] * r * gv;
      u32x2 o; o.x = pk2(y[0], y[1]); o.y = pk2(y[2], y[3]);
      *(u32x2*)(yp + db * 16 + 4 * g) = o;
    }
  }
}

__device__ __forceinline__ void phaseB(unsigned char* lds, const Params& P, int l) {
  const bool ctxout = (l == 0);
  const bf16* Z = (const bf16*)(P.ws + WS_Z);
  bf16* Y = (bf16*)P.out;
  const float* mixg = P.mix_g + l * 1024;
  const int tid = get_tid(), lane = tid & 63, w = __builtin_amdgcn_readfirstlane(tid >> 6), grp = w >> 2, wl4 = w & 3, tg = tid & 255, G = gridDim.x;
  { const int n = 256 + (ctxout ? 8 : 0);
#pragma unroll 1
    for (int r = blockIdx.x; r < n; r += G) {
      int b, kvh, qtok0, nlat, ntiles; size_t yrow0;
      if (r < 256) { b = r >> 7; kvh = (r >> 6) & 1; const int qt = r & 63; qtok0 = qt * 128; nlat = 128; ntiles = 132; yrow0 = (size_t)b * NSEQ + qt * 128; }
      else { const int q = r - 256; b = q >> 2; kvh = (q >> 1) & 1; const int qt = q & 1; qtok0 = NSEQ + qt * 128; nlat = 0; ntiles = 4; yrow0 = (size_t)NLAT + b * CL + qt * 128; }
      attn_pp_item<3>(lds, w, lane, Z + (size_t)b * NSLOT * NT_TOK * 64, S_AQ + kvh * 3, S_AK + kvh, S_AV + kvh, qtok0, nlat, ntiles, Y, yrow0, kvh * 192, mixg);
      __syncthreads();
    }
  }
  { const int n = 1024 + (ctxout ? 32 : 0);
    int start = (int)blockIdx.x - 8; if (start < 0) start += G;
#pragma unroll 1
    for (int pr = start; pr * 2 < n; pr += G) {
      const int r = pr * 2 + grp;
      int b, h, qtok0, lat0, nlat, ntiles, drbase; size_t yrow0;
      if (r < 1024) { b = r >> 9; h = (r >> 7) & 3; const int row = r & 127; int rs = row - 4; rs = rs < 0 ? 0 : (rs > 120 ? 120 : rs);
        qtok0 = row * 64; lat0 = rs * 64; nlat = 8; ntiles = 12; drbase = rs - row + 7; yrow0 = (size_t)b * NSEQ + row * 64; }
      else { const int q = r - 1024; b = q >> 4; h = (q >> 2) & 3; const int qt = q & 3; qtok0 = NSEQ + qt * 64; lat0 = 0; nlat = 0; ntiles = 4; drbase = 0; yrow0 = (size_t)NLAT + b * CL + qt * 64; }
      float* rp = (float*)(lds + grp * 65536 + 49152);
      const float* src = P.rpb + ((size_t)l * 4 + h) * 465;
      for (int e = tg; e < 465; e += 256) rp[e] = src[e] * LOG2E;
      __syncthreads();
      attn_item<1, true, 4>(lds, grp * 65536, wl4, lane, Z + (size_t)b * NSLOT * NT_TOK * 64, S_NQ + h, S_NK + h, S_NV + h, qtok0, lat0, nlat, ntiles, drbase, Y, yrow0, 384 + h * 64, mixg);
    }
  }
  { int start = (int)blockIdx.x - 40; if (start < 0) start += G;
#pragma unroll 1
    for (int pr = start; pr * 2 < 2 * 6 * 66; pr += G) {
      const int r = pr * 2 + grp;
      const int b = r / 396, q = r % 396, h = q / 66, c = q % 66;
      const float lgf2 = log_sigmoid_f(P.ret_decay[(l * 2 + 0) * 6 + h]) * LOG2E, lgb2 = log_sigmoid_f(P.ret_decay[(l * 2 + 1) * 6 + h]) * LOG2E;
      float* U = (float*)(P.ws + WS_R1);
      ret_u_item(lds, grp * 65536, tg, Z + (size_t)b * NSLOT * NT_TOK * 64, h, c, lgf2, lgb2, U + ((size_t)((b * 6 + h) * 2 + 0) * 66 + c) * 4096, U + ((size_t)((b * 6 + h) * 2 + 1) * 66 + c) * 4096);
    }
  }
}

__device__ __forceinline__ void phaseB2(const Params& P, int l) {
  const float* U = (const float*)(P.ws + WS_R1);
#pragma unroll 1
  for (int it = blockIdx.x; it < 192; it += gridDim.x) {
    const int seq = it >> 3, off = (it & 7) * 512 + get_tid();
    const int dir = seq & 1, h = (seq >> 1) % 6;
    const float lg = log_sigmoid_f(P.ret_decay[(l * 2 + dir) * 6 + h]);
    const float decay = expf(128.f * lg);
    const float* base = U + (size_t)seq * 66 * 4096 + off;
    float* sbase = (float*)((unsigned char*)P.out + S_OFF) + (size_t)seq * 66 * 4096 + off;
    float u[66];
    if (dir == 0) {
#pragma unroll
      for (int st = 0; st < 66; ++st) u[st] = __builtin_nontemporal_load(base + (size_t)st * 4096);
      float s = 0.f;
#pragma unroll
      for (int st = 0; st < 66; ++st) { sbase[(size_t)st * 4096] = s; s = s * decay + u[st]; }
    } else {
#pragma unroll
      for (int st = 0; st < 66; ++st) { const int c = st < 2 ? 1 - st : 67 - st; u[st] = __builtin_nontemporal_load(base + (size_t)c * 4096); }
      float s = 0.f;
#pragma unroll
      for (int st = 0; st < 66; ++st) { const int c = st < 2 ? 1 - st : 67 - st; sbase[(size_t)c * 4096] = s; s = s * decay + u[st]; }
    }
  }
}

__device__ __forceinline__ void phaseB3(unsigned char* lds, const Params& P, int l) {
  const bf16* Z = (const bf16*)(P.ws + WS_Z);
  bf16* Y = (bf16*)P.out;
  const float* mixg = P.mix_g + l * 1024;
  const float* U = (const float*)((const unsigned char*)P.out + S_OFF);
  const int tid = get_tid(), grp = __builtin_amdgcn_readfirstlane(tid >> 8), tg = tid & 255;
  const int cpb = (l == 0) ? 66 : 64, total = 2 * 6 * cpb;
#pragma unroll 1
  for (int pr = blockIdx.x; pr * 2 < total; pr += gridDim.x) {
    const int it = pr * 2 + grp;
    const int b = it / (6 * cpb), q = it % (6 * cpb), h = q / cpb, c = (q % cpb) + (66 - cpb);
    const float lgf2 = log_sigmoid_f(P.ret_decay[(l * 2 + 0) * 6 + h]) * LOG2E, lgb2 = log_sigmoid_f(P.ret_decay[(l * 2 + 1) * 6 + h]) * LOG2E;
    const size_t yrow0 = c < 2 ? (size_t)NLAT + b * CL + 128 * c : (size_t)b * NSEQ + 128 * (c - 2);
    ret_out_item(lds, grp * 65536, tg, Z + (size_t)b * NSLOT * NT_TOK * 64, h, c, lgf2, lgb2, U + ((size_t)((b * 6 + h) * 2 + 0) * 66 + c) * 4096, U + ((size_t)((b * 6 + h) * 2 + 1) * 66 + c) * 4096, Y, yrow0, mixg);
  }
}

__device__ __forceinline__ void pc_small_item(const Params& P, int l, int item) {
  const int tid = get_tid(), lane = tid & 63, w = tid >> 6, g = lane >> 4, li = lane & 15;
  const bf16* Y = (const bf16*)P.out;
  const bf16* Wt = (const bf16*)(P.ws + WS_WO) + (size_t)l * 1024 * 1024;
  float* XR = (float*)(P.ws + WS_XR);
  const int mb = item >> 5, nb = item & 31;
  const int m0 = NLAT + mb * 64 + (w >> 1) * 16, n0 = nb * 32 + (w & 1) * 16;
  const bf16* ar = Y + (size_t)(m0 + li) * D + g * 8;
  const bf16* br = Wt + (size_t)(n0 + li) * D + g * 8;
  f32x4 acc = {0.f, 0.f, 0.f, 0.f};
#pragma unroll 1
  for (int kb = 0; kb < 32; kb += 8) {
    bf16x8 af[8], bf[8];
#pragma unroll
    for (int c = 0; c < 8; ++c) { af[c] = *(const bf16x8*)(ar + (kb + c) * 32); bf[c] = *(const bf16x8*)(br + (kb + c) * 32); }
#pragma unroll
    for (int c = 0; c < 8; ++c) acc = __builtin_amdgcn_mfma_f32_16x16x32_bf16(bf[c], af[c], acc, 0, 0, 0);
  }
  const int m = m0 + li, n = n0 + 4 * g;
  const float* gt = (const float*)(P.ws + WS_MOD) + (l * 3 + 2) * 6144 + 2048;
  const f32x4 xv = *(const f32x4*)(P.ctx + (size_t)(m - NLAT) * D + n), gv = *(const f32x4*)(gt + n);
  *(f32x4*)(XR + (size_t)m * D + n) = xv + gv * acc;
}
__device__ __forceinline__ void phaseC(unsigned char* lds, const Params& P, int l) {
  const bf16* Y = (const bf16*)P.out;
  const bf16* Wt = (const bf16*)(P.ws + WS_WO) + (size_t)l * 1024 * 1024;
  float* XR = (float*)(P.ws + WS_XR);
  EpiOutProj E{l == 0 ? P.x : XR, l == 0 ? P.ctx : XR + (size_t)NLAT * D, (const float*)(P.ws + WS_MOD) + l * 3 * 6144, XR};
  const int nitem = NLAT / 256 * 4;
  { const int c0 = xcd_vidx(0), G = gridDim.x;
    SrcC8 S{Y, Wt, &E, c0, G, c0 < nitem ? (nitem - c0 + G - 1) / G : 0};
    gemm8_stream(lds, S); }
  if (l == 0) {
#pragma unroll 1
    for (int it = blockIdx.x; it < 256; it += gridDim.x) pc_small_item(P, l, it);
  }
}

__device__ __forceinline__ void phaseD(unsigned char* lds, const Params& P, int l) {
  const int tid = get_tid(), lane = tid & 63, w = tid >> 6, g = lane >> 4, li = lane & 15;
  const float* XR = (const float*)(P.ws + WS_XR);
  bf16* H2 = (bf16*)(P.ws + WS_R1);
  int* cnt = (int*)(P.ws + WS_CNT) + l * 16;
  int* list = (int*)(P.ws + WS_LIST) + (size_t)l * 16 * NROWS;
  float* gatew = (float*)(P.ws + WS_GATEW);
  float* part = (float*)lds;
  float* ssqp = part + 2048;
  float* rsl = ssqp + 128;
  int* hist = (int*)(rsl + 64);
  const int nitems = NLAT / 64 + (l == 0 ? 32 : 0);
  const int rgp = w >> 1, kh = w & 1;
#pragma unroll 1
  for (int it = blockIdx.x; it < nitems; it += gridDim.x) {
    const int nrows = it < NLAT / 64 ? 64 : 16;
    const int r0 = it < NLAT / 64 ? it * 64 : NLAT + (it - NLAT / 64) * 16, seg = r0 < NSEQ ? 0 : (r0 < NLAT ? 1 : 2);
    const bool active = rgp * 16 < nrows;
    const float* wr = (const float*)(P.ws + WS_WR) + (size_t)(l * 3 + seg) * 16384;
    const float* xrow = XR + (size_t)(r0 + (active ? rgp * 16 : 0) + li) * D + 512 * kh + 4 * g;
    const float* wp0 = wr + (size_t)(512 * kh + 4 * g) * 16 + li;
    if (tid < 32) hist[tid] = 0;
    f32x4 acc = {0.f, 0.f, 0.f, 0.f}; float ssq = 0.f;
#pragma unroll 1
    for (int cb = 0; cb < (active ? 32 : 0); cb += 8) {
      f32x4 xv[8]; float bw[8][4];
#pragma unroll
      for (int c = 0; c < 8; ++c) {
        xv[c] = *(const f32x4*)(xrow + 16 * (cb + c));
        const float* wp = wp0 + (cb + c) * 256;
        bw[c][0] = wp[0]; bw[c][1] = wp[16]; bw[c][2] = wp[32]; bw[c][3] = wp[48];
      }
#pragma unroll
      for (int c = 0; c < 8; ++c) {
        ssq += xv[c][0] * xv[c][0] + xv[c][1] * xv[c][1] + xv[c][2] * xv[c][2] + xv[c][3] * xv[c][3];
        acc = __builtin_amdgcn_mfma_f32_16x16x4f32(xv[c][0], bw[c][0], acc, 0, 0, 0);
        acc = __builtin_amdgcn_mfma_f32_16x16x4f32(xv[c][1], bw[c][1], acc, 0, 0, 0);
        acc = __builtin_amdgcn_mfma_f32_16x16x4f32(xv[c][2], bw[c][2], acc, 0, 0, 0);
        acc = __builtin_amdgcn_mfma_f32_16x16x4f32(xv[c][3], bw[c][3], acc, 0, 0, 0);
      }
    }
    ssq += __shfl_xor(ssq, 16); ssq += __shfl_xor(ssq, 32);
#pragma unroll
    for (int j = 0; j < 4; ++j) part[(w * 16 + 4 * g + j) * 16 + li] = acc[j];
    if (g == 0) ssqp[w * 16 + li] = ssq;
    __syncthreads();
    int e1 = 0, e2 = 0, q1 = 0, q2 = 0; float g1 = 0.f, g2 = 0.f;
    if (tid < nrows) {
      const int rg2 = tid >> 4, rr = tid & 15;
      const float ss = ssqp[(2 * rg2) * 16 + rr] + ssqp[(2 * rg2 + 1) * 16 + rr];
      const float rs = rsqrtf(ss * (1.f / 1024.f) + EPS);
      rsl[tid] = rs;
      const float* cr = (const float*)(P.ws + WS_CR) + (l * 3 + seg) * 16;
      float lg[16]; float mx = -1e30f;
#pragma unroll
      for (int e = 0; e < 16; ++e) { lg[e] = rs * (part[((2 * rg2) * 16 + rr) * 16 + e] + part[((2 * rg2 + 1) * 16 + rr) * 16 + e]) + cr[e]; mx = fmaxf(mx, lg[e]); }
#pragma unroll
      for (int e = 0; e < 16; ++e) lg[e] = expf(lg[e] - mx);
      float best = -1.f; int bg = 0; float b0 = 0.f, b1 = 0.f, b2 = 0.f, b3 = 0.f;
#pragma unroll
      for (int gi = 0; gi < 4; ++gi) {
        const float a0 = lg[4 * gi], a1 = lg[4 * gi + 1], a2 = lg[4 * gi + 2], a3 = lg[4 * gi + 3];
        const float sc = fmaxf(fmaxf(fmaxf(a0 + a1, a0 + a2), fmaxf(a0 + a3, a1 + a2)), fmaxf(a1 + a3, a2 + a3));
        if (sc > best) { best = sc; bg = gi; b0 = a0; b1 = a1; b2 = a2; b3 = a3; }
      }
      int i1 = 0; float v1 = b0;
      if (b1 > v1) { v1 = b1; i1 = 1; } if (b2 > v1) { v1 = b2; i1 = 2; } if (b3 > v1) { v1 = b3; i1 = 3; }
      int i2 = -1; float v2 = -1.f;
      if (i1 != 0 && b0 > v2) { v2 = b0; i2 = 0; } if (i1 != 1 && b1 > v2) { v2 = b1; i2 = 1; } if (i1 != 2 && b2 > v2) { v2 = b2; i2 = 2; } if (i1 != 3 && b3 > v2) { v2 = b3; i2 = 3; }
      const float inv = 1.f / (v1 + v2);
      e1 = bg * 4 + i1; e2 = bg * 4 + i2; g1 = v1 * inv; g2 = v2 * inv;
      q1 = atomicAdd(&hist[e1], 1); q2 = atomicAdd(&hist[e2], 1);
    }
    __syncthreads();
    if (tid < 16) hist[16 + tid] = atomicAdd(&cnt[tid], hist[tid]);
    __syncthreads();
    if (tid < nrows) {
      const int row = r0 + tid;
      list[(size_t)e1 * NROWS + hist[16 + e1] + q1] = row * 2; gatew[row * 2] = g1;
      list[(size_t)e2 * NROWS + hist[16 + e2] + q2] = row * 2 + 1; gatew[row * 2 + 1] = g2;
    }
    {
      const float* m = (const float*)(P.ws + WS_MOD) + (l * 3 + seg) * 6144;
      f32x4 gs[4], sh[4];
#pragma unroll
      for (int j = 0; j < 4; ++j) { const int k = 4 * lane + 256 * j; gs[j] = *(const f32x4*)(P.n2g + l * 1024 + k) * (*(const f32x4*)(m + 4096 + k) + 1.f); sh[j] = *(const f32x4*)(m + 3072 + k); }
      const int rpw = nrows >> 3;
#pragma unroll 1
      for (int q = 0; q < rpw; q += 4) {
        f32x4 xx[4][4];
#pragma unroll
        for (int u = 0; u < 4; ++u)
#pragma unroll
          for (int j = 0; j < 4; ++j) { const int rr = w * rpw + (q + u < rpw ? q + u : 0); xx[u][j] = *(const f32x4*)(XR + (size_t)(r0 + rr) * D + 4 * lane + 256 * j); }
#pragma unroll
        for (int u = 0; u < 4; ++u) {
          if (q + u < rpw) {
            const int rr = w * rpw + q + u; const float rs = rsl[rr]; bf16* hp = H2 + (size_t)(r0 + rr) * D;
#pragma unroll
            for (int j = 0; j < 4; ++j) { const f32x4 o = xx[u][j] * rs * gs[j] + sh[j]; u32x2 ov; ov.x = pk2(o[0], o[1]); ov.y = pk2(o[2], o[3]); *(u32x2*)(hp + 4 * lane + 256 * j) = ov; }
          }
        }
      }
    }
    __syncthreads();
  }
}

__device__ __forceinline__ void phaseEF(unsigned char* lds, const Params& P, int l, bool down) {
  const int* cnt = (const int*)(P.ws + WS_CNT) + l * 16;
  const int* list = (const int*)(P.ws + WS_LIST) + (size_t)l * 16 * NROWS;
  bf16* act = (bf16*)(P.ws + WS_Z + Z_ACT);
  MoeU* desc = (MoeU*)(lds + LDS_MISC);
  int* dn = (int*)(lds + LDS_MISC + 1024);
  const int c0 = xcd_vidx(0), G = gridDim.x;
  { const int j = get_tid();
    if (j < 8) {
      int NF = 0, NH = 0;
#pragma unroll 1
      for (int e = 0; e < 16; ++e) { const int c = cnt[e], rem = c & 255; NF += ((c >> 8) + (rem > 128 ? 1 : 0)) * 4; NH += (rem >= 1 && rem <= 128) ? 4 : 0; }
      const int NFA = NF < 2 * G ? NF : 2 * G;
      MoeU t{0, 0, 0, 0, 0}; int kind = 0;
      int v = -1, half = 0;
      if (j < 2) { v = j * G + c0; if (v >= NFA) v = -1; }
      else { const int ub = (j - 2) * G + c0, nsplit = 2 * (NF - NFA);
        if (ub < nsplit) { v = NFA + (ub >> 1); half = ub & 1; kind = 2; } else if (ub < nsplit + NH) { v = NF + (ub - nsplit); kind = 3; } }
      if (v >= 0 && v < NF) {
        int base = 0, sb = 0;
#pragma unroll 1
        for (int e = 0; e < 16; ++e) { const int c = cnt[e], rem = c & 255, fu = ((c >> 8) + (rem > 128 ? 1 : 0)) * 4; if (v < base + fu) { const int k = v - base, mt = k >> 2; int nv = c - mt * 256; nv = nv < 256 ? nv : 256;
            if (kind == 0) { t = MoeU{e, mt * 256, nv, k & 3, sb + mt * 256}; kind = 1; }
            else { int nh2 = nv - 128 * half; nh2 = nh2 < 128 ? nh2 : 128; if (nh2 > 0) t = MoeU{e, mt * 256 + 128 * half, nh2, k & 3, sb + mt * 256 + 128 * half}; else kind = 0; }
            break; } base += fu; sb += c; }
      } else if (kind == 3) {
        const int vh = v - NF; int base = 0, sb = 0; kind = 0;
#pragma unroll 1
        for (int e = 0; e < 16; ++e) { const int c = cnt[e], rem = c & 255, hv = (rem >= 1 && rem <= 128) ? 4 : 0; if (vh < base + hv) { const int k = vh - base, r0 = (c >> 8) * 256;
            t = MoeU{e, r0, rem, k & 3, sb + r0}; kind = 2; break; } base += hv; sb += c; }
      }
      if (kind == 3) kind = 0;
      desc[j] = t; dn[j] = kind;
    }
    __syncthreads(); }
  const int nf = (dn[0] == 1 ? 1 : 0) + (dn[1] == 1 ? 1 : 0);
  if (!down) {
    SrcUp8 S{desc, (const bf16*)(P.ws + WS_R1), list, (const bf16*)(P.ws + WS_W13) + (size_t)(l * 16) * 1024 * 1024, act, nf};
    gemm8_stream<SrcUp8, true>(lds, S);
  } else {
    SrcDown8 S{desc, act, list, (const bf16*)(P.ws + WS_W2) + (size_t)(l * 16) * 1024 * 512, (const float*)(P.ws + WS_GATEW), (bf16*)(P.ws + WS_R1), (bf16*)(P.ws + WS_Z + Z_YM1), nf};
    gemm8_stream<SrcDown8, false>(lds, S);
  }
#pragma unroll 1
  for (int j = 2; j < 8; ++j) {
    if (dn[j] != 2) continue;
    const MoeU t = desc[j];
    const int* lst = list + (size_t)t.e * NROWS + t.row0;
    if (!down) {
      ARowGather ar{(const bf16*)(P.ws + WS_R1), lst, t.nvalid};
      EpiMoeUp E{act, t.slot0, t.nvalid};
      gemm_tile<4, 4>(lds, ar, (const bf16*)(P.ws + WS_W13) + (size_t)(l * 16 + t.e) * 1024 * 1024, 1024, 0, t.nt * 256, E);
    } else {
      ARowAct ar{act, t.slot0};
      EpiMoeDown E{lst, (const float*)(P.ws + WS_GATEW), (bf16*)(P.ws + WS_R1), (bf16*)(P.ws + WS_Z + Z_YM1), t.nvalid};
      gemm_tile<4, 4>(lds, ar, (const bf16*)(P.ws + WS_W2) + (size_t)(l * 16 + t.e) * 1024 * 512, 512, 0, t.nt * 256, E);
    }
  }
  __syncthreads();
}

__device__ __forceinline__ void phaseG(const Params& P, int l) {
  const int tid = get_tid(), lane = tid & 63, w = tid >> 6;
  float* XR = (float*)(P.ws + WS_XR);
  const bf16* Y0 = (const bf16*)(P.ws + WS_R1); const bf16* Y1 = (const bf16*)(P.ws + WS_Z + Z_YM1);
  const float* mod = (const float*)(P.ws + WS_MOD);
  const int nrows = l == 0 ? NROWS : NLAT;
#pragma unroll 1
  for (int it = blockIdx.x; it < nrows / 16; it += gridDim.x) {
    const int row0 = it * 16 + 2 * w, seg = row0 < NSEQ ? 0 : (row0 < NLAT ? 1 : 2);
    const float* gt2 = mod + (l * 3 + seg) * 6144 + 5120;
    f32x4 x1[2][4]; u32x2 ya[2][4], yb[2][4];
#pragma unroll
    for (int u = 0; u < 2; ++u)
#pragma unroll
      for (int j = 0; j < 4; ++j) { const size_t o = (size_t)(row0 + u) * D + 4 * lane + 256 * j; x1[u][j] = __builtin_nontemporal_load((const f32x4*)(XR + o)); ya[u][j] = __builtin_nontemporal_load((const u32x2*)(Y0 + o)); yb[u][j] = __builtin_nontemporal_load((const u32x2*)(Y1 + o)); }
    f32x4 gv[4];
#pragma unroll
    for (int j = 0; j < 4; ++j) gv[j] = *(const f32x4*)(gt2 + 4 * lane + 256 * j);
#pragma unroll
    for (int u = 0; u < 2; ++u) {
      const int row = row0 + u;
      f32x4 xv[4]; float ss = 0.f;
#pragma unroll
      for (int j = 0; j < 4; ++j) {
        const u32x2 a = ya[u][j], b = yb[u][j];
        f32x4 m; m[0] = bflo(a.x) + bflo(b.x); m[1] = bfhi(a.x) + bfhi(b.x); m[2] = bflo(a.y) + bflo(b.y); m[3] = bfhi(a.y) + bfhi(b.y);
        xv[j] = x1[u][j] + gv[j] * m;
        ss += xv[j][0] * xv[j][0] + xv[j][1] * xv[j][1] + xv[j][2] * xv[j][2] + xv[j][3] * xv[j][3];
      }
      ss = wsum(ss);
      if (l == 0) {
        const float* sc1 = mod + (1 * 3 + seg) * 6144 + 1024;
        bf16* xb = (bf16*)(P.ws + WS_R1) + (size_t)row * D;
        if (lane == 0) ((float*)(P.ws + WS_RSS))[row] = ss;
#pragma unroll
        for (int j = 0; j < 4; ++j) {
          const int k = 4 * lane + 256 * j;
          *(f32x4*)(XR + (size_t)row * D + k) = xv[j];
          const f32x4 gg = *(const f32x4*)(P.n1g + 1024 + k), sc = *(const f32x4*)(sc1 + k);
          const f32x4 o = xv[j] * gg * (sc + 1.f);
          u32x2 ov; ov.x = pk2(o[0], o[1]); ov.y = pk2(o[2], o[3]); *(u32x2*)(xb + k) = ov;
        }
      } else {
        const float rs = rsqrtf(ss * (1.f / 1024.f) + EPS);
#pragma unroll
        for (int j = 0; j < 4; ++j) {
          const int k = 4 * lane + 256 * j;
          const f32x4 gg = *(const f32x4*)(P.final_g + k);
          __builtin_nontemporal_store(xv[j] * rs * gg, (f32x4*)(P.out + (size_t)row * D + k));
        }
      }
    }
  }
}

#define XB_TMO      128
#define XB_XCNT(j)  (256  + 64 * (j))
#define XB_XSUB(j)  (1280 + 64 * (j))
#define XB_XGEN(j)  (2304 + 64 * (j))
#define XB_TOP      3328
#define XB_TOPGEN   3392
#define XB_SPIN_CAP (1u << 20)
__device__ __forceinline__ unsigned xb_ld(unsigned* p)              { return __hip_atomic_load(p, __ATOMIC_RELAXED, __HIP_MEMORY_SCOPE_AGENT); }
__device__ __forceinline__ unsigned xb_add(unsigned* p, unsigned v) { return __hip_atomic_fetch_add(p, v, __ATOMIC_RELAXED, __HIP_MEMORY_SCOPE_AGENT); }
__device__ __forceinline__ unsigned xb_xcc_id() { return (unsigned)__builtin_amdgcn_s_getreg((3 << 11) | 20) & 0xFu; }
#define XB_SPIN(cond, bar) do { unsigned _sp = 0; while (cond) { __builtin_amdgcn_s_sleep(1); \
    if ((++_sp & 255u) == 0u) { if (xb_ld(&(bar)[XB_TMO])) break; if (_sp > XB_SPIN_CAP) { atomicAdd(&(bar)[XB_TMO], 1u); break; } } } } while (0)
struct XBar { unsigned* bar; unsigned* st; };
__device__ __forceinline__ void xbar_init(XBar& b, unsigned* bar, unsigned* st) {
  b.bar = bar; b.st = st;
  if (threadIdx.x == 0) { st[0] = 0u; st[1] = 0u; (void)xb_add(&bar[XB_XCNT(xb_xcc_id())], 1u); }
}
__device__ __forceinline__ void xbar_sync(XBar& b) {
  asm volatile("s_waitcnt vmcnt(0)" ::: "memory");
  __syncthreads();
  if (threadIdx.x == 0) {
    unsigned* bar = b.bar;
    const unsigned x = xb_xcc_id();
    __builtin_amdgcn_s_waitcnt(0);
    unsigned nloc = b.st[0], nx = b.st[1];
    if (nloc == 0u) {
      const unsigned G = gridDim.x; unsigned sum, cnt, mine, sp = 0u;
      for (;;) {
        sum = 0u; cnt = 0u; mine = 0u;
#pragma unroll
        for (unsigned j = 0; j < 16; ++j) { const unsigned c = xb_ld(&bar[XB_XCNT(j)]); sum += c; cnt += (c > 0u) ? 1u : 0u; mine = (j == x) ? c : mine; }
        if (sum == G) break;
        __builtin_amdgcn_s_sleep(1);
        if ((++sp & 255u) == 0u) { if (xb_ld(&bar[XB_TMO])) break; if (sp > XB_SPIN_CAP) { atomicAdd(&bar[XB_TMO], 1u); break; } }
      }
      nloc = mine > 0u ? mine : 1u; nx = cnt > 0u ? cnt : 1u;
      b.st[0] = nloc; b.st[1] = nx;
    }
    const unsigned old = xb_add(&bar[XB_XSUB(x)], 1u);
    const unsigned gen = old / nloc;
    if (old + 1u == (gen + 1u) * nloc) {
      __builtin_amdgcn_fence(__ATOMIC_RELEASE, "agent");
      asm volatile("s_waitcnt vmcnt(0)" ::: "memory");
      const unsigned og = xb_add(&bar[XB_TOP], 1u);
      const unsigned tg = og / nx;
      if (og + 1u == (tg + 1u) * nx) xb_add(&bar[XB_TOPGEN], 1u);
      else XB_SPIN(xb_ld(&bar[XB_TOPGEN]) == tg, bar);
      __builtin_amdgcn_fence(__ATOMIC_ACQUIRE, "agent");
      xb_add(&bar[XB_XGEN(x)], 1u);
      asm volatile("s_waitcnt vmcnt(0)" ::: "memory");
    } else {
      XB_SPIN(xb_ld(&bar[XB_XGEN(x)]) == gen, bar);
      __builtin_amdgcn_fence(__ATOMIC_ACQUIRE, "agent");
      asm volatile("s_waitcnt vmcnt(0)" ::: "memory");
    }
  }
  __syncthreads();
}

__global__ void __launch_bounds__(NTHR, 2) fwd_mega(Params P) {
  extern __shared__ __attribute__((aligned(16))) unsigned char lds[];
  cg::grid_group grid = cg::this_grid();
  XBar xb; xbar_init(xb, (unsigned*)(P.ws + WS_BAR), (unsigned*)(lds + LDS_BARW));
#define GSYNC() xbar_sync(xb)
  phase0(lds, P);
  VM_WAIT(); __syncthreads(); grid.sync();
  phase1(lds, P); GSYNC();
#pragma unroll 1
  for (int l = 0; l < 2; ++l) {
    phaseA(lds, P, l); GSYNC();
    phaseB(lds, P, l); GSYNC();
    phaseB2(P, l); GSYNC();
    phaseB3(lds, P, l); GSYNC();
    phaseC(lds, P, l); GSYNC();
    phaseD(lds, P, l); GSYNC();
    phaseEF(lds, P, l, false); GSYNC();
    phaseEF(lds, P, l, true); GSYNC();
    phaseG(P, l);
    if (l == 0) GSYNC();
  }
#undef GSYNC
}

extern "C" void kernel_launch(void* const* d_in, const int* in_sizes, int n_in, void* d_out, int out_size, void* d_ws, size_t ws_size, hipStream_t stream) {
  static int grid_blocks = 0;
  if (!grid_blocks) {
    int dev = 0, cus = 0, per_cu = 0;
    (void)hipGetDevice(&dev);
    (void)hipDeviceGetAttribute(&cus, hipDeviceAttributeMultiprocessorCount, dev);
    (void)hipFuncSetAttribute((const void*)fwd_mega, hipFuncAttributeMaxDynamicSharedMemorySize, LDS_BYTES);
    (void)hipOccupancyMaxActiveBlocksPerMultiprocessor(&per_cu, fwd_mega, NTHR, LDS_BYTES);
    if (per_cu > 1) per_cu = 1;
    if (per_cu < 1) per_cu = 1;
    grid_blocks = cus * per_cu;
    if (ws_size < WS_END) fprintf(stderr, "kernel_launch: workspace too small: %zu < %zu\n", ws_size, (size_t)WS_END);
  }
  (void)hipMemsetAsync(d_ws, 0, WS_ZERO_BYTES, stream);
  Params p{};
  const float** pp = (const float**)&p;
  for (int i = 0; i < 21; ++i) pp[i] = (const float*)d_in[i];
  p.out = (float*)d_out; p.ws = (unsigned char*)d_ws;
  void* args[] = {&p};
  hipError_t e = hipLaunchCooperativeKernel((void*)fwd_mega, dim3(grid_blocks), dim3(NTHR), args, LDS_BYTES, stream);
  if (e != hipSuccess) fprintf(stderr, "cooperative launch failed: %s (grid %d)\n", hipGetErrorString(e), grid_blocks);
}
```

```cpp
#include <hip/hip_runtime.h>
#include <hip/hip_cooperative_groups.h>
#include <cstdio>
#include <cstdint>
namespace cg = cooperative_groups;

typedef unsigned short bf16;
typedef short bf16x8 __attribute__((ext_vector_type(8)));
typedef short s16x4 __attribute__((ext_vector_type(4)));
typedef float f32x4 __attribute__((ext_vector_type(4)));
typedef float f32x2 __attribute__((ext_vector_type(2)));
typedef unsigned u32x4 __attribute__((ext_vector_type(4)));
typedef unsigned u32x2 __attribute__((ext_vector_type(2)));
typedef __bf16 bf2_t __attribute__((ext_vector_type(2)));
#define LAS __attribute__((address_space(3)))
constexpr int NTHR = 512;
constexpr int LDS_BYTES = 147456 + 64;
constexpr int LDS_BARW = 147456;
constexpr int LDS_MISC = 131072;

constexpr int D = 1024, NSEQ = 8192, CL = 256, NT_TOK = NSEQ + CL, NLAT = 2 * NSEQ, NROWS = NLAT + 2 * CL;
constexpr int INC = 2944, NSLOT = 46;
constexpr float EPS = 1e-6f;
constexpr float LOG2E = 1.4426950408889634f;
constexpr float QSCALE = 0.125f * LOG2E;
constexpr int S_AQ = 0, S_AK = 6, S_AV = 8, S_NQ = 10, S_NK = 14, S_NV = 18, S_RQ = 22, S_RK = 28, S_RV = 34, S_RG = 40;

constexpr size_t WS_BAR = 0;
constexpr size_t WS_CNT = 16384;
constexpr size_t WS_ZERO_BYTES = 16384 + 4096;
constexpr size_t WS_MOD = WS_ZERO_BYTES;
constexpr size_t WS_BIAS = WS_MOD + 2 * 3 * 6144 * 4;
constexpr size_t WS_ROPE = WS_BIAS + 2 * 3 * 2944 * 4;
constexpr size_t WS_RSS = WS_ROPE + 128 * 16 * 2 * 4;
constexpr size_t WS_WR = WS_RSS + 16896 * 4;
constexpr size_t WS_CR = WS_WR + 2 * 3 * 1024 * 16 * 4;
constexpr size_t WS_GATEW = WS_CR + 4096;
constexpr size_t WS_LIST = WS_GATEW + 16896 * 2 * 4;
constexpr size_t WS_WIN = (WS_LIST + (size_t)2 * 16 * 16896 * 4 + 4095) / 4096 * 4096;
constexpr size_t WS_WO = WS_WIN + (size_t)2 * 2944 * 1024 * 2;
constexpr size_t WS_W13 = WS_WO + (size_t)2 * 1024 * 1024 * 2;
constexpr size_t WS_W2 = WS_W13 + (size_t)32 * 1024 * 1024 * 2;
constexpr size_t WS_XR = WS_W2 + (size_t)32 * 1024 * 512 * 2;
constexpr size_t WS_R1 = WS_XR + (size_t)NROWS * 1024 * 4;
constexpr size_t WS_Z = WS_R1 + (size_t)NROWS * 1024 * 2;
constexpr size_t WS_U = WS_Z + (size_t)2 * NSLOT * NT_TOK * 64 * 2;
constexpr size_t WS_END = WS_U + (size_t)2 * 6 * 2 * 66 * 4096 * 4;
constexpr size_t S_OFF = (size_t)34 << 20;
constexpr size_t Z_YM1 = 0, Z_ACT = (size_t)NROWS * 1024 * 2;
static_assert(Z_ACT + (size_t)(2 * NROWS + 128) * 512 * 2 <= (size_t)2 * NSLOT * NT_TOK * 64 * 2, "act overlay");
static_assert((size_t)2 * 6 * 2 * 66 * 4096 * 4 <= (size_t)NROWS * 1024 * 2, "U overlay");

struct Params {
  const float *x, *c, *ctx, *c_ctx, *w_ada, *b_ada, *n1g, *n2g, *w_in, *qg, *kg, *rpb, *ret_decay, *mix_g, *w_out, *w_router, *b_router, *w1, *w3, *w2, *final_g;
  float* out; unsigned char* ws;
};

__device__ __forceinline__ unsigned pk2(float lo, float hi) { f32x2 v = {lo, hi}; bf2_t b = __builtin_convertvector(v, bf2_t); return __builtin_bit_cast(unsigned, b); }
__device__ __forceinline__ float bflo(unsigned u) { return __builtin_bit_cast(float, u << 16); }
__device__ __forceinline__ float bfhi(unsigned u) { return __builtin_bit_cast(float, u & 0xffff0000u); }
__device__ __forceinline__ float wsum(float v) {
#pragma unroll
  for (int o = 1; o < 64; o <<= 1) v += __shfl_xor(v, o);
  return v;
}
__device__ __forceinline__ float silu_f(float v) { return v * __builtin_amdgcn_rcpf(1.f + __expf(-v)); }
__device__ __forceinline__ int lds_swz(int row, int chunk) { return row * 128 + ((chunk ^ ((row >> 1) & 7)) << 4); }
#define VM_WAIT() asm volatile("s_waitcnt vmcnt(0)" ::: "memory")
__device__ __forceinline__ int get_tid() { int t = threadIdx.x; asm volatile("" : "+v"(t)); return t; }

template <int R, int NW>
__device__ __forceinline__ void stage_rows(unsigned char* lds, int dst, const bf16* src, int ld, int wl, int lane) {
#pragma unroll
  for (int i = 0; i < R / (8 * NW); ++i) {
    const int q = wl + NW * i, row = q * 8 + (lane >> 3), ch = (lane & 7) ^ ((row >> 1) & 7);
    __builtin_amdgcn_global_load_lds((const void*)(src + (size_t)row * ld + ch * 8), (LAS void*)(lds + dst + q * 1024), 16, 0, 0);
  }
}
#define VMCNT(n) asm volatile("s_waitcnt vmcnt(" #n ")" ::: "memory")
#define LGKM0() asm volatile("s_waitcnt lgkmcnt(0)" ::: "memory")
#define RAW_BAR() __builtin_amdgcn_s_barrier()
__device__ __forceinline__ bf16x8 lds_frag(const unsigned char* lds, int off) { return *(const bf16x8*)(lds + off); }
__device__ __forceinline__ bf16x8 lds_tr2(unsigned char* lds, int off0, int off1) {
  s16x4 a = __builtin_amdgcn_ds_read_tr16_b64_v4i16((LAS s16x4*)(lds + off0));
  s16x4 b = __builtin_amdgcn_ds_read_tr16_b64_v4i16((LAS s16x4*)(lds + off1));
  return __builtin_shufflevector(a, b, 0, 1, 2, 3, 4, 5, 6, 7);
}

template <int MT, int NT, int ST> struct GStep {
  static __device__ __forceinline__ void run(f32x4 (&acc)[MT][NT], bf16x8 (&W0)[NT], bf16x8 (&W1)[NT], bf16x8 (&X)[2 * MT], const unsigned char* base, int xoff, int woff) {
    constexpr int S = 2 * MT, kk = ST / MT, mt = ST % MT;
#pragma unroll
    for (int nt = 0; nt < NT; ++nt) acc[mt][nt] = __builtin_amdgcn_mfma_f32_16x16x32_bf16(kk ? W1[nt] : W0[nt], X[ST], acc[mt][nt], 0, 0, 0);
    __builtin_amdgcn_sched_group_barrier(0x008, NT, 0);
    if constexpr (ST + 2 < S) { constexpr int k2 = (ST + 2) / MT, m2 = (ST + 2) % MT; X[ST + 2] = lds_frag(base, (xoff + m2 * 2048) ^ (k2 << 6)); }
    if constexpr (ST < NT) W1[ST] = lds_frag(base, (woff + ST * 2048) ^ 64);
    constexpr int nds = (ST + 2 < S ? 1 : 0) + (ST < NT ? 1 : 0);
    if constexpr (nds > 0) __builtin_amdgcn_sched_group_barrier(0x100, nds, 0);
    if constexpr (ST + 1 < S) GStep<MT, NT, ST + 1>::run(acc, W0, W1, X, base, xoff, woff);
  }
};

template <int MT, int NT, class ARow, class Epi>
__device__ __forceinline__ void gemm_tile(unsigned char* lds, const ARow& arow, const bf16* __restrict__ Bt, int K, int m0, int n0, const Epi& epi,
                                          bool staged0 = false, bool hasnext = false, const ARow* narow = nullptr, const bf16* nBt = nullptr, int nn0 = 0) {
  const int tid = get_tid(), lane = tid & 63, w = __builtin_amdgcn_readfirstlane(tid >> 6);
  const int wr = w >> 2, wc = w & 3, g = lane >> 4, li = lane & 15;
  constexpr int NA = MT / 2, NB = NT;
  const bf16* ap[NA]; const bf16* bp[NB];
#pragma unroll
  for (int i = 0; i < NA; ++i) { const int q = w + 8 * i, row = q * 8 + (lane >> 3), ch = (lane & 7) ^ ((row >> 1) & 7); ap[i] = arow(row) + ch * 8; }
#pragma unroll
  for (int i = 0; i < NB; ++i) { const int q = w + 8 * i, row = q * 8 + (lane >> 3), ch = (lane & 7) ^ ((row >> 1) & 7); bp[i] = Bt + (size_t)(n0 + row) * K + ch * 8; }
  f32x4 acc[MT][NT];
#pragma unroll
  for (int a = 0; a < MT; ++a)
#pragma unroll
    for (int b = 0; b < NT; ++b) acc[a][b] = (f32x4){0.f, 0.f, 0.f, 0.f};
  const int f = (li >> 1) & 7;
  const int xoff = (wr * (MT * 16) + li) * 128 + ((g ^ f) << 4);
  const int woff = 32768 + (wc * (NT * 16) + li) * 128 + ((g ^ f) << 4);
  const int nk = K >> 6;
#define GT_STAGE(s, k0) do { _Pragma("unroll") for (int i = 0; i < NA; ++i) \
    __builtin_amdgcn_global_load_lds((const void*)(ap[i] + (k0)), (LAS void*)(lds + (s) * 65536 + (w + 8 * i) * 1024), 16, 0, 0); \
    _Pragma("unroll") for (int i = 0; i < NB; ++i) \
    __builtin_amdgcn_global_load_lds((const void*)(bp[i] + (k0)), (LAS void*)(lds + (s) * 65536 + 32768 + (w + 8 * i) * 1024), 16, 0, 0); } while (0)
  if (!staged0) GT_STAGE(0, 0);
  VM_WAIT(); __syncthreads();
  for (int t = 0; t < nk; ++t) {
    const int s = t & 1;
    if (t + 1 < nk) GT_STAGE(s ^ 1, (t + 1) * 64);
    const unsigned char* base = lds + s * 65536;
    {
      bf16x8 W0[NT], W1[NT], X[2 * MT];
#pragma unroll
      for (int nt = 0; nt < NT; ++nt) W0[nt] = lds_frag(base, woff + nt * 2048);
      X[0] = lds_frag(base, xoff); X[1] = lds_frag(base, xoff + 2048);
      __builtin_amdgcn_sched_group_barrier(0x100, NT + 2, 0);
      GStep<MT, NT, 0>::run(acc, W0, W1, X, base, xoff, woff);
    }
    VM_WAIT(); __syncthreads();
  }
  if (hasnext) {
#pragma unroll
    for (int i = 0; i < NA; ++i) { const int q = w + 8 * i, row = q * 8 + (lane >> 3), ch = (lane & 7) ^ ((row >> 1) & 7); ap[i] = (*narow)(row) + ch * 8; }
#pragma unroll
    for (int i = 0; i < NB; ++i) { const int q = w + 8 * i, row = q * 8 + (lane >> 3), ch = (lane & 7) ^ ((row >> 1) & 7); bp[i] = nBt + (size_t)(nn0 + row) * K + ch * 8; }
    GT_STAGE(0, 0);
  }
#undef GT_STAGE
  epi(acc, m0 + wr * (MT * 16), n0 + wc * (NT * 16), g, li);
}


template <int MT, int NT, int WC, class ARow, class Epi>
__device__ __forceinline__ void gemm_tile3(unsigned char* lds, const ARow& arow, const bf16* __restrict__ Bt, int K, int m0, int n0, const Epi& epi) {
  const int tid = get_tid(), lane = tid & 63, w = __builtin_amdgcn_readfirstlane(tid >> 6);
  constexpr int WR = 8 / WC;
  const int wr = w / WC, wc = w % WC, g = lane >> 4, li = lane & 15, half = w >> 2;
  constexpr int NA = WR * MT / 4, NB = WC * NT / 4, ABY = WR * MT * 2048, STB = ABY + WC * NT * 2048;
  static_assert(3 * STB <= 147456, "three stages must fit");
  const bf16* ap[NA]; const bf16* bp[NB];
#pragma unroll
  for (int i = 0; i < NA; ++i) { const int q = w + 8 * i, row = q * 8 + (lane >> 3), ch = (lane & 7) ^ ((row >> 1) & 7); ap[i] = arow(row) + ch * 8; }
#pragma unroll
  for (int i = 0; i < NB; ++i) { const int q = w + 8 * i, row = q * 8 + (lane >> 3), ch = (lane & 7) ^ ((row >> 1) & 7); bp[i] = Bt + (size_t)(n0 + row) * K + ch * 8; }
  f32x4 acc[MT][NT];
#pragma unroll
  for (int a = 0; a < MT; ++a)
#pragma unroll
    for (int b = 0; b < NT; ++b) acc[a][b] = (f32x4){0.f, 0.f, 0.f, 0.f};
  const int f = (li >> 1) & 7;
  const int xoff = (wr * (MT * 16) + li) * 128 + ((g ^ f) << 4);
  const int woff = ABY + (wc * (NT * 16) + li) * 128 + ((g ^ f) << 4);
  const int nk = K >> 6;
#define GT3_STAGE(s, k0) do { _Pragma("unroll") for (int i = 0; i < NA; ++i) \
    __builtin_amdgcn_global_load_lds((const void*)(ap[i] + (k0)), (LAS void*)(lds + (s) * STB + (w + 8 * i) * 1024), 16, 0, 0); \
    _Pragma("unroll") for (int i = 0; i < NB; ++i) \
    __builtin_amdgcn_global_load_lds((const void*)(bp[i] + (k0)), (LAS void*)(lds + (s) * STB + ABY + (w + 8 * i) * 1024), 16, 0, 0); } while (0)
#define GT3_WAIT(more) do { if (more) asm volatile("s_waitcnt vmcnt(%0)" :: "n"(NA + NB) : "memory"); else VM_WAIT(); } while (0)
#define GT3_BAR() do { __builtin_amdgcn_sched_barrier(0); RAW_BAR(); __builtin_amdgcn_sched_barrier(0); } while (0)
  GT3_STAGE(0, 0); GT3_STAGE(1, 64); GT3_STAGE(2, 128);
  asm volatile("s_waitcnt vmcnt(%0)" :: "n"(2 * (NA + NB)) : "memory");
  GT3_BAR();
  if (half) GT3_BAR();
  int s = 0;
#pragma unroll 1
  for (int t = 0; t < nk; ++t) {
    if (!half && t >= 1 && t + 2 < nk) GT3_STAGE(s >= 1 ? s - 1 : 2, (t + 2) * 64);
    const unsigned char* base = lds + s * STB;
    bf16x8 X[MT][2], W[NT][2];
#pragma unroll
    for (int kk = 0; kk < 2; ++kk) {
#pragma unroll
      for (int nt = 0; nt < NT; ++nt) W[nt][kk] = lds_frag(base, (woff + nt * 2048) ^ (kk << 6));
#pragma unroll
      for (int mt = 0; mt < MT; ++mt) X[mt][kk] = lds_frag(base, (xoff + mt * 2048) ^ (kk << 6));
    }
    LGKM0();
    if (half) GT3_WAIT(t + 2 < nk);
    GT3_BAR();
    if (half && t + 3 < nk) GT3_STAGE(s, (t + 3) * 64);
#pragma unroll
    for (int kk = 0; kk < 2; ++kk)
#pragma unroll
      for (int mt = 0; mt < MT; ++mt)
#pragma unroll
        for (int nt = 0; nt < NT; ++nt) acc[mt][nt] = __builtin_amdgcn_mfma_f32_16x16x32_bf16(W[nt][kk], X[mt][kk], acc[mt][nt], 0, 0, 0);
    if (!half) GT3_WAIT(t + 2 < nk);
    GT3_BAR();
    s = s == 2 ? 0 : s + 1;
  }
  if (!half) GT3_BAR();
#undef GT3_STAGE
#undef GT3_WAIT
#undef GT3_BAR
  epi(acc, m0 + wr * (MT * 16), n0 + wc * (NT * 16), g, li);
}

namespace g8 {
constexpr int HT_B = 128 * 64 * 2;
__device__ __forceinline__ int lds_byte(int r, int c) { const int st = (r >> 4) * 2 + (c >> 5), rr = r & 15, cc = c & 31, ob = rr * 64 + cc * 2; return st * 1024 + (ob ^ (((ob >> 9) & 1) << 5)); }
__device__ __forceinline__ void stage_rc(int b, int& R, int& C) { const int st = b / 1024, sb = b % 1024, swz = sb ^ (((sb >> 9) & 1) << 5); R = (st >> 1) * 16 + swz / 64; C = (st & 1) * 32 + (swz % 64) / 2; }
}
template <class ARow, class Epi>
__device__ __forceinline__ void gemm8_tile(unsigned char* lds, const ARow& arow, const bf16* __restrict__ Bt, int K, int m0, int n0, const Epi& epi) {
  using namespace g8;
  const int tid = get_tid(), lane = tid & 63, wid = __builtin_amdgcn_readfirstlane(tid >> 6), wr = wid >> 2, wc = wid & 3, fr = lane & 15, fq = lane >> 4;
  const char* abase = (const char*)arow(0);
  const char* bbase = (const char*)(Bt + (size_t)n0 * K);
  unsigned oa[2][2], ob[2][2];
#pragma unroll
  for (int i = 0; i < 2; ++i) {
    int R, C; stage_rc(tid * 16 + i * 8192, R, C);
    const int ra = (R >> 6) * 128 + ((R >> 4) & 3) * 16 + (R & 15);
    const int rb = (R >> 5) * 64 + ((R >> 4) & 1) * 16 + (R & 15);
#pragma unroll
    for (int hh = 0; hh < 2; ++hh) { oa[hh][i] = (unsigned)((ra + hh * 64) * K + C) * 2u; ob[hh][i] = (unsigned)((rb + hh * 32) * K + C) * 2u; }
  }
#define G8_SA(b, h) (((b) * 2 + (h)) * HT_B)
#define G8_SB(b, h) ((4 + (b) * 2 + (h)) * HT_B)
#define G8_STAGE(bufoff, BASE, O2, kt) do { _Pragma("unroll") for (int _i = 0; _i < 2; ++_i) \
    __builtin_amdgcn_global_load_lds((const void*)((BASE) + (O2)[_i] + (unsigned)(kt) * 128u), (LAS void*)(lds + (bufoff) + wid * 1024 + _i * 8192), 16, 0, 0); } while (0)
  const int aoff = lds_byte(wr * 64 + fr, fq * 8), boff = lds_byte(wc * 32 + fr, fq * 8);
#define G8_LDA(dst, b, h) do { _Pragma("unroll") for (int m = 0; m < 4; ++m) _Pragma("unroll") for (int k = 0; k < 2; ++k) dst[m][k] = *(const bf16x8*)(lds + G8_SA(b, h) + aoff + m * 2048 + k * 1024); } while (0)
#define G8_LDB(dst, b, h) do { _Pragma("unroll") for (int n = 0; n < 2; ++n) _Pragma("unroll") for (int k = 0; k < 2; ++k) dst[n][k] = *(const bf16x8*)(lds + G8_SB(b, h) + boff + n * 2048 + k * 1024); } while (0)
#define G8_MMA(ai, bj, At_, Bt_) do { __builtin_amdgcn_s_setprio(1); _Pragma("unroll") for (int m = 0; m < 4; ++m) _Pragma("unroll") for (int n = 0; n < 2; ++n) _Pragma("unroll") for (int k = 0; k < 2; ++k) \
    acc[(ai) * 4 + m][(bj) * 2 + n] = __builtin_amdgcn_mfma_f32_16x16x32_bf16(Bt_[n][k], At_[m][k], acc[(ai) * 4 + m][(bj) * 2 + n], 0, 0, 0); __builtin_amdgcn_s_setprio(0); } while (0)
#define G8_WV(n) asm volatile("s_waitcnt vmcnt(" #n ")" ::: "memory")
#define G8_WL(n) asm volatile("s_waitcnt lgkmcnt(" #n ")" ::: "memory")
#define G8_BAR __builtin_amdgcn_s_barrier()
#define G8_SCHED __builtin_amdgcn_sched_barrier(0)
  f32x4 acc[8][4];
#pragma unroll
  for (int a = 0; a < 8; ++a)
#pragma unroll
    for (int b = 0; b < 4; ++b) acc[a][b] = (f32x4){0.f, 0.f, 0.f, 0.f};
  bf16x8 At[4][2], B0[2][2], B1[2][2];
  const int nt = K >> 6;
  G8_STAGE(G8_SB(0, 0), bbase, ob[0], 0); G8_STAGE(G8_SA(0, 0), abase, oa[0], 0);
  G8_STAGE(G8_SB(0, 1), bbase, ob[1], 0); G8_STAGE(G8_SA(0, 1), abase, oa[1], 0);
  if (wr == 1) G8_BAR;
  G8_WV(4); G8_BAR;
  G8_STAGE(G8_SB(1, 0), bbase, ob[0], 1); G8_STAGE(G8_SA(1, 0), abase, oa[0], 1); G8_STAGE(G8_SB(1, 1), bbase, ob[1], 1);
  G8_WV(6); G8_BAR;
#pragma unroll 1
  for (int t = 0; t < nt - 2; t += 2) {
    G8_LDB(B0, 0, 0); G8_SCHED; G8_LDA(At, 0, 0); G8_STAGE(G8_SA(1, 1), abase, oa[1], t + 1);
    G8_WL(8); G8_BAR; G8_WL(0); G8_MMA(0, 0, At, B0); G8_BAR; G8_SCHED;
    G8_LDB(B1, 0, 1); G8_STAGE(G8_SB(0, 0), bbase, ob[0], t + 2);
    G8_BAR; G8_WL(0); G8_MMA(0, 1, At, B1); G8_BAR;
    G8_LDA(At, 0, 1); G8_STAGE(G8_SA(0, 0), abase, oa[0], t + 2);
    G8_BAR; G8_WL(0); G8_MMA(1, 0, At, B0); G8_BAR; G8_SCHED;
    G8_STAGE(G8_SB(0, 1), bbase, ob[1], t + 2);
    G8_WV(6); G8_BAR; G8_MMA(1, 1, At, B1); G8_BAR;
    G8_LDB(B0, 1, 0); G8_SCHED; G8_LDA(At, 1, 0); G8_STAGE(G8_SA(0, 1), abase, oa[1], t + 2);
    G8_WL(8); G8_BAR; G8_WL(0); G8_MMA(0, 0, At, B0); G8_BAR; G8_SCHED;
    G8_LDB(B1, 1, 1); G8_STAGE(G8_SB(1, 0), bbase, ob[0], t + 3);
    G8_BAR; G8_WL(0); G8_MMA(0, 1, At, B1); G8_BAR;
    G8_LDA(At, 1, 1); G8_STAGE(G8_SA(1, 0), abase, oa[0], t + 3);
    G8_BAR; G8_WL(0); G8_MMA(1, 0, At, B0); G8_BAR; G8_SCHED;
    G8_STAGE(G8_SB(1, 1), bbase, ob[1], t + 3);
    G8_WV(6); G8_BAR; G8_MMA(1, 1, At, B1); G8_BAR;
  }
  { G8_LDB(B0, 0, 0); G8_LDA(At, 0, 0); G8_STAGE(G8_SA(1, 1), abase, oa[1], nt - 1);
    G8_BAR; G8_WL(0); G8_MMA(0, 0, At, B0); G8_BAR;
    G8_LDB(B1, 0, 1); G8_BAR; G8_WL(0); G8_MMA(0, 1, At, B1); G8_BAR;
    G8_LDA(At, 0, 1); G8_WV(4); G8_BAR; G8_WL(0); G8_MMA(1, 0, At, B0); G8_MMA(1, 1, At, B1); G8_BAR; }
  { G8_LDB(B0, 1, 0); G8_LDA(At, 1, 0); G8_WV(2); G8_BAR; G8_WL(0); G8_MMA(0, 0, At, B0); G8_BAR;
    G8_LDB(B1, 1, 1); G8_WV(0); G8_BAR; G8_WL(0); G8_MMA(0, 1, At, B1); G8_BAR;
    G8_LDA(At, 1, 1); G8_BAR; G8_WL(0); G8_MMA(1, 0, At, B0); G8_MMA(1, 1, At, B1); G8_BAR; }
  if (wr == 0) G8_BAR;
#undef G8_SA
#undef G8_SB
#undef G8_STAGE
#undef G8_LDA
#undef G8_LDB
#undef G8_MMA
#undef G8_WV
#undef G8_WL
#undef G8_BAR
#undef G8_SCHED
  epi(acc, m0 + wr * 128, n0 + wc * 64, fq, fr);
  __syncthreads();
}

struct ARowLinear { const bf16* A; int K; int m0; __device__ __forceinline__ const bf16* operator()(int r) const { return A + (size_t)(m0 + r) * K; } };

template <int MT, int NT>
struct EpiInProj {
  const float* rowss; const float* biasp; const float* qg; const float* kg; const float* rope  ; bf16* Z;
  __device__ __forceinline__ void operator()(f32x4 (&acc)[MT][NT], int mw, int nw, int g, int li) const {
    int b, seg, tokbase; bool latent;
    if (mw < NLAT) { b = mw >> 13; seg = b; tokbase = (mw & 8191); latent = true; }
    else { const int mc = mw - NLAT; b = mc >> 8; seg = 2; tokbase = NSEQ + (mc & 255); latent = false; }
    const int s = nw >> 6, coff = nw & 63;
    bf16* zb = Z + ((size_t)(b * NSLOT + s) * NT_TOK) * 64 + coff;
    float rss[MT];
#pragma unroll
    for (int mt = 0; mt < MT; ++mt) rss[mt] = rowss[mw + mt * 16 + li];
    f32x4 bv[NT], gvv[NT];
#pragma unroll
    for (int nt = 0; nt < NT; ++nt) bv[nt] = *(const f32x4*)(biasp + seg * INC + nw + nt * 16 + 4 * g);
    if (NT == 4 && s < 8) {
      const float* gn = (s < 6) ? qg : kg;
#pragma unroll
      for (int nt = 0; nt < NT; ++nt) gvv[nt] = *(const f32x4*)(gn + nt * 16 + 4 * g);
    } else {
#pragma unroll
      for (int nt = 0; nt < NT; ++nt) gvv[nt] = (f32x4){1.f, 1.f, 1.f, 1.f};
    }
#pragma unroll
    for (int mt = 0; mt < MT; ++mt) {
      const int tok = tokbase + mt * 16 + li;
      const float irms = rsqrtf(rss[mt] * (1.f / 1024.f) + EPS);
      f32x4 v[NT];
#pragma unroll
      for (int nt = 0; nt < NT; ++nt) v[nt] = acc[mt][nt] * irms + bv[nt];
      if constexpr (NT == 4) {
        if (s < 8) {
          float ss = 0.f;
#pragma unroll
          for (int nt = 0; nt < 4; ++nt) ss += v[nt][0] * v[nt][0] + v[nt][1] * v[nt][1] + v[nt][2] * v[nt][2] + v[nt][3] * v[nt][3];
          ss += __shfl_xor(ss, 16); ss += __shfl_xor(ss, 32);
          const float r = rsqrtf(ss * (1.f / 64.f) + EPS) * (s < 6 ? QSCALE : 1.f);
#pragma unroll
          for (int nt = 0; nt < 4; ++nt) v[nt] = v[nt] * r * gvv[nt];
          if (latent) {
            const int pr = tok >> 6, pc = tok & 63;
            const f32x4 r0 = *(const f32x4*)(rope + (pr * 16 + 4 * g) * 2), r1 = *(const f32x4*)(rope + (pr * 16 + 4 * g) * 2 + 4);
            const f32x4 c0 = *(const f32x4*)(rope + (pc * 16 + 4 * g) * 2), c1 = *(const f32x4*)(rope + (pc * 16 + 4 * g) * 2 + 4);
            const float cr_[4] = {r0[0], r0[2], r1[0], r1[2]}, sr_[4] = {r0[1], r0[3], r1[1], r1[3]};
            const float cc_[4] = {c0[0], c0[2], c1[0], c1[2]}, sc_[4] = {c0[1], c0[3], c1[1], c1[3]};
#pragma unroll
            for (int j = 0; j < 4; ++j) {
              const float t1 = v[0][j], t2 = v[1][j]; v[0][j] = t1 * cr_[j] - t2 * sr_[j]; v[1][j] = t2 * cr_[j] + t1 * sr_[j];
              const float u1 = v[2][j], u2 = v[3][j]; v[2][j] = u1 * cc_[j] - u2 * sc_[j]; v[3][j] = u2 * cc_[j] + u1 * sc_[j];
            }
          }
        }
      }
      if (s >= S_NQ && s < S_NK) {
#pragma unroll
        for (int nt = 0; nt < NT; ++nt) v[nt] = v[nt] * QSCALE;
      } else if (s >= S_RK && s < S_RV) {
#pragma unroll
        for (int nt = 0; nt < NT; ++nt) v[nt] = v[nt] * 0.125f;
      } else if (s >= S_RG) {
#pragma unroll
        for (int nt = 0; nt < NT; ++nt)
#pragma unroll
          for (int j = 0; j < 4; ++j) v[nt][j] = silu_f(v[nt][j]);
      }
#pragma unroll
      for (int nt = 0; nt < NT; ++nt) { u32x2 o; o.x = pk2(v[nt][0], v[nt][1]); o.y = pk2(v[nt][2], v[nt][3]); *(u32x2*)(zb + (size_t)tok * 64 + nt * 16 + 4 * g) = o; }
    }
  }
};

struct EpiOutProj {
  const float* xlat; const float* xctx; const float* mod; float* XR;
  __device__ __forceinline__ void operator()(f32x4 (&acc)[8][4], int mw, int nw, int g, int li) const {
    const int seg = (mw < NLAT) ? (mw >> 13) : 2;
    const float* gt = mod + seg * 6144 + 2048;
    f32x4 gv[4];
#pragma unroll
    for (int nt = 0; nt < 4; ++nt) gv[nt] = *(const f32x4*)(gt + nw + nt * 16 + 4 * g);
    const float* xbase = (mw < NLAT) ? (xlat + (size_t)mw * D) : (xctx + (size_t)(mw - NLAT) * D);
#pragma unroll
    for (int mb = 0; mb < 8; mb += 2) {
      f32x4 xv[2][4];
#pragma unroll
      for (int u = 0; u < 2; ++u)
#pragma unroll
        for (int nt = 0; nt < 4; ++nt) xv[u][nt] = __builtin_nontemporal_load((const f32x4*)(xbase + (size_t)((mb + u) * 16 + li) * D + nw + nt * 16 + 4 * g));
#pragma unroll
      for (int u = 0; u < 2; ++u)
#pragma unroll
        for (int nt = 0; nt < 4; ++nt) *(f32x4*)(XR + (size_t)(mw + (mb + u) * 16 + li) * D + nw + nt * 16 + 4 * g) = xv[u][nt] + gv[nt] * acc[mb + u][nt];
    }
  }
};

template <int MT> struct EpiMoeUpT {
  bf16* act; int slot0; int nvalid;
  __device__ __forceinline__ void operator()(f32x4 (&acc)[MT][4], int mw, int nw, int g, int li) const {
#pragma unroll
    for (int mt = 0; mt < MT; ++mt) {
      const int r = mw + mt * 16 + li;
      if (r < nvalid) {
#pragma unroll
        for (int u = 0; u < 2; ++u) {
          const int hid = (nw >> 1) + u * 16 + 4 * g;
          const f32x4 a1 = acc[mt][2 * u], a3 = acc[mt][2 * u + 1];
          u32x2 o; o.x = pk2(silu_f(a1[0]) * a3[0], silu_f(a1[1]) * a3[1]); o.y = pk2(silu_f(a1[2]) * a3[2], silu_f(a1[3]) * a3[3]);
          *(u32x2*)(act + (size_t)(slot0 + r) * 512 + hid) = o;
        }
      }
    }
  }
};

template <int MT> struct EpiMoeDownT {
  const int* list; const float* gatew; bf16* ym0; bf16* ym1; int nvalid;
  __device__ __forceinline__ void operator()(f32x4 (&acc)[MT][4], int mw, int nw, int g, int li) const {
#pragma unroll
    for (int mb = 0; mb < MT; mb += 4) {
      int ent[4]; float gw[4];
#pragma unroll
      for (int mt = 0; mt < 4; ++mt) { const int r = mw + (mb + mt) * 16 + li; ent[mt] = list[r < nvalid ? r : nvalid - 1]; }
#pragma unroll
      for (int mt = 0; mt < 4; ++mt) gw[mt] = gatew[ent[mt]];
#pragma unroll
      for (int mt = 0; mt < 4; ++mt) {
        const int r = mw + (mb + mt) * 16 + li;
        if (r < nvalid) {
          bf16* y = ((ent[mt] & 1) ? ym1 : ym0) + (size_t)(ent[mt] >> 1) * D;
#pragma unroll
          for (int nt = 0; nt < 4; ++nt) {
            const int n = nw + nt * 16 + 4 * g;
            u32x2 o; o.x = pk2(acc[mb + mt][nt][0] * gw[mt], acc[mb + mt][nt][1] * gw[mt]); o.y = pk2(acc[mb + mt][nt][2] * gw[mt], acc[mb + mt][nt][3] * gw[mt]);
            *(u32x2*)(y + n) = o;
          }
        }
      }
    }
  }
};
typedef EpiMoeUpT<4> EpiMoeUp; typedef EpiMoeDownT<4> EpiMoeDown;

template <class Src, bool GATHER = false>
__device__ __forceinline__ void gemm8_stream(unsigned char* lds, const Src& src) {
  using namespace g8;
  const int nunit = src.count();
  if (nunit <= 0) return;
  const int tid = get_tid(), lane = tid & 63, wid = __builtin_amdgcn_readfirstlane(tid >> 6), wr = wid >> 2, wc = wid & 3, fr = lane & 15, fq = lane >> 4;
  const int K = src.K(), nt = K >> 6;
  unsigned oa[2][2], noa[2][2], ob[2][2];
#pragma unroll
  for (int i = 0; i < 2; ++i) {
    int R, C; stage_rc(tid * 16 + i * 8192, R, C);
    const int ra = (R >> 6) * 128 + ((R >> 4) & 3) * 16 + (R & 15);
    const int rb = (R >> 5) * 64 + ((R >> 4) & 1) * 16 + (R & 15);
#pragma unroll
    for (int hh = 0; hh < 2; ++hh) {
      if constexpr (GATHER) oa[hh][i] = src.aoff(0, ra + hh * 64) + (unsigned)C * 2u; else oa[hh][i] = (unsigned)((ra + hh * 64) * K + C) * 2u;
      noa[hh][i] = oa[hh][i];
      ob[hh][i] = (unsigned)((rb + hh * 32) * K + C) * 2u;
    }
  }
#define G8_SA(b, h) (((b) * 2 + (h)) * HT_B)
#define G8_SB(b, h) ((4 + (b) * 2 + (h)) * HT_B)
#define G8_STAGE(bufoff, BASE, O2, kt) do { _Pragma("unroll") for (int _i = 0; _i < 2; ++_i) \
    __builtin_amdgcn_global_load_lds((const void*)((BASE) + (O2)[_i] + (unsigned)(kt) * 128u), (LAS void*)(lds + (bufoff) + wid * 1024 + _i * 8192), 16, 0, 0); } while (0)
  const int aoff = lds_byte(wr * 64 + fr, fq * 8), boff = lds_byte(wc * 32 + fr, fq * 8);
#define G8_LDA(dst, b, h) do { _Pragma("unroll") for (int m = 0; m < 4; ++m) _Pragma("unroll") for (int k = 0; k < 2; ++k) dst[m][k] = *(const bf16x8*)(lds + G8_SA(b, h) + aoff + m * 2048 + k * 1024); } while (0)
#define G8_LDB(dst, b, h) do { _Pragma("unroll") for (int n = 0; n < 2; ++n) _Pragma("unroll") for (int k = 0; k < 2; ++k) dst[n][k] = *(const bf16x8*)(lds + G8_SB(b, h) + boff + n * 2048 + k * 1024); } while (0)
#define G8_MMA(ai, bj, At_, Bt_) do { __builtin_amdgcn_s_setprio(1); _Pragma("unroll") for (int m = 0; m < 4; ++m) _Pragma("unroll") for (int n = 0; n < 2; ++n) _Pragma("unroll") for (int k = 0; k < 2; ++k) \
    acc[(ai) * 4 + m][(bj) * 2 + n] = __builtin_amdgcn_mfma_f32_16x16x32_bf16(Bt_[n][k], At_[m][k], acc[(ai) * 4 + m][(bj) * 2 + n], 0, 0, 0); __builtin_amdgcn_s_setprio(0); } while (0)
#define G8_WV(n) asm volatile("s_waitcnt vmcnt(" #n ")" ::: "memory")
#define G8_WL(n) asm volatile("s_waitcnt lgkmcnt(" #n ")" ::: "memory")
#define G8_BAR __builtin_amdgcn_s_barrier()
#define G8_SCHED __builtin_amdgcn_sched_barrier(0)
  f32x4 acc[8][4];
  bf16x8 At[4][2], B0[2][2], B1[2][2];
  const char* ab = (const char*)src.abase(0); const char* bb = (const char*)src.bbase(0);
  G8_STAGE(G8_SB(0, 0), bb, ob[0], 0); G8_STAGE(G8_SB(0, 1), bb, ob[1], 0); G8_STAGE(G8_SA(0, 0), ab, oa[0], 0); G8_STAGE(G8_SA(0, 1), ab, oa[1], 0);
  if (wr == 1) G8_BAR;
  G8_WV(2); G8_BAR;
  G8_STAGE(G8_SB(1, 0), bb, ob[0], 1); G8_STAGE(G8_SA(1, 0), ab, oa[0], 1); G8_STAGE(G8_SB(1, 1), bb, ob[1], 1);
  G8_WV(6); G8_BAR;
#pragma unroll 1
  for (int u = 0; u < nunit; ++u) {
    const bool has_next = u + 1 < nunit;
    const char* nab = has_next ? (const char*)src.abase(u + 1) : ab; const char* nbb = has_next ? (const char*)src.bbase(u + 1) : bb;
    if constexpr (GATHER) {
#pragma unroll
      for (int i = 0; i < 2; ++i)
#pragma unroll
        for (int hh = 0; hh < 2; ++hh) { int R, C; stage_rc(get_tid() * 16 + i * 8192, R, C); const int ra = (R >> 6) * 128 + ((R >> 4) & 3) * 16 + (R & 15);
          noa[hh][i] = has_next ? src.aoff(u + 1, ra + hh * 64) + (unsigned)C * 2u : oa[hh][i]; }
    }
#pragma unroll
    for (int a = 0; a < 8; ++a)
#pragma unroll
      for (int b = 0; b < 4; ++b) acc[a][b] = (f32x4){0.f, 0.f, 0.f, 0.f};
#pragma unroll 1
    for (int t = 0; t < nt; t += 2) {
      const bool lastit = (t == nt - 2);
      const char* a2 = lastit ? nab : ab; const char* b2 = lastit ? nbb : bb;
      const int k2 = lastit ? 0 : t + 2, k3 = lastit ? 1 : t + 3;
      unsigned oa2[2][2];
#pragma unroll
      for (int i = 0; i < 2; ++i)
#pragma unroll
        for (int hh = 0; hh < 2; ++hh) oa2[hh][i] = (GATHER && lastit) ? noa[hh][i] : oa[hh][i];
      G8_LDB(B0, 0, 0); G8_LDB(B1, 0, 1); G8_SCHED; G8_LDA(At, 0, 0); G8_STAGE(G8_SA(1, 1), ab, oa[1], t + 1);
      G8_WV(8); G8_WL(0); G8_BAR; G8_MMA(0, 0, At, B0); G8_MMA(0, 1, At, B1); G8_BAR; G8_SCHED;
      G8_LDA(At, 0, 1); G8_STAGE(G8_SB(0, 0), b2, ob[0], k2); G8_STAGE(G8_SB(0, 1), b2, ob[1], k2); G8_STAGE(G8_SA(0, 0), a2, oa2[0], k2);
      G8_WV(8); G8_WL(0); G8_BAR; G8_MMA(1, 0, At, B0); G8_MMA(1, 1, At, B1); G8_BAR; G8_SCHED;
      G8_LDB(B0, 1, 0); G8_LDB(B1, 1, 1); G8_SCHED; G8_LDA(At, 1, 0); G8_STAGE(G8_SA(0, 1), a2, oa2[1], k2);
      G8_WV(8); G8_WL(0); G8_BAR; G8_MMA(0, 0, At, B0); G8_MMA(0, 1, At, B1); G8_BAR; G8_SCHED;
      G8_LDA(At, 1, 1); G8_STAGE(G8_SB(1, 0), b2, ob[0], k3); G8_STAGE(G8_SB(1, 1), b2, ob[1], k3); G8_STAGE(G8_SA(1, 0), a2, oa2[0], k3);
      G8_WV(8); G8_WL(0); G8_BAR; G8_MMA(1, 0, At, B0); G8_MMA(1, 1, At, B1); G8_BAR; G8_SCHED;
    }
    if (wr == 0) G8_BAR;
    src.epi(u)(acc, src.mrow(u) + wr * 128, src.ncol(u) + wc * 64, fq, fr);
    if (!has_next) break;
    ab = nab; bb = nbb;
    if (GATHER) {
#pragma unroll
      for (int i = 0; i < 2; ++i)
#pragma unroll
        for (int hh = 0; hh < 2; ++hh) oa[hh][i] = noa[hh][i];
    }
    if (wr == 1) G8_BAR;
  }
  G8_WV(0);
  G8_BAR;
#undef G8_SA
#undef G8_SB
#undef G8_STAGE
#undef G8_LDA
#undef G8_LDB
#undef G8_MMA
#undef G8_WV
#undef G8_WL
#undef G8_BAR
#undef G8_SCHED
  __syncthreads();
}

struct SrcA8 {
  const bf16* XB; const bf16* Wt; const EpiInProj<8, 4>* E; int c0, G, n;
  __device__ __forceinline__ int count() const { return n; }
  __device__ __forceinline__ int K() const { return 1024; }
  __device__ __forceinline__ const bf16* abase(int j) const { const int v = j * G + c0; return XB + (size_t)((v / 11) * 256) * 1024; }
  __device__ __forceinline__ const bf16* bbase(int j) const { const int v = j * G + c0; return Wt + (size_t)((v % 11) * 256) * 1024; }
  __device__ __forceinline__ const EpiInProj<8, 4>& epi(int) const { return *E; }
  __device__ __forceinline__ int mrow(int j) const { return ((j * G + c0) / 11) * 256; }
  __device__ __forceinline__ int ncol(int j) const { return ((j * G + c0) % 11) * 256; }
};
struct SrcC8 {
  const bf16* Y; const bf16* Wt; const struct EpiOutProj* E; int c0, G, n;
  __device__ __forceinline__ int count() const { return n; }
  __device__ __forceinline__ int K() const { return 1024; }
  __device__ __forceinline__ const bf16* abase(int j) const { const int v = j * G + c0; return Y + (size_t)((v >> 2) * 256) * 1024; }
  __device__ __forceinline__ const bf16* bbase(int j) const { const int v = j * G + c0; return Wt + (size_t)((v & 3) * 256) * 1024; }
  __device__ __forceinline__ const EpiOutProj& epi(int) const { return *E; }
  __device__ __forceinline__ int mrow(int j) const { return ((j * G + c0) >> 2) * 256; }
  __device__ __forceinline__ int ncol(int j) const { return ((j * G + c0) & 3) * 256; }
};


struct MoeU { int e, row0, nvalid, nt, slot0; };
struct SrcUp8 {
  const MoeU* d; const bf16* H; const int* list; const bf16* W; bf16* act; int n;
  __device__ __forceinline__ int count() const { return n; }
  __device__ __forceinline__ int K() const { return 1024; }
  __device__ __forceinline__ const bf16* abase(int) const { return H; }
  __device__ __forceinline__ unsigned aoff(int u, int r) const { const MoeU t = d[u]; const int rr = r < t.nvalid ? r : t.nvalid - 1; return (unsigned)(list[(size_t)t.e * NROWS + t.row0 + rr] >> 1) * 2048u; }
  __device__ __forceinline__ const bf16* bbase(int u) const { const MoeU t = d[u]; return W + (size_t)t.e * 1024 * 1024 + (size_t)(t.nt * 256) * 1024; }
  __device__ __forceinline__ EpiMoeUpT<8> epi(int u) const { const MoeU t = d[u]; return EpiMoeUpT<8>{act, t.slot0, t.nvalid}; }
  __device__ __forceinline__ int mrow(int) const { return 0; }
  __device__ __forceinline__ int ncol(int u) const { return d[u].nt * 256; }
};
struct SrcDown8 {
  const MoeU* d; const bf16* act; const int* list; const bf16* W; const float* gatew; bf16* ym0; bf16* ym1; int n;
  __device__ __forceinline__ int count() const { return n; }
  __device__ __forceinline__ int K() const { return 512; }
  __device__ __forceinline__ const bf16* abase(int u) const { return act + (size_t)d[u].slot0 * 512; }
  __device__ __forceinline__ const bf16* bbase(int u) const { const MoeU t = d[u]; return W + (size_t)t.e * 1024 * 512 + (size_t)(t.nt * 256) * 512; }
  __device__ __forceinline__ EpiMoeDownT<8> epi(int u) const { const MoeU t = d[u]; return EpiMoeDownT<8>{list + (size_t)t.e * NROWS + t.row0, gatew, ym0, ym1, t.nvalid}; }
  __device__ __forceinline__ int mrow(int) const { return 0; }
  __device__ __forceinline__ int ncol(int u) const { return d[u].nt * 256; }
};

struct ARowGather { const bf16* H; const int* list; int nvalid; __device__ __forceinline__ const bf16* operator()(int r) const { const int rr = r < nvalid ? r : nvalid - 1; return H + (size_t)(list[rr] >> 1) * D; } };
struct ARowAct { const bf16* act; int slot0; __device__ __forceinline__ const bf16* operator()(int r) const { int s = slot0 + r; s = s < 2 * NROWS ? s : 2 * NROWS - 1; return act + (size_t)s * 512; } };

template <int NQB, bool NAM, int NW>
__device__ __forceinline__ void attn_item(unsigned char* lds, int gb, int wl, int lane, const bf16* zb, int sq0, int sk, int sv, int qtok0, int lat0, int nlat, int ntiles,
                                          int drbase, bf16* Y, size_t yrow0, int ycol0, const float* mixg) {
  const int g = lane >> 4, li = lane & 15;
  const int qtok = qtok0 + 16 * wl + li;
  bf16x8 qf[NQB][2];
#pragma unroll
  for (int qb = 0; qb < NQB; ++qb)
#pragma unroll
    for (int kk = 0; kk < 2; ++kk) qf[qb][kk] = *(const bf16x8*)(zb + ((size_t)(sq0 + qb) * NT_TOK + qtok) * 64 + kk * 32 + g * 8);
  const bf16* kbp = zb + (size_t)sk * NT_TOK * 64;
  const bf16* vbp = zb + (size_t)sv * NT_TOK * 64;
  f32x4 O[4][NQB], L[NQB];
  const bf16x8 ones = {0x3f80, 0x3f80, 0x3f80, 0x3f80, 0x3f80, 0x3f80, 0x3f80, 0x3f80};
#pragma unroll
  for (int qb = 0; qb < NQB; ++qb) { L[qb] = (f32x4){0.f, 0.f, 0.f, 0.f};
#pragma unroll
    for (int db = 0; db < 4; ++db) O[db][qb] = (f32x4){0.f, 0.f, 0.f, 0.f}; }
  const int f = (li >> 1) & 7;
  const int koff = li * 128 + ((g ^ f) << 4);
  const int q_ = li >> 2, p_ = li & 3, fv = (2 * g + (q_ >> 1)) & 7;
  const int voff = (4 * g + q_) * 128 + (p_ & 1) * 8;
  const float* rpbt = (const float*)(lds + gb + 49152);
  const int qc = 16 * wl + li;
  int cs = qc - 8; cs = cs < 0 ? 0 : (cs > 48 ? 48 : cs);
#define AT_TOK(t) ((t) < nlat ? lat0 + 64 * (t) : NSEQ + 64 * ((t) - nlat))
#define AT_STAGE(t, bi) do { const int tk_ = AT_TOK(t); stage_rows<64, NW>(lds, gb + (bi) * 16384, kbp + (size_t)tk_ * 64, 64, wl, lane); \
                             stage_rows<64, NW>(lds, gb + (bi) * 16384 + 8192, vbp + (size_t)tk_ * 64, 64, wl, lane); } while (0)
#define AT_WAIT1() do { if (NW == 8) VMCNT(2); else VMCNT(4); } while (0)
  AT_STAGE(0, 0);
  if (ntiles > 1) { AT_STAGE(1, 1); AT_WAIT1(); } else { VMCNT(0); }
  RAW_BAR();
  int cur = 0;
  for (int t = 0; t < ntiles; ++t) {
    const int kb_off = gb + cur * 16384, vb_off = kb_off + 8192;
    const int pfb = cur == 0 ? 2 : cur - 1;
    if (t + 2 < ntiles) AT_STAGE(t + 2, pfb);
#pragma unroll
    for (int ks = 0; ks < 2; ++ks) {
      f32x4 s[2][NQB];
#pragma unroll
      for (int h2 = 0; h2 < 2; ++h2) {
#pragma unroll
        for (int qb = 0; qb < NQB; ++qb) s[h2][qb] = (f32x4){0.f, 0.f, 0.f, 0.f};
#pragma unroll
        for (int kk = 0; kk < 2; ++kk) {
          const bf16x8 kf = lds_frag(lds, kb_off + (((2 * ks + h2) * 2048 + koff) ^ (kk << 6)));
#pragma unroll
          for (int qb = 0; qb < NQB; ++qb) s[h2][qb] = __builtin_amdgcn_mfma_f32_16x16x32_bf16(kf, qf[qb][kk], s[h2][qb], 0, 0, 0);
        }
      }
      bf16x8 pf[NQB];
#pragma unroll
      for (int qb = 0; qb < NQB; ++qb) {
        float p[8];
#pragma unroll
        for (int h2 = 0; h2 < 2; ++h2)
#pragma unroll
          for (int j = 0; j < 4; ++j) {
            float x = s[h2][qb][j];
            if (NAM) {
              if (t < nlat) {
                const int kc = (2 * ks + h2) * 16 + 4 * g + j;
                const bool valid = (kc >= cs) && (kc < cs + 16);
                int dc = kc - qc + 15; dc = dc < 0 ? 0 : (dc > 30 ? 30 : dc);
                x += rpbt[(drbase + t) * 31 + dc];
                x = valid ? x : -1e30f;
              }
            }
            const float e = __builtin_amdgcn_exp2f(x);
            p[h2 * 4 + j] = e;
          }
        u32x4 pw; pw.x = pk2(p[0], p[1]); pw.y = pk2(p[2], p[3]); pw.z = pk2(p[4], p[5]); pw.w = pk2(p[6], p[7]);
        pf[qb] = __builtin_bit_cast(bf16x8, pw);
        L[qb] = __builtin_amdgcn_mfma_f32_16x16x32_bf16(ones, pf[qb], L[qb], 0, 0, 0);
      }
#pragma unroll
      for (int db = 0; db < 4; ++db) {
        const int a0 = vb_off + ks * 4096 + voff + (((db * 2 + (p_ >> 1)) ^ fv) << 4);
        const bf16x8 vf = lds_tr2(lds, a0, a0 + 2048);
#pragma unroll
        for (int qb = 0; qb < NQB; ++qb) O[db][qb] = __builtin_amdgcn_mfma_f32_16x16x32_bf16(vf, pf[qb], O[db][qb], 0, 0, 0);
      }
    }
    if (t + 2 < ntiles) { AT_WAIT1(); } else { VMCNT(0); }
    LGKM0(); RAW_BAR();
    cur = cur == 2 ? 0 : cur + 1;
  }
#undef AT_TOK
#undef AT_STAGE
#undef AT_WAIT1
#pragma unroll
  for (int qb = 0; qb < NQB; ++qb) {
    const float inv = 1.f / L[qb][0];
    float ss = 0.f;
#pragma unroll
    for (int db = 0; db < 4; ++db) { O[db][qb] = O[db][qb] * inv; ss += O[db][qb][0] * O[db][qb][0] + O[db][qb][1] * O[db][qb][1] + O[db][qb][2] * O[db][qb][2] + O[db][qb][3] * O[db][qb][3]; }
    ss += __shfl_xor(ss, 16); ss += __shfl_xor(ss, 32);
    const float r = rsqrtf(ss * (1.f / 64.f) + EPS);
    bf16* yp = Y + (yrow0 + 16 * wl + li) * D + ycol0 + qb * 64;
#pragma unroll
    for (int db = 0; db < 4; ++db) {
      const f32x4 gv = *(const f32x4*)(mixg + ycol0 + qb * 64 + db * 16 + 4 * g);
      const f32x4 y = O[db][qb] * r * gv;
      u32x2 o; o.x = pk2(y[0], y[1]); o.y = pk2(y[2], y[3]);
      *(u32x2*)(yp + db * 16 + 4 * g) = o;
    }
  }
}

__device__ __forceinline__ void ret_u_item(unsigned char* lds, int gb, int tg, const bf16* zb, int h, int c, float lgf2, float lgb2, float* Uf, float* Ub) {
  const int lane = tg & 63, w = __builtin_amdgcn_readfirstlane(tg >> 6), g = lane >> 4, li = lane & 15;
  const int tok0 = c < 2 ? NSEQ + 128 * c : 128 * (c - 2);
  const bf16* kp = zb + ((size_t)(S_RK + h) * NT_TOK + tok0) * 64;
  const bf16* vp = zb + ((size_t)(S_RV + h) * NT_TOK + tok0) * 64;
  stage_rows<128, 4>(lds, gb, kp, 64, w, lane);
  {
    const int row = tg >> 1, half = tg & 1;
    const float wf = __builtin_amdgcn_exp2f(lgf2 * (float)(127 - row)), wb = __builtin_amdgcn_exp2f(lgb2 * (float)row);
#pragma unroll
    for (int c4 = 0; c4 < 4; ++c4) {
      const int chunk = half * 4 + c4;
      const u32x4 v = *(const u32x4*)(vp + (size_t)row * 64 + chunk * 8);
      u32x4 of, ob;
#pragma unroll
      for (int i = 0; i < 4; ++i) { const float lo = bflo(v[i]), hi = bfhi(v[i]); of[i] = pk2(lo * wf, hi * wf); ob[i] = pk2(lo * wb, hi * wb); }
      *(u32x4*)(lds + gb + 16384 + lds_swz(row, chunk)) = of;
      *(u32x4*)(lds + gb + 32768 + lds_swz(row, chunk)) = ob;
    }
  }
  VM_WAIT(); __syncthreads();
  const int q_ = li >> 2, p_ = li & 3, fv = (2 * g + (q_ >> 1)) & 7;
  const int toff = gb + (4 * g + q_) * 128 + (p_ & 1) * 8;
  f32x4 acc[2][4];
#pragma unroll
  for (int d_ = 0; d_ < 2; ++d_)
#pragma unroll
    for (int eb = 0; eb < 4; ++eb) acc[d_][eb] = (f32x4){0.f, 0.f, 0.f, 0.f};
#pragma unroll
  for (int ks = 0; ks < 4; ++ks) {
    const int a0 = ks * 4096 + toff + (((w * 2 + (p_ >> 1)) ^ fv) << 4);
    const bf16x8 kf = lds_tr2(lds, a0, a0 + 2048);
#pragma unroll
    for (int eb = 0; eb < 4; ++eb) {
      const int b0 = ks * 4096 + toff + (((eb * 2 + (p_ >> 1)) ^ fv) << 4);
      const bf16x8 vf = lds_tr2(lds, 16384 + b0, 16384 + b0 + 2048);
      const bf16x8 vb = lds_tr2(lds, 32768 + b0, 32768 + b0 + 2048);
      acc[0][eb] = __builtin_amdgcn_mfma_f32_16x16x32_bf16(kf, vf, acc[0][eb], 0, 0, 0);
      acc[1][eb] = __builtin_amdgcn_mfma_f32_16x16x32_bf16(kf, vb, acc[1][eb], 0, 0, 0);
    }
  }
#pragma unroll
  for (int eb = 0; eb < 4; ++eb) {
    *(f32x4*)(Uf + (eb * 16 + li) * 64 + w * 16 + 4 * g) = acc[0][eb];
    *(f32x4*)(Ub + (eb * 16 + li) * 64 + w * 16 + 4 * g) = acc[1][eb];
  }
  __syncthreads();
}

__device__ __forceinline__ void ret_out_item(unsigned char* lds, int gb, int tg, const bf16* zb, int h, int c, float lgf2, float lgb2, const float* Sf, const float* Sb,
                                             bf16* Y, size_t yrow0, const float* mixg) {
  const int lane = tg & 63, w = __builtin_amdgcn_readfirstlane(tg >> 6), g = lane >> 4, li = lane & 15;
  const int tok0 = c < 2 ? NSEQ + 128 * c : 128 * (c - 2);
  const bf16* qp = zb + ((size_t)(S_RQ + h) * NT_TOK + tok0) * 64;
  const bf16* kp = zb + ((size_t)(S_RK + h) * NT_TOK + tok0) * 64;
  const bf16* vp = zb + ((size_t)(S_RV + h) * NT_TOK + tok0) * 64;
  const bf16* gp = zb + ((size_t)(S_RG + h) * NT_TOK + tok0) * 64;
  stage_rows<128, 4>(lds, gb, kp, 64, w, lane);
  stage_rows<128, 4>(lds, gb + 16384, vp, 64, w, lane);
  {
    const int e = tg >> 2, dq = tg & 3;
#pragma unroll
    for (int hh = 0; hh < 2; ++hh) {
      const f32x4 a0 = *(const f32x4*)(Sf + e * 64 + dq * 16 + hh * 8), a1 = *(const f32x4*)(Sf + e * 64 + dq * 16 + hh * 8 + 4);
      const f32x4 b0 = *(const f32x4*)(Sb + e * 64 + dq * 16 + hh * 8), b1 = *(const f32x4*)(Sb + e * 64 + dq * 16 + hh * 8 + 4);
      u32x4 oa, ob; oa.x = pk2(a0[0], a0[1]); oa.y = pk2(a0[2], a0[3]); oa.z = pk2(a1[0], a1[1]); oa.w = pk2(a1[2], a1[3]);
      ob.x = pk2(b0[0], b0[1]); ob.y = pk2(b0[2], b0[3]); ob.z = pk2(b1[0], b1[1]); ob.w = pk2(b1[2], b1[3]);
      *(u32x4*)(lds + gb + 32768 + lds_swz(e, dq * 2 + hh)) = oa;
      *(u32x4*)(lds + gb + 40960 + lds_swz(e, dq * 2 + hh)) = ob;
    }
  }
  bf16x8 qf[2][2];
#pragma unroll
  for (int ib = 0; ib < 2; ++ib)
#pragma unroll
    for (int kk = 0; kk < 2; ++kk) qf[ib][kk] = *(const bf16x8*)(qp + (size_t)(32 * w + 16 * ib + li) * 64 + kk * 32 + g * 8);
  VM_WAIT(); __syncthreads();
  const int f = (li >> 1) & 7;
  const int koff = gb + li * 128 + ((g ^ f) << 4);
  const int q_ = li >> 2, p_ = li & 3, fv = (2 * g + (q_ >> 1)) & 7;
  const int voff = gb + 16384 + (4 * g + q_) * 128 + (p_ & 1) * 8;
  f32x4 O[4][2], CF[4][2], CB[4][2];
#pragma unroll
  for (int eb = 0; eb < 4; ++eb)
#pragma unroll
    for (int ib = 0; ib < 2; ++ib) { O[eb][ib] = (f32x4){0.f, 0.f, 0.f, 0.f}; CF[eb][ib] = O[eb][ib]; CB[eb][ib] = O[eb][ib]; }
#pragma unroll
  for (int ks = 0; ks < 4; ++ks) {
    f32x4 s[2][2];
#pragma unroll
    for (int h2 = 0; h2 < 2; ++h2) {
      s[h2][0] = (f32x4){0.f, 0.f, 0.f, 0.f}; s[h2][1] = s[h2][0];
#pragma unroll
      for (int kk = 0; kk < 2; ++kk) {
        const bf16x8 kf = lds_frag(lds, ((2 * ks + h2) * 2048 + koff) ^ (kk << 6));
        s[h2][0] = __builtin_amdgcn_mfma_f32_16x16x32_bf16(kf, qf[0][kk], s[h2][0], 0, 0, 0);
        s[h2][1] = __builtin_amdgcn_mfma_f32_16x16x32_bf16(kf, qf[1][kk], s[h2][1], 0, 0, 0);
      }
    }
    bf16x8 pf[2];
#pragma unroll
    for (int ib = 0; ib < 2; ++ib) {
      const int i = 32 * w + 16 * ib + li;
      float p[8];
#pragma unroll
      for (int h2 = 0; h2 < 2; ++h2)
#pragma unroll
        for (int j = 0; j < 4; ++j) {
          const int jj = (2 * ks + h2) * 16 + 4 * g + j, df = i - jj;
          const float dw = df > 0 ? __builtin_amdgcn_exp2f(lgf2 * (float)df) : (df < 0 ? __builtin_amdgcn_exp2f(lgb2 * (float)(-df)) : 2.f);
          p[h2 * 4 + j] = s[h2][ib][j] * dw;
        }
      u32x4 pw; pw.x = pk2(p[0], p[1]); pw.y = pk2(p[2], p[3]); pw.z = pk2(p[4], p[5]); pw.w = pk2(p[6], p[7]);
      pf[ib] = __builtin_bit_cast(bf16x8, pw);
    }
#pragma unroll
    for (int eb = 0; eb < 4; ++eb) {
      const int a0 = voff + ks * 4096 + (((eb * 2 + (p_ >> 1)) ^ fv) << 4);
      const bf16x8 vf = lds_tr2(lds, a0, a0 + 2048);
      O[eb][0] = __builtin_amdgcn_mfma_f32_16x16x32_bf16(vf, pf[0], O[eb][0], 0, 0, 0);
      O[eb][1] = __builtin_amdgcn_mfma_f32_16x16x32_bf16(vf, pf[1], O[eb][1], 0, 0, 0);
    }
  }
#pragma unroll
  for (int kk = 0; kk < 2; ++kk)
#pragma unroll
    for (int eb = 0; eb < 4; ++eb) {
      const bf16x8 sf = lds_frag(lds, 32768 + ((eb * 2048 + koff) ^ (kk << 6)));
      const bf16x8 sb = lds_frag(lds, 40960 + ((eb * 2048 + koff) ^ (kk << 6)));
#pragma unroll
      for (int ib = 0; ib < 2; ++ib) {
        CF[eb][ib] = __builtin_amdgcn_mfma_f32_16x16x32_bf16(sf, qf[ib][kk], CF[eb][ib], 0, 0, 0);
        CB[eb][ib] = __builtin_amdgcn_mfma_f32_16x16x32_bf16(sb, qf[ib][kk], CB[eb][ib], 0, 0, 0);
      }
    }
#pragma unroll
  for (int ib = 0; ib < 2; ++ib) {
    const int i = 32 * w + 16 * ib + li;
    const float xf = __builtin_amdgcn_exp2f(lgf2 * (float)(i + 1)), xb = __builtin_amdgcn_exp2f(lgb2 * (float)(128 - i));
    float ss = 0.f;
#pragma unroll
    for (int eb = 0; eb < 4; ++eb) { O[eb][ib] = O[eb][ib] + CF[eb][ib] * xf + CB[eb][ib] * xb; ss += O[eb][ib][0] * O[eb][ib][0] + O[eb][ib][1] * O[eb][ib][1] + O[eb][ib][2] * O[eb][ib][2] + O[eb][ib][3] * O[eb][ib][3]; }
    ss += __shfl_xor(ss, 16); ss += __shfl_xor(ss, 32);
    const float r = rsqrtf(ss * (1.f / 64.f) + EPS);
    bf16* yp = Y + (yrow0 + i) * D + 640 + h * 64;
#pragma unroll
    for (int eb = 0; eb < 4; ++eb) {
      const f32x4 gv = *(const f32x4*)(mixg + 640 + h * 64 + eb * 16 + 4 * g);
      const u32x2 gg = *(const u32x2*)(gp + (size_t)i * 64 + eb * 16 + 4 * g);
      const f32x4 y = O[eb][ib] * r * gv;
      u32x2 o; o.x = pk2(y[0] * bflo(gg.x), y[1] * bfhi(gg.x)); o.y = pk2(y[2] * bflo(gg.y), y[3] * bfhi(gg.y));
      *(u32x2*)(yp + eb * 16 + 4 * g) = o;
    }
  }
  __syncthreads();
}

__device__ __forceinline__ float log_sigmoid_f(float x) { return x >= 0.f ? -log1pf(expf(-x)) : x - log1pf(expf(x)); }

__device__ __forceinline__ void p0_mod_item(unsigned char* lds, const Params& P, int item) {
  const int l = item / 96, chunk = item % 96, tid = get_tid(), ks = tid >> 4, cg4 = tid & 15;
  float* red = (float*)lds;
  float* sil = (float*)(lds + 32768);
#pragma unroll
  for (int i = 0; i < 2; ++i) { const int k = tid + 512 * i; sil[k] = silu_f(P.c[k]); sil[1024 + k] = silu_f(P.c[1024 + k]); sil[2048 + k] = silu_f(P.c_ctx[k]); }
  __syncthreads();
  const float* wa = P.w_ada + (size_t)l * 1024 * 6144 + chunk * 64 + cg4 * 4;
  f32x4 a0 = {0.f, 0.f, 0.f, 0.f}, a1 = a0, a2 = a0;
#pragma unroll 16
  for (int i = 0; i < 32; ++i) {
    const int k = ks * 32 + i;
    const f32x4 wv = __builtin_nontemporal_load((const f32x4*)(wa + (size_t)k * 6144));
    a0 += wv * sil[k]; a1 += wv * sil[1024 + k]; a2 += wv * sil[2048 + k];
  }
  *(f32x4*)(red + (ks * 3 + 0) * 64 + cg4 * 4) = a0; *(f32x4*)(red + (ks * 3 + 1) * 64 + cg4 * 4) = a1; *(f32x4*)(red + (ks * 3 + 2) * 64 + cg4 * 4) = a2;
  __syncthreads();
  if (tid < 192) {
    const int seg = tid >> 6, col = tid & 63; float s = P.b_ada[l * 6144 + chunk * 64 + col];
#pragma unroll
    for (int k2 = 0; k2 < 32; ++k2) s += red[(k2 * 3 + seg) * 64 + col];
    ((float*)(P.ws + WS_MOD))[(l * 3 + seg) * 6144 + chunk * 64 + col] = s;
  }
  __syncthreads();
}

__device__ __forceinline__ void p0_tr_item(unsigned char* lds, const float* src, int srcN, int k0, int n0, bf16* dst, int dstK, int mode) {
  float* tile = (float*)lds;
  const int tid = get_tid();
  f32x4 v[8];
#pragma unroll
  for (int ps = 0; ps < 8; ++ps) v[ps] = __builtin_nontemporal_load((const f32x4*)(src + (size_t)(k0 + (tid >> 5) + 16 * ps) * srcN + n0 + (tid & 31) * 4));
#pragma unroll
  for (int ps = 0; ps < 8; ++ps) { float* tp = tile + ((tid >> 5) + 16 * ps) * 129 + (tid & 31) * 4; tp[0] = v[ps][0]; tp[1] = v[ps][1]; tp[2] = v[ps][2]; tp[3] = v[ps][3]; }
  __syncthreads();
  const int n = tid >> 2, kc = tid & 3, ncol = n0 + n;
  int row = ncol;
  if (mode) row = (ncol >> 4) * 32 + (ncol & 15) + (mode == 2 ? 16 : 0);
  bf16* dp = dst + (size_t)row * dstK + k0 + kc * 32;
  const float* tp = tile + (kc * 32) * 129 + n;
#pragma unroll
  for (int q = 0; q < 4; ++q) {
    u32x4 o;
#pragma unroll
    for (int i = 0; i < 4; ++i) o[i] = pk2(tp[(q * 8 + 2 * i) * 129], tp[(q * 8 + 2 * i + 1) * 129]);
    *(u32x4*)(dp + q * 8) = o;
  }
  __syncthreads();
}

constexpr int P0_MOD = 192, P0_MISC = 1, P0_WIN = 2 * 8 * 23, P0_WO = 2 * 8 * 8, P0_W1 = 32 * 32, P0_W2 = 32 * 32;
constexpr int P0_ITEMS = P0_MOD + P0_MISC + P0_WIN + P0_WO + 2 * P0_W1 + P0_W2;

__device__ __forceinline__ void phase0(unsigned char* lds, const Params& P) {
#pragma unroll 1
  for (int it = blockIdx.x; it < P0_ITEMS; it += gridDim.x) {
    int r = it;
    if (r < P0_MOD) { p0_mod_item(lds, P, r); continue; } r -= P0_MOD;
    if (r < P0_MISC) {
      const int tid = get_tid();
      float* rope = (float*)(P.ws + WS_ROPE);
      for (int e = tid; e < 2048; e += NTHR) { const int pos = e >> 4, f = e & 15; const float inv = powf(10000.f, -(float)f / 16.f); const float ang = (float)pos * inv; rope[e * 2] = cosf(ang); rope[e * 2 + 1] = sinf(ang); }
      continue;
    } r -= P0_MISC;
    const float* src; int srcN, k0, n0, dstK, mode; bf16* dst;
    if (r < P0_WIN) { const int l = r / 184, q = r % 184, kt = q / 23, nt = q % 23;
      src = P.w_in + (size_t)l * 1024 * INC; srcN = INC; k0 = kt * 128; n0 = nt * 128; dst = (bf16*)(P.ws + WS_WIN) + (size_t)l * INC * 1024; dstK = 1024; mode = 0; }
    else if (r < P0_WIN + P0_WO) { const int r2 = r - P0_WIN, l = r2 / 64, q = r2 % 64, kt = q / 8, nt = q % 8;
      src = P.w_out + (size_t)l * 1024 * 1024; srcN = 1024; k0 = kt * 128; n0 = nt * 128; dst = (bf16*)(P.ws + WS_WO) + (size_t)l * 1024 * 1024; dstK = 1024; mode = 0; }
    else if (r < P0_WIN + P0_WO + 2 * P0_W1) { const int r2 = r - P0_WIN - P0_WO, which = r2 / P0_W1, q2 = r2 % P0_W1, le = q2 / 32, q = q2 % 32, kt = q / 4, nt = q % 4;
      src = (which ? P.w3 : P.w1) + (size_t)le * 1024 * 512; srcN = 512; k0 = kt * 128; n0 = nt * 128; dst = (bf16*)(P.ws + WS_W13) + (size_t)le * 1024 * 1024; dstK = 1024; mode = which ? 2 : 1; }
    else { const int r2 = r - P0_WIN - P0_WO - 2 * P0_W1, le = r2 / 32, q = r2 % 32, kt = q / 8, nt = q % 8;
      src = P.w2 + (size_t)le * 512 * 1024; srcN = 1024; k0 = kt * 128; n0 = nt * 128; dst = (bf16*)(P.ws + WS_W2) + (size_t)le * 1024 * 512; dstK = 512; mode = 0; }
    p0_tr_item(lds, src, srcN, k0, n0, dst, dstK, mode);
  }
}

constexpr int P1_XB = NROWS / 16, P1_BIAS = 2 * INC / 8, P1_WR = 6, P1_ITEMS = P1_XB + P1_BIAS + P1_WR;
__device__ __forceinline__ void phase1(unsigned char* lds, const Params& P) {
  const int tid = get_tid(), lane = tid & 63, w = tid >> 6;
  const float* mod = (const float*)(P.ws + WS_MOD);
#pragma unroll 1
  for (int it = blockIdx.x; it < P1_ITEMS; it += gridDim.x) {
    int r = it;
    if (r < P1_XB) {
      f32x4 v[2][4];
#pragma unroll
      for (int u = 0; u < 2; ++u) { const int row = r * 16 + 2 * w + u; const float* xr = row < NLAT ? P.x + (size_t)row * D : P.ctx + (size_t)(row - NLAT) * D;
#pragma unroll
        for (int j = 0; j < 4; ++j) v[u][j] = __builtin_nontemporal_load((const f32x4*)(xr + 4 * lane + 256 * j)); }
      const int row0 = r * 16 + 2 * w, seg = row0 < NSEQ ? 0 : (row0 < NLAT ? 1 : 2);
      const float* sc1 = mod + (0 * 3 + seg) * 6144 + 1024;
      f32x4 gs[4];
#pragma unroll
      for (int j = 0; j < 4; ++j) { const int k = 4 * lane + 256 * j; gs[j] = *(const f32x4*)(P.n1g + k) * (*(const f32x4*)(sc1 + k) + 1.f); }
#pragma unroll
      for (int u = 0; u < 2; ++u) {
        const int row = row0 + u; bf16* xb = (bf16*)(P.ws + WS_R1) + (size_t)row * D; float ss = 0.f;
#pragma unroll
        for (int j = 0; j < 4; ++j) { const f32x4 x = v[u][j]; ss += x[0] * x[0] + x[1] * x[1] + x[2] * x[2] + x[3] * x[3]; const f32x4 o = x * gs[j]; u32x2 ov; ov.x = pk2(o[0], o[1]); ov.y = pk2(o[2], o[3]); *(u32x2*)(xb + 4 * lane + 256 * j) = ov; }
        ss = wsum(ss);
        if (lane == 0) ((float*)(P.ws + WS_RSS))[row] = ss;
      }
      continue;
    } r -= P1_XB;
    if (r < P1_BIAS) {
      const int idx = r * 8 + w, l = idx / INC, n = idx % INC;
      const bf16* wrow = (const bf16*)(P.ws + WS_WIN) + ((size_t)l * INC + n) * 1024 + lane * 16;
      const u32x4 w0 = *(const u32x4*)wrow, w1 = *(const u32x4*)(wrow + 8);
      float wv[16];
#pragma unroll
      for (int i = 0; i < 4; ++i) { wv[2 * i] = bflo(w0[i]); wv[2 * i + 1] = bfhi(w0[i]); wv[8 + 2 * i] = bflo(w1[i]); wv[8 + 2 * i + 1] = bfhi(w1[i]); }
#pragma unroll
      for (int seg = 0; seg < 3; ++seg) {
        const float* sh = mod + (l * 3 + seg) * 6144 + lane * 16; float a = 0.f;
#pragma unroll
        for (int i = 0; i < 16; ++i) a += wv[i] * sh[i];
        a = wsum(a);
        if (lane == 0) ((float*)(P.ws + WS_BIAS))[(l * 3 + seg) * INC + n] = a;
      }
      continue;
    } r -= P1_BIAS;
    { const int l = r / 3, seg = r % 3;
      const float* m = mod + (l * 3 + seg) * 6144;
      float* wr = (float*)(P.ws + WS_WR) + (size_t)(l * 3 + seg) * 16384;
      for (int e = tid; e < 16384; e += NTHR) { const int k = e >> 4; wr[e] = P.n2g[l * 1024 + k] * (1.f + m[4096 + k]) * P.w_router[e]; }
      const int ex = tid & 15, ks = tid >> 4; float a = 0.f;
      for (int i = 0; i < 32; ++i) { const int k = ks * 32 + i; a += m[3072 + k] * P.w_router[k * 16 + ex]; }
      float* red = (float*)lds; red[ks * 16 + ex] = a; __syncthreads();
      if (tid < 16) { float s = P.b_router[tid]; for (int k2 = 0; k2 < 32; ++k2) s += red[k2 * 16 + tid]; ((float*)(P.ws + WS_CR))[(l * 3 + seg) * 16 + tid] = s; }
      __syncthreads();
    }
  }
}

__device__ __forceinline__ int xcd_vidx(int round) {
  const int G = gridDim.x, b = blockIdx.x;
  return (G & 7) == 0 ? round * G + (b & 7) * (G >> 3) + (b >> 3) : round * G + b;
}

__device__ __forceinline__ void phaseA(unsigned char* lds, const Params& P, int l) {
  const bf16* XB = (const bf16*)(P.ws + WS_R1);
  const bf16* Wt = (const bf16*)(P.ws + WS_WIN) + (size_t)l * INC * 1024;
  { const int tid = get_tid(); const f32x4* s4 = (const f32x4*)(P.ws + WS_ROPE); f32x4* d4 = (f32x4*)(lds + LDS_MISC);
    for (int e = tid; e < 1024; e += NTHR) d4[e] = s4[e];
    __syncthreads(); }
  const float* ropel = (const float*)(lds + LDS_MISC);
  EpiInProj<8, 4> E4{(const float*)(P.ws + WS_RSS), (const float*)(P.ws + WS_BIAS) + l * 3 * INC, P.qg + l * 64, P.kg + l * 64, ropel, (bf16*)(P.ws + WS_Z)};
  EpiInProj<4, 4> E44{(const float*)(P.ws + WS_RSS), (const float*)(P.ws + WS_BIAS) + l * 3 * INC, P.qg + l * 64, P.kg + l * 64, ropel, (bf16*)(P.ws + WS_Z)};
  EpiInProj<8, 2> E2{(const float*)(P.ws + WS_RSS), (const float*)(P.ws + WS_BIAS) + l * 3 * INC, P.qg + l * 64, P.kg + l * 64, ropel, (bf16*)(P.ws + WS_Z)};
  constexpr int NFULL = 66 * 11, NITEM = NFULL + 33;
  const int c0 = xcd_vidx(0), G = gridDim.x;
  const int nfull = c0 < NFULL ? (NFULL - c0 + G - 1) / G : 0;
  { SrcA8 S{XB, Wt, &E4, c0, G, nfull};
    gemm8_stream(lds, S); }
  if (nfull == 2 && c0 >= 214 && c0 - 214 < 42) {
    const int pn = c0 - 214;
    ARowLinear ar{XB, 1024, pn * 256}; gemm_tile3<4, 4, 2>(lds, ar, Wt, 1024, pn * 256, 2816, E44);
  }
}


__device__ __forceinline__ u32x2 tr_read_asm0(unsigned a) { u32x2 r; asm volatile("ds_read_b64_tr_b16 %0, %1 offset:8192" : "=v"(r) : "v"(a)); return r; }
__device__ __forceinline__ u32x2 tr_read_asm1(unsigned a) { u32x2 r; asm volatile("ds_read_b64_tr_b16 %0, %1 offset:10240" : "=v"(r) : "v"(a)); return r; }
__device__ __forceinline__ u32x2 tr_read_asm2(unsigned a) { u32x2 r; asm volatile("ds_read_b64_tr_b16 %0, %1 offset:12288" : "=v"(r) : "v"(a)); return r; }
__device__ __forceinline__ u32x2 tr_read_asm3(unsigned a) { u32x2 r; asm volatile("ds_read_b64_tr_b16 %0, %1 offset:14336" : "=v"(r) : "v"(a)); return r; }
#define PP_SCHED __builtin_amdgcn_sched_barrier(0)
template <int NQB>
__device__ __forceinline__ void attn_pp_item(unsigned char* lds, int wl, int lane, const bf16* zb, int sq0, int sk, int sv, int qtok0, int nlat, int ntiles,
                                             bf16* Y, size_t yrow0, int ycol0, const float* mixg) {
  const int g = lane >> 4, li = lane & 15, half = wl >> 2;
  const int qtok = qtok0 + 16 * wl + li;
  bf16x8 qf[NQB][2];
#pragma unroll
  for (int qb = 0; qb < NQB; ++qb)
#pragma unroll
    for (int kk = 0; kk < 2; ++kk) qf[qb][kk] = *(const bf16x8*)(zb + ((size_t)(sq0 + qb) * NT_TOK + qtok) * 64 + kk * 32 + g * 8);
  const bf16* kbp = zb + (size_t)sk * NT_TOK * 64;
  const bf16* vbp = zb + (size_t)sv * NT_TOK * 64;
  f32x4 O[4][NQB], L[NQB];
  const bf16x8 ones = {0x3f80, 0x3f80, 0x3f80, 0x3f80, 0x3f80, 0x3f80, 0x3f80, 0x3f80};
#pragma unroll
  for (int qb = 0; qb < NQB; ++qb) { L[qb] = (f32x4){0.f, 0.f, 0.f, 0.f};
#pragma unroll
    for (int db = 0; db < 4; ++db) O[db][qb] = (f32x4){0.f, 0.f, 0.f, 0.f}; }
  const int f = (li >> 1) & 7;
  const int koff = li * 128 + ((g ^ f) << 4);
  const int q_ = li >> 2, p_ = li & 3, fv = (2 * g + (q_ >> 1)) & 7;
  const unsigned lbase = (unsigned)(size_t)(LAS unsigned char*)lds;
  unsigned vo[4];
#pragma unroll
  for (int db = 0; db < 4; ++db) vo[db] = lbase + (4 * g + q_) * 128 + (p_ & 1) * 8 + (((db * 2 + (p_ >> 1)) ^ fv) << 4);
#define PP_TOK(t) ((t) < nlat ? 64 * (t) : NSEQ + 64 * ((t) - nlat))
#define PP_STAGE(t) do { const int tk_ = PP_TOK(t); const int so_ = ((t) & 3) * 16384; stage_rows<64, 8>(lds, so_, kbp + (size_t)tk_ * 64, 64, wl, lane); \
                         stage_rows<64, 8>(lds, so_ + 8192, vbp + (size_t)tk_ * 64, 64, wl, lane); } while (0)
  bf16x8 kf[2][2], pf[NQB];
  u32x2 va[4], vb[4];
  f32x4 s[2][NQB];
#define PP_READK(hh) do { const int so_ = (((hh) >> 1) & 3) * 16384 + ((hh) & 1) * 4096; _Pragma("unroll") for (int h2 = 0; h2 < 2; ++h2) _Pragma("unroll") for (int kk = 0; kk < 2; ++kk) \
                            kf[h2][kk] = lds_frag(lds, so_ + ((h2 * 2048 + koff) ^ (kk << 6))); } while (0)
#define PP_READV(hh) do { const unsigned so_ = (((hh) >> 1) & 3) * 16384; if ((hh) & 1) { _Pragma("unroll") for (int db = 0; db < 4; ++db) { va[db] = tr_read_asm2(vo[db] + so_); vb[db] = tr_read_asm3(vo[db] + so_); } } \
                            else { _Pragma("unroll") for (int db = 0; db < 4; ++db) { va[db] = tr_read_asm0(vo[db] + so_); vb[db] = tr_read_asm1(vo[db] + so_); } } } while (0)
#define PP_SMMA() do { _Pragma("unroll") for (int h2 = 0; h2 < 2; ++h2) _Pragma("unroll") for (int qb = 0; qb < NQB; ++qb) \
                           s[h2][qb] = __builtin_amdgcn_mfma_f32_16x16x32_bf16(kf[h2][0], qf[qb][0], (f32x4){0.f, 0.f, 0.f, 0.f}, 0, 0, 0); \
                         _Pragma("unroll") for (int h2 = 0; h2 < 2; ++h2) _Pragma("unroll") for (int qb = 0; qb < NQB; ++qb) \
                           s[h2][qb] = __builtin_amdgcn_mfma_f32_16x16x32_bf16(kf[h2][1], qf[qb][1], s[h2][qb], 0, 0, 0); } while (0)
#define PP_PV() do { asm volatile("s_waitcnt lgkmcnt(0)" : "+v"(va[0]), "+v"(va[1]), "+v"(va[2]), "+v"(va[3]), "+v"(vb[0]), "+v"(vb[1]), "+v"(vb[2]), "+v"(vb[3]) :: "memory"); \
                       _Pragma("unroll") for (int qb = 0; qb < NQB; ++qb) L[qb] = __builtin_amdgcn_mfma_f32_16x16x32_bf16(ones, pf[qb], L[qb], 0, 0, 0); \
                       _Pragma("unroll") for (int db = 0; db < 4; ++db) { u32x4 vw; vw.x = va[db].x; vw.y = va[db].y; vw.z = vb[db].x; vw.w = vb[db].y; const bf16x8 vf = __builtin_bit_cast(bf16x8, vw); \
                         _Pragma("unroll") for (int qb = 0; qb < NQB; ++qb) O[db][qb] = __builtin_amdgcn_mfma_f32_16x16x32_bf16(vf, pf[qb], O[db][qb], 0, 0, 0); } } while (0)
#define PP_EXP() do { _Pragma("unroll") for (int qb = 0; qb < NQB; ++qb) { u32x4 pw; \
                        pw.x = pk2(__builtin_amdgcn_exp2f(s[0][qb][0]), __builtin_amdgcn_exp2f(s[0][qb][1])); pw.y = pk2(__builtin_amdgcn_exp2f(s[0][qb][2]), __builtin_amdgcn_exp2f(s[0][qb][3])); \
                        pw.z = pk2(__builtin_amdgcn_exp2f(s[1][qb][0]), __builtin_amdgcn_exp2f(s[1][qb][1])); pw.w = pk2(__builtin_amdgcn_exp2f(s[1][qb][2]), __builtin_amdgcn_exp2f(s[1][qb][3])); \
                        pf[qb] = __builtin_bit_cast(bf16x8, pw); } } while (0)
#define PP_BAR() do { PP_SCHED; RAW_BAR(); PP_SCHED; } while (0)
  PP_STAGE(0);
  if (ntiles > 1) PP_STAGE(1);
  if (ntiles > 2) PP_STAGE(2);
  if (ntiles > 2) VMCNT(4); else if (ntiles > 1) VMCNT(2); else VMCNT(0);
  RAW_BAR();
  PP_READK(0);
  if (half) PP_BAR();
  PP_SMMA();
  PP_BAR();
  PP_EXP(); PP_READV(0); PP_READK(1);
  if (ntiles > 2) VMCNT(2); else VMCNT(0);
  PP_BAR();
#pragma unroll 1
  for (int t = 0; t < ntiles; ++t) {
    const int h1 = 2 * t + 1;
    PP_PV(); PP_SMMA();
    PP_BAR();
    __builtin_amdgcn_s_setprio(1); PP_EXP(); PP_READV(h1);
    if (t + 1 < ntiles) PP_READK(h1 + 1);
    if (t + 3 < ntiles) PP_STAGE(t + 3);
    __builtin_amdgcn_s_setprio(0);
    PP_BAR();
    if (t + 1 < ntiles) {
      PP_PV(); PP_SMMA();
      PP_BAR();
      __builtin_amdgcn_s_setprio(1); PP_EXP(); PP_READV(h1 + 1); PP_READK(h1 + 2); __builtin_amdgcn_s_setprio(0);
      if (t + 3 < ntiles) VMCNT(2); else VMCNT(0);
      PP_BAR();
    }
  }
  PP_PV();
  if (!half) PP_BAR();
#undef PP_TOK
#undef PP_STAGE
#pragma unroll
  for (int qb = 0; qb < NQB; ++qb) {
    const float inv = 1.f / L[qb][0];
    float ss = 0.f;
#pragma unroll
    for (int db = 0; db < 4; ++db) { O[db][qb] = O[db][qb] * inv; ss += O[db][qb][0] * O[db][qb][0] + O[db][qb][1] * O[db][qb][1] + O[db][qb][2] * O[db][qb][2] + O[db][qb][3] * O[db][qb][3]; }
    ss += __shfl_xor(ss, 16); ss += __shfl_xor(ss, 32);
    const float r = rsqrtf(ss * (1.f / 64.f) + EPS);
    bf16* yp = Y + (yrow0 + 16 * wl + li) * D + ycol0 + qb * 64;
#pragma unroll
    for (int db = 0; db < 4; ++db) {
      const f32x4 gv = *(const f32x4*)(mixg + ycol0 + qb * 64 + db * 16 + 4 * g);
      const f32x4 y = O[db][qb] * r * gv;
      u32x2 o; o.x = pk2(y[0], y[1]); o.y = pk2(y[2], y[3]);
      *(u32x2*)(yp + db * 16 + 4 * g) = o;
    }
  }
}

__device__ __forceinline__ void phaseB(unsigned char* lds, const Params& P, int l) {
  const bool ctxout = (l == 0);
  const bf16* Z = (const bf16*)(P.ws + WS_Z);
  bf16* Y = (bf16*)P.out;
  const float* mixg = P.mix_g + l * 1024;
  const int tid = get_tid(), lane = tid & 63, w = __builtin_amdgcn_readfirstlane(tid >> 6), grp = w >> 2, wl4 = w & 3, tg = tid & 255, G = gridDim.x;
  { const int n = 256 + (ctxout ? 8 : 0);
#pragma unroll 1
    for (int r = blockIdx.x; r < n; r += G) {
      int b, kvh, qtok0, nlat, ntiles; size_t yrow0;
      if (r < 256) { b = r >> 7; kvh = (r >> 6) & 1; const int qt = r & 63; qtok0 = qt * 128; nlat = 128; ntiles = 132; yrow0 = (size_t)b * NSEQ + qt * 128; }
      else { const int q = r - 256; b = q >> 2; kvh = (q >> 1) & 1; const int qt = q & 1; qtok0 = NSEQ + qt * 128; nlat = 0; ntiles = 4; yrow0 = (size_t)NLAT + b * CL + qt * 128; }
      attn_pp_item<3>(lds, w, lane, Z + (size_t)b * NSLOT * NT_TOK * 64, S_AQ + kvh * 3, S_AK + kvh, S_AV + kvh, qtok0, nlat, ntiles, Y, yrow0, kvh * 192, mixg);
      __syncthreads();
    }
  }
  { const int n = 1024 + (ctxout ? 32 : 0);
    int start = (int)blockIdx.x - 8; if (start < 0) start += G;
#pragma unroll 1
    for (int pr = start; pr * 2 < n; pr += G) {
      const int r = pr * 2 + grp;
      int b, h, qtok0, lat0, nlat, ntiles, drbase; size_t yrow0;
      if (r < 1024) { b = r >> 9; h = (r >> 7) & 3; const int row = r & 127; int rs = row - 4; rs = rs < 0 ? 0 : (rs > 120 ? 120 : rs);
        qtok0 = row * 64; lat0 = rs * 64; nlat = 8; ntiles = 12; drbase = rs - row + 7; yrow0 = (size_t)b * NSEQ + row * 64; }
      else { const int q = r - 1024; b = q >> 4; h = (q >> 2) & 3; const int qt = q & 3; qtok0 = NSEQ + qt * 64; lat0 = 0; nlat = 0; ntiles = 4; drbase = 0; yrow0 = (size_t)NLAT + b * CL + qt * 64; }
      float* rp = (float*)(lds + grp * 65536 + 49152);
      const float* src = P.rpb + ((size_t)l * 4 + h) * 465;
      for (int e = tg; e < 465; e += 256) rp[e] = src[e] * LOG2E;
      __syncthreads();
      attn_item<1, true, 4>(lds, grp * 65536, wl4, lane, Z + (size_t)b * NSLOT * NT_TOK * 64, S_NQ + h, S_NK + h, S_NV + h, qtok0, lat0, nlat, ntiles, drbase, Y, yrow0, 384 + h * 64, mixg);
    }
  }
  { int start = (int)blockIdx.x - 40; if (start < 0) start += G;
#pragma unroll 1
    for (int pr = start; pr * 2 < 2 * 6 * 66; pr += G) {
      const int r = pr * 2 + grp;
      const int b = r / 396, q = r % 396, h = q / 66, c = q % 66;
      const float lgf2 = log_sigmoid_f(P.ret_decay[(l * 2 + 0) * 6 + h]) * LOG2E, lgb2 = log_sigmoid_f(P.ret_decay[(l * 2 + 1) * 6 + h]) * LOG2E;
      float* U = (float*)(P.ws + WS_U);
      ret_u_item(lds, grp * 65536, tg, Z + (size_t)b * NSLOT * NT_TOK * 64, h, c, lgf2, lgb2, U + ((size_t)((b * 6 + h) * 2 + 0) * 66 + c) * 4096, U + ((size_t)((b * 6 + h) * 2 + 1) * 66 + c) * 4096);
    }
  }
}

__device__ __forceinline__ void phaseB2(unsigned char* lds, const Params& P, int l) {
  { const int qt = (int)blockIdx.x - 192;
    if (qt >= 0 && qt < 48) {
      const bf16* XB = (const bf16*)(P.ws + WS_R1);
      const bf16* Wt = (const bf16*)(P.ws + WS_WIN) + (size_t)l * INC * 1024;
      EpiInProj<2, 4> E24{(const float*)(P.ws + WS_RSS), (const float*)(P.ws + WS_BIAS) + l * 3 * INC, P.qg + l * 64, P.kg + l * 64, (const float*)(lds + LDS_MISC), (bf16*)(P.ws + WS_Z)};
      const int r0 = (42 + (qt >> 1)) * 256 + (qt & 1) * 128;
      ARowLinear ar{XB, 1024, r0};
      gemm_tile3<2, 4, 2>(lds, ar, Wt, 1024, r0, 2816, E24);
    }
  }
  const float* U = (const float*)(P.ws + WS_U);
#pragma unroll 1
  for (int it = blockIdx.x; it < 192; it += gridDim.x) {
    const int seq = it >> 3, off = (it & 7) * 512 + get_tid();
    const int dir = seq & 1, h = (seq >> 1) % 6;
    const float lg = log_sigmoid_f(P.ret_decay[(l * 2 + dir) * 6 + h]);
    const float decay = expf(128.f * lg);
    const float* base = U + (size_t)seq * 66 * 4096 + off;
    float* sbase = (float*)((unsigned char*)P.out + S_OFF) + (size_t)seq * 66 * 4096 + off;
    float u[66];
    if (dir == 0) {
#pragma unroll
      for (int st = 0; st < 66; ++st) u[st] = __builtin_nontemporal_load(base + (size_t)st * 4096);
      float s = 0.f;
#pragma unroll
      for (int st = 0; st < 66; ++st) { sbase[(size_t)st * 4096] = s; s = s * decay + u[st]; }
    } else {
#pragma unroll
      for (int st = 0; st < 66; ++st) { const int c = st < 2 ? 1 - st : 67 - st; u[st] = __builtin_nontemporal_load(base + (size_t)c * 4096); }
      float s = 0.f;
#pragma unroll
      for (int st = 0; st < 66; ++st) { const int c = st < 2 ? 1 - st : 67 - st; sbase[(size_t)c * 4096] = s; s = s * decay + u[st]; }
    }
  }
}

__device__ __forceinline__ void phaseB3(unsigned char* lds, const Params& P, int l) {
  const bf16* Z = (const bf16*)(P.ws + WS_Z);
  bf16* Y = (bf16*)P.out;
  const float* mixg = P.mix_g + l * 1024;
  const float* U = (const float*)((const unsigned char*)P.out + S_OFF);
  const int tid = get_tid(), grp = __builtin_amdgcn_readfirstlane(tid >> 8), tg = tid & 255;
  const int cpb = (l == 0) ? 66 : 64, total = 2 * 6 * cpb;
#pragma unroll 1
  for (int pr = blockIdx.x; pr * 2 < total; pr += gridDim.x) {
    const int it = pr * 2 + grp;
    const int b = it / (6 * cpb), q = it % (6 * cpb), h = q / cpb, c = (q % cpb) + (66 - cpb);
    const float lgf2 = log_sigmoid_f(P.ret_decay[(l * 2 + 0) * 6 + h]) * LOG2E, lgb2 = log_sigmoid_f(P.ret_decay[(l * 2 + 1) * 6 + h]) * LOG2E;
    const size_t yrow0 = c < 2 ? (size_t)NLAT + b * CL + 128 * c : (size_t)b * NSEQ + 128 * (c - 2);
    ret_out_item(lds, grp * 65536, tg, Z + (size_t)b * NSLOT * NT_TOK * 64, h, c, lgf2, lgb2, U + ((size_t)((b * 6 + h) * 2 + 0) * 66 + c) * 4096, U + ((size_t)((b * 6 + h) * 2 + 1) * 66 + c) * 4096, Y, yrow0, mixg);
  }
}

__device__ __forceinline__ void pc_small_item(const Params& P, int l, int item) {
  const int tid = get_tid(), lane = tid & 63, w = tid >> 6, g = lane >> 4, li = lane & 15;
  const bf16* Y = (const bf16*)P.out;
  const bf16* Wt = (const bf16*)(P.ws + WS_WO) + (size_t)l * 1024 * 1024;
  float* XR = (float*)(P.ws + WS_XR);
  const int mb = item >> 5, nb = item & 31;
  const int m0 = NLAT + mb * 64 + (w >> 1) * 16, n0 = nb * 32 + (w & 1) * 16;
  const bf16* ar = Y + (size_t)(m0 + li) * D + g * 8;
  const bf16* br = Wt + (size_t)(n0 + li) * D + g * 8;
  f32x4 acc = {0.f, 0.f, 0.f, 0.f};
#pragma unroll 1
  for (int kb = 0; kb < 32; kb += 8) {
    bf16x8 af[8], bf[8];
#pragma unroll
    for (int c = 0; c < 8; ++c) { af[c] = *(const bf16x8*)(ar + (kb + c) * 32); bf[c] = *(const bf16x8*)(br + (kb + c) * 32); }
#pragma unroll
    for (int c = 0; c < 8; ++c) acc = __builtin_amdgcn_mfma_f32_16x16x32_bf16(bf[c], af[c], acc, 0, 0, 0);
  }
  const int m = m0 + li, n = n0 + 4 * g;
  const float* gt = (const float*)(P.ws + WS_MOD) + (l * 3 + 2) * 6144 + 2048;
  const f32x4 xv = *(const f32x4*)(P.ctx + (size_t)(m - NLAT) * D + n), gv = *(const f32x4*)(gt + n);
  *(f32x4*)(XR + (size_t)m * D + n) = xv + gv * acc;
}
__device__ __forceinline__ void phaseC(unsigned char* lds, const Params& P, int l) {
  const bf16* Y = (const bf16*)P.out;
  const bf16* Wt = (const bf16*)(P.ws + WS_WO) + (size_t)l * 1024 * 1024;
  float* XR = (float*)(P.ws + WS_XR);
  EpiOutProj E{l == 0 ? P.x : XR, l == 0 ? P.ctx : XR + (size_t)NLAT * D, (const float*)(P.ws + WS_MOD) + l * 3 * 6144, XR};
  const int nitem = NLAT / 256 * 4;
  { const int c0 = xcd_vidx(0), G = gridDim.x;
    SrcC8 S{Y, Wt, &E, c0, G, c0 < nitem ? (nitem - c0 + G - 1) / G : 0};
    gemm8_stream(lds, S); }
  if (l == 0) {
#pragma unroll 1
    for (int it = blockIdx.x; it < 256; it += gridDim.x) pc_small_item(P, l, it);
  }
}

__device__ __forceinline__ void phaseD(unsigned char* lds, const Params& P, int l) {
  const int tid = get_tid(), lane = tid & 63, w = tid >> 6, g = lane >> 4, li = lane & 15;
  const float* XR = (const float*)(P.ws + WS_XR);
  bf16* H2 = (bf16*)(P.ws + WS_R1);
  int* cnt = (int*)(P.ws + WS_CNT) + l * 16;
  int* list = (int*)(P.ws + WS_LIST) + (size_t)l * 16 * NROWS;
  float* gatew = (float*)(P.ws + WS_GATEW);
  float* part = (float*)lds;
  float* ssqp = part + 2048;
  float* rsl = ssqp + 128;
  int* hist = (int*)(rsl + 64);
  const int nitems = NLAT / 64 + (l == 0 ? 32 : 0);
  const int rgp = w >> 1, kh = w & 1;
#pragma unroll 1
  for (int it = blockIdx.x; it < nitems; it += gridDim.x) {
    const int nrows = it < NLAT / 64 ? 64 : 16;
    const int r0 = it < NLAT / 64 ? it * 64 : NLAT + (it - NLAT / 64) * 16, seg = r0 < NSEQ ? 0 : (r0 < NLAT ? 1 : 2);
    const bool active = rgp * 16 < nrows;
    const float* wr = (const float*)(P.ws + WS_WR) + (size_t)(l * 3 + seg) * 16384;
    const float* xrow = XR + (size_t)(r0 + (active ? rgp * 16 : 0) + li) * D + 512 * kh + 4 * g;
    const float* wp0 = wr + (size_t)(512 * kh + 4 * g) * 16 + li;
    if (tid < 32) hist[tid] = 0;
    f32x4 acc = {0.f, 0.f, 0.f, 0.f}; float ssq = 0.f;
#pragma unroll 1
    for (int cb = 0; cb < (active ? 32 : 0); cb += 8) {
      f32x4 xv[8]; float bw[8][4];
#pragma unroll
      for (int c = 0; c < 8; ++c) {
        xv[c] = *(const f32x4*)(xrow + 16 * (cb + c));
        const float* wp = wp0 + (cb + c) * 256;
        bw[c][0] = wp[0]; bw[c][1] = wp[16]; bw[c][2] = wp[32]; bw[c][3] = wp[48];
      }
#pragma unroll
      for (int c = 0; c < 8; ++c) {
        ssq += xv[c][0] * xv[c][0] + xv[c][1] * xv[c][1] + xv[c][2] * xv[c][2] + xv[c][3] * xv[c][3];
        acc = __builtin_amdgcn_mfma_f32_16x16x4f32(xv[c][0], bw[c][0], acc, 0, 0, 0);
        acc = __builtin_amdgcn_mfma_f32_16x16x4f32(xv[c][1], bw[c][1], acc, 0, 0, 0);
        acc = __builtin_amdgcn_mfma_f32_16x16x4f32(xv[c][2], bw[c][2], acc, 0, 0, 0);
        acc = __builtin_amdgcn_mfma_f32_16x16x4f32(xv[c][3], bw[c][3], acc, 0, 0, 0);
      }
    }
    ssq += __shfl_xor(ssq, 16); ssq += __shfl_xor(ssq, 32);
#pragma unroll
    for (int j = 0; j < 4; ++j) part[(w * 16 + 4 * g + j) * 16 + li] = acc[j];
    if (g == 0) ssqp[w * 16 + li] = ssq;
    __syncthreads();
    int e1 = 0, e2 = 0, q1 = 0, q2 = 0; float g1 = 0.f, g2 = 0.f;
    if (tid < nrows) {
      const int rg2 = tid >> 4, rr = tid & 15;
      const float ss = ssqp[(2 * rg2) * 16 + rr] + ssqp[(2 * rg2 + 1) * 16 + rr];
      const float rs = rsqrtf(ss * (1.f / 1024.f) + EPS);
      rsl[tid] = rs;
      const float* cr = (const float*)(P.ws + WS_CR) + (l * 3 + seg) * 16;
      float lg[16]; float mx = -1e30f;
#pragma unroll
      for (int e = 0; e < 16; ++e) { lg[e] = rs * (part[((2 * rg2) * 16 + rr) * 16 + e] + part[((2 * rg2 + 1) * 16 + rr) * 16 + e]) + cr[e]; mx = fmaxf(mx, lg[e]); }
#pragma unroll
      for (int e = 0; e < 16; ++e) lg[e] = expf(lg[e] - mx);
      float best = -1.f; int bg = 0; float b0 = 0.f, b1 = 0.f, b2 = 0.f, b3 = 0.f;
#pragma unroll
      for (int gi = 0; gi < 4; ++gi) {
        const float a0 = lg[4 * gi], a1 = lg[4 * gi + 1], a2 = lg[4 * gi + 2], a3 = lg[4 * gi + 3];
        const float sc = fmaxf(fmaxf(fmaxf(a0 + a1, a0 + a2), fmaxf(a0 + a3, a1 + a2)), fmaxf(a1 + a3, a2 + a3));
        if (sc > best) { best = sc; bg = gi; b0 = a0; b1 = a1; b2 = a2; b3 = a3; }
      }
      int i1 = 0; float v1 = b0;
      if (b1 > v1) { v1 = b1; i1 = 1; } if (b2 > v1) { v1 = b2; i1 = 2; } if (b3 > v1) { v1 = b3; i1 = 3; }
      int i2 = -1; float v2 = -1.f;
      if (i1 != 0 && b0 > v2) { v2 = b0; i2 = 0; } if (i1 != 1 && b1 > v2) { v2 = b1; i2 = 1; } if (i1 != 2 && b2 > v2) { v2 = b2; i2 = 2; } if (i1 != 3 && b3 > v2) { v2 = b3; i2 = 3; }
      const float inv = 1.f / (v1 + v2);
      e1 = bg * 4 + i1; e2 = bg * 4 + i2; g1 = v1 * inv; g2 = v2 * inv;
      q1 = atomicAdd(&hist[e1], 1); q2 = atomicAdd(&hist[e2], 1);
    }
    __syncthreads();
    if (tid < 16) hist[16 + tid] = atomicAdd(&cnt[tid], hist[tid]);
    __syncthreads();
    if (tid < nrows) {
      const int row = r0 + tid;
      list[(size_t)e1 * NROWS + hist[16 + e1] + q1] = row * 2; gatew[row * 2] = g1;
      list[(size_t)e2 * NROWS + hist[16 + e2] + q2] = row * 2 + 1; gatew[row * 2 + 1] = g2;
    }
    {
      const float* m = (const float*)(P.ws + WS_MOD) + (l * 3 + seg) * 6144;
      f32x4 gs[4], sh[4];
#pragma unroll
      for (int j = 0; j < 4; ++j) { const int k = 4 * lane + 256 * j; gs[j] = *(const f32x4*)(P.n2g + l * 1024 + k) * (*(const f32x4*)(m + 4096 + k) + 1.f); sh[j] = *(const f32x4*)(m + 3072 + k); }
      const int rpw = nrows >> 3;
#pragma unroll 1
      for (int q = 0; q < rpw; q += 4) {
        f32x4 xx[4][4];
#pragma unroll
        for (int u = 0; u < 4; ++u)
#pragma unroll
          for (int j = 0; j < 4; ++j) { const int rr = w * rpw + (q + u < rpw ? q + u : 0); xx[u][j] = *(const f32x4*)(XR + (size_t)(r0 + rr) * D + 4 * lane + 256 * j); }
#pragma unroll
        for (int u = 0; u < 4; ++u) {
          if (q + u < rpw) {
            const int rr = w * rpw + q + u; const float rs = rsl[rr]; bf16* hp = H2 + (size_t)(r0 + rr) * D;
#pragma unroll
            for (int j = 0; j < 4; ++j) { const f32x4 o = xx[u][j] * rs * gs[j] + sh[j]; u32x2 ov; ov.x = pk2(o[0], o[1]); ov.y = pk2(o[2], o[3]); *(u32x2*)(hp + 4 * lane + 256 * j) = ov; }
          }
        }
      }
    }
    __syncthreads();
  }
}

__device__ __forceinline__ void phaseEF(unsigned char* lds, const Params& P, int l, bool down) {
  const int* cnt = (const int*)(P.ws + WS_CNT) + l * 16;
  const int* list = (const int*)(P.ws + WS_LIST) + (size_t)l * 16 * NROWS;
  bf16* act = (bf16*)(P.ws + WS_Z + Z_ACT);
  MoeU* desc = (MoeU*)(lds + LDS_MISC);
  int* dn = (int*)(lds + LDS_MISC + 1024);
  const int c0 = xcd_vidx(0), G = gridDim.x;
  { const int j = get_tid();
    if (j < 8) {
      int NF = 0, NH = 0;
#pragma unroll 1
      for (int e = 0; e < 16; ++e) { const int c = cnt[e], rem = c & 255; NF += ((c >> 8) + (rem > 128 ? 1 : 0)) * 4; NH += (rem >= 1 && rem <= 128) ? 4 : 0; }
      const int NFA = NF < 2 * G ? NF : 2 * G;
      MoeU t{0, 0, 0, 0, 0}; int kind = 0;
      int v = -1, half = 0;
      if (j < 2) { v = j * G + c0; if (v >= NFA) v = -1; }
      else { const int ub = (j - 2) * G + c0, nsplit = 2 * (NF - NFA);
        if (ub < nsplit) { v = NFA + (ub >> 1); half = ub & 1; kind = 2; } else if (ub < nsplit + NH) { v = NF + (ub - nsplit); kind = 3; } }
      if (v >= 0 && v < NF) {
        int base = 0, sb = 0;
#pragma unroll 1
        for (int e = 0; e < 16; ++e) { const int c = cnt[e], rem = c & 255, fu = ((c >> 8) + (rem > 128 ? 1 : 0)) * 4; if (v < base + fu) { const int k = v - base, mt = k >> 2; int nv = c - mt * 256; nv = nv < 256 ? nv : 256;
            if (kind == 0) { t = MoeU{e, mt * 256, nv, k & 3, sb + mt * 256}; kind = 1; }
            else { int nh2 = nv - 128 * half; nh2 = nh2 < 128 ? nh2 : 128; if (nh2 > 0) t = MoeU{e, mt * 256 + 128 * half, nh2, k & 3, sb + mt * 256 + 128 * half}; else kind = 0; }
            break; } base += fu; sb += c; }
      } else if (kind == 3) {
        const int vh = v - NF; int base = 0, sb = 0; kind = 0;
#pragma unroll 1
        for (int e = 0; e < 16; ++e) { const int c = cnt[e], rem = c & 255, hv = (rem >= 1 && rem <= 128) ? 4 : 0; if (vh < base + hv) { const int k = vh - base, r0 = (c >> 8) * 256;
            t = MoeU{e, r0, rem, k & 3, sb + r0}; kind = 2; break; } base += hv; sb += c; }
      }
      if (kind == 3) kind = 0;
      desc[j] = t; dn[j] = kind;
    }
    __syncthreads(); }
  const int nf = (dn[0] == 1 ? 1 : 0) + (dn[1] == 1 ? 1 : 0);
  if (!down) {
    SrcUp8 S{desc, (const bf16*)(P.ws + WS_R1), list, (const bf16*)(P.ws + WS_W13) + (size_t)(l * 16) * 1024 * 1024, act, nf};
    gemm8_stream<SrcUp8, true>(lds, S);
  } else {
    SrcDown8 S{desc, act, list, (const bf16*)(P.ws + WS_W2) + (size_t)(l * 16) * 1024 * 512, (const float*)(P.ws + WS_GATEW), (bf16*)(P.ws + WS_R1), (bf16*)(P.ws + WS_Z + Z_YM1), nf};
    gemm8_stream<SrcDown8, false>(lds, S);
  }
#pragma unroll 1
  for (int j = 2; j < 8; ++j) {
    if (dn[j] != 2) continue;
    const MoeU t = desc[j];
    const int* lst = list + (size_t)t.e * NROWS + t.row0;
    if (!down) {
      ARowGather ar{(const bf16*)(P.ws + WS_R1), lst, t.nvalid};
      EpiMoeUp E{act, t.slot0, t.nvalid};
      gemm_tile<4, 4>(lds, ar, (const bf16*)(P.ws + WS_W13) + (size_t)(l * 16 + t.e) * 1024 * 1024, 1024, 0, t.nt * 256, E);
    } else {
      ARowAct ar{act, t.slot0};
      EpiMoeDown E{lst, (const float*)(P.ws + WS_GATEW), (bf16*)(P.ws + WS_R1), (bf16*)(P.ws + WS_Z + Z_YM1), t.nvalid};
      gemm_tile<4, 4>(lds, ar, (const bf16*)(P.ws + WS_W2) + (size_t)(l * 16 + t.e) * 1024 * 512, 512, 0, t.nt * 256, E);
    }
  }
  __syncthreads();
}

__device__ __forceinline__ void phaseG(const Params& P, int l) {
  const int tid = get_tid(), lane = tid & 63, w = tid >> 6;
  float* XR = (float*)(P.ws + WS_XR);
  const bf16* Y0 = (const bf16*)(P.ws + WS_R1); const bf16* Y1 = (const bf16*)(P.ws + WS_Z + Z_YM1);
  const float* mod = (const float*)(P.ws + WS_MOD);
  const int nrows = l == 0 ? NROWS : NLAT;
#pragma unroll 1
  for (int it = blockIdx.x; it < nrows / 16; it += gridDim.x) {
    const int row0 = it * 16 + 2 * w, seg = row0 < NSEQ ? 0 : (row0 < NLAT ? 1 : 2);
    const float* gt2 = mod + (l * 3 + seg) * 6144 + 5120;
    f32x4 x1[2][4]; u32x2 ya[2][4], yb[2][4];
#pragma unroll
    for (int u = 0; u < 2; ++u)
#pragma unroll
      for (int j = 0; j < 4; ++j) { const size_t o = (size_t)(row0 + u) * D + 4 * lane + 256 * j; x1[u][j] = __builtin_nontemporal_load((const f32x4*)(XR + o)); ya[u][j] = __builtin_nontemporal_load((const u32x2*)(Y0 + o)); yb[u][j] = __builtin_nontemporal_load((const u32x2*)(Y1 + o)); }
    f32x4 gv[4];
#pragma unroll
    for (int j = 0; j < 4; ++j) gv[j] = *(const f32x4*)(gt2 + 4 * lane + 256 * j);
#pragma unroll
    for (int u = 0; u < 2; ++u) {
      const int row = row0 + u;
      f32x4 xv[4]; float ss = 0.f;
#pragma unroll
      for (int j = 0; j < 4; ++j) {
        const u32x2 a = ya[u][j], b = yb[u][j];
        f32x4 m; m[0] = bflo(a.x) + bflo(b.x); m[1] = bfhi(a.x) + bfhi(b.x); m[2] = bflo(a.y) + bflo(b.y); m[3] = bfhi(a.y) + bfhi(b.y);
        xv[j] = x1[u][j] + gv[j] * m;
        ss += xv[j][0] * xv[j][0] + xv[j][1] * xv[j][1] + xv[j][2] * xv[j][2] + xv[j][3] * xv[j][3];
      }
      ss = wsum(ss);
      if (l == 0) {
        const float* sc1 = mod + (1 * 3 + seg) * 6144 + 1024;
        bf16* xb = (bf16*)(P.ws + WS_R1) + (size_t)row * D;
        if (lane == 0) ((float*)(P.ws + WS_RSS))[row] = ss;
#pragma unroll
        for (int j = 0; j < 4; ++j) {
          const int k = 4 * lane + 256 * j;
          *(f32x4*)(XR + (size_t)row * D + k) = xv[j];
          const f32x4 gg = *(const f32x4*)(P.n1g + 1024 + k), sc = *(const f32x4*)(sc1 + k);
          const f32x4 o = xv[j] * gg * (sc + 1.f);
          u32x2 ov; ov.x = pk2(o[0], o[1]); ov.y = pk2(o[2], o[3]); *(u32x2*)(xb + k) = ov;
        }
      } else {
        const float rs = rsqrtf(ss * (1.f / 1024.f) + EPS);
#pragma unroll
        for (int j = 0; j < 4; ++j) {
          const int k = 4 * lane + 256 * j;
          const f32x4 gg = *(const f32x4*)(P.final_g + k);
          __builtin_nontemporal_store(xv[j] * rs * gg, (f32x4*)(P.out + (size_t)row * D + k));
        }
      }
    }
  }
}

#define XB_TMO      128
#define XB_XCNT(j)  (256  + 64 * (j))
#define XB_XSUB(j)  (1280 + 64 * (j))
#define XB_XGEN(j)  (2304 + 64 * (j))
#define XB_TOP      3328
#define XB_TOPGEN   3392
#define XB_SPIN_CAP (1u << 20)
__device__ __forceinline__ unsigned xb_ld(unsigned* p)              { return __hip_atomic_load(p, __ATOMIC_RELAXED, __HIP_MEMORY_SCOPE_AGENT); }
__device__ __forceinline__ unsigned xb_add(unsigned* p, unsigned v) { return __hip_atomic_fetch_add(p, v, __ATOMIC_RELAXED, __HIP_MEMORY_SCOPE_AGENT); }
__device__ __forceinline__ unsigned xb_xcc_id() { return (unsigned)__builtin_amdgcn_s_getreg((3 << 11) | 20) & 0xFu; }
#define XB_SPIN(cond, bar) do { unsigned _sp = 0; while (cond) { __builtin_amdgcn_s_sleep(1); \
    if ((++_sp & 255u) == 0u) { if (xb_ld(&(bar)[XB_TMO])) break; if (_sp > XB_SPIN_CAP) { atomicAdd(&(bar)[XB_TMO], 1u); break; } } } } while (0)
struct XBar { unsigned* bar; unsigned* st; };
__device__ __forceinline__ void xbar_init(XBar& b, unsigned* bar, unsigned* st) {
  b.bar = bar; b.st = st;
  if (threadIdx.x == 0) { st[0] = 0u; st[1] = 0u; (void)xb_add(&bar[XB_XCNT(xb_xcc_id())], 1u); }
}
__device__ __forceinline__ void xbar_sync(XBar& b) {
  asm volatile("s_waitcnt vmcnt(0)" ::: "memory");
  __syncthreads();
  if (threadIdx.x == 0) {
    unsigned* bar = b.bar;
    const unsigned x = xb_xcc_id();
    __builtin_amdgcn_s_waitcnt(0);
    unsigned nloc = b.st[0], nx = b.st[1];
    if (nloc == 0u) {
      const unsigned G = gridDim.x; unsigned sum, cnt, mine, sp = 0u;
      for (;;) {
        sum = 0u; cnt = 0u; mine = 0u;
#pragma unroll
        for (unsigned j = 0; j < 16; ++j) { const unsigned c = xb_ld(&bar[XB_XCNT(j)]); sum += c; cnt += (c > 0u) ? 1u : 0u; mine = (j == x) ? c : mine; }
        if (sum == G) break;
        __builtin_amdgcn_s_sleep(1);
        if ((++sp & 255u) == 0u) { if (xb_ld(&bar[XB_TMO])) break; if (sp > XB_SPIN_CAP) { atomicAdd(&bar[XB_TMO], 1u); break; } }
      }
      nloc = mine > 0u ? mine : 1u; nx = cnt > 0u ? cnt : 1u;
      b.st[0] = nloc; b.st[1] = nx;
    }
    const unsigned old = xb_add(&bar[XB_XSUB(x)], 1u);
    const unsigned gen = old / nloc;
    if (old + 1u == (gen + 1u) * nloc) {
      __builtin_amdgcn_fence(__ATOMIC_RELEASE, "agent");
      asm volatile("s_waitcnt vmcnt(0)" ::: "memory");
      const unsigned og = xb_add(&bar[XB_TOP], 1u);
      const unsigned tg = og / nx;
      if (og + 1u == (tg + 1u) * nx) xb_add(&bar[XB_TOPGEN], 1u);
      else XB_SPIN(xb_ld(&bar[XB_TOPGEN]) == tg, bar);
      __builtin_amdgcn_fence(__ATOMIC_ACQUIRE, "agent");
      xb_add(&bar[XB_XGEN(x)], 1u);
      asm volatile("s_waitcnt vmcnt(0)" ::: "memory");
    } else {
      XB_SPIN(xb_ld(&bar[XB_XGEN(x)]) == gen, bar);
      __builtin_amdgcn_fence(__ATOMIC_ACQUIRE, "agent");
      asm volatile("s_waitcnt vmcnt(0)" ::: "memory");
    }
  }
  __syncthreads();
}

__global__ void __launch_bounds__(NTHR, 2) fwd_mega(Params P) {
  extern __shared__ __attribute__((aligned(16))) unsigned char lds[];
  cg::grid_group grid = cg::this_grid();
  XBar xb; xbar_init(xb, (unsigned*)(P.ws + WS_BAR), (unsigned*)(lds + LDS_BARW));
#define GSYNC() xbar_sync(xb)
  phase0(lds, P);
  VM_WAIT(); __syncthreads(); grid.sync();
  phase1(lds, P); GSYNC();
#pragma unroll 1
  for (int l = 0; l < 2; ++l) {
    phaseA(lds, P, l); GSYNC();
    phaseB(lds, P, l); GSYNC();
    phaseB2(lds, P, l); GSYNC();
    phaseB3(lds, P, l); GSYNC();
    phaseC(lds, P, l); GSYNC();
    phaseD(lds, P, l); GSYNC();
    phaseEF(lds, P, l, false); GSYNC();
    phaseEF(lds, P, l, true); GSYNC();
    phaseG(P, l);
    if (l == 0) GSYNC();
  }
#undef GSYNC
}

extern "C" void kernel_launch(void* const* d_in, const int* in_sizes, int n_in, void* d_out, int out_size, void* d_ws, size_t ws_size, hipStream_t stream) {
  static int grid_blocks = 0;
  if (!grid_blocks) {
    int dev = 0, cus = 0, per_cu = 0;
    (void)hipGetDevice(&dev);
    (void)hipDeviceGetAttribute(&cus, hipDeviceAttributeMultiprocessorCount, dev);
    (void)hipFuncSetAttribute((const void*)fwd_mega, hipFuncAttributeMaxDynamicSharedMemorySize, LDS_BYTES);
    (void)hipOccupancyMaxActiveBlocksPerMultiprocessor(&per_cu, fwd_mega, NTHR, LDS_BYTES);
    if (per_cu > 1) per_cu = 1;
    if (per_cu < 1) per_cu = 1;
    grid_blocks = cus * per_cu;
    if (ws_size < WS_END) fprintf(stderr, "kernel_launch: workspace too small: %zu < %zu\n", ws_size, (size_t)WS_END);
  }
  (void)hipMemsetAsync(d_ws, 0, WS_ZERO_BYTES, stream);
  Params p{};
  const float** pp = (const float**)&p;
  for (int i = 0; i < 21; ++i) pp[i] = (const float*)d_in[i];
  p.out = (float*)d_out; p.ws = (unsigned char*)d_ws;
  void* args[] = {&p};
  hipError_t e = hipLaunchCooperativeKernel((void*)fwd_mega, dim3(grid_blocks), dim3(NTHR), args, LDS_BYTES, stream);
  if (e != hipSuccess) fprintf(stderr, "cooperative launch failed: %s (grid %d)\n", hipGetErrorString(e), grid_blocks);
}
```
